# Optimizing an MI355X kernel written in HIP

```python
import math
import jax
import jax.numpy as jnp
from jax import lax
import numpy as np

D_MODEL = 4096
BATCH = 2
SEQ = 8192
DEPTH = 2

CHUNK = 64
HEAD_DIM = 128
FOX_HEADS = 12
FOX_WIDTH = FOX_HEADS * HEAD_DIM
Q_BLOCK = 128
SC_GROUPS = 8
SC_WIDTH = SC_GROUPS * HEAD_DIM
SC_KERNEL = 3
GDN_HEADS = 12
GDN_WIDTH = GDN_HEADS * HEAD_DIM
GDN_CONV = 4
MIX_WIDTH = FOX_WIDTH + SC_WIDTH + GDN_WIDTH
PROJ_DIM = 3 * FOX_WIDTH + FOX_HEADS + 3 * SC_WIDTH + 4 * GDN_WIDTH + 2 * GDN_HEADS
FFN_HIDDEN = -(-8 * D_MODEL // 768) * 256
RMS_EPS = 1e-6

kernel_name = "hybrid_fox_shortconv_gdn_sandwich"


def _proj_split_points():
    sizes = (FOX_WIDTH, FOX_WIDTH, FOX_WIDTH, FOX_HEADS,
             SC_WIDTH, SC_WIDTH, SC_WIDTH,
             GDN_WIDTH, GDN_WIDTH, GDN_WIDTH, GDN_HEADS, GDN_HEADS, GDN_WIDTH)
    pts, acc = [], 0
    for s in sizes[:-1]:
        acc += s
        pts.append(acc)
    return pts


def rms_norm(x, gain):
    xf = x.astype(jnp.float32)
    y = xf * lax.rsqrt(jnp.mean(xf * xf, axis=-1, keepdims=True) + RMS_EPS)
    return (y * gain.astype(jnp.float32)).astype(x.dtype)


def l2_normalize(t):
    return t * lax.rsqrt(jnp.sum(t * t, axis=-1, keepdims=True) + RMS_EPS)


def causal_depthwise_conv(x, w):
    K = w.shape[0]
    S = x.shape[1]
    xp = jnp.pad(x, ((0, 0), (K - 1, 0), (0, 0)))
    y = w[0] * xp[:, 0:S]
    for j in range(1, K):
        y = y + w[j] * xp[:, j:j + S]
    return y


def forgetting_attention(q, k, v, f_logit, b_f, out_gain):
    B_, S, H, D = q.shape
    log_f = jax.nn.log_sigmoid(f_logit.astype(jnp.float32) + b_f.astype(jnp.float32))
    F = jnp.cumsum(log_f, axis=1).transpose(0, 2, 1)
    kh = k.transpose(0, 2, 1, 3)
    vh = v.transpose(0, 2, 1, 3)
    n_blocks = S // Q_BLOCK
    qb = q.transpose(0, 2, 1, 3).reshape(B_, H, n_blocks, Q_BLOCK, D).transpose(2, 0, 1, 3, 4)
    Fq = F.reshape(B_, H, n_blocks, Q_BLOCK).transpose(2, 0, 1, 3)
    scale = D ** -0.5
    k_pos = jnp.arange(S)

    def block(args):
        i, q_blk, F_blk = args
        s = jnp.einsum('bhqd,bhkd->bhqk', q_blk, kh).astype(jnp.float32) * scale
        s = s + F_blk[..., :, None] - F[:, :, None, :]
        q_pos = i * Q_BLOCK + jnp.arange(Q_BLOCK)
        s = jnp.where(k_pos[None, :] <= q_pos[:, None], s, -jnp.inf)
        p = jax.nn.softmax(s, axis=-1)
        return jnp.einsum('bhqk,bhkd->bhqd', p.astype(vh.dtype), vh)

    out = lax.map(block, (jnp.arange(n_blocks), qb, Fq))
    out = out.transpose(1, 0, 3, 2, 4).reshape(B_, S, H, D)
    out = rms_norm(out, out_gain)
    return out.reshape(B_, S, H * D)


def short_conv_mixer(b_gate, c_gate, h, conv_w):
    return b_gate * causal_depthwise_conv(c_gate * h, conv_w)


def gated_deltanet(q, k, v, a, b, z, conv_w, a_log, dt_bias, out_gain):
    f32 = jnp.float32
    qkv = jax.nn.silu(causal_depthwise_conv(jnp.concatenate([q, k, v], axis=-1), conv_w))
    q, k, v = jnp.split(qkv, 3, axis=-1)
    B_, S, _ = q.shape
    H, D = GDN_HEADS, HEAD_DIM
    N = S // CHUNK

    def heads(t):
        return t.reshape(B_, N, CHUNK, H, D).transpose(0, 3, 1, 2, 4).astype(f32)

    def per_head(t):
        return t.reshape(B_, N, CHUNK, H).transpose(0, 3, 1, 2)

    q = l2_normalize(heads(q)) * (D ** -0.5)
    k = l2_normalize(heads(k))
    v = heads(v)
    beta = per_head(jax.nn.sigmoid(b.astype(f32)))
    g = -jnp.exp(a_log.astype(f32)) * jax.nn.softplus(a.astype(f32) + dt_bias.astype(f32))
    g = jnp.cumsum(per_head(g), axis=-1)

    tri_incl = jnp.tril(jnp.ones((CHUNK, CHUNK), dtype=bool))
    tri_strict = jnp.tril(jnp.ones((CHUNK, CHUNK), dtype=bool), -1)
    decay = jnp.exp(jnp.where(tri_incl, g[..., :, None] - g[..., None, :], -jnp.inf))

    kk = jnp.einsum('bhncd,bhnsd->bhncs', k, k)
    L = jnp.where(tri_strict, beta[..., :, None] * kk * decay, 0.0)
    A = L + jnp.eye(CHUNK, dtype=f32)
    rhs = jnp.concatenate([v * beta[..., None], k * (beta * jnp.exp(g))[..., None]], axis=-1)
    sol = lax.linalg.triangular_solve(A, rhs, left_side=True, lower=True, unit_diagonal=True)
    u, w = jnp.split(sol, 2, axis=-1)

    attn_intra = jnp.where(tri_incl, jnp.einsum('bhncd,bhnsd->bhncs', q, k) * decay, 0.0)
    q_dec = q * jnp.exp(g)[..., None]
    k_dec = k * jnp.exp(g[..., -1:] - g)[..., None]
    g_last = jnp.exp(g[..., -1])

    def step(state, inp):
        u_c, w_c, q_c, k_c, a_c, gl = inp
        v_new = u_c - jnp.einsum('bhcd,bhde->bhce', w_c, state)
        o = jnp.einsum('bhcd,bhde->bhce', q_c, state) + jnp.einsum('bhcs,bhse->bhce', a_c, v_new)
        state = state * gl[..., None, None] + jnp.einsum('bhcd,bhce->bhde', k_c, v_new)
        return state, o

    xs = (jnp.moveaxis(u, 2, 0), jnp.moveaxis(w, 2, 0), jnp.moveaxis(q_dec, 2, 0),
          jnp.moveaxis(k_dec, 2, 0), jnp.moveaxis(attn_intra, 2, 0), jnp.moveaxis(g_last, 2, 0))
    state0 = jnp.zeros((B_, H, D, D), f32)
    _, o = lax.scan(step, state0, xs)
    o = o.transpose(1, 0, 3, 2, 4).reshape(B_, S, H, D)
    o = rms_norm(o, out_gain) * jax.nn.silu(z.reshape(B_, S, H, D).astype(f32))
    return o.reshape(B_, S, H * D).astype(z.dtype)


def hybrid_layer(x, mix_pre_norm, w_in, fox_forget_bias, fox_out_norm, sc_conv_w,
                 gdn_conv_w, gdn_a_log, gdn_dt_bias, gdn_out_norm, w_out, mix_post_norm,
                 ffn_pre_norm, w_gate, w_up, w_down, ffn_post_norm):
    B_, S, _ = x.shape
    u = rms_norm(x, mix_pre_norm)
    proj = u @ w_in
    (fq, fk, fv, ff, sb, sc, sh, gq, gk, gv, ga, gb, gz) = jnp.split(proj, _proj_split_points(), axis=-1)

    fox_out = forgetting_attention(fq.reshape(B_, S, FOX_HEADS, HEAD_DIM),
                                   fk.reshape(B_, S, FOX_HEADS, HEAD_DIM),
                                   fv.reshape(B_, S, FOX_HEADS, HEAD_DIM),
                                   ff, fox_forget_bias, fox_out_norm)
    sc_out = short_conv_mixer(sb, sc, sh, sc_conv_w)
    gdn_out = gated_deltanet(gq, gk, gv, ga, gb, gz, gdn_conv_w, gdn_a_log, gdn_dt_bias, gdn_out_norm)

    mix = jnp.concatenate([fox_out.astype(x.dtype), sc_out.astype(x.dtype), gdn_out.astype(x.dtype)], axis=-1)
    h = x + rms_norm(mix @ w_out, mix_post_norm)

    v = rms_norm(h, ffn_pre_norm)
    y = (jax.nn.silu(v @ w_gate) * (v @ w_up)) @ w_down
    return h + rms_norm(y, ffn_post_norm)


def setup_inputs(seed: int = 0) -> dict:
    key = jax.random.key(seed)
    ks = jax.random.split(key, 18)
    f32 = jnp.float32

    def normal(k, shape, scale):
        return jax.random.normal(k, shape, f32) * scale

    def gain(k, shape):
        return 1.0 + 0.05 * jax.random.normal(k, shape, f32)

    x = normal(ks[0], (BATCH, SEQ, D_MODEL), 1.0)
    mix_pre_norm = gain(ks[1], (DEPTH, D_MODEL))
    w_in = normal(ks[2], (DEPTH, D_MODEL, PROJ_DIM), D_MODEL ** -0.5)
    fox_forget_bias = 3.0 + 0.5 * jax.random.normal(ks[3], (DEPTH, FOX_HEADS), f32)
    fox_out_norm = gain(ks[4], (DEPTH, HEAD_DIM))
    sc_conv_w = normal(ks[5], (DEPTH, SC_KERNEL, SC_WIDTH), SC_KERNEL ** -0.5)
    gdn_conv_w = normal(ks[6], (DEPTH, GDN_CONV, 3 * GDN_WIDTH), GDN_CONV ** -0.5)
    gdn_a_log = jnp.log(jax.random.uniform(ks[7], (DEPTH, GDN_HEADS), f32, 1.0, 16.0))
    dt = jnp.exp(jax.random.uniform(ks[8], (DEPTH, GDN_HEADS), f32, math.log(1e-3), math.log(1e-1)))
    gdn_dt_bias = dt + jnp.log(-jnp.expm1(-dt))
    gdn_out_norm = gain(ks[9], (DEPTH, HEAD_DIM))
    w_out = normal(ks[10], (DEPTH, MIX_WIDTH, D_MODEL), MIX_WIDTH ** -0.5)
    mix_post_norm = gain(ks[11], (DEPTH, D_MODEL))
    ffn_pre_norm = gain(ks[12], (DEPTH, D_MODEL))
    w_gate = normal(ks[13], (DEPTH, D_MODEL, FFN_HIDDEN), D_MODEL ** -0.5)
    w_up = normal(ks[14], (DEPTH, D_MODEL, FFN_HIDDEN), D_MODEL ** -0.5)
    w_down = normal(ks[15], (DEPTH, FFN_HIDDEN, D_MODEL), FFN_HIDDEN ** -0.5)
    ffn_post_norm = gain(ks[16], (DEPTH, D_MODEL))
    return {"x": x, "mix_pre_norm": mix_pre_norm, "w_in": w_in, "fox_forget_bias": fox_forget_bias,
            "fox_out_norm": fox_out_norm, "sc_conv_w": sc_conv_w, "gdn_conv_w": gdn_conv_w,
            "gdn_a_log": gdn_a_log, "gdn_dt_bias": gdn_dt_bias, "gdn_out_norm": gdn_out_norm,
            "w_out": w_out, "mix_post_norm": mix_post_norm, "ffn_pre_norm": ffn_pre_norm,
            "w_gate": w_gate, "w_up": w_up, "w_down": w_down, "ffn_post_norm": ffn_post_norm}


def reference(x, mix_pre_norm, w_in, fox_forget_bias, fox_out_norm, sc_conv_w, gdn_conv_w,
              gdn_a_log, gdn_dt_bias, gdn_out_norm, w_out, mix_post_norm, ffn_pre_norm,
              w_gate, w_up, w_down, ffn_post_norm):
    h = x
    for l in range(DEPTH):
        h = hybrid_layer(h, mix_pre_norm[l], w_in[l], fox_forget_bias[l], fox_out_norm[l],
                         sc_conv_w[l], gdn_conv_w[l], gdn_a_log[l], gdn_dt_bias[l],
                         gdn_out_norm[l], w_out[l], mix_post_norm[l], ffn_pre_norm[l],
                         w_gate[l], w_up[l], w_down[l], ffn_post_norm[l])
    return h
```

```cpp
#include <hip/hip_runtime.h>
#include <hip/hip_bf16.h>
#include <cstdio>
#include <cstdint>
#include <cmath>

#ifndef GDN_BASELINE
#define GDN_BASELINE 1
#endif
#ifndef MK_N_LAUNCHES
#define MK_N_LAUNCHES 0
#endif

constexpr int BATCH = 2, SEQ = 8192, DM = 4096, M = BATCH * SEQ, DEPTH = 2;
constexpr int HD = 128, FOXH = 12, FOXW = FOXH * HD, SCW = 1024, GDNH = 12, GDNW = GDNH * HD;
constexpr int PROJ_SRC = 13860;
constexpr int NP = 14080;
constexpr int FFN = 11008, NGU = 2 * FFN;
constexpr float RMS_EPS = 1e-6f;
constexpr int PC_FQ = 0, PC_FK = 1536, PC_FV = 3072, PC_SB = 4608, PC_SC = 5632, PC_SH = 6656, PC_GQ = 7680, PC_GK = 9216, PC_GV = 10752, PC_GZ = 12288, PC_SMALL = 13824;
constexpr int SBW = 64, SB_FF = 0, SB_GA = 12, SB_GB = 24;
constexpr int SRC_FF = 4608, SRC_SB = 4620, SRC_GQ = 7692, SRC_GA = 12300, SRC_GB = 12312, SRC_GZ = 12324;

constexpr size_t MiB = 1u << 20;
constexpr size_t WS_CTL = 0, CTL_ZERO_BYTES = 1 * MiB;
constexpr size_t WS_W = 16 * MiB;
constexpr size_t WO_IN = 0, WO_OUT = 110 * MiB, WO_GU = 142 * MiB, WO_DN = 314 * MiB;
constexpr size_t WS_XN = 416 * MiB;
constexpr size_t WS_MIX = 544 * MiB;
constexpr size_t WS_Y = 672 * MiB;
constexpr size_t WS_H = 800 * MiB;
constexpr size_t WS_PROJ = 1056 * MiB;
constexpr size_t WS_SB = 1496 * MiB;
constexpr size_t WS_SS = 1500 * MiB;
constexpr size_t WS_FG = 1504 * MiB;
constexpr size_t WS_END = 1506 * MiB;
constexpr size_t WS_AO = WS_XN;
constexpr size_t WS_GQ = WS_Y, WS_GK = WS_Y + 96 * MiB, WS_GV = WS_Y + 192 * MiB, WS_GO = WS_Y + 288 * MiB;
constexpr int CW_TMO = 0, CW_BAR = 4096, CW_Q = 16384;

constexpr int NWAVES = 8;
constexpr int RING_BYTES = 131072, LDSCTL_OFF = RING_BYTES, MISC_OFF = LDSCTL_OFF + 320, LDS_BYTES = 147456;


#define GAS __attribute__((address_space(1)))
#define LAS __attribute__((address_space(3)))
typedef unsigned short bf16;
typedef unsigned v4u __attribute__((ext_vector_type(4)));
typedef float f32x4 __attribute__((ext_vector_type(4)));
typedef short bf16x8 __attribute__((ext_vector_type(8)));
typedef GAS unsigned gu32;
typedef GAS unsigned long long gu64;
#define RLX_AGENT __ATOMIC_RELAXED, __HIP_MEMORY_SCOPE_AGENT
#define LDS_WAIT() asm volatile("s_waitcnt lgkmcnt(0)" ::: "memory")
#define VM_WAIT() asm volatile("s_waitcnt vmcnt(0)" ::: "memory")
__device__ __forceinline__ unsigned long long rt() { return __builtin_amdgcn_s_memrealtime(); }
__device__ __forceinline__ unsigned f2bf(float f) { unsigned u = __builtin_bit_cast(unsigned, f); return (u + 0x7fffu + ((u >> 16) & 1u)) >> 16; }
__device__ __forceinline__ unsigned pk2(float lo, float hi) { return f2bf(lo) | (f2bf(hi) << 16); }

#define XB_TMO      128
#define XB_XCNT(j)  (256  + 64 * (j))
#define XB_XSUB(j)  (1280 + 64 * (j))
#define XB_XGEN(j)  (2304 + 64 * (j))
#define XB_TOP      3328
#define XB_TOPGEN   3392
#define XCD_BAR_WORDS 3456
#define XB_SPIN_CAP (1u << 18)

__device__ __forceinline__ unsigned xb_ld(unsigned* p)              { return __hip_atomic_load(p, __ATOMIC_RELAXED, __HIP_MEMORY_SCOPE_AGENT); }
__device__ __forceinline__ unsigned xb_add(unsigned* p, unsigned v) { return __hip_atomic_fetch_add(p, v, __ATOMIC_RELAXED, __HIP_MEMORY_SCOPE_AGENT); }
__device__ __forceinline__ unsigned xb_xcc_id() { return (unsigned)__builtin_amdgcn_s_getreg((3 << 11) | 20) & 0xFu; }
#define XB_SPIN(cond, bar) do { unsigned _sp = 0; while (cond) { __builtin_amdgcn_s_sleep(1); \
    if ((++_sp & 255u) == 0u) { if (xb_ld(&(bar)[XB_TMO])) break; if (_sp > XB_SPIN_CAP) { atomicAdd(&(bar)[XB_TMO], 1u); break; } } } } while (0)

struct XcdBarrier {
    unsigned* bar; unsigned x;
    volatile LAS unsigned* st;
};

__device__ __forceinline__ XcdBarrier xcd_barrier_post(unsigned* bar, volatile LAS unsigned* st) {
    XcdBarrier b; b.bar = bar; b.x = xb_xcc_id(); b.st = st;
    if (threadIdx.x == 0) (void)xb_add(&bar[XB_XCNT(b.x)], 1u);
    return b;
}
__device__ __forceinline__ void xcd_barrier_complete(unsigned* bar, unsigned x, unsigned& nloc, unsigned& nx) {
    const unsigned G = gridDim.x * gridDim.y * gridDim.z;
    unsigned sum, cnt, mine, sp = 0u;
    for (;;) {
        sum = 0u; cnt = 0u; mine = 0u;
#pragma unroll
        for (unsigned j = 0; j < 16; ++j) { const unsigned c = xb_ld(&bar[XB_XCNT(j)]); sum += c; cnt += (c > 0u) ? 1u : 0u; mine = (j == x) ? c : mine; }
        if (sum == G) break;
        __builtin_amdgcn_s_sleep(1);
        if ((++sp & 255u) == 0u) { if (xb_ld(&bar[XB_TMO])) break; if (sp > XB_SPIN_CAP) { atomicAdd(&bar[XB_TMO], 1u); break; } }
    }
    nloc = mine > 0u ? mine : 1u; nx = cnt > 0u ? cnt : 1u;
}

__device__ __forceinline__ void xcd_barrier(const XcdBarrier& b) {
    asm volatile("s_waitcnt vmcnt(0)" ::: "memory");
    __syncthreads();
    if (threadIdx.x == 0) {
        unsigned* bar = b.bar;
        __builtin_amdgcn_s_waitcnt(0);
        unsigned nloc = b.st[0], nx = b.st[1];
        if (nloc == 0u) { xcd_barrier_complete(bar, b.x, nloc, nx); b.st[0] = nloc; b.st[1] = nx; }
        const unsigned old = xb_add(&bar[XB_XSUB(b.x)], 1u);
        const unsigned gen = old / nloc;
        if (old + 1u == (gen + 1u) * nloc) {
            __builtin_amdgcn_fence(__ATOMIC_RELEASE, "agent");
            asm volatile("s_waitcnt vmcnt(0)" ::: "memory");
            const unsigned og = xb_add(&bar[XB_TOP], 1u);
            const unsigned tg = og / nx;
            if (og + 1u == (tg + 1u) * nx) xb_add(&bar[XB_TOPGEN], 1u);
            else XB_SPIN(xb_ld(&bar[XB_TOPGEN]) == tg, bar);
            __builtin_amdgcn_fence(__ATOMIC_ACQUIRE, "agent");
            xb_add(&bar[XB_XGEN(b.x)], 1u);
            asm volatile("s_waitcnt vmcnt(0)" ::: "memory");
        } else {
            XB_SPIN(xb_ld(&bar[XB_XGEN(b.x)]) == gen, bar);
            __builtin_amdgcn_fence(__ATOMIC_ACQUIRE, "agent");
            asm volatile("s_waitcnt vmcnt(0)" ::: "memory");
        }
    }
    __syncthreads();
}

namespace pg8 {
#define PG8_LAS __attribute__((address_space(3)))
typedef unsigned short bf16_t;
typedef short bf16x8 __attribute__((ext_vector_type(8)));
typedef float f32x4 __attribute__((ext_vector_type(4)));
typedef unsigned u32x4 __attribute__((ext_vector_type(4)));
constexpr int BM = 256, BK = 64, HALF = 128, HTB = HALF * BK * 2  , STAGE_BYTES = 8 * HTB, NXCD = 8, WGM = 8;

__host__ __device__ __forceinline__ int lds_byte(int r, int c) { const int st = (r >> 4) * 2 + (c >> 5), rr = r & 15, cc = c & 31, ob = rr * 64 + cc * 2; return st * 1024 + (ob ^ (((ob >> 9) & 1) << 5)); }
__host__ __device__ __forceinline__ void stage_rc(int b, int& R, int& C) { const int st = b / 1024, sb = b % 1024, swz = sb ^ (((sb >> 9) & 1) << 5); R = (st >> 1) * 16 + swz / 64; C = (st & 1) * 32 + (swz % 64) / 2; }
__host__ __device__ __forceinline__ int perm32(int rho) { const int n = rho >> 4, i = rho & 15; return 8 * (i >> 2) + 4 * n + (i & 3); }

struct Unit { int pm, pn; };
struct Gemm { const bf16_t* A; const bf16_t* Bt; int M, N, K; };

struct StaticOrder {
    int nM, nN, nwg, G, c;
    __host__ __device__ void init(int M, int N, int G_, int c_) { nM = M / BM; nN = N / BM; nwg = nM * nN; G = G_; c = c_; }
    __host__ __device__ bool next(int i, Unit& u) const {
        const long L = (long)i * G + c; if (L >= nwg) return false;
        int wgid = (int)L; { const int q = nwg / NXCD, r = nwg % NXCD, xcd = wgid % NXCD, off = wgid / NXCD; wgid = (xcd < r ? xcd * (q + 1) : r * (q + 1) + (xcd - r) * q) + off; }
        const int nig = WGM * nN, gid = wgid / nig, fm = gid * WGM, gsz = (nM - fm) < WGM ? (nM - fm) : WGM;
        u.pm = fm + ((wgid % nig) % gsz); u.pn = (wgid % nig) / gsz; return true;
    }
    __device__ __forceinline__ void a_ready(const Unit&) const {}
    __device__ __forceinline__ void done(const Unit&) const {}
};


__device__ __forceinline__ unsigned cvt_pk_bf16(float lo, float hi) { unsigned r; asm volatile("v_cvt_pk_bf16_f32 %0, %1, %2" : "=v"(r) : "v"(lo), "v"(hi)); return r; }
__device__ __forceinline__ u32x4 pack8_bf16(const f32x4 v0, const f32x4 v1) { u32x4 w; w.x = cvt_pk_bf16(v0[0], v0[1]); w.y = cvt_pk_bf16(v0[2], v0[3]); w.z = cvt_pk_bf16(v1[0], v1[1]); w.w = cvt_pk_bf16(v1[2], v1[3]); return w; }

struct EpiProj {
    static constexpr bool PERM = true, AFTER_DRAIN = false;
    bf16_t* O; float* SBp;
    __device__ __forceinline__ void operator()(const f32x4 (&acc)[2][2][4][2], const Unit& u, int wr, int wc, int fr, int fq) const {
        const int row0 = u.pm * BM + wr * 64 + fr;
        if (u.pn * BM == PC_SMALL) {
            if (wc < 2) {
#pragma unroll
                for (int ai = 0; ai < 2; ++ai)
#pragma unroll
                    for (int m = 0; m < 4; ++m) { float* rp = SBp + (size_t)(row0 + ai * HALF + m * 16) * SBW + wc * 32 + 8 * fq;
                        *(f32x4*)rp = acc[ai][0][m][0]; *(f32x4*)(rp + 4) = acc[ai][0][m][1]; }
            }
            return;
        }
        const int col0 = u.pn * BM + wc * 32 + 8 * fq;
#pragma unroll
        for (int ai = 0; ai < 2; ++ai)
#pragma unroll
            for (int m = 0; m < 4; ++m) { bf16_t* rowp = O + (size_t)(row0 + ai * HALF + m * 16) * NP + col0;
#pragma unroll
                for (int bj = 0; bj < 2; ++bj) *(u32x4*)(rowp + bj * HALF) = pack8_bf16(acc[ai][bj][m][0], acc[ai][bj][m][1]); }
    }
};
struct EpiY {
    static constexpr bool PERM = true, AFTER_DRAIN = false;
    bf16_t* Y; float* SS;
    __device__ __forceinline__ void operator()(const f32x4 (&acc)[2][2][4][2], const Unit& u, int wr, int wc, int fr, int fq) const {
        const int row0 = u.pm * BM + wr * 64 + fr, col0 = u.pn * BM + wc * 32 + 8 * fq;
#pragma unroll
        for (int ai = 0; ai < 2; ++ai)
#pragma unroll
            for (int m = 0; m < 4; ++m) { const int row = row0 + ai * HALF + m * 16; bf16_t* rowp = Y + (size_t)row * DM + col0; float s = 0.f;
#pragma unroll
                for (int bj = 0; bj < 2; ++bj) { const f32x4 a = acc[ai][bj][m][0], b = acc[ai][bj][m][1];
                    s += (a[0] * a[0] + a[1] * a[1]) + (a[2] * a[2] + a[3] * a[3]) + (b[0] * b[0] + b[1] * b[1]) + (b[2] * b[2] + b[3] * b[3]);
                    *(u32x4*)(rowp + bj * HALF) = pack8_bf16(a, b); }
                s += __shfl_xor(s, 16); s += __shfl_xor(s, 32);
                if (fq == 0) SS[(size_t)row * 64 + u.pn * 4 + wc] = s; }
    }
};
__device__ __forceinline__ float silu_f(float x) { return x * __builtin_amdgcn_rcpf(1.0f + __builtin_amdgcn_exp2f(-1.4426950408889634f * x)); }
struct EpiSwiGLU {
    static constexpr bool PERM = true, AFTER_DRAIN = false;
    bf16_t* Hd;
    __device__ __forceinline__ void operator()(const f32x4 (&acc)[2][2][4][2], const Unit& u, int wr, int wc, int fr, int fq) const {
        const int row0 = u.pm * BM + wr * 64 + fr, col0 = u.pn * HALF + wc * 32 + 8 * fq;
#pragma unroll
        for (int ai = 0; ai < 2; ++ai)
#pragma unroll
            for (int m = 0; m < 4; ++m) { const f32x4 g0 = acc[ai][0][m][0], g1 = acc[ai][0][m][1], u0 = acc[ai][1][m][0], u1 = acc[ai][1][m][1]; f32x4 h0, h1;
#pragma unroll
                for (int e = 0; e < 4; ++e) { h0[e] = silu_f(g0[e]) * u0[e]; h1[e] = silu_f(g1[e]) * u1[e]; }
                *(u32x4*)(Hd + (size_t)(row0 + ai * HALF + m * 16) * FFN + col0) = pack8_bf16(h0, h1); }
    }
};
template <class Epi, class Sched, bool ALIGN_EPI = false, bool SP2 = false>
__device__ __forceinline__ void gemm_phase(PG8_LAS unsigned char* lds, const Gemm g, const Sched& S, const Epi& E) {
    int tid_ = threadIdx.x; asm volatile("" : "+v"(tid_));
    const int tid = tid_, wid = __builtin_amdgcn_readfirstlane(tid >> 6), lane = tid & 63, wr = wid >> 2, wc = wid & 3, fr = lane & 15, fq = lane >> 4;
    const int K = g.K, nt = K / BK;
    unsigned voffA[2], voffB[2];
#pragma unroll
    for (int i = 0; i < 2; ++i) { int R, C; stage_rc(tid * 16 + i * 8192, R, C); const int Rb = Epi::PERM ? ((R & ~31) + perm32(R & 31)) : R;
        voffA[i] = (unsigned)(R * K + C) * 2u; voffB[i] = (unsigned)(Rb * K + C) * 2u; }
    const size_t kstep = (size_t)(BK * 2);
    const size_t hstep = (size_t)HALF * K * 2;
    const size_t tstep = 2 * hstep;
    const unsigned ldsw = (unsigned)wid * 1024u;
    const int aoff = lds_byte(wr * 64 + fr, fq * 8), boff = lds_byte(wc * 32 + fr, fq * 8);
#define PG8_SA(b, h) (((b) * 2 + (h)) * HTB)
#define PG8_SB(b, h) ((4 + (b) * 2 + (h)) * HTB)
#define PG8_STAGE(bufoff, gbase, voff) do { _Pragma("unroll") for (int _i = 0; _i < 2; ++_i) \
        __builtin_amdgcn_global_load_lds((const unsigned*)((const char*)(gbase) + (voff)[_i]), (PG8_LAS unsigned*)(lds + (bufoff) + ldsw + _i * 8192), 16, 0, 0); } while (0)
#define PG8_LDA(dst, b, h) do { _Pragma("unroll") for (int m = 0; m < 4; ++m) _Pragma("unroll") for (int k = 0; k < 2; ++k) dst[m][k] = *(const PG8_LAS bf16x8*)(lds + PG8_SA(b, h) + aoff + m * 2048 + k * 1024); } while (0)
#define PG8_LDB(dst, b, h) do { _Pragma("unroll") for (int n = 0; n < 2; ++n) _Pragma("unroll") for (int k = 0; k < 2; ++k) dst[n][k] = *(const PG8_LAS bf16x8*)(lds + PG8_SB(b, h) + boff + n * 2048 + k * 1024); } while (0)
#define PG8_MMA(ai, bj, At, Bt) do { __builtin_amdgcn_s_setprio(1); _Pragma("unroll") for (int m = 0; m < 4; ++m) _Pragma("unroll") for (int n = 0; n < 2; ++n) _Pragma("unroll") for (int k = 0; k < 2; ++k) \
        acc[ai][bj][m][n] = __builtin_amdgcn_mfma_f32_16x16x32_bf16(Bt[n][k], At[m][k], acc[ai][bj][m][n], 0, 0, 0); __builtin_amdgcn_s_setprio(0); } while (0)
#define PG8_WAIT_V(n) asm volatile("s_waitcnt vmcnt(" #n ")" ::: "memory")
#define PG8_WAIT_L(n) asm volatile("s_waitcnt lgkmcnt(" #n ")" ::: "memory")
#define PG8_BAR __builtin_amdgcn_s_barrier()
#define PG8_SCHED __builtin_amdgcn_sched_barrier(0)
    Unit cur, nxt; int ui = 0;
    if (!S.next(0, cur)) return;
    f32x4 acc[2][2][4][2];
#pragma unroll
    for (int a = 0; a < 2; ++a)
#pragma unroll
        for (int b = 0; b < 2; ++b)
#pragma unroll
            for (int m = 0; m < 4; ++m)
#pragma unroll
                for (int n = 0; n < 2; ++n) acc[a][b][m][n] = (f32x4){0.f, 0.f, 0.f, 0.f};
    bf16x8 At[4][2], B0[2][2], B1[2][2];
    const char* cA = (const char*)g.A + (size_t)cur.pm * tstep; const char* cB = (const char*)g.Bt + (size_t)cur.pn * tstep;
    S.a_ready(cur);
    if constexpr (SP2) {
        PG8_STAGE(PG8_SB(0, 0), cB, voffB); PG8_STAGE(PG8_SB(0, 1), cB + hstep, voffB); PG8_STAGE(PG8_SA(0, 0), cA, voffA); PG8_STAGE(PG8_SA(0, 1), cA + hstep, voffA);
        if (wr == 1) PG8_BAR;
        PG8_WAIT_V(2); PG8_BAR;
        PG8_STAGE(PG8_SB(1, 0), cB + kstep, voffB); PG8_STAGE(PG8_SA(1, 0), cA + kstep, voffA); PG8_STAGE(PG8_SB(1, 1), cB + hstep + kstep, voffB);
        PG8_WAIT_V(6); PG8_BAR;
    } else {
        PG8_STAGE(PG8_SB(0, 0), cB, voffB); PG8_STAGE(PG8_SA(0, 0), cA, voffA); PG8_STAGE(PG8_SB(0, 1), cB + hstep, voffB); PG8_STAGE(PG8_SA(0, 1), cA + hstep, voffA);
        if (wr == 1) PG8_BAR;
        PG8_WAIT_V(4); PG8_BAR;
        PG8_STAGE(PG8_SB(1, 0), cB + kstep, voffB); PG8_STAGE(PG8_SA(1, 0), cA + kstep, voffA); PG8_STAGE(PG8_SB(1, 1), cB + hstep + kstep, voffB);
        PG8_WAIT_V(6); PG8_BAR;
    }
    for (;;) {
        const bool has_next = S.next(ui + 1, nxt);
        const char* nA = has_next ? (const char*)g.A + (size_t)nxt.pm * tstep : cA; const char* nB = has_next ? (const char*)g.Bt + (size_t)nxt.pn * tstep : cB;
        for (int t = 0; t < nt; t += 2) {
            const bool last = (t == nt - 2);
            const char* a1 = cA + (size_t)(t + 1) * kstep;
            const char* a2 = last ? nA : cA + (size_t)(t + 2) * kstep; const char* b2 = last ? nB : cB + (size_t)(t + 2) * kstep;
            const char* a3 = a2 + kstep; const char* b3 = b2 + kstep;
            if (last && has_next) S.a_ready(nxt);
            if constexpr (SP2) {
            PG8_LDB(B0, 0, 0); PG8_LDB(B1, 0, 1); PG8_SCHED; PG8_LDA(At, 0, 0); PG8_STAGE(PG8_SA(1, 1), a1 + hstep, voffA);
            PG8_WAIT_V(8); PG8_WAIT_L(0); PG8_BAR; PG8_MMA(0, 0, At, B0); PG8_MMA(0, 1, At, B1); PG8_BAR; PG8_SCHED;
            PG8_LDA(At, 0, 1); PG8_STAGE(PG8_SB(0, 0), b2, voffB); PG8_STAGE(PG8_SB(0, 1), b2 + hstep, voffB); PG8_STAGE(PG8_SA(0, 0), a2, voffA);
            PG8_WAIT_V(8); PG8_WAIT_L(0); PG8_BAR; PG8_MMA(1, 0, At, B0); PG8_MMA(1, 1, At, B1); PG8_BAR; PG8_SCHED;
            PG8_LDB(B0, 1, 0); PG8_LDB(B1, 1, 1); PG8_SCHED; PG8_LDA(At, 1, 0); PG8_STAGE(PG8_SA(0, 1), a2 + hstep, voffA);
            PG8_WAIT_V(8); PG8_WAIT_L(0); PG8_BAR; PG8_MMA(0, 0, At, B0); PG8_MMA(0, 1, At, B1); PG8_BAR; PG8_SCHED;
            PG8_LDA(At, 1, 1); PG8_STAGE(PG8_SB(1, 0), b3, voffB); PG8_STAGE(PG8_SB(1, 1), b3 + hstep, voffB); PG8_STAGE(PG8_SA(1, 0), a3, voffA);
            PG8_WAIT_V(8); PG8_WAIT_L(0); PG8_BAR; PG8_MMA(1, 0, At, B0); PG8_MMA(1, 1, At, B1); PG8_BAR; PG8_SCHED;
            } else {
            PG8_LDB(B0, 0, 0); PG8_SCHED; PG8_LDA(At, 0, 0); PG8_STAGE(PG8_SA(1, 1), a1 + hstep, voffA);
            PG8_WAIT_L(8); PG8_BAR; PG8_WAIT_L(0); PG8_MMA(0, 0, At, B0); PG8_BAR; PG8_SCHED;
            PG8_LDB(B1, 0, 1); PG8_STAGE(PG8_SB(0, 0), b2, voffB);
            PG8_BAR; PG8_WAIT_L(0); PG8_MMA(0, 1, At, B1); PG8_BAR;
            PG8_LDA(At, 0, 1); PG8_STAGE(PG8_SA(0, 0), a2, voffA);
            PG8_BAR; PG8_WAIT_L(0); PG8_MMA(1, 0, At, B0); PG8_BAR; PG8_SCHED;
            PG8_STAGE(PG8_SB(0, 1), b2 + hstep, voffB);
            PG8_WAIT_V(6); PG8_BAR; PG8_MMA(1, 1, At, B1); PG8_BAR;
            PG8_LDB(B0, 1, 0); PG8_SCHED; PG8_LDA(At, 1, 0); PG8_STAGE(PG8_SA(0, 1), a2 + hstep, voffA);
            PG8_WAIT_L(8); PG8_BAR; PG8_WAIT_L(0); PG8_MMA(0, 0, At, B0); PG8_BAR; PG8_SCHED;
            PG8_LDB(B1, 1, 1); PG8_STAGE(PG8_SB(1, 0), b3, voffB);
            PG8_BAR; PG8_WAIT_L(0); PG8_MMA(0, 1, At, B1); PG8_BAR;
            PG8_LDA(At, 1, 1); PG8_STAGE(PG8_SA(1, 0), a3, voffA);
            PG8_BAR; PG8_WAIT_L(0); PG8_MMA(1, 0, At, B0); PG8_BAR; PG8_SCHED;
            PG8_STAGE(PG8_SB(1, 1), b3 + hstep, voffB);
            PG8_WAIT_V(6); PG8_BAR; PG8_MMA(1, 1, At, B1); PG8_BAR;
            }
        }
        if constexpr (ALIGN_EPI) { if (wr == 0) PG8_BAR; }
        if constexpr (!Epi::AFTER_DRAIN) { E(acc, cur, wr, wc, fr, fq); S.done(cur); }
        if (!has_next) break;
#pragma unroll
        for (int a = 0; a < 2; ++a)
#pragma unroll
            for (int b = 0; b < 2; ++b)
#pragma unroll
                for (int m = 0; m < 4; ++m)
#pragma unroll
                    for (int n = 0; n < 2; ++n) acc[a][b][m][n] = (f32x4){0.f, 0.f, 0.f, 0.f};
        cur = nxt; cA = nA; cB = nB; ++ui;
        if constexpr (ALIGN_EPI) { if (wr == 1) PG8_BAR; }
    }
    PG8_WAIT_V(0);
    if constexpr (!ALIGN_EPI) { if (wr == 0) PG8_BAR; }
    PG8_BAR;
    if constexpr (Epi::AFTER_DRAIN) { E.fused(acc, cur, wr, wc, fr, fq, lds, wid, lane); S.done(cur); }
#undef PG8_SA
#undef PG8_SB
#undef PG8_STAGE
#undef PG8_LDA
#undef PG8_LDB
#undef PG8_MMA
#undef PG8_WAIT_V
#undef PG8_WAIT_L
#undef PG8_BAR
#undef PG8_SCHED
}
}

namespace attn {
constexpr int KVP = NP, OP = FOXW;
constexpr float SCALE = 0.08838834764831845f;
constexpr int D = 128;
constexpr int NW = 8, QBLK = 32, KVBLK = 64, QB = NW * QBLK;
constexpr int SHM_V = KVBLK * D * 2, SHM_K = KVBLK * D * 2;
constexpr int FB_OFF = 2 * SHM_V + 2 * SHM_K + NW * 64 * 4;
constexpr int LDS_BYTES = FB_OFF + 2 * 64 * 4;
constexpr bool WSKIP = false;
constexpr float THR = 8.f;

using bf16 = __hip_bfloat16;
typedef short bf16x8 __attribute__((ext_vector_type(8)));
typedef short s16x4 __attribute__((ext_vector_type(4)));
typedef float f32x16 __attribute__((ext_vector_type(16)));
typedef float f32x4 __attribute__((ext_vector_type(4)));
typedef unsigned u32x4 __attribute__((ext_vector_type(4)));
template <class A, class Bt> struct same_t { static constexpr bool v = false; };
template <class A> struct same_t<A, A> { static constexpr bool v = true; };

#define KSWZ(row, colB) ((row) * 256 + ((colB) ^ (((row) & 7) << 4)))
#define SBAR() __builtin_amdgcn_sched_barrier(0)
__device__ __forceinline__ int v_st(int k, int c) { const int kk = (k & ~0xC) | ((k & 4) << 1) | ((k & 8) >> 1); return ((kk >> 3) * 4 + (c >> 5)) * 512 + ((kk & 7) * 32 + (c & 31)) * 2; }
__device__ __forceinline__ int v_rd_base(int lane) { return ((lane & 3) << 3) | (((lane >> 2) & 3) << 6) | (((lane >> 4) & 1) << 5) | (((lane >> 5) & 1) << 8); }
constexpr int v_rd_off(int d0, int ks, int half) { return d0 * 512 + ks * 4096 + half * 2048; }
__device__ __forceinline__ int crow(int r, int hi) { return (r & 3) + 8 * (r >> 2) + 4 * hi; }
__device__ __forceinline__ unsigned cvtpk(float lo, float hi) {
    unsigned r; asm volatile("v_cvt_pk_bf16_f32 %0, %1, %2" : "=v"(r) : "v"(lo), "v"(hi)); return r;
}
__device__ __forceinline__ bf16x8 pack8(f32x4 a, f32x4 b) {
    u32x4 w = {cvtpk(a[0], a[1]), cvtpk(a[2], a[3]), cvtpk(b[0], b[1]), cvtpk(b[2], b[3])};
    return *reinterpret_cast<bf16x8*>(&w);
}
template <class T> __device__ __forceinline__ bf16x8 load8(const T* p) {
    if constexpr (same_t<T, float>::v) { return pack8(*(const f32x4*)p, *(const f32x4*)(p + 4)); }
    else { return *reinterpret_cast<const bf16x8*>(p); }
}
__device__ __forceinline__ void mask_tile(f32x16& p0, f32x16& p1, int dq, unsigned W) {
    const float NEG = -__builtin_inff();
#pragma unroll
    for (int r = 0; r < 16; ++r) {
        const int c = (r & 3) + 8 * (r >> 2);
        if ((unsigned)(dq - c) >= W) p0[r] = NEG;
        if ((unsigned)(dq - c - 32) >= W) p1[r] = NEG;
    }
}
__device__ __forceinline__ void partialSM(f32x16& p0, f32x16& p1, float& m_reg, float& mn, float& alpha) {
    float pmax = p0[0]; for (int r = 1; r < 16; ++r) pmax = fmaxf(pmax, p0[r]); for (int r = 0; r < 16; ++r) pmax = fmaxf(pmax, p1[r]);
    { auto rr = __builtin_amdgcn_permlane32_swap(__float_as_uint(pmax), __float_as_uint(pmax), false, false);
      pmax = fmaxf(__uint_as_float(rr[0]), __uint_as_float(rr[1])); }
    constexpr float C2 = 1.4426950408889634f * SCALE;
    if (__builtin_expect(__all((pmax - m_reg) * SCALE <= THR), 1)) { mn = m_reg; alpha = 1.f; }
    else { mn = fmaxf(m_reg, pmax); alpha = __builtin_amdgcn_exp2f((m_reg - mn) * C2); m_reg = mn; }
    const float mnL = -mn * C2;
    for (int r = 0; r < 16; ++r) p0[r] = fmaf(p0[r], C2, mnL); for (int r = 0; r < 16; ++r) p1[r] = fmaf(p1[r], C2, mnL);
    for (int r = 0; r < 16; ++r) p0[r] = __builtin_amdgcn_exp2f(p0[r]);
}
__device__ __forceinline__ void finishSM(f32x16& p0, f32x16& p1, float alpha, float& l_reg, bf16x8& pa0, bf16x8& pa1, bf16x8& pa2, bf16x8& pa3) {
    for (int r = 0; r < 16; ++r) p1[r] = __builtin_amdgcn_exp2f(p1[r]);
    float ps = 0; for (int r = 0; r < 16; ++r) ps += p0[r]; for (int r = 0; r < 16; ++r) ps += p1[r];
    { auto rr = __builtin_amdgcn_permlane32_swap(__float_as_uint(ps), __float_as_uint(ps), false, false);
      ps = __uint_as_float(rr[0]) + __uint_as_float(rr[1]); }
    l_reg = l_reg * alpha + ps;
#define PK4(P, B_, OUT) do { unsigned a0 = cvtpk(P[B_+0], P[B_+1]), a1 = cvtpk(P[B_+2], P[B_+3]);                          \
        unsigned b0 = cvtpk(P[B_+4], P[B_+5]), b1 = cvtpk(P[B_+6], P[B_+7]);                                             \
        auto r0 = __builtin_amdgcn_permlane32_swap(a0, b0, false, false); auto r1 = __builtin_amdgcn_permlane32_swap(a1, b1, false, false); \
        u32x4 w = {r0[0], r1[0], r0[1], r1[1]}; OUT = *reinterpret_cast<bf16x8*>(&w); } while (0)
    PK4(p0, 0, pa0); PK4(p0, 8, pa1); PK4(p1, 0, pa2); PK4(p1, 8, pa3);
#undef PK4
}
template <int KB, bool SK>
__device__ __forceinline__ void qkt(f32x16& p0, f32x16& p1, const char* K_lds, int r32, int hi, const bf16x8* qr, bool act) {
    if (SK && !act) { const float NEG = -__builtin_inff();
#pragma unroll
        for (int r = 0; r < 16; ++r) { p0[r] = NEG; p1[r] = NEG; } return; }
    { const char* fb = K_lds + 2 * SHM_K + NW * 64 * 4 + KB * 256 + hi * 16;
#pragma unroll
      for (int g = 0; g < 4; ++g) { const f32x4 a = *reinterpret_cast<const f32x4*>(fb + g * 32), b = *reinterpret_cast<const f32x4*>(fb + 128 + g * 32);
          p0[4 * g] = a[0]; p0[4 * g + 1] = a[1]; p0[4 * g + 2] = a[2]; p0[4 * g + 3] = a[3]; p1[4 * g] = b[0]; p1[4 * g + 1] = b[1]; p1[4 * g + 2] = b[2]; p1[4 * g + 3] = b[3]; } }
    const char* kb[4];
#pragma unroll
    for (int dd = 0; dd < 4; ++dd) kb[dd] = K_lds + KB * SHM_K + KSWZ(r32, (dd * 16 + hi * 8) * 2);
#pragma unroll
    for (int d0 = 0; d0 < 8; ++d0) { const char* a = kb[d0 & 3] + (d0 >> 2) * 128;
        bf16x8 b0 = *reinterpret_cast<const bf16x8*>(a);
        bf16x8 b1 = *reinterpret_cast<const bf16x8*>(a + 32 * 256);
        p0 = __builtin_amdgcn_mfma_f32_32x32x16_bf16(b0, qr[d0], p0, 0, 0, 0);
        p1 = __builtin_amdgcn_mfma_f32_32x32x16_bf16(b1, qr[d0], p1, 0, 0, 0); }
}
template <int VB, bool SK>
__device__ __forceinline__ void pv_tile(f32x16* o, int vb0, bf16x8 pa0, bf16x8 pa1, bf16x8 pa2, bf16x8 pa3, bool act) {
    if (SK && !act) return;
#define TRRD(dst, off) asm volatile("ds_read_b64_tr_b16 %0, %1 offset:%2" : "=&v"(dst) : "v"(vb0), "i"(off) : "memory")
#define PV_D0(d0) do { s16x4 l0, l1, l2, l3, h0, h1, h2, h3; constexpr int b_ = VB * SHM_V + v_rd_off(d0, 0, 0);     \
        TRRD(l0, b_); TRRD(h0, b_ + 2048); TRRD(l1, b_ + 4096); TRRD(h1, b_ + 6144); TRRD(l2, b_ + 8192); TRRD(h2, b_ + 10240); TRRD(l3, b_ + 12288); TRRD(h3, b_ + 14336); \
        asm volatile("s_waitcnt lgkmcnt(0)" ::: "memory"); SBAR();                 \
        o[d0] = __builtin_amdgcn_mfma_f32_32x32x16_bf16(pa0, (bf16x8){l0[0], l0[1], l0[2], l0[3], h0[0], h0[1], h0[2], h0[3]}, o[d0], 0, 0, 0);   \
        o[d0] = __builtin_amdgcn_mfma_f32_32x32x16_bf16(pa1, (bf16x8){l1[0], l1[1], l1[2], l1[3], h1[0], h1[1], h1[2], h1[3]}, o[d0], 0, 0, 0);   \
        o[d0] = __builtin_amdgcn_mfma_f32_32x32x16_bf16(pa2, (bf16x8){l2[0], l2[1], l2[2], l2[3], h2[0], h2[1], h2[2], h2[3]}, o[d0], 0, 0, 0);   \
        o[d0] = __builtin_amdgcn_mfma_f32_32x32x16_bf16(pa3, (bf16x8){l3[0], l3[1], l3[2], l3[3], h3[0], h3[1], h3[2], h3[3]}, o[d0], 0, 0, 0); } while (0)
    PV_D0(0); PV_D0(1); PV_D0(2); PV_D0(3);
#undef PV_D0
#undef TRRD
}

template <class TIn, class TOut> struct BlockRef { const TIn* Q; const TIn* K; const TIn* V; const float* F; TOut* O; int P0; };
template <class TIn> struct Seam {
    bf16x8 qr[8];
    bf16x8 st_v0, st_v1, st_k0, st_k1; float st_f; f32x4 sf0, sf1, sf2, sf3;
    f32x4 tq[16];
};
__device__ __forceinline__ int swa_jlo(int P0, int W) { const int lowk = P0 - W + 1; return lowk > 0 ? lowk / KVBLK : 0; }
#define ROW(p, k0, rr) ((p) + (size_t)((k0) + (rr)) * KVP + sc)
#define VMW() asm volatile("s_waitcnt vmcnt(0)" ::: "memory")
#define VMWN(n) asm volatile("s_waitcnt vmcnt(%0)" :: "i"(n) : "memory")
#define SLOAD_H(Kp, Vp, Fp, k0) do { S.st_v0 = load8<TIn>(ROW(Vp, k0, sr)); S.st_v1 = load8<TIn>(ROW(Vp, k0, 32 + sr));              \
                         S.st_k0 = load8<TIn>(ROW(Kp, k0, sr)); S.st_k1 = load8<TIn>(ROW(Kp, k0, 32 + sr)); if (tid < 64) S.st_f = (Fp)[(k0) + tid]; } while (0)
#define SWRITE_HK(bf) do { *(bf16x8*)(K_lds + (bf) * SHM_K + kws) = S.st_k0; *(bf16x8*)(K_lds + (bf) * SHM_K + kws + 32 * 256) = S.st_k1; if (tid < 64) *(float*)(K_lds + 2 * SHM_K + NW * 64 * 4 + (bf) * 256 + tid * 4) = S.st_f; } while (0)
#define SWRITE_HV(bf) do { *(bf16x8*)(V_lds + (bf) * SHM_V + vst0) = S.st_v0; *(bf16x8*)(V_lds + (bf) * SHM_V + vst1) = S.st_v1; } while (0)
#define SWRITE_H(bf) do { SWRITE_HV(bf); SWRITE_HK(bf); } while (0)
#define SLOAD_F(p, k0) do { S.sf0 = *(const f32x4*)ROW(p, k0, sr); S.sf1 = *(const f32x4*)(ROW(p, k0, sr) + 4);                \
                            S.sf2 = *(const f32x4*)ROW(p, k0, 32 + sr); S.sf3 = *(const f32x4*)(ROW(p, k0, 32 + sr) + 4); } while (0)
#define SWRITE_KF(bf) do { *(bf16x8*)(K_lds + (bf) * SHM_K + kws) = pack8(S.sf0, S.sf1); *(bf16x8*)(K_lds + (bf) * SHM_K + kws + 32 * 256) = pack8(S.sf2, S.sf3); } while (0)
#define SWRITE_VF(bf) do { *(bf16x8*)(V_lds + (bf) * SHM_V + vst0) = pack8(S.sf0, S.sf1); *(bf16x8*)(V_lds + (bf) * SHM_V + vst1) = pack8(S.sf2, S.sf3); } while (0)
template <class TIn, class TOut>
__device__ __forceinline__ void causal_swa_prime(const BlockRef<TIn, TOut>& cur, int W, char* lds, Seam<TIn>& S) {
    constexpr bool F32 = same_t<TIn, float>::v;
    int tid_ = threadIdx.x; asm volatile("" : "+v"(tid_));
    const int tid = tid_, wid = __builtin_amdgcn_readfirstlane(tid >> 6), lane = tid & 63, r32 = lane & 31, hi = lane >> 5;
    const int sr = tid >> 4, sc = (tid & 15) * 8, kws = KSWZ(sr, sc * 2); char* K_lds = lds + 2 * SHM_V;
    const int kb0 = swa_jlo(cur.P0, W) * KVBLK;
    for (int d0 = 0; d0 < 8; ++d0) S.qr[d0] = load8<TIn>(cur.Q + (size_t)(wid * QBLK + r32) * KVP + d0 * 16 + hi * 8);
    if constexpr (F32) { SLOAD_F((const float*)cur.K, kb0); VMW(); SWRITE_KF(0); SBAR(); SLOAD_F((const float*)cur.V, kb0); }
    else { SLOAD_H(cur.K, cur.V, cur.F, kb0); VMW(); SWRITE_HK(0); }
    __syncthreads();
}
template <class TIn, class TOut>
__device__ __forceinline__ void causal_swa_block(const BlockRef<TIn, TOut>& cur, const BlockRef<TIn, TOut>& nxt, int skv, int W, char* lds, Seam<TIn>& S) {
    constexpr bool F32 = same_t<TIn, float>::v;
    int tid_ = threadIdx.x; asm volatile("" : "+v"(tid_));
    const int tid = tid_, wid = __builtin_amdgcn_readfirstlane(tid >> 6), lane = tid & 63, r32 = lane & 31, hi = lane >> 5;
    const int j_lo = swa_jlo(cur.P0, W);
    int j_hi = (cur.P0 + QB - 1) / KVBLK + 1; if (j_hi > skv / KVBLK) j_hi = skv / KVBLK;
    const int NT = j_hi - j_lo;
    const int kbn = swa_jlo(nxt.P0, W) * KVBLK;
    const int qlo = cur.P0 + wid * QBLK, qm = qlo + r32 - 4 * hi;
    char* V_lds = lds; char* K_lds = lds + 2 * SHM_V;
    float* ws = (float*)(lds + 2 * SHM_V + 2 * SHM_K) + wid * 64; float* li_l = ws, * al_l = ws + 32;
    float m_reg = -1e30f, l_reg = 0; f32x16 o[4] = {};
    const int sr = tid >> 4, sc = (tid & 15) * 8, vst0 = v_st(sr, sc), vst1 = v_st(32 + sr, sc), kws = KSWZ(sr, sc * 2);
    const int vb0 = (int)(uintptr_t)V_lds + v_rd_base(lane);
    const TIn* Kh = cur.K; const TIn* Vh = cur.V; const float* Fh = cur.F;
#define RESC(a) do { if (__any((a) < 1.f)) { if (hi == 0) al_l[r32] = (a); asm volatile("s_waitcnt lgkmcnt(0)" ::: "memory");              \
                     for (int d_ = 0; d_ < 4; ++d_) for (int r = 0; r < 16; ++r) o[d_][r] *= al_l[crow(r, hi)]; } } while (0)
#define KBASE(t) ((j_lo + (t)) * KVBLK)
#define ACT(t) (KBASE(t) <= qlo + QBLK - 1 && KBASE(t) + KVBLK - 1 >= qlo - W + 1)
#define MASKT(P0_, P1_, t) do { const int kb_ = KBASE(t); if ((!SK || ACT(t)) && (kb_ + KVBLK - 1 > qlo || kb_ <= qlo + QBLK - 1 - W)) mask_tile(P0_, P1_, qm - kb_, (unsigned)W); } while (0)
    constexpr int NQL = F32 ? 16 : 8;
    constexpr bool SK = WSKIP && !F32;
#define SEAM_K0() do { VMWN(NQL); if constexpr (F32) { SWRITE_KF(0); SBAR(); SLOAD_F((const float*)nxt.V, kbn); } else { SWRITE_HK(0); } SBAR(); } while (0)
    f32x16 pA0, pA1, pB0, pB1; float mnA, mnB, alA, alB; bf16x8 pa0, pa1, pa2, pa3;
    if constexpr (F32) { VMW(); SWRITE_VF(0); SBAR(); } else { SWRITE_HV(0); SBAR(); }
    if (NT > 1) { if constexpr (F32) SLOAD_F((const float*)Kh, KBASE(1)); else SLOAD_H(Kh, Vh, Fh, KBASE(1)); }
    SBAR(); qkt<0, SK>(pA0, pA1, K_lds, r32, hi, S.qr, ACT(0));
    if constexpr (F32) { if (NT > 1) { VMW(); SWRITE_KF(1); SBAR(); SLOAD_F((const float*)Vh, KBASE(1)); } }
    MASKT(pA0, pA1, 0); partialSM(pA0, pA1, m_reg, mnA, alA);
    if (NT > 1) { VMW(); if constexpr (F32) { SWRITE_VF(1); SBAR(); if (NT > 2) SLOAD_F((const float*)Kh, KBASE(2)); } else SWRITE_H(1); }
    __syncthreads();
#define HALF_STEP(PX0, PX1, mnX, alX, PY0, PY1, alY, t, KB, VB, SB) do {                                                      \
        SBAR(); qkt<KB, SK>(PX0, PX1, K_lds, r32, hi, S.qr, ACT(t));                                             \
        finishSM(PY0, PY1, alY, l_reg, pa0, pa1, pa2, pa3); SBAR();                                                           \
        if ((t) + 1 < NT) { if constexpr (F32) { VMW(); SWRITE_KF(SB); SBAR(); SLOAD_F((const float*)Vh, KBASE((t) + 1)); }  \
                            else { SLOAD_H(Kh, Vh, Fh, KBASE((t) + 1)); } SBAR(); }                                               \
        pv_tile<VB, SK>(o, vb0, pa0, pa1, pa2, pa3, ACT((t) - 1)); MASKT(PX0, PX1, (t)); partialSM(PX0, PX1, m_reg, mnX, alX);                                        \
        __syncthreads();                                                                                                      \
        if ((t) + 1 < NT) { VMW(); if constexpr (F32) { SWRITE_VF(SB); SBAR(); if ((t) + 2 < NT) SLOAD_F((const float*)Kh, KBASE((t) + 2)); } \
                            else { SWRITE_H(SB); } }                                                                          \
        RESC(alX); __syncthreads(); } while (0)
    for (int t = 1; t + 1 < NT; t += 2) {
        HALF_STEP(pB0, pB1, mnB, alB, pA0, pA1, alA, t, 1, 0, 0);
        HALF_STEP(pA0, pA1, mnA, alA, pB0, pB1, alB, t + 1, 0, 1, 1);
    }
    const bool even = (NT & 1) == 0;
    if (even) { SBAR(); qkt<1, SK>(pB0, pB1, K_lds, r32, hi, S.qr, ACT(NT - 1)); SBAR(); }
#define QROW(e) (nxt.Q + (size_t)(wid * QBLK + r32) * KVP + ((e) >> 1) * 16 + hi * 8 + ((e) & 1) * 4)
    if constexpr (F32) { SLOAD_F((const float*)nxt.K, kbn); SBAR();
#pragma unroll
        for (int e = 0; e < 8; ++e) S.tq[e] = *(const f32x4*)QROW(e); }
    else { SLOAD_H(nxt.K, nxt.V, nxt.F, kbn); SBAR();
#pragma unroll
        for (int d0 = 0; d0 < 8; ++d0) S.qr[d0] = load8<TIn>(nxt.Q + (size_t)(wid * QBLK + r32) * KVP + d0 * 16 + hi * 8); }
    SBAR();
    finishSM(pA0, pA1, alA, l_reg, pa0, pa1, pa2, pa3); SBAR();
    if constexpr (F32) {
#pragma unroll
        for (int e = 8; e < 16; ++e) S.tq[e] = *(const f32x4*)QROW(e); SBAR(); }
#undef QROW
    pv_tile<0, SK>(o, vb0, pa0, pa1, pa2, pa3, ACT(even ? NT - 2 : NT - 1));
    if (even) { MASKT(pB0, pB1, NT - 1); partialSM(pB0, pB1, m_reg, mnB, alB); __syncthreads(); RESC(alB);
        finishSM(pB0, pB1, alB, l_reg, pa0, pa1, pa2, pa3); SBAR(); pv_tile<1, SK>(o, vb0, pa0, pa1, pa2, pa3, ACT(NT - 1)); }
    SBAR(); SEAM_K0();
    if (hi == 0) li_l[r32] = l_reg; asm volatile("s_waitcnt lgkmcnt(0)" ::: "memory");
    float rli[16];
#pragma unroll
    for (int r = 0; r < 16; ++r) rli[r] = __builtin_amdgcn_rcpf(li_l[crow(r, hi)]);
    TOut* Ow = cur.O + (size_t)(wid * QBLK) * OP;
#pragma unroll
    for (int r = 0; r < 16; ++r) { const int orow = crow(r, hi);
#pragma unroll
        for (int d0 = 0; d0 < 4; ++d0) { const float v = o[d0][r] * rli[r];
            if constexpr (same_t<TOut, float>::v) { Ow[(size_t)orow * OP + d0 * 32 + r32] = v; }
            else { const float vn = __shfl_xor(v, 1);
                   if ((r32 & 1) == 0) *(unsigned*)(Ow + (size_t)orow * OP + d0 * 32 + r32) = cvtpk(v, vn); } } }
    if constexpr (F32) {
#pragma unroll
        for (int d0 = 0; d0 < 8; ++d0) S.qr[d0] = pack8(S.tq[2 * d0], S.tq[2 * d0 + 1]); }
    __syncthreads();
#undef RESC
#undef KBASE
#undef ACT
#undef MASKT
#undef SEAM_K0
#undef HALF_STEP
}
#undef ROW
#undef VMW
#undef VMWN
#undef SLOAD_H
#undef SWRITE_HK
#undef SWRITE_HV
#undef SWRITE_H
#undef SLOAD_F
#undef SWRITE_KF
#undef SWRITE_VF


}

__device__ __forceinline__ float bflo(unsigned w) { return __uint_as_float(w << 16); }
__device__ __forceinline__ float bfhi(unsigned w) { return __uint_as_float(w & 0xffff0000u); }
__device__ __forceinline__ float wave_sum(float v) {
#pragma unroll
    for (int o = 1; o < 64; o <<= 1) v += __shfl_xor(v, o);
    return v;
}
__device__ __forceinline__ float sigmoid_f(float x) { return 1.0f / (1.0f + __expf(-x)); }
__device__ __forceinline__ float silu_acc(float x) { return x / (1.0f + __expf(-x)); }
__device__ __forceinline__ float softplus_f(float x) { return fmaxf(x, 0.f) + log1pf(__expf(-fabsf(x))); }
__device__ __forceinline__ float logsigmoid_f(float x) { return fminf(x, 0.f) - log1pf(__expf(-fabsf(x))); }

struct Args { const float* in[17]; float* out; unsigned char* ws; int ph_lo, ph_hi; };
typedef const __attribute__((address_space(4))) Args* ArgsP;
enum { I_X = 0, I_MIXPRE, I_WIN, I_FOXFB, I_FOXON, I_SCW, I_GDNCW, I_GDNALOG, I_GDNDTB, I_GDNON, I_WOUT, I_MIXPOST, I_FFNPRE, I_WGATE, I_WUP, I_WDOWN, I_FFNPOST };
struct Ptrs {
    ArgsP ap;
    int tid, lane, wave, gw, NGW, G, bid;
};
__device__ __forceinline__ Ptrs fresh_ptrs(ArgsP ap0);
__device__ __forceinline__ int ftid() { int t = threadIdx.x; asm volatile("" : "+v"(t)); return t; }
__device__ __forceinline__ int fbid() { int b = blockIdx.x; asm volatile("" : "+s"(b)); return b; }
__device__ __forceinline__ ArgsP fresh(ArgsP a) { asm volatile("" : "+s"(a)); return a; }
__device__ __forceinline__ Ptrs fresh_ptrs(ArgsP ap0) { Ptrs P; P.ap = fresh(ap0); P.tid = ftid(); P.lane = P.tid & 63; P.wave = __builtin_amdgcn_readfirstlane(P.tid >> 6); P.bid = fbid();
    P.G = gridDim.x; P.gw = P.bid * NWAVES + P.wave; P.NGW = P.G * NWAVES; return P; }

__device__ __forceinline__ int win_src4(int d) {
    if (d < PC_SB) return d;
    if (d < PC_GQ) return d - PC_SB + SRC_SB;
    if (d < PC_GZ) return d - PC_GQ + SRC_GQ;
    if (d < PC_SMALL) return d - PC_GZ + SRC_GZ;
    const int e = d - PC_SMALL;
    if (e < 12) return SRC_FF + e;
    if (e < 24) return SRC_GA + e - 12;
    if (e < 36) return SRC_GB + e - 24;
    return -1;
}
__device__ __forceinline__ void tr_item(const float* __restrict__ W, int Ns, int scol, int k0, bf16* WT, int K, int dn0, LAS float* scr, int lane) {
    const int sub = lane >> 3, g = lane & 7;
    f32x4 v[8];
#pragma unroll
    for (int i = 0; i < 8; ++i) { const int kk = 8 * i + sub; v[i] = (f32x4){0.f, 0.f, 0.f, 0.f}; if (scol >= 0) v[i] = *(const f32x4*)(W + (size_t)(k0 + kk) * Ns + scol); }
#pragma unroll
    for (int i = 0; i < 8; ++i) { const int kk = 8 * i + sub; LAS float* s = scr + kk * 33 + 4 * g; s[0] = v[i][0]; s[1] = v[i][1]; s[2] = v[i][2]; s[3] = v[i][3]; }
    LDS_WAIT(); asm volatile("" ::: "memory");
    const int c = lane & 7;
#pragma unroll
    for (int j = 0; j < 4; ++j) { const int n = (lane >> 3) + 8 * j; const LAS float* s = scr + (8 * c) * 33 + n;
        v4u o; o.x = pk2(s[0 * 33], s[1 * 33]); o.y = pk2(s[2 * 33], s[3 * 33]); o.z = pk2(s[4 * 33], s[5 * 33]); o.w = pk2(s[6 * 33], s[7 * 33]);
        *(v4u*)(WT + (size_t)(dn0 + n) * K + k0 + 8 * c) = o; }
    LDS_WAIT(); asm volatile("" ::: "memory");
}
constexpr int I_IN = 64 * (NP / 32), I_OUT = 64 * (DM / 32), I_GU = 64 * (NGU / 32), I_DN = (FFN / 64) * (DM / 32), I_LAYER = I_IN + I_OUT + I_GU + I_DN;

__device__ __forceinline__ void rms_row_to_bf16(const float* xrow, const float* gain, bf16* orow, int lane) {
    f32x4 a[8], b[8]; float ss = 0.f;
#pragma unroll
    for (int j = 0; j < 8; ++j) { const float* p = xrow + 512 * j + 8 * lane; a[j] = *(const f32x4*)p; b[j] = *(const f32x4*)(p + 4);
        ss += (a[j][0] * a[j][0] + a[j][1] * a[j][1]) + (a[j][2] * a[j][2] + a[j][3] * a[j][3]) + (b[j][0] * b[j][0] + b[j][1] * b[j][1]) + (b[j][2] * b[j][2] + b[j][3] * b[j][3]); }
    const float r = 1.0f / sqrtf(wave_sum(ss) * (1.0f / DM) + RMS_EPS);
#pragma unroll
    for (int j = 0; j < 8; ++j) { const float* gp = gain + 512 * j + 8 * lane; const f32x4 g0 = *(const f32x4*)gp, g1 = *(const f32x4*)(gp + 4);
        v4u o; o.x = pk2(a[j][0] * r * g0[0], a[j][1] * r * g0[1]); o.y = pk2(a[j][2] * r * g0[2], a[j][3] * r * g0[3]);
        o.z = pk2(b[j][0] * r * g1[0], b[j][1] * r * g1[1]); o.w = pk2(b[j][2] * r * g1[2], b[j][3] * r * g1[3]);
        *(v4u*)(orow + 512 * j + 8 * lane) = o; }
}
__device__ __forceinline__ void resid_norm_row(const float* base_row, const bf16* yrow, const float* ssrow, const float* gpost, float* out_row, const float* gnext, bf16* xn_row, int lane) {
    const float ry = 1.0f / sqrtf(wave_sum(ssrow[lane]) * (1.0f / DM) + RMS_EPS);
    f32x4 a[8], b[8]; float ss = 0.f;
#pragma unroll
    for (int j = 0; j < 8; ++j) { const int c = 512 * j + 8 * lane; const v4u yw = *(const v4u*)(yrow + c);
        const f32x4 x0 = *(const f32x4*)(base_row + c), x1 = *(const f32x4*)(base_row + c + 4), g0 = *(const f32x4*)(gpost + c), g1 = *(const f32x4*)(gpost + c + 4);
        a[j][0] = x0[0] + bflo(yw.x) * ry * g0[0]; a[j][1] = x0[1] + bfhi(yw.x) * ry * g0[1]; a[j][2] = x0[2] + bflo(yw.y) * ry * g0[2]; a[j][3] = x0[3] + bfhi(yw.y) * ry * g0[3];
        b[j][0] = x1[0] + bflo(yw.z) * ry * g1[0]; b[j][1] = x1[1] + bfhi(yw.z) * ry * g1[1]; b[j][2] = x1[2] + bflo(yw.w) * ry * g1[2]; b[j][3] = x1[3] + bfhi(yw.w) * ry * g1[3];
        *(f32x4*)(out_row + c) = a[j]; *(f32x4*)(out_row + c + 4) = b[j];
        ss += (a[j][0] * a[j][0] + a[j][1] * a[j][1]) + (a[j][2] * a[j][2] + a[j][3] * a[j][3]) + (b[j][0] * b[j][0] + b[j][1] * b[j][1]) + (b[j][2] * b[j][2] + b[j][3] * b[j][3]); }
    if (gnext) {
        const float r = 1.0f / sqrtf(wave_sum(ss) * (1.0f / DM) + RMS_EPS);
#pragma unroll
        for (int j = 0; j < 8; ++j) { const float* gp = gnext + 512 * j + 8 * lane; const f32x4 g0 = *(const f32x4*)gp, g1 = *(const f32x4*)(gp + 4);
            v4u o; o.x = pk2(a[j][0] * r * g0[0], a[j][1] * r * g0[1]); o.y = pk2(a[j][2] * r * g0[2], a[j][3] * r * g0[3]);
            o.z = pk2(b[j][0] * r * g1[0], b[j][1] * r * g1[1]); o.w = pk2(b[j][2] * r * g1[2], b[j][3] * r * g1[3]);
            *(v4u*)(xn_row + 512 * j + 8 * lane) = o; }
    }
}

__device__ __forceinline__ void convert_weights(ArgsP ap0, LAS unsigned char* lds, int l) {
    const Ptrs P = fresh_ptrs(ap0); const ArgsP A = P.ap;
    LAS float* scr = (LAS float*)(lds + P.wave * 16384);
    const int g = P.lane & 7;
    bf16* wl = (bf16*)(A->ws + WS_W);
    for (int it = P.gw; it < I_LAYER; it += P.NGW) {
        int r = it;
        if (r < I_IN) { const int kb = r / (NP / 32), nb = r % (NP / 32);
            tr_item(A->in[I_WIN] + (size_t)l * DM * PROJ_SRC, PROJ_SRC, win_src4(32 * nb + 4 * g), 64 * kb, (bf16*)((unsigned char*)wl + WO_IN), DM, 32 * nb, scr, P.lane); continue; }
        r -= I_IN;
        if (r < I_OUT) { const int kb = r / (DM / 32), nb = r % (DM / 32);
            tr_item(A->in[I_WOUT] + (size_t)l * DM * DM, DM, 32 * nb + 4 * g, 64 * kb, (bf16*)((unsigned char*)wl + WO_OUT), DM, 32 * nb, scr, P.lane); continue; }
        r -= I_OUT;
        if (r < I_GU) { const int kb = r / (NGU / 32), nb = r % (NGU / 32), dn0 = 32 * nb, j = dn0 >> 8, w = dn0 & 255;
            const float* src = (w < 128 ? A->in[I_WGATE] : A->in[I_WUP]) + (size_t)l * DM * FFN;
            tr_item(src, FFN, 128 * j + (w & 127) + 4 * g, 64 * kb, (bf16*)((unsigned char*)wl + WO_GU), DM, dn0, scr, P.lane); continue; }
        r -= I_GU;
        { const int kb = r / (DM / 32), nb = r % (DM / 32);
            tr_item(A->in[I_WDOWN] + (size_t)l * FFN * DM, DM, 32 * nb + 4 * g, 64 * kb, (bf16*)((unsigned char*)wl + WO_DN), FFN, 32 * nb, scr, P.lane); }
    }
}
__device__ __forceinline__ void p0_prologue(ArgsP ap0, LAS unsigned char* lds) {
    convert_weights(ap0, lds, 0);
    const Ptrs P = fresh_ptrs(ap0); const ArgsP A = P.ap;
    bf16* XN = (bf16*)(A->ws + WS_XN);
    for (int m = P.gw; m < M; m += P.NGW) rms_row_to_bf16(A->in[I_X] + (size_t)m * DM, A->in[I_MIXPRE], XN + (size_t)m * DM, P.lane);
}

__device__ __forceinline__ void p2_prep(ArgsP ap0, int l) {
    const Ptrs P = fresh_ptrs(ap0); const ArgsP A = P.ap;
    const bf16* PROJ = (const bf16*)(A->ws + WS_PROJ); const float* SB = (const float*)(A->ws + WS_SB);
    bf16* MIX = (bf16*)(A->ws + WS_MIX); float* FG = (float*)(A->ws + WS_FG);
    const int lane = P.lane;
    if (P.gw < BATCH * FOXH) {
        const int bh = P.gw, b = bh / FOXH, h = bh % FOXH; const float fb = A->in[I_FOXFB][l * FOXH + h];
        const float* sb = SB + (size_t)(b * SEQ) * SBW + SB_FF + h;
        float loc = 0.f;
        for (int i = 0; i < 128; ++i) loc += logsigmoid_f(sb[(size_t)(lane * 128 + i) * SBW] + fb);
        float incl = loc;
#pragma unroll
        for (int o = 1; o < 64; o <<= 1) { const float n = __shfl_up(incl, o); if (lane >= o) incl += n; }
        float run = incl - loc;
        for (int i = 0; i < 128; ++i) { const int t = lane * 128 + i; run += logsigmoid_f(sb[(size_t)t * SBW] + fb); FG[(size_t)bh * SEQ + t] = -run * 11.313708498984761f; }
    }
    { const float* cw = A->in[I_SCW] + (size_t)l * 3 * SCW;
      for (int idx = P.bid * 512 + P.tid; idx < M * (SCW / 8); idx += P.G * 512) {
        const int m = idx >> 7, c = (idx & 127) * 8, tp = m & (SEQ - 1);
        const bf16* row = PROJ + (size_t)m * NP;
        const v4u bw = *(const v4u*)(row + PC_SB + c);
        float acc[8];
#pragma unroll
        for (int e = 0; e < 8; ++e) acc[e] = 0.f;
#pragma unroll
        for (int j = 0; j < 3; ++j) { const int dt = 2 - j;
            if (tp - dt >= 0) { const bf16* rj = row - (size_t)dt * NP; const v4u cwv = *(const v4u*)(rj + PC_SC + c), hw = *(const v4u*)(rj + PC_SH + c);
                const f32x4 w0 = *(const f32x4*)(cw + j * SCW + c), w1 = *(const f32x4*)(cw + j * SCW + c + 4);
                acc[0] += w0[0] * bflo(cwv.x) * bflo(hw.x); acc[1] += w0[1] * bfhi(cwv.x) * bfhi(hw.x); acc[2] += w0[2] * bflo(cwv.y) * bflo(hw.y); acc[3] += w0[3] * bfhi(cwv.y) * bfhi(hw.y);
                acc[4] += w1[0] * bflo(cwv.z) * bflo(hw.z); acc[5] += w1[1] * bfhi(cwv.z) * bfhi(hw.z); acc[6] += w1[2] * bflo(cwv.w) * bflo(hw.w); acc[7] += w1[3] * bfhi(cwv.w) * bfhi(hw.w); } }
        v4u o; o.x = pk2(acc[0] * bflo(bw.x), acc[1] * bfhi(bw.x)); o.y = pk2(acc[2] * bflo(bw.y), acc[3] * bfhi(bw.y)); o.z = pk2(acc[4] * bflo(bw.z), acc[5] * bfhi(bw.z)); o.w = pk2(acc[6] * bflo(bw.w), acc[7] * bfhi(bw.w));
        *(v4u*)(MIX + (size_t)m * DM + FOXW + c) = o; } }
#if GDN_BASELINE
    { const float* cw = A->in[I_GDNCW] + (size_t)l * 4 * (3 * GDNW);
      float* GQ = (float*)(A->ws + WS_GQ); float* GK = (float*)(A->ws + WS_GK); float* GV = (float*)(A->ws + WS_GV);
      for (int it = P.gw; it < M * GDNH; it += P.NGW) {
        const int m = it / GDNH, h = it % GDNH, tp = m & (SEQ - 1), ch = h * HD + 2 * lane;
        float y[3][2];
#pragma unroll
        for (int part = 0; part < 3; ++part) { float a0 = 0.f, a1 = 0.f;
#pragma unroll
            for (int j = 0; j < 4; ++j) { const int dt = 3 - j;
                if (tp - dt >= 0) { const unsigned xw = *(const unsigned*)(PROJ + (size_t)(m - dt) * NP + PC_GQ + part * GDNW + ch);
                    const float* wp = cw + j * (3 * GDNW) + part * GDNW + ch; a0 += wp[0] * bflo(xw); a1 += wp[1] * bfhi(xw); } }
            y[part][0] = silu_acc(a0); y[part][1] = silu_acc(a1); }
        const float rq = 1.0f / sqrtf(wave_sum(y[0][0] * y[0][0] + y[0][1] * y[0][1]) + RMS_EPS) * 0.08838834764831845f;
        const float rk = 1.0f / sqrtf(wave_sum(y[1][0] * y[1][0] + y[1][1] * y[1][1]) + RMS_EPS);
        typedef float f32x2 __attribute__((ext_vector_type(2)));
        *(f32x2*)(GQ + (size_t)m * GDNW + ch) = (f32x2){y[0][0] * rq, y[0][1] * rq};
        *(f32x2*)(GK + (size_t)m * GDNW + ch) = (f32x2){y[1][0] * rk, y[1][1] * rk};
        *(f32x2*)(GV + (size_t)m * GDNW + ch) = (f32x2){y[2][0], y[2][1]}; } }
#endif
}

#if GDN_BASELINE
__device__ __forceinline__ void gdn_seq(ArgsP ap0, int l, char* lds) {
    const Ptrs P = fresh_ptrs(ap0); const ArgsP A = P.ap; const int bh = P.bid;
    const int b = bh / GDNH, h = bh % GDNH, tid = P.tid;
    const float* GQ = (const float*)(A->ws + WS_GQ); const float* GK = (const float*)(A->ws + WS_GK); const float* GV = (const float*)(A->ws + WS_GV);
    float* GO = (float*)(A->ws + WS_GO); const float* SB = (const float*)(A->ws + WS_SB);
    float* Qs = (float*)lds; float* Ks = Qs + 64 * 128;
    const float nA = -__expf(A->in[I_GDNALOG][l * GDNH + h]), dtb = A->in[I_GDNDTB][l * GDNH + h];
    float S[128];
#pragma unroll
    for (int i = 0; i < 128; ++i) S[i] = 0.f;
    for (int c0 = 0; c0 < SEQ; c0 += 64) {
        __syncthreads();
        for (int e = tid; e < 64 * 32; e += 512) { const int t = e >> 5, c4 = (e & 31) * 4; const size_t off = (size_t)(b * SEQ + c0 + t) * GDNW + h * HD + c4;
            *(f32x4*)(Qs + t * 128 + c4) = *(const f32x4*)(GQ + off); *(f32x4*)(Ks + t * 128 + c4) = *(const f32x4*)(GK + off); }
        __syncthreads();
        if (tid < 128) {
            for (int t = 0; t < 64; ++t) {
                const size_t m = (size_t)(b * SEQ + c0 + t);
                const float v = GV[m * GDNW + h * HD + tid];
                const float beta = sigmoid_f(SB[m * SBW + SB_GB + h]);
                const float alpha = __expf(nA * softplus_f(SB[m * SBW + SB_GA + h] + dtb));
                float kS = 0.f;
#pragma unroll
                for (int i4 = 0; i4 < 32; ++i4) { const f32x4 kk = *(const f32x4*)(Ks + t * 128 + 4 * i4);
                    kS += kk[0] * S[4 * i4] + kk[1] * S[4 * i4 + 1] + kk[2] * S[4 * i4 + 2] + kk[3] * S[4 * i4 + 3];
                    if ((i4 & 3) == 3) __builtin_amdgcn_sched_barrier(0); }
                const float d = beta * (v - alpha * kS);
                float o = 0.f;
#pragma unroll
                for (int i4 = 0; i4 < 32; ++i4) { const f32x4 kk = *(const f32x4*)(Ks + t * 128 + 4 * i4), qq = *(const f32x4*)(Qs + t * 128 + 4 * i4);
#pragma unroll
                    for (int e = 0; e < 4; ++e) { S[4 * i4 + e] = alpha * S[4 * i4 + e] + kk[e] * d; o += qq[e] * S[4 * i4 + e]; }
                    if ((i4 & 3) == 3) __builtin_amdgcn_sched_barrier(0); }
                GO[m * GDNW + h * HD + tid] = o;
            }
        }
    }
    __syncthreads();
}
#endif

__device__ __forceinline__ void p4_finalize(ArgsP ap0, int l) {
    const Ptrs P = fresh_ptrs(ap0); const ArgsP A = P.ap;
    const float* AO = (const float*)(A->ws + WS_AO); const float* GO = (const float*)(A->ws + WS_GO); const bf16* PROJ = (const bf16*)(A->ws + WS_PROJ);
    bf16* MIX = (bf16*)(A->ws + WS_MIX); const int lane = P.lane;
    typedef float f32x2 __attribute__((ext_vector_type(2)));
    const f32x2 gf = *(const f32x2*)(A->in[I_FOXON] + l * HD + 2 * lane), gg = *(const f32x2*)(A->in[I_GDNON] + l * HD + 2 * lane);
    for (int it = P.gw; it < 2 * M * FOXH; it += P.NGW) {
        const int which = it >= M * FOXH, r = which ? it - M * FOXH : it, m = r / FOXH, h = r % FOXH, ch = h * HD + 2 * lane;
        if (!which) { const f32x2 v = *(const f32x2*)(AO + (size_t)m * FOXW + ch);
            const float rr = 1.0f / sqrtf(wave_sum(v[0] * v[0] + v[1] * v[1]) * (1.0f / HD) + RMS_EPS);
            *(unsigned*)(MIX + (size_t)m * DM + ch) = pk2(v[0] * rr * gf[0], v[1] * rr * gf[1]); }
        else { const f32x2 v = *(const f32x2*)(GO + (size_t)m * GDNW + ch); const unsigned zw = *(const unsigned*)(PROJ + (size_t)m * NP + PC_GZ + ch);
            const float rr = 1.0f / sqrtf(wave_sum(v[0] * v[0] + v[1] * v[1]) * (1.0f / HD) + RMS_EPS);
            *(unsigned*)(MIX + (size_t)m * DM + FOXW + SCW + ch) = pk2(v[0] * rr * gg[0] * silu_acc(bflo(zw)), v[1] * rr * gg[1] * silu_acc(bfhi(zw))); }
    }
}

__device__ __forceinline__ attn::BlockRef<attn::bf16, float> fox_ref(ArgsP A, int bh, int qb) {
    const int b = bh / FOXH, h = bh % FOXH; const size_t row0 = (size_t)b * SEQ;
    const attn::bf16* PROJ = (const attn::bf16*)(A->ws + WS_PROJ);
    attn::BlockRef<attn::bf16, float> r;
    r.Q = PROJ + (row0 + (size_t)qb * attn::QB) * NP + PC_FQ + h * HD;
    r.K = PROJ + row0 * NP + PC_FK + h * HD; r.V = PROJ + row0 * NP + PC_FV + h * HD;
    r.F = (const float*)(A->ws + WS_FG) + (size_t)bh * SEQ;
    r.O = (float*)(A->ws + WS_AO) + (row0 + (size_t)qb * attn::QB) * FOXW + h * HD; r.P0 = qb * attn::QB;
    return r;
}
__device__ __forceinline__ void p3_attention(ArgsP ap0, char* lds, int first, int n) {
    const ArgsP A = fresh(ap0);
    constexpr int NQB = SEQ / attn::QB, NX = NQB / 2, TOTAL = BATCH * FOXH * NX;
    int L = fbid() - first; if (L < 0 || L >= n || L >= TOTAL) return;
    int bh = L / NX, x = L % NX, pass = 0;
    attn::BlockRef<attn::bf16, float> cur = fox_ref(A, bh, x);
    attn::Seam<attn::bf16> S;
    attn::causal_swa_prime<attn::bf16, float>(cur, SEQ, lds, S);
    for (;;) {
        const bool more_pass = pass == 0, more_item = L + n < TOTAL, last = !more_pass && !more_item;
        int bhn = bh, xn = x, passn = pass + 1, Ln = L;
        if (!more_pass) { passn = 0; Ln = more_item ? L + n : L; bhn = Ln / NX; xn = Ln % NX; }
        const attn::BlockRef<attn::bf16, float> nxt = last ? cur : fox_ref(A, bhn, passn ? NQB - 1 - xn : xn);
        attn::causal_swa_block<attn::bf16, float>(cur, nxt, SEQ, SEQ, lds, S);
        if (last) break;
        cur = nxt; bh = bhn; x = xn; pass = passn; L = Ln;
    }
}

constexpr int N_PHASES = 1 + 9 * DEPTH;

#ifndef PH_EN
#define PH_EN 0x3ff
#endif
#define IN(k) (lo <= (k) && (k) < hi)
#define EN(j) ((PH_EN >> (j)) & 1)
#define SEAM(k) do { if (IN(k) && IN((k) + 1)) { XcdBarrier b_; b_.bar = (unsigned*)(fresh(ap0)->ws + WS_CTL) + CW_BAR; b_.x = xb_xcc_id(); b_.st = (volatile LAS unsigned*)((LAS unsigned char*)lds + MISC_OFF) + 8; xcd_barrier(b_); } } while (0)
#define WSP(T, off) ((T*)(A->ws + (off)))


template <int l>
__device__ __forceinline__ void layer_phases(ArgsP ap0, LAS unsigned char* ldsl, unsigned char* lds, int lo, int hi) {

        const int pb = 1 + 9 * l;
        if (EN(1) && IN(pb + 0)) {
            const Ptrs P = fresh_ptrs(ap0); const ArgsP A = P.ap;
            pg8::Gemm g{WSP(bf16, WS_XN), WSP(bf16, WS_W + WO_IN), M, NP, DM}; pg8::StaticOrder S; S.init(M, NP, P.G, P.bid);
            pg8::EpiProj E{WSP(bf16, WS_PROJ), WSP(float, WS_SB)};
            pg8::gemm_phase<pg8::EpiProj, pg8::StaticOrder, true, true>(ldsl, g, S, E);
            SEAM(pb + 0);
        }
        if (EN(2) && IN(pb + 1)) { p2_prep(ap0, l); SEAM(pb + 1); }
        if (EN(3) && IN(pb + 2)) {
#if GDN_BASELINE
            if ((int)blockIdx.x < BATCH * GDNH) gdn_seq(ap0, l, (char*)lds);
            else p3_attention(ap0, (char*)lds, BATCH * GDNH, (int)gridDim.x - BATCH * GDNH);
#endif
            SEAM(pb + 2);
        }
        if (EN(4) && IN(pb + 3)) { p4_finalize(ap0, l); SEAM(pb + 3); }
        if (EN(5) && IN(pb + 4)) {
            const Ptrs P = fresh_ptrs(ap0); const ArgsP A = P.ap;
            pg8::Gemm g{WSP(bf16, WS_MIX), WSP(bf16, WS_W + WO_OUT), M, DM, DM}; pg8::StaticOrder S; S.init(M, DM, P.G, P.bid);
            pg8::EpiY E{WSP(bf16, WS_Y), WSP(float, WS_SS)};
            pg8::gemm_phase<pg8::EpiY, pg8::StaticOrder, true, true>(ldsl, g, S, E);
            SEAM(pb + 4);
        }
        if (EN(6) && IN(pb + 5)) {
            const Ptrs P = fresh_ptrs(ap0); const ArgsP A = P.ap;
            const float* xin = l == 0 ? A->in[I_X] : (const float*)A->out;
            const float* gpost = A->in[I_MIXPOST] + l * DM; const float* gpre = A->in[I_FFNPRE] + l * DM;
            const bf16* Y = WSP(bf16, WS_Y); const float* SS = WSP(float, WS_SS); float* H = WSP(float, WS_H); bf16* XN = WSP(bf16, WS_XN);
            for (int m = P.gw; m < M; m += P.NGW)
                resid_norm_row(xin + (size_t)m * DM, Y + (size_t)m * DM, SS + (size_t)m * 64, gpost, H + (size_t)m * DM, gpre, XN + (size_t)m * DM, P.lane);
            SEAM(pb + 5);
        }
        if (EN(7) && IN(pb + 6)) {
            const Ptrs P = fresh_ptrs(ap0); const ArgsP A = P.ap;
            pg8::Gemm g{WSP(bf16, WS_XN), WSP(bf16, WS_W + WO_GU), M, NGU, DM}; pg8::StaticOrder S; S.init(M, NGU, P.G, P.bid);
            pg8::EpiSwiGLU E{WSP(bf16, WS_PROJ)};
            pg8::gemm_phase<pg8::EpiSwiGLU, pg8::StaticOrder, true, true>(ldsl, g, S, E);
            SEAM(pb + 6);
        }
        if (EN(8) && IN(pb + 7)) {
            const Ptrs P = fresh_ptrs(ap0); const ArgsP A = P.ap;
            pg8::Gemm g{WSP(bf16, WS_PROJ), WSP(bf16, WS_W + WO_DN), M, DM, FFN}; pg8::StaticOrder S; S.init(M, DM, P.G, P.bid);
            pg8::EpiY E{WSP(bf16, WS_Y), WSP(float, WS_SS)};
            pg8::gemm_phase<pg8::EpiY, pg8::StaticOrder, true, true>(ldsl, g, S, E);
            SEAM(pb + 7);
        }
        if (EN(9) && IN(pb + 8)) {
            const Ptrs P = fresh_ptrs(ap0); const ArgsP A = P.ap;
            const float* gnext = l + 1 < DEPTH ? A->in[I_MIXPRE] + (l + 1) * DM : nullptr; const float* gpost = A->in[I_FFNPOST] + l * DM;
            const bf16* Y = WSP(bf16, WS_Y); const float* SS = WSP(float, WS_SS); const float* H = WSP(float, WS_H); bf16* XN = WSP(bf16, WS_XN); float* outp = A->out;
            for (int m = P.gw; m < M; m += P.NGW)
                resid_norm_row(H + (size_t)m * DM, Y + (size_t)m * DM, SS + (size_t)m * 64, gpost, outp + (size_t)m * DM, gnext, XN + (size_t)m * DM, P.lane);
            if (l + 1 < DEPTH) convert_weights(ap0, ldsl, l + 1);
            SEAM(pb + 8);
        }
    }

__global__ void __launch_bounds__(NWAVES * 64, 2) hybrid_fwd(Args args) {
    extern __shared__ __attribute__((aligned(16))) unsigned char lds[];
    LAS unsigned char* ldsl = (LAS unsigned char*)lds;
    volatile LAS unsigned* MISC = (volatile LAS unsigned*)(ldsl + MISC_OFF);
    const ArgsP ap0 = (ArgsP)__builtin_amdgcn_kernarg_segment_ptr();
    for (int u = threadIdx.x; u < (LDS_BYTES - LDSCTL_OFF) / 4; u += NWAVES * 64) ((LAS unsigned*)(ldsl + LDSCTL_OFF))[u] = 0u;
    __syncthreads();
    const int lo = args.ph_lo, hi = args.ph_hi;
    if (hi - lo > 1) (void)xcd_barrier_post((unsigned*)(args.ws + WS_CTL) + CW_BAR, MISC + 8);
    if (EN(0) && IN(0)) { p0_prologue(ap0, ldsl); SEAM(0); }
    layer_phases<0>(ap0, ldsl, lds, lo, hi);
    layer_phases<1>(ap0, ldsl, lds, lo, hi);
}

#undef IN
#undef SEAM
extern "C" void kernel_launch(void* const* d_in, const int* in_sizes, int n_in, void* d_out, int out_size, void* d_ws, size_t ws_size, hipStream_t stream) {
    static int grid = 0;
    if (grid == 0) {
        if (n_in != 17 || in_sizes[0] != M * DM || out_size != M * DM || ws_size < WS_END) {
            fprintf(stderr, "kernel_launch: shape/workspace mismatch: n_in %d in0 %d out %d ws %zu (need %zu)\n", n_in, n_in > 0 ? in_sizes[0] : -1, out_size, ws_size, (size_t)WS_END); grid = -1; return; }
        int dev = 0, cus = 0, per_cu = 0;
        if (hipGetDevice(&dev) != hipSuccess || hipDeviceGetAttribute(&cus, hipDeviceAttributeMultiprocessorCount, dev) != hipSuccess) { fprintf(stderr, "kernel_launch: device query failed\n"); grid = -1; return; }
        if (hipFuncSetAttribute((const void*)hybrid_fwd, hipFuncAttributeMaxDynamicSharedMemorySize, LDS_BYTES) != hipSuccess) { fprintf(stderr, "kernel_launch: hipFuncSetAttribute failed\n"); grid = -1; return; }
        if (hipOccupancyMaxActiveBlocksPerMultiprocessor(&per_cu, (const void*)hybrid_fwd, NWAVES * 64, LDS_BYTES) != hipSuccess || per_cu < 1)
            fprintf(stderr, "kernel_launch: note: occupancy query reports %d workgroups per CU\n", per_cu);
        (void)hipGetLastError();
        grid = cus;
    }
    if (grid < 0) return;
    if (hipMemsetAsync((char*)d_ws + WS_CTL, 0, CTL_ZERO_BYTES, stream) != hipSuccess) { fprintf(stderr, "kernel_launch: memset failed\n"); return; }
    Args a{};
    for (int i = 0; i < 17; ++i) a.in[i] = (const float*)d_in[i];
    a.out = (float*)d_out; a.ws = (unsigned char*)d_ws;
#if MK_N_LAUNCHES == 1
    a.ph_lo = 0; a.ph_hi = N_PHASES;
    hipLaunchKernelGGL(hybrid_fwd, dim3(grid), dim3(NWAVES * 64), LDS_BYTES, stream, a);
#else
    for (int p = 0; p < N_PHASES; ++p) { a.ph_lo = p; a.ph_hi = p + 1; hipLaunchKernelGGL(hybrid_fwd, dim3(grid), dim3(NWAVES * 64), LDS_BYTES, stream, a); }
#endif
    const hipError_t le = hipPeekAtLastError();
    if (le != hipSuccess) fprintf(stderr, "kernel_launch: launch failed: %s\n", hipGetErrorName(le));
}
```

```cpp
#include <hip/hip_runtime.h>
#include <hip/hip_bf16.h>
#include <cstdio>
#include <cstdint>
#include <cmath>

#ifndef MK_N_LAUNCHES
#define MK_N_LAUNCHES 1
#endif

constexpr int BATCH = 2, SEQ = 8192, DM = 4096, M = BATCH * SEQ, DEPTH = 2;
constexpr int HD = 128, FOXH = 12, FOXW = FOXH * HD, SCW = 1024, GDNH = 12, GDNW = GDNH * HD;
constexpr int PROJ_SRC = 13860;
constexpr int NP = 14080;
constexpr int FFN = 11008, NGU = 2 * FFN;
constexpr float RMS_EPS = 1e-6f;
constexpr int PC_FQ = 0, PC_FK = 1536, PC_FV = 3072, PC_SB = 4608, PC_SC = 5632, PC_SH = 6656, PC_GQ = 7680, PC_GK = 9216, PC_GV = 10752, PC_GZ = 12288, PC_SMALL = 13824;
constexpr int SBW = 64, SB_FF = 0, SB_GA = 12, SB_GB = 24;
constexpr int SRC_FF = 4608, SRC_SB = 4620, SRC_GQ = 7692, SRC_GA = 12300, SRC_GB = 12312, SRC_GZ = 12324;

constexpr size_t MiB = 1u << 20;
constexpr size_t WS_CTL = 0, CTL_ZERO_BYTES = 1 * MiB;
constexpr size_t WS_W = 16 * MiB;
constexpr size_t WO_IN = 0, WO_OUT = 110 * MiB, WO_GU = 142 * MiB, WO_DN = 314 * MiB;
constexpr size_t WS_XN = 416 * MiB;
constexpr size_t WS_MIX = 544 * MiB;
constexpr size_t WS_Y = 672 * MiB;
constexpr size_t WS_H = 800 * MiB;
constexpr size_t WS_PROJ = 1056 * MiB;
constexpr size_t WS_SCB = WS_PROJ + 336 * MiB;
constexpr int HM_FQ = 0, HM_FK = 1, HM_FV = 2, HM_GQ = 3, HM_GZ = 6, SCBW = 3 * SCW;
__host__ __device__ constexpr size_t hm_off(int part, int bh) { return ((size_t)(part * (BATCH * FOXH) + bh) * SEQ) * HD; }
constexpr size_t WS_SB = 1496 * MiB;
constexpr size_t WS_SS = 1500 * MiB;
constexpr size_t WS_FG = 1504 * MiB;
constexpr size_t WS_END = 1506 * MiB;
constexpr size_t WS_AO = WS_XN;
constexpr size_t WS_GQ = WS_Y, WS_GK = WS_Y + 96 * MiB, WS_GV = WS_Y + 192 * MiB, WS_GO = WS_Y + 288 * MiB;
constexpr int CW_TMO = 0, CW_BAR = 4096, CW_Q = 16384, CW_NRM = 32768;

constexpr int NWAVES = 8;
constexpr int RING_BYTES = 131072, LDSCTL_OFF = RING_BYTES, MISC_OFF = LDSCTL_OFF + 320, LDS_BYTES = 147456;


extern __shared__ __attribute__((aligned(16))) unsigned char g_lds[];
constexpr int TIDTAB_OFF = LDSCTL_OFF + 512;
__device__ __forceinline__ unsigned hw_slot() { return (unsigned)__builtin_amdgcn_s_getreg((5 << 11) | 4) & 63u; }
__device__ __forceinline__ int my_lane() { int l; asm volatile("v_mbcnt_lo_u32_b32 %0, -1, 0\n\tv_mbcnt_hi_u32_b32 %0, -1, %0" : "=v"(l)); return l; }
__device__ __forceinline__ int my_wave() { return __builtin_amdgcn_readfirstlane(*(volatile __attribute__((address_space(3))) int*)((__attribute__((address_space(3))) unsigned char*)g_lds + TIDTAB_OFF + 4 * hw_slot())); }
__device__ __forceinline__ int my_tid() { return my_wave() * 64 + my_lane(); }

#define GAS __attribute__((address_space(1)))
#define LAS __attribute__((address_space(3)))
typedef unsigned short bf16;
typedef unsigned v4u __attribute__((ext_vector_type(4)));
typedef float f32x4 __attribute__((ext_vector_type(4)));
typedef short bf16x8 __attribute__((ext_vector_type(8)));
typedef GAS unsigned gu32;
typedef GAS unsigned long long gu64;
#define RLX_AGENT __ATOMIC_RELAXED, __HIP_MEMORY_SCOPE_AGENT
#define LDS_WAIT() asm volatile("s_waitcnt lgkmcnt(0)" ::: "memory")
#define VM_WAIT() asm volatile("s_waitcnt vmcnt(0)" ::: "memory")
__device__ __forceinline__ unsigned long long rt() { return __builtin_amdgcn_s_memrealtime(); }
__device__ __forceinline__ unsigned f2bf(float f) { unsigned u = __builtin_bit_cast(unsigned, f); return (u + 0x7fffu + ((u >> 16) & 1u)) >> 16; }
__device__ __forceinline__ unsigned pk2(float lo, float hi) { return f2bf(lo) | (f2bf(hi) << 16); }

#define XB_TMO      128
#define XB_XCNT(j)  (256  + 64 * (j))
#define XB_XSUB(j)  (1280 + 64 * (j))
#define XB_XGEN(j)  (2304 + 64 * (j))
#define XB_TOP      3328
#define XB_TOPGEN   3392
#define XCD_BAR_WORDS 3456
#define XB_SPIN_CAP (1u << 18)

__device__ __forceinline__ unsigned xb_ld(unsigned* p)              { return __hip_atomic_load(p, __ATOMIC_RELAXED, __HIP_MEMORY_SCOPE_AGENT); }
__device__ __forceinline__ unsigned xb_add(unsigned* p, unsigned v) { return __hip_atomic_fetch_add(p, v, __ATOMIC_RELAXED, __HIP_MEMORY_SCOPE_AGENT); }
__device__ __forceinline__ unsigned xb_xcc_id() { return (unsigned)__builtin_amdgcn_s_getreg((3 << 11) | 20) & 0xFu; }
#define XB_SPIN(cond, bar) do { unsigned _sp = 0; while (cond) { __builtin_amdgcn_s_sleep(1); \
    if ((++_sp & 255u) == 0u) { if (xb_ld(&(bar)[XB_TMO])) break; if (_sp > XB_SPIN_CAP) { atomicAdd(&(bar)[XB_TMO], 1u); break; } } } } while (0)

struct XcdBarrier {
    unsigned* bar; unsigned x;
    volatile LAS unsigned* st;
};

__device__ __forceinline__ XcdBarrier xcd_barrier_post(unsigned* bar, volatile LAS unsigned* st) {
    XcdBarrier b; b.bar = bar; b.x = xb_xcc_id(); b.st = st;
    if (my_tid() == 0) (void)xb_add(&bar[XB_XCNT(b.x)], 1u);
    return b;
}
__device__ __forceinline__ void xcd_barrier_complete(unsigned* bar, unsigned x, unsigned& nloc, unsigned& nx) {
    const unsigned G = gridDim.x * gridDim.y * gridDim.z;
    unsigned sum, cnt, mine, sp = 0u;
    for (;;) {
        sum = 0u; cnt = 0u; mine = 0u;
#pragma unroll
        for (unsigned j = 0; j < 16; ++j) { const unsigned c = xb_ld(&bar[XB_XCNT(j)]); sum += c; cnt += (c > 0u) ? 1u : 0u; mine = (j == x) ? c : mine; }
        if (sum == G) break;
        __builtin_amdgcn_s_sleep(1);
        if ((++sp & 255u) == 0u) { if (xb_ld(&bar[XB_TMO])) break; if (sp > XB_SPIN_CAP) { atomicAdd(&bar[XB_TMO], 1u); break; } }
    }
    nloc = mine > 0u ? mine : 1u; nx = cnt > 0u ? cnt : 1u;
}

__device__ __forceinline__ void xcd_barrier(const XcdBarrier& b) {
    asm volatile("s_waitcnt vmcnt(0)" ::: "memory");
    __syncthreads();
    if (my_tid() == 0) {
        unsigned* bar = b.bar;
        __builtin_amdgcn_s_waitcnt(0);
        unsigned nloc = b.st[0], nx = b.st[1];
        if (nloc == 0u) { xcd_barrier_complete(bar, b.x, nloc, nx); b.st[0] = nloc; b.st[1] = nx; }
        const unsigned old = xb_add(&bar[XB_XSUB(b.x)], 1u);
        const unsigned gen = old / nloc;
        if (old + 1u == (gen + 1u) * nloc) {
            __builtin_amdgcn_fence(__ATOMIC_RELEASE, "agent");
            asm volatile("s_waitcnt vmcnt(0)" ::: "memory");
            const unsigned og = xb_add(&bar[XB_TOP], 1u);
            const unsigned tg = og / nx;
            if (og + 1u == (tg + 1u) * nx) xb_add(&bar[XB_TOPGEN], 1u);
            else XB_SPIN(xb_ld(&bar[XB_TOPGEN]) == tg, bar);
            __builtin_amdgcn_fence(__ATOMIC_ACQUIRE, "agent");
            xb_add(&bar[XB_XGEN(b.x)], 1u);
            asm volatile("s_waitcnt vmcnt(0)" ::: "memory");
        } else {
            XB_SPIN(xb_ld(&bar[XB_XGEN(b.x)]) == gen, bar);
            __builtin_amdgcn_fence(__ATOMIC_ACQUIRE, "agent");
            asm volatile("s_waitcnt vmcnt(0)" ::: "memory");
        }
    }
    __syncthreads();
}

namespace pg8 {
#define PG8_LAS __attribute__((address_space(3)))
typedef unsigned short bf16_t;
typedef short bf16x8 __attribute__((ext_vector_type(8)));
typedef float f32x4 __attribute__((ext_vector_type(4)));
typedef unsigned u32x4 __attribute__((ext_vector_type(4)));
constexpr int BM = 256, BK = 64, HALF = 128, HTB = HALF * BK * 2  , STAGE_BYTES = 8 * HTB, NXCD = 8, WGM = 8;

__host__ __device__ __forceinline__ int lds_byte(int r, int c) { const int st = (r >> 4) * 2 + (c >> 5), rr = r & 15, cc = c & 31, ob = rr * 64 + cc * 2; return st * 1024 + (ob ^ (((ob >> 9) & 1) << 5)); }
__host__ __device__ __forceinline__ void stage_rc(int b, int& R, int& C) { const int st = b / 1024, sb = b % 1024, swz = sb ^ (((sb >> 9) & 1) << 5); R = (st >> 1) * 16 + swz / 64; C = (st & 1) * 32 + (swz % 64) / 2; }
__host__ __device__ __forceinline__ int perm32(int rho) { const int n = rho >> 4, i = rho & 15; return 8 * (i >> 2) + 4 * n + (i & 3); }

struct Unit { int pm, pn; };
struct Gemm { const bf16_t* A; const bf16_t* Bt; int M, N, K; };

struct StaticOrder {
    int nM, nN, nwg, G, c;
    __host__ __device__ void init(int M, int N, int G_, int c_) { nM = M / BM; nN = N / BM; nwg = nM * nN; G = G_; c = c_; }
    __host__ __device__ bool next(int i, Unit& u) const {
        const long L = (long)i * G + c; if (L >= nwg) return false;
        int wgid = (int)L; { const int q = nwg / NXCD, r = nwg % NXCD, xcd = wgid % NXCD, off = wgid / NXCD; wgid = (xcd < r ? xcd * (q + 1) : r * (q + 1) + (xcd - r) * q) + off; }
        const int nig = WGM * nN, gid = wgid / nig, fm = gid * WGM, gsz = (nM - fm) < WGM ? (nM - fm) : WGM;
        u.pm = fm + ((wgid % nig) % gsz); u.pn = (wgid % nig) / gsz; return true;
    }
    __device__ __forceinline__ void a_ready(const Unit&) const {}
    __device__ __forceinline__ void done(const Unit&) const {}
};


typedef float f32x2e __attribute__((ext_vector_type(2))); typedef __bf16 bf16x2e __attribute__((ext_vector_type(2)));
__device__ __forceinline__ unsigned cvt_pk_bf16(float lo, float hi) { const f32x2e v = {lo, hi}; const bf16x2e b = __builtin_convertvector(v, bf16x2e); return __builtin_bit_cast(unsigned, b); }
__device__ __forceinline__ u32x4 pack8_bf16(const f32x4 v0, const f32x4 v1) { u32x4 w; w.x = cvt_pk_bf16(v0[0], v0[1]); w.y = cvt_pk_bf16(v0[2], v0[3]); w.z = cvt_pk_bf16(v1[0], v1[1]); w.w = cvt_pk_bf16(v1[2], v1[3]); return w; }

struct EpiProj {
    static constexpr bool PERM = true, AFTER_DRAIN = false;
    bf16_t* HM; bf16_t* SCB; float* SBp;
    __device__ __forceinline__ void operator()(const f32x4 (&acc)[2][2][4][2], const Unit& u, int wr, int wc, int fr, int fq) const {
        const int row0 = u.pm * BM + wr * 64 + fr;
        if (u.pn * BM == PC_SMALL) {
            if (wc < 2) {
#pragma unroll
                for (int ai = 0; ai < 2; ++ai)
#pragma unroll
                    for (int m = 0; m < 4; ++m) { float* rp = SBp + (size_t)(row0 + ai * HALF + m * 16) * SBW + wc * 32 + 8 * fq;
                        *(f32x4*)rp = acc[ai][0][m][0]; *(f32x4*)(rp + 4) = acc[ai][0][m][1]; }
            }
            return;
        }
        const int b = (u.pm * BM) / SEQ, s0 = row0 - b * SEQ;
#pragma unroll
        for (int bj = 0; bj < 2; ++bj) { const int colbase = u.pn * BM + bj * HALF;
            bf16_t* dst; size_t pitch;
            if (colbase >= PC_SB && colbase < PC_GQ) { dst = SCB + (size_t)row0 * SCBW + (colbase - PC_SB) + wc * 32 + 8 * fq; pitch = SCBW; }
            else { const int hc = colbase < PC_SB ? colbase : colbase - (PC_GQ - PC_SB), part = hc / 1536, head = (hc % 1536) / HD;
                   dst = HM + hm_off(part, b * FOXH + head) + (size_t)s0 * HD + wc * 32 + 8 * fq; pitch = HD; }
#pragma unroll
            for (int ai = 0; ai < 2; ++ai)
#pragma unroll
                for (int m = 0; m < 4; ++m) *(u32x4*)(dst + (size_t)(ai * HALF + m * 16) * pitch) = pack8_bf16(acc[ai][bj][m][0], acc[ai][bj][m][1]); }
    }
};
struct EpiY {
    static constexpr bool PERM = true, AFTER_DRAIN = false;
    bf16_t* Y; float* SS;
    __device__ __forceinline__ void operator()(const f32x4 (&acc)[2][2][4][2], const Unit& u, int wr, int wc, int fr, int fq) const {
        const int row0 = u.pm * BM + wr * 64 + fr, col0 = u.pn * BM + wc * 32 + 8 * fq;
#pragma unroll
        for (int ai = 0; ai < 2; ++ai)
#pragma unroll
            for (int m = 0; m < 4; ++m) { const int row = row0 + ai * HALF + m * 16; bf16_t* rowp = Y + (size_t)row * DM + col0; float s = 0.f;
#pragma unroll
                for (int bj = 0; bj < 2; ++bj) { const f32x4 a = acc[ai][bj][m][0], b = acc[ai][bj][m][1];
                    s += (a[0] * a[0] + a[1] * a[1]) + (a[2] * a[2] + a[3] * a[3]) + (b[0] * b[0] + b[1] * b[1]) + (b[2] * b[2] + b[3] * b[3]);
                    *(u32x4*)(rowp + bj * HALF) = pack8_bf16(a, b); }
                s += __shfl_xor(s, 16); s += __shfl_xor(s, 32);
                if (fq == 0) SS[(size_t)row * 64 + u.pn * 4 + wc] = s; }
    }
};
__device__ __forceinline__ float silu_f(float x) { return x * __builtin_amdgcn_rcpf(1.0f + __builtin_amdgcn_exp2f(-1.4426950408889634f * x)); }
struct EpiSwiGLU {
    static constexpr bool PERM = true, AFTER_DRAIN = false;
    bf16_t* Hd;
    __device__ __forceinline__ void operator()(const f32x4 (&acc)[2][2][4][2], const Unit& u, int wr, int wc, int fr, int fq) const {
        const int row0 = u.pm * BM + wr * 64 + fr, col0 = u.pn * HALF + wc * 32 + 8 * fq;
#pragma unroll
        for (int ai = 0; ai < 2; ++ai)
#pragma unroll
            for (int m = 0; m < 4; ++m) { const f32x4 g0 = acc[ai][0][m][0], g1 = acc[ai][0][m][1], u0 = acc[ai][1][m][0], u1 = acc[ai][1][m][1]; f32x4 h0, h1;
#pragma unroll
                for (int e = 0; e < 4; ++e) { h0[e] = silu_f(g0[e]) * u0[e]; h1[e] = silu_f(g1[e]) * u1[e]; }
                *(u32x4*)(Hd + (size_t)(row0 + ai * HALF + m * 16) * FFN + col0) = pack8_bf16(h0, h1); }
    }
};
template <class Epi, class Sched, bool ALIGN_EPI = false, bool SP2 = false>
__device__ __forceinline__ void gemm_phase(PG8_LAS unsigned char* lds, const Gemm g, const Sched& S, const Epi& E) {
    int tid_ = my_tid(); asm volatile("" : "+v"(tid_));
    const int tid = tid_, wid = __builtin_amdgcn_readfirstlane(tid >> 6), lane = tid & 63, wr = wid >> 2, wc = wid & 3, fr = lane & 15, fq = lane >> 4;
    const int K = g.K, nt = K / BK;
    unsigned voffA[2], voffB[2];
#pragma unroll
    for (int i = 0; i < 2; ++i) { int R, C; stage_rc(tid * 16 + i * 8192, R, C); const int Rb = Epi::PERM ? ((R & ~31) + perm32(R & 31)) : R;
        voffA[i] = (unsigned)(R * K + C) * 2u; voffB[i] = (unsigned)(Rb * K + C) * 2u; }
    const size_t kstep = (size_t)(BK * 2);
    const size_t hstep = (size_t)HALF * K * 2;
    const size_t tstep = 2 * hstep;
    const unsigned ldsw = (unsigned)wid * 1024u;
    const int aoff = lds_byte(wr * 64 + fr, fq * 8), boff = lds_byte(wc * 32 + fr, fq * 8);
#define PG8_SA(b, h) (((b) * 2 + (h)) * HTB)
#define PG8_SB(b, h) ((4 + (b) * 2 + (h)) * HTB)
#define PG8_STAGE(bufoff, gbase, voff) do { _Pragma("unroll") for (int _i = 0; _i < 2; ++_i) \
        __builtin_amdgcn_global_load_lds((const unsigned*)((const char*)(gbase) + (voff)[_i]), (PG8_LAS unsigned*)(lds + (bufoff) + ldsw + _i * 8192), 16, 0, 0); } while (0)
#define PG8_LDA(dst, b, h) do { _Pragma("unroll") for (int m = 0; m < 4; ++m) _Pragma("unroll") for (int k = 0; k < 2; ++k) dst[m][k] = *(const PG8_LAS bf16x8*)(lds + PG8_SA(b, h) + aoff + m * 2048 + k * 1024); } while (0)
#define PG8_LDB(dst, b, h) do { _Pragma("unroll") for (int n = 0; n < 2; ++n) _Pragma("unroll") for (int k = 0; k < 2; ++k) dst[n][k] = *(const PG8_LAS bf16x8*)(lds + PG8_SB(b, h) + boff + n * 2048 + k * 1024); } while (0)
#define PG8_MMA(ai, bj, At, Bt) do { __builtin_amdgcn_s_setprio(1); _Pragma("unroll") for (int m = 0; m < 4; ++m) _Pragma("unroll") for (int n = 0; n < 2; ++n) _Pragma("unroll") for (int k = 0; k < 2; ++k) \
        acc[ai][bj][m][n] = __builtin_amdgcn_mfma_f32_16x16x32_bf16(Bt[n][k], At[m][k], acc[ai][bj][m][n], 0, 0, 0); __builtin_amdgcn_s_setprio(0); } while (0)
#define PG8_WAIT_V(n) asm volatile("s_waitcnt vmcnt(" #n ")" ::: "memory")
#define PG8_WAIT_L(n) asm volatile("s_waitcnt lgkmcnt(" #n ")" ::: "memory")
#define PG8_BAR __builtin_amdgcn_s_barrier()
#define PG8_SCHED __builtin_amdgcn_sched_barrier(0)
    Unit cur, nxt; int ui = 0;
    if (!S.next(0, cur)) return;
    f32x4 acc[2][2][4][2];
#pragma unroll
    for (int a = 0; a < 2; ++a)
#pragma unroll
        for (int b = 0; b < 2; ++b)
#pragma unroll
            for (int m = 0; m < 4; ++m)
#pragma unroll
                for (int n = 0; n < 2; ++n) acc[a][b][m][n] = (f32x4){0.f, 0.f, 0.f, 0.f};
    bf16x8 At[4][2], B0[2][2], B1[2][2];
    const char* cA = (const char*)g.A + (size_t)cur.pm * tstep; const char* cB = (const char*)g.Bt + (size_t)cur.pn * tstep;
    S.a_ready(cur);
    if constexpr (SP2) {
        PG8_STAGE(PG8_SB(0, 0), cB, voffB); PG8_STAGE(PG8_SB(0, 1), cB + hstep, voffB); PG8_STAGE(PG8_SA(0, 0), cA, voffA); PG8_STAGE(PG8_SA(0, 1), cA + hstep, voffA);
        if (wr == 1) PG8_BAR;
        PG8_WAIT_V(2); PG8_BAR;
        PG8_STAGE(PG8_SB(1, 0), cB + kstep, voffB); PG8_STAGE(PG8_SA(1, 0), cA + kstep, voffA); PG8_STAGE(PG8_SB(1, 1), cB + hstep + kstep, voffB);
        PG8_WAIT_V(6); PG8_BAR;
    } else {
        PG8_STAGE(PG8_SB(0, 0), cB, voffB); PG8_STAGE(PG8_SA(0, 0), cA, voffA); PG8_STAGE(PG8_SB(0, 1), cB + hstep, voffB); PG8_STAGE(PG8_SA(0, 1), cA + hstep, voffA);
        if (wr == 1) PG8_BAR;
        PG8_WAIT_V(4); PG8_BAR;
        PG8_STAGE(PG8_SB(1, 0), cB + kstep, voffB); PG8_STAGE(PG8_SA(1, 0), cA + kstep, voffA); PG8_STAGE(PG8_SB(1, 1), cB + hstep + kstep, voffB);
        PG8_WAIT_V(6); PG8_BAR;
    }
    for (;;) {
        const bool has_next = S.next(ui + 1, nxt);
        const char* nA = has_next ? (const char*)g.A + (size_t)nxt.pm * tstep : cA; const char* nB = has_next ? (const char*)g.Bt + (size_t)nxt.pn * tstep : cB;
        for (int t = 0; t < nt; t += 2) {
            const bool last = (t == nt - 2);
            const char* a1 = cA + (size_t)(t + 1) * kstep;
            const char* a2 = last ? nA : cA + (size_t)(t + 2) * kstep; const char* b2 = last ? nB : cB + (size_t)(t + 2) * kstep;
            const char* a3 = a2 + kstep; const char* b3 = b2 + kstep;
            if (last && has_next) S.a_ready(nxt);
            if constexpr (SP2) {
            PG8_LDB(B0, 0, 0); PG8_LDB(B1, 0, 1); PG8_SCHED; PG8_LDA(At, 0, 0); PG8_STAGE(PG8_SA(1, 1), a1 + hstep, voffA);
            PG8_WAIT_V(8); PG8_WAIT_L(0); PG8_BAR; PG8_MMA(0, 0, At, B0); PG8_MMA(0, 1, At, B1); PG8_BAR; PG8_SCHED;
            PG8_LDA(At, 0, 1); PG8_STAGE(PG8_SB(0, 0), b2, voffB); PG8_STAGE(PG8_SB(0, 1), b2 + hstep, voffB); PG8_STAGE(PG8_SA(0, 0), a2, voffA);
            PG8_WAIT_V(8); PG8_WAIT_L(0); PG8_BAR; PG8_MMA(1, 0, At, B0); PG8_MMA(1, 1, At, B1); PG8_BAR; PG8_SCHED;
            PG8_LDB(B0, 1, 0); PG8_LDB(B1, 1, 1); PG8_SCHED; PG8_LDA(At, 1, 0); PG8_STAGE(PG8_SA(0, 1), a2 + hstep, voffA);
            PG8_WAIT_V(8); PG8_WAIT_L(0); PG8_BAR; PG8_MMA(0, 0, At, B0); PG8_MMA(0, 1, At, B1); PG8_BAR; PG8_SCHED;
            PG8_LDA(At, 1, 1); PG8_STAGE(PG8_SB(1, 0), b3, voffB); PG8_STAGE(PG8_SB(1, 1), b3 + hstep, voffB); PG8_STAGE(PG8_SA(1, 0), a3, voffA);
            PG8_WAIT_V(8); PG8_WAIT_L(0); PG8_BAR; PG8_MMA(1, 0, At, B0); PG8_MMA(1, 1, At, B1); PG8_BAR; PG8_SCHED;
            } else {
            PG8_LDB(B0, 0, 0); PG8_SCHED; PG8_LDA(At, 0, 0); PG8_STAGE(PG8_SA(1, 1), a1 + hstep, voffA);
            PG8_WAIT_L(8); PG8_BAR; PG8_WAIT_L(0); PG8_MMA(0, 0, At, B0); PG8_BAR; PG8_SCHED;
            PG8_LDB(B1, 0, 1); PG8_STAGE(PG8_SB(0, 0), b2, voffB);
            PG8_BAR; PG8_WAIT_L(0); PG8_MMA(0, 1, At, B1); PG8_BAR;
            PG8_LDA(At, 0, 1); PG8_STAGE(PG8_SA(0, 0), a2, voffA);
            PG8_BAR; PG8_WAIT_L(0); PG8_MMA(1, 0, At, B0); PG8_BAR; PG8_SCHED;
            PG8_STAGE(PG8_SB(0, 1), b2 + hstep, voffB);
            PG8_WAIT_V(6); PG8_BAR; PG8_MMA(1, 1, At, B1); PG8_BAR;
            PG8_LDB(B0, 1, 0); PG8_SCHED; PG8_LDA(At, 1, 0); PG8_STAGE(PG8_SA(0, 1), a2 + hstep, voffA);
            PG8_WAIT_L(8); PG8_BAR; PG8_WAIT_L(0); PG8_MMA(0, 0, At, B0); PG8_BAR; PG8_SCHED;
            PG8_LDB(B1, 1, 1); PG8_STAGE(PG8_SB(1, 0), b3, voffB);
            PG8_BAR; PG8_WAIT_L(0); PG8_MMA(0, 1, At, B1); PG8_BAR;
            PG8_LDA(At, 1, 1); PG8_STAGE(PG8_SA(1, 0), a3, voffA);
            PG8_BAR; PG8_WAIT_L(0); PG8_MMA(1, 0, At, B0); PG8_BAR; PG8_SCHED;
            PG8_STAGE(PG8_SB(1, 1), b3 + hstep, voffB);
            PG8_WAIT_V(6); PG8_BAR; PG8_MMA(1, 1, At, B1); PG8_BAR;
            }
        }
        if constexpr (ALIGN_EPI) { if (wr == 0) PG8_BAR; }
        if constexpr (!Epi::AFTER_DRAIN) { E(acc, cur, wr, wc, fr, fq); S.done(cur); }
        if (!has_next) break;
#pragma unroll
        for (int a = 0; a < 2; ++a)
#pragma unroll
            for (int b = 0; b < 2; ++b)
#pragma unroll
                for (int m = 0; m < 4; ++m)
#pragma unroll
                    for (int n = 0; n < 2; ++n) acc[a][b][m][n] = (f32x4){0.f, 0.f, 0.f, 0.f};
        cur = nxt; cA = nA; cB = nB; ++ui;
        if constexpr (ALIGN_EPI) { if (wr == 1) PG8_BAR; }
    }
    PG8_WAIT_V(0);
    if constexpr (!ALIGN_EPI) { if (wr == 0) PG8_BAR; }
    PG8_BAR;
    if constexpr (Epi::AFTER_DRAIN) { E.fused(acc, cur, wr, wc, fr, fq, lds, wid, lane); S.done(cur); }
#undef PG8_SA
#undef PG8_SB
#undef PG8_STAGE
#undef PG8_LDA
#undef PG8_LDB
#undef PG8_MMA
#undef PG8_WAIT_V
#undef PG8_WAIT_L
#undef PG8_BAR
#undef PG8_SCHED
}
}

namespace attn {
constexpr int KVP = HD, OP = DM;
constexpr float SCALE = 0.08838834764831845f;
constexpr int D = 128;
constexpr int NW = 8, QBLK = 32, KVBLK = 64, QB = NW * QBLK;
constexpr int SHM_V = KVBLK * D * 2, SHM_K = KVBLK * D * 2;
constexpr int FB_OFF = 2 * SHM_V + 2 * SHM_K + NW * 64 * 4;
constexpr int LDS_BYTES = FB_OFF + 2 * 64 * 4;
constexpr bool WSKIP = false;
constexpr float THR = 16.f;

using bf16 = __hip_bfloat16;
typedef short bf16x8 __attribute__((ext_vector_type(8)));
typedef short s16x4 __attribute__((ext_vector_type(4)));
typedef float f32x16 __attribute__((ext_vector_type(16)));
typedef float f32x4 __attribute__((ext_vector_type(4)));
typedef unsigned u32x4 __attribute__((ext_vector_type(4)));
template <class A, class Bt> struct same_t { static constexpr bool v = false; };
template <class A> struct same_t<A, A> { static constexpr bool v = true; };

#define KSWZ(row, colB) ((row) * 256 + ((colB) ^ (((row) & 7) << 4)))
#define SBAR() __builtin_amdgcn_sched_barrier(0)
__device__ __forceinline__ int v_st(int k, int c) { const int kk = (k & ~0xC) | ((k & 4) << 1) | ((k & 8) >> 1); return ((kk >> 3) * 4 + (c >> 5)) * 512 + ((kk & 7) * 32 + (c & 31)) * 2; }
__device__ __forceinline__ int v_rd_base(int lane) { return ((lane & 3) << 3) | (((lane >> 2) & 3) << 6) | (((lane >> 4) & 1) << 5) | (((lane >> 5) & 1) << 8); }
constexpr int v_rd_off(int d0, int ks, int half) { return d0 * 512 + ks * 4096 + half * 2048; }
__device__ __forceinline__ int crow(int r, int hi) { return (r & 3) + 8 * (r >> 2) + 4 * hi; }
__device__ __forceinline__ unsigned cvtpk(float lo, float hi) {
    unsigned r; asm volatile("v_cvt_pk_bf16_f32 %0, %1, %2" : "=v"(r) : "v"(lo), "v"(hi)); return r;
}
__device__ __forceinline__ bf16x8 pack8(f32x4 a, f32x4 b) {
    u32x4 w = {cvtpk(a[0], a[1]), cvtpk(a[2], a[3]), cvtpk(b[0], b[1]), cvtpk(b[2], b[3])};
    return *reinterpret_cast<bf16x8*>(&w);
}
template <class T> __device__ __forceinline__ bf16x8 load8(const T* p) {
    if constexpr (same_t<T, float>::v) { return pack8(*(const f32x4*)p, *(const f32x4*)(p + 4)); }
    else { return *reinterpret_cast<const bf16x8*>(p); }
}
__device__ __forceinline__ void mask_tile(f32x16& p0, f32x16& p1, int dq, unsigned W) {
    const float NEG = -__builtin_inff();
#pragma unroll
    for (int r = 0; r < 16; ++r) {
        const int c = (r & 3) + 8 * (r >> 2);
        if ((unsigned)(dq - c) >= W) p0[r] = NEG;
        if ((unsigned)(dq - c - 32) >= W) p1[r] = NEG;
    }
}
__device__ __forceinline__ void partialSM(f32x16& p0, f32x16& p1, float& m_reg, float& mn, float& alpha) {
    float pmax = p0[0]; for (int r = 1; r < 16; ++r) pmax = fmaxf(pmax, p0[r]); for (int r = 0; r < 16; ++r) pmax = fmaxf(pmax, p1[r]);
    { auto rr = __builtin_amdgcn_permlane32_swap(__float_as_uint(pmax), __float_as_uint(pmax), false, false);
      pmax = fmaxf(__uint_as_float(rr[0]), __uint_as_float(rr[1])); }
    constexpr float C2 = 1.4426950408889634f * SCALE;
    if (__builtin_expect(__all((pmax - m_reg) * SCALE <= THR), 1)) { mn = m_reg; alpha = 1.f; }
    else { mn = fmaxf(m_reg, pmax); alpha = __builtin_amdgcn_exp2f((m_reg - mn) * C2); m_reg = mn; }
    const float mnL = -mn * C2;
    for (int r = 0; r < 16; ++r) p0[r] = fmaf(p0[r], C2, mnL); for (int r = 0; r < 16; ++r) p1[r] = fmaf(p1[r], C2, mnL);
    for (int r = 0; r < 16; ++r) p0[r] = __builtin_amdgcn_exp2f(p0[r]);
}
__device__ __forceinline__ void finishSM(f32x16& p0, f32x16& p1, float alpha, float& l_reg, bf16x8& pa0, bf16x8& pa1, bf16x8& pa2, bf16x8& pa3) {
    for (int r = 0; r < 16; ++r) p1[r] = __builtin_amdgcn_exp2f(p1[r]);
    float ps = 0; for (int r = 0; r < 16; ++r) ps += p0[r]; for (int r = 0; r < 16; ++r) ps += p1[r];
    { auto rr = __builtin_amdgcn_permlane32_swap(__float_as_uint(ps), __float_as_uint(ps), false, false);
      ps = __uint_as_float(rr[0]) + __uint_as_float(rr[1]); }
    l_reg = l_reg * alpha + ps;
#define PK4(P, B_, OUT) do { unsigned a0 = cvtpk(P[B_+0], P[B_+1]), a1 = cvtpk(P[B_+2], P[B_+3]);                          \
        unsigned b0 = cvtpk(P[B_+4], P[B_+5]), b1 = cvtpk(P[B_+6], P[B_+7]);                                             \
        auto r0 = __builtin_amdgcn_permlane32_swap(a0, b0, false, false); auto r1 = __builtin_amdgcn_permlane32_swap(a1, b1, false, false); \
        u32x4 w = {r0[0], r1[0], r0[1], r1[1]}; OUT = *reinterpret_cast<bf16x8*>(&w); } while (0)
    PK4(p0, 0, pa0); PK4(p0, 8, pa1); PK4(p1, 0, pa2); PK4(p1, 8, pa3);
#undef PK4
}
template <int KB, bool SK>
__device__ __forceinline__ void qkt(f32x16& p0, f32x16& p1, const char* K_lds, int r32, int hi, const bf16x8* qr, bool act) {
    if (SK && !act) { const float NEG = -__builtin_inff();
#pragma unroll
        for (int r = 0; r < 16; ++r) { p0[r] = NEG; p1[r] = NEG; } return; }
    { const char* fb = K_lds + 2 * SHM_K + NW * 64 * 4 + KB * 256 + hi * 16;
#pragma unroll
      for (int g = 0; g < 4; ++g) { const f32x4 a = *reinterpret_cast<const f32x4*>(fb + g * 32), b = *reinterpret_cast<const f32x4*>(fb + 128 + g * 32);
          p0[4 * g] = a[0]; p0[4 * g + 1] = a[1]; p0[4 * g + 2] = a[2]; p0[4 * g + 3] = a[3]; p1[4 * g] = b[0]; p1[4 * g + 1] = b[1]; p1[4 * g + 2] = b[2]; p1[4 * g + 3] = b[3]; } }
    const char* kb[4];
#pragma unroll
    for (int dd = 0; dd < 4; ++dd) kb[dd] = K_lds + KB * SHM_K + KSWZ(r32, (dd * 16 + hi * 8) * 2);
#pragma unroll
    for (int d0 = 0; d0 < 8; ++d0) { const char* a = kb[d0 & 3] + (d0 >> 2) * 128;
        bf16x8 b0 = *reinterpret_cast<const bf16x8*>(a);
        bf16x8 b1 = *reinterpret_cast<const bf16x8*>(a + 32 * 256);
        p0 = __builtin_amdgcn_mfma_f32_32x32x16_bf16(b0, qr[d0], p0, 0, 0, 0);
        p1 = __builtin_amdgcn_mfma_f32_32x32x16_bf16(b1, qr[d0], p1, 0, 0, 0); }
}
template <int VB, bool SK>
__device__ __forceinline__ void pv_tile(f32x16* o, int vb0, bf16x8 pa0, bf16x8 pa1, bf16x8 pa2, bf16x8 pa3, bool act) {
    if (SK && !act) return;
#define TRRD(dst, off) asm volatile("ds_read_b64_tr_b16 %0, %1 offset:%2" : "=&v"(dst) : "v"(vb0), "i"(off) : "memory")
#define PV_D0(d0) do { s16x4 l0, l1, l2, l3, h0, h1, h2, h3; constexpr int b_ = VB * SHM_V + v_rd_off(d0, 0, 0);     \
        TRRD(l0, b_); TRRD(h0, b_ + 2048); TRRD(l1, b_ + 4096); TRRD(h1, b_ + 6144); TRRD(l2, b_ + 8192); TRRD(h2, b_ + 10240); TRRD(l3, b_ + 12288); TRRD(h3, b_ + 14336); \
        asm volatile("s_waitcnt lgkmcnt(0)" ::: "memory"); SBAR();                 \
        o[d0] = __builtin_amdgcn_mfma_f32_32x32x16_bf16(pa0, (bf16x8){l0[0], l0[1], l0[2], l0[3], h0[0], h0[1], h0[2], h0[3]}, o[d0], 0, 0, 0);   \
        o[d0] = __builtin_amdgcn_mfma_f32_32x32x16_bf16(pa1, (bf16x8){l1[0], l1[1], l1[2], l1[3], h1[0], h1[1], h1[2], h1[3]}, o[d0], 0, 0, 0);   \
        o[d0] = __builtin_amdgcn_mfma_f32_32x32x16_bf16(pa2, (bf16x8){l2[0], l2[1], l2[2], l2[3], h2[0], h2[1], h2[2], h2[3]}, o[d0], 0, 0, 0);   \
        o[d0] = __builtin_amdgcn_mfma_f32_32x32x16_bf16(pa3, (bf16x8){l3[0], l3[1], l3[2], l3[3], h3[0], h3[1], h3[2], h3[3]}, o[d0], 0, 0, 0); } while (0)
    PV_D0(0); PV_D0(1); PV_D0(2); PV_D0(3);
#undef PV_D0
#undef TRRD
}

template <class TIn, class TOut> struct BlockRef { const TIn* Q; const TIn* K; const TIn* V; const float* F; TOut* O; int P0; int JLO; };
template <class TIn> struct Seam {
    bf16x8 qr[8];
    bf16x8 st_v0, st_v1, st_k0, st_k1; float st_f; f32x4 sf0, sf1, sf2, sf3;
    f32x4 tq[16];
};
__device__ __forceinline__ int swa_jlo(int P0, int W) { const int lowk = P0 - W + 1; return lowk > 0 ? lowk / KVBLK : 0; }
#define ROW(p, k0, rr) ((p) + (size_t)((k0) + (rr)) * KVP + sc)
#define VMW() asm volatile("s_waitcnt vmcnt(0)" ::: "memory")
#define VMWN(n) asm volatile("s_waitcnt vmcnt(%0)" :: "i"(n) : "memory")
#define SLOAD_H(Kp, Vp, Fp, k0) do { S.st_v0 = load8<TIn>(ROW(Vp, k0, sr)); S.st_v1 = load8<TIn>(ROW(Vp, k0, 32 + sr));              \
                         S.st_k0 = load8<TIn>(ROW(Kp, k0, sr)); S.st_k1 = load8<TIn>(ROW(Kp, k0, 32 + sr)); if (tid < 64) S.st_f = (Fp)[(k0) + tid]; } while (0)
#define SWRITE_HK(bf) do { *(bf16x8*)(K_lds + (bf) * SHM_K + kws) = S.st_k0; *(bf16x8*)(K_lds + (bf) * SHM_K + kws + 32 * 256) = S.st_k1; if (tid < 64) *(float*)(K_lds + 2 * SHM_K + NW * 64 * 4 + (bf) * 256 + tid * 4) = S.st_f; } while (0)
#define SWRITE_HV(bf) do { *(bf16x8*)(V_lds + (bf) * SHM_V + vst0) = S.st_v0; *(bf16x8*)(V_lds + (bf) * SHM_V + vst1) = S.st_v1; } while (0)
#define SWRITE_H(bf) do { SWRITE_HV(bf); SWRITE_HK(bf); } while (0)
#define SLOAD_F(p, k0) do { S.sf0 = *(const f32x4*)ROW(p, k0, sr); S.sf1 = *(const f32x4*)(ROW(p, k0, sr) + 4);                \
                            S.sf2 = *(const f32x4*)ROW(p, k0, 32 + sr); S.sf3 = *(const f32x4*)(ROW(p, k0, 32 + sr) + 4); } while (0)
#define SWRITE_KF(bf) do { *(bf16x8*)(K_lds + (bf) * SHM_K + kws) = pack8(S.sf0, S.sf1); *(bf16x8*)(K_lds + (bf) * SHM_K + kws + 32 * 256) = pack8(S.sf2, S.sf3); } while (0)
#define SWRITE_VF(bf) do { *(bf16x8*)(V_lds + (bf) * SHM_V + vst0) = pack8(S.sf0, S.sf1); *(bf16x8*)(V_lds + (bf) * SHM_V + vst1) = pack8(S.sf2, S.sf3); } while (0)
template <class TIn, class TOut>
__device__ __forceinline__ void causal_swa_prime(const BlockRef<TIn, TOut>& cur, int W, char* lds, Seam<TIn>& S) {
    constexpr bool F32 = same_t<TIn, float>::v;
    int tid_ = my_tid(); asm volatile("" : "+v"(tid_));
    const int tid = tid_, wid = __builtin_amdgcn_readfirstlane(tid >> 6), lane = tid & 63, r32 = lane & 31, hi = lane >> 5;
    const int sr = tid >> 4, sc = (tid & 15) * 8, kws = KSWZ(sr, sc * 2); char* K_lds = lds + 2 * SHM_V;
    const int kb0 = cur.JLO * KVBLK;
    for (int d0 = 0; d0 < 8; ++d0) S.qr[d0] = load8<TIn>(cur.Q + (size_t)(wid * QBLK + r32) * KVP + d0 * 16 + hi * 8);
    if constexpr (F32) { SLOAD_F((const float*)cur.K, kb0); VMW(); SWRITE_KF(0); SBAR(); SLOAD_F((const float*)cur.V, kb0); }
    else { SLOAD_H(cur.K, cur.V, cur.F, kb0); VMW(); SWRITE_HK(0); }
    __syncthreads();
}
template <class TIn, class TOut>
__device__ __forceinline__ void causal_swa_block(const BlockRef<TIn, TOut>& cur, const BlockRef<TIn, TOut>& nxt, int skv, int W, char* lds, Seam<TIn>& S, const float* const __attribute__((address_space(4)))* gslot, int goff) {
    constexpr bool F32 = same_t<TIn, float>::v;
    int tid_ = my_tid(); asm volatile("" : "+v"(tid_));
    const int tid = tid_, wid = __builtin_amdgcn_readfirstlane(tid >> 6), lane = tid & 63, r32 = lane & 31, hi = lane >> 5;
    const int j_lo = cur.JLO;
    int j_hi = (cur.P0 + QB - 1) / KVBLK + 1; if (j_hi > skv / KVBLK) j_hi = skv / KVBLK;
    const int NT = j_hi - j_lo;
    const int kbn = nxt.JLO * KVBLK;
    const int qlo = cur.P0 + wid * QBLK, qm = qlo + r32 - 4 * hi;
    char* V_lds = lds; char* K_lds = lds + 2 * SHM_V;
    float* ws = (float*)(lds + 2 * SHM_V + 2 * SHM_K) + wid * 64; float* li_l = ws, * al_l = ws + 32;
    float m_reg = -1e30f, l_reg = 0; f32x16 o[4] = {};
    const int sr = tid >> 4, sc = (tid & 15) * 8, vst0 = v_st(sr, sc), vst1 = v_st(32 + sr, sc), kws = KSWZ(sr, sc * 2);
    const int vb0 = (int)(uintptr_t)V_lds + v_rd_base(lane);
    const TIn* Kh = cur.K; const TIn* Vh = cur.V; const float* Fh = cur.F;
#define RESC(a) do { if (__any((a) < 1.f)) { if (hi == 0) al_l[r32] = (a); asm volatile("s_waitcnt lgkmcnt(0)" ::: "memory");              \
                     for (int d_ = 0; d_ < 4; ++d_) for (int r = 0; r < 16; ++r) o[d_][r] *= al_l[crow(r, hi)]; } } while (0)
#define KBASE(t) ((j_lo + (t)) * KVBLK)
#define ACT(t) (KBASE(t) <= qlo + QBLK - 1 && KBASE(t) + KVBLK - 1 >= qlo - W + 1)
#define MASKT(P0_, P1_, t) do { const int kb_ = KBASE(t); if ((!SK || ACT(t)) && (kb_ + KVBLK - 1 > qlo || kb_ <= qlo + QBLK - 1 - W)) mask_tile(P0_, P1_, qm - kb_, (unsigned)W); } while (0)
    constexpr int NQL = F32 ? 16 : 8;
    constexpr bool SK = WSKIP && !F32;
#define SEAM_K0() do { VMWN(NQL); if constexpr (F32) { SWRITE_KF(0); SBAR(); SLOAD_F((const float*)nxt.V, kbn); } else { SWRITE_HK(0); } SBAR(); } while (0)
    f32x16 pA0, pA1, pB0, pB1; float mnA, mnB, alA, alB; bf16x8 pa0, pa1, pa2, pa3;
    if constexpr (F32) { VMW(); SWRITE_VF(0); SBAR(); } else { SWRITE_HV(0); SBAR(); }
    if (NT > 1) { if constexpr (F32) SLOAD_F((const float*)Kh, KBASE(1)); else SLOAD_H(Kh, Vh, Fh, KBASE(1)); }
    SBAR(); qkt<0, SK>(pA0, pA1, K_lds, r32, hi, S.qr, ACT(0));
    if constexpr (F32) { if (NT > 1) { VMW(); SWRITE_KF(1); SBAR(); SLOAD_F((const float*)Vh, KBASE(1)); } }
    MASKT(pA0, pA1, 0); partialSM(pA0, pA1, m_reg, mnA, alA);
    if (NT > 1) { VMW(); if constexpr (F32) { SWRITE_VF(1); SBAR(); if (NT > 2) SLOAD_F((const float*)Kh, KBASE(2)); } else SWRITE_H(1); }
    __syncthreads();
#define HALF_STEP(PX0, PX1, mnX, alX, PY0, PY1, alY, t, KB, VB, SB) do {                                                      \
        SBAR(); qkt<KB, SK>(PX0, PX1, K_lds, r32, hi, S.qr, ACT(t));                                             \
        finishSM(PY0, PY1, alY, l_reg, pa0, pa1, pa2, pa3); SBAR();                                                           \
        if ((t) + 1 < NT) { if constexpr (F32) { VMW(); SWRITE_KF(SB); SBAR(); SLOAD_F((const float*)Vh, KBASE((t) + 1)); }  \
                            else { SLOAD_H(Kh, Vh, Fh, KBASE((t) + 1)); } SBAR(); }                                               \
        pv_tile<VB, SK>(o, vb0, pa0, pa1, pa2, pa3, ACT((t) - 1)); MASKT(PX0, PX1, (t)); partialSM(PX0, PX1, m_reg, mnX, alX);                                        \
        __syncthreads();                                                                                                      \
        if ((t) + 1 < NT) { VMW(); if constexpr (F32) { SWRITE_VF(SB); SBAR(); if ((t) + 2 < NT) SLOAD_F((const float*)Kh, KBASE((t) + 2)); } \
                            else { SWRITE_H(SB); } }                                                                          \
        RESC(alX); __syncthreads(); } while (0)
    for (int t = 1; t + 1 < NT; t += 2) {
        HALF_STEP(pB0, pB1, mnB, alB, pA0, pA1, alA, t, 1, 0, 0);
        HALF_STEP(pA0, pA1, mnA, alA, pB0, pB1, alB, t + 1, 0, 1, 1);
    }
    const bool even = (NT & 1) == 0;
    if (even) { SBAR(); qkt<1, SK>(pB0, pB1, K_lds, r32, hi, S.qr, ACT(NT - 1)); SBAR(); }
#define QROW(e) (nxt.Q + (size_t)(wid * QBLK + r32) * KVP + ((e) >> 1) * 16 + hi * 8 + ((e) & 1) * 4)
    if constexpr (F32) { SLOAD_F((const float*)nxt.K, kbn); SBAR();
#pragma unroll
        for (int e = 0; e < 8; ++e) S.tq[e] = *(const f32x4*)QROW(e); }
    else { SLOAD_H(nxt.K, nxt.V, nxt.F, kbn); SBAR();
#pragma unroll
        for (int d0 = 0; d0 < 8; ++d0) S.qr[d0] = load8<TIn>(nxt.Q + (size_t)(wid * QBLK + r32) * KVP + d0 * 16 + hi * 8); }
    SBAR();
    finishSM(pA0, pA1, alA, l_reg, pa0, pa1, pa2, pa3); SBAR();
    if constexpr (F32) {
#pragma unroll
        for (int e = 8; e < 16; ++e) S.tq[e] = *(const f32x4*)QROW(e); SBAR(); }
#undef QROW
    pv_tile<0, SK>(o, vb0, pa0, pa1, pa2, pa3, ACT(even ? NT - 2 : NT - 1));
    if (even) { MASKT(pB0, pB1, NT - 1); partialSM(pB0, pB1, m_reg, mnB, alB); __syncthreads(); RESC(alB);
        finishSM(pB0, pB1, alB, l_reg, pa0, pa1, pa2, pa3); SBAR(); pv_tile<1, SK>(o, vb0, pa0, pa1, pa2, pa3, ACT(NT - 1)); }
    SBAR(); SEAM_K0();
    if (hi == 0) li_l[r32] = l_reg; asm volatile("s_waitcnt lgkmcnt(0)" ::: "memory");
    float rli[16];
#pragma unroll
    for (int r = 0; r < 16; ++r) rli[r] = __builtin_amdgcn_rcpf(li_l[crow(r, hi)]);
    TOut* Ow = cur.O + (size_t)(wid * QBLK) * OP;
    float gn[4];
    { const float* G = *gslot + goff;
#pragma unroll
    for (int d0 = 0; d0 < 4; ++d0) gn[d0] = G[d0 * 32 + r32]; }
#pragma unroll
    for (int r = 0; r < 16; ++r) { const int orow = crow(r, hi);
        float y[4]; float ss = 0.f;
#pragma unroll
        for (int d0 = 0; d0 < 4; ++d0) { y[d0] = o[d0][r] * rli[r]; ss += y[d0] * y[d0]; }
        ss += __shfl_xor(ss, 1); ss += __shfl_xor(ss, 2); ss += __shfl_xor(ss, 4); ss += __shfl_xor(ss, 8); ss += __shfl_xor(ss, 16);
        const float rs = __builtin_amdgcn_rsqf(ss * (1.0f / 128.0f) + 1e-6f);
#pragma unroll
        for (int d0 = 0; d0 < 4; ++d0) { const float v = y[d0] * rs * gn[d0];
            if constexpr (same_t<TOut, float>::v) { Ow[(size_t)orow * OP + d0 * 32 + r32] = v; }
            else { const float vn = __shfl_xor(v, 1);
                   if ((r32 & 1) == 0) *(unsigned*)(Ow + (size_t)orow * OP + d0 * 32 + r32) = cvtpk(v, vn); } }
        SBAR(); }
    if constexpr (F32) {
#pragma unroll
        for (int d0 = 0; d0 < 8; ++d0) S.qr[d0] = pack8(S.tq[2 * d0], S.tq[2 * d0 + 1]); }
    __syncthreads();
#undef RESC
#undef KBASE
#undef ACT
#undef MASKT
#undef SEAM_K0
#undef HALF_STEP
}
#undef ROW
#undef VMW
#undef VMWN
#undef SLOAD_H
#undef SWRITE_HK
#undef SWRITE_HV
#undef SWRITE_H
#undef SLOAD_F
#undef SWRITE_KF
#undef SWRITE_VF


}

__device__ __forceinline__ float bflo(unsigned w) { return __uint_as_float(w << 16); }
__device__ __forceinline__ float bfhi(unsigned w) { return __uint_as_float(w & 0xffff0000u); }
__device__ __forceinline__ float wave_sum(float v) {
#pragma unroll
    for (int o = 1; o < 64; o <<= 1) v += __shfl_xor(v, o);
    return v;
}
__device__ __forceinline__ float sigmoid_f(float x) { return 1.0f / (1.0f + __expf(-x)); }
__device__ __forceinline__ float silu_acc(float x) { return x / (1.0f + __expf(-x)); }
__device__ __forceinline__ float softplus_f(float x) { return fmaxf(x, 0.f) + log1pf(__expf(-fabsf(x))); }
__device__ __forceinline__ float logsigmoid_f(float x) { return fminf(x, 0.f) - log1pf(__expf(-fabsf(x))); }

struct Args { const float* in[17]; float* out; unsigned char* ws; int ph_lo, ph_hi; };
typedef const __attribute__((address_space(4))) Args* ArgsP;
enum { I_X = 0, I_MIXPRE, I_WIN, I_FOXFB, I_FOXON, I_SCW, I_GDNCW, I_GDNALOG, I_GDNDTB, I_GDNON, I_WOUT, I_MIXPOST, I_FFNPRE, I_WGATE, I_WUP, I_WDOWN, I_FFNPOST };
struct Ptrs {
    ArgsP ap;
    int tid, lane, wave, gw, NGW, G, bid;
};
__device__ __forceinline__ Ptrs fresh_ptrs(ArgsP ap0);
__device__ __forceinline__ int ftid() { int t = my_tid(); asm volatile("" : "+v"(t)); return t; }
__device__ __forceinline__ int fbid() { int b = blockIdx.x; asm volatile("" : "+s"(b)); return b; }
__device__ __forceinline__ ArgsP fresh(ArgsP a) { asm volatile("" : "+s"(a)); return a; }
__device__ __forceinline__ Ptrs fresh_ptrs(ArgsP ap0) { Ptrs P; P.ap = fresh(ap0); P.tid = ftid(); P.lane = P.tid & 63; P.wave = __builtin_amdgcn_readfirstlane(P.tid >> 6); P.bid = fbid();
    P.G = gridDim.x; P.gw = P.bid * NWAVES + P.wave; P.NGW = P.G * NWAVES; return P; }

__device__ __forceinline__ int win_src4(int d) {
    if (d < PC_SB) return d;
    if (d < PC_GQ) return d - PC_SB + SRC_SB;
    if (d < PC_GZ) return d - PC_GQ + SRC_GQ;
    if (d < PC_SMALL) return d - PC_GZ + SRC_GZ;
    const int e = d - PC_SMALL;
    if (e < 12) return SRC_FF + e;
    if (e < 24) return SRC_GA + e - 12;
    if (e < 36) return SRC_GB + e - 24;
    return -1;
}
__device__ __forceinline__ void tr_item(const float* __restrict__ W, int Ns, int scol, int k0, bf16* WT, int K, int dn0, LAS float* scr, int lane) {
    const int sub = lane >> 3, g = lane & 7;
    f32x4 v[8];
#pragma unroll
    for (int i = 0; i < 8; ++i) { const int kk = 8 * i + sub; v[i] = (f32x4){0.f, 0.f, 0.f, 0.f}; if (scol >= 0) v[i] = *(const f32x4*)(W + (size_t)(k0 + kk) * Ns + scol); }
#pragma unroll
    for (int i = 0; i < 8; ++i) { const int kk = 8 * i + sub; LAS float* s = scr + kk * 33 + 4 * g; s[0] = v[i][0]; s[1] = v[i][1]; s[2] = v[i][2]; s[3] = v[i][3]; }
    LDS_WAIT(); asm volatile("" ::: "memory");
    const int c = lane & 7;
#pragma unroll
    for (int j = 0; j < 4; ++j) { const int n = (lane >> 3) + 8 * j; const LAS float* s = scr + (8 * c) * 33 + n;
        v4u o; o.x = pk2(s[0 * 33], s[1 * 33]); o.y = pk2(s[2 * 33], s[3 * 33]); o.z = pk2(s[4 * 33], s[5 * 33]); o.w = pk2(s[6 * 33], s[7 * 33]);
        *(v4u*)(WT + (size_t)(dn0 + n) * K + k0 + 8 * c) = o; }
    LDS_WAIT(); asm volatile("" ::: "memory");
}
constexpr int I_IN = 64 * (NP / 32), I_OUT = 64 * (DM / 32), I_GU = 64 * (NGU / 32), I_DN = (FFN / 64) * (DM / 32), I_LAYER = I_IN + I_OUT + I_GU + I_DN;

typedef unsigned u32x2t __attribute__((ext_vector_type(2)));
__device__ __forceinline__ float sq4(const f32x4 v) { return (v[0] * v[0] + v[1] * v[1]) + (v[2] * v[2] + v[3] * v[3]); }
__device__ __forceinline__ void rms_row_to_bf16(const float* xrow, const float* gain, bf16* orow, int lane) {
    f32x4 a[16]; float ss = 0.f;
#pragma unroll
    for (int j = 0; j < 16; ++j) { a[j] = *(const f32x4*)(xrow + 256 * j + 4 * lane); ss += sq4(a[j]); }
    const float r = 1.0f / sqrtf(wave_sum(ss) * (1.0f / DM) + RMS_EPS);
#pragma unroll
    for (int j = 0; j < 16; ++j) { const f32x4 g = *(const f32x4*)(gain + 256 * j + 4 * lane);
        u32x2t o; o.x = pk2(a[j][0] * r * g[0], a[j][1] * r * g[1]); o.y = pk2(a[j][2] * r * g[2], a[j][3] * r * g[3]);
        *(u32x2t*)(orow + 256 * j + 4 * lane) = o; }
}
__device__ __forceinline__ void resid_norm_row(const float* base_row, const bf16* yrow, const float* ssrow, const float* gpost, float* out_row, const float* gnext, bf16* xn_row, int lane) {
    const float ry = 1.0f / sqrtf(wave_sum(ssrow[lane]) * (1.0f / DM) + RMS_EPS);
    f32x4 a[16]; float ss = 0.f;
#pragma unroll
    for (int j = 0; j < 16; ++j) { const int c = 256 * j + 4 * lane; const u32x2t yw = *(const u32x2t*)(yrow + c);
        const f32x4 x0 = *(const f32x4*)(base_row + c), g0 = *(const f32x4*)(gpost + c);
        a[j][0] = x0[0] + bflo(yw.x) * ry * g0[0]; a[j][1] = x0[1] + bfhi(yw.x) * ry * g0[1]; a[j][2] = x0[2] + bflo(yw.y) * ry * g0[2]; a[j][3] = x0[3] + bfhi(yw.y) * ry * g0[3];
        *(f32x4*)(out_row + c) = a[j]; ss += sq4(a[j]); }
    if (gnext) {
        const float r = 1.0f / sqrtf(wave_sum(ss) * (1.0f / DM) + RMS_EPS);
#pragma unroll
        for (int j = 0; j < 16; ++j) { const f32x4 g = *(const f32x4*)(gnext + 256 * j + 4 * lane);
            u32x2t o; o.x = pk2(a[j][0] * r * g[0], a[j][1] * r * g[1]); o.y = pk2(a[j][2] * r * g[2], a[j][3] * r * g[3]);
            *(u32x2t*)(xn_row + 256 * j + 4 * lane) = o; }
    }
}

__device__ __forceinline__ void convert_weights(ArgsP ap0, LAS unsigned char* lds, int l, int lo = 0, int hi = I_LAYER, int wg_lo = 0) {
    const Ptrs P = fresh_ptrs(ap0); const ArgsP A = P.ap;
    if (P.bid < wg_lo) return;
    LAS float* scr = (LAS float*)(lds + P.wave * 16384);
    const int g = P.lane & 7;
    bf16* wl = (bf16*)(A->ws + WS_W);
    for (int it = lo + (P.bid - wg_lo) * NWAVES + P.wave; it < hi; it += (P.G - wg_lo) * NWAVES) {
        int r = it;
        if (r < I_IN) { const int kb = r / (NP / 32), nb = r % (NP / 32);
            tr_item(A->in[I_WIN] + (size_t)l * DM * PROJ_SRC, PROJ_SRC, win_src4(32 * nb + 4 * g), 64 * kb, (bf16*)((unsigned char*)wl + WO_IN), DM, 32 * nb, scr, P.lane); continue; }
        r -= I_IN;
        if (r < I_OUT) { const int kb = r / (DM / 32), nb = r % (DM / 32);
            tr_item(A->in[I_WOUT] + (size_t)l * DM * DM, DM, 32 * nb + 4 * g, 64 * kb, (bf16*)((unsigned char*)wl + WO_OUT), DM, 32 * nb, scr, P.lane); continue; }
        r -= I_OUT;
        if (r < I_GU) { const int kb = r / (NGU / 32), nb = r % (NGU / 32), dn0 = 32 * nb, j = dn0 >> 8, w = dn0 & 255;
            const float* src = (w < 128 ? A->in[I_WGATE] : A->in[I_WUP]) + (size_t)l * DM * FFN;
            tr_item(src, FFN, 128 * j + (w & 127) + 4 * g, 64 * kb, (bf16*)((unsigned char*)wl + WO_GU), DM, dn0, scr, P.lane); continue; }
        r -= I_GU;
        { const int kb = r / (DM / 32), nb = r % (DM / 32);
            tr_item(A->in[I_WDOWN] + (size_t)l * FFN * DM, DM, 32 * nb + 4 * g, 64 * kb, (bf16*)((unsigned char*)wl + WO_DN), FFN, 32 * nb, scr, P.lane); }
    }
}
__device__ __forceinline__ void p0_prologue(ArgsP ap0, LAS unsigned char* lds) {
    convert_weights(ap0, lds, 0, 0, I_IN + I_OUT + I_GU);
    const Ptrs P = fresh_ptrs(ap0); const ArgsP A = P.ap;
    bf16* XN = (bf16*)(A->ws + WS_XN);
    for (int m = P.gw; m < M; m += P.NGW) rms_row_to_bf16(A->in[I_X] + (size_t)m * DM, A->in[I_MIXPRE], XN + (size_t)m * DM, P.lane);
}

__device__ __forceinline__ void p2_prep(ArgsP ap0, LAS unsigned char* lds, int l) {
    const Ptrs P = fresh_ptrs(ap0); const ArgsP A = P.ap;
    const bf16* SCB = (const bf16*)(A->ws + WS_SCB); const float* SB = (const float*)(A->ws + WS_SB);
    bf16* MIX = (bf16*)(A->ws + WS_MIX); float* FG = (float*)(A->ws + WS_FG);
    const int lane = P.lane;
    if (P.bid < BATCH * FOXH) {
        const int bh = P.bid, b = bh / FOXH, h = bh % FOXH; const float fb = A->in[I_FOXFB][l * FOXH + h];
        const float* sb = SB + ((size_t)(b * SEQ) + 16 * P.tid) * SBW + SB_FF + h;
        float ls[16]; float loc = 0.f;
#pragma unroll
        for (int i = 0; i < 16; ++i) ls[i] = sb[(size_t)i * SBW];
#pragma unroll
        for (int i = 0; i < 16; ++i) { ls[i] = logsigmoid_f(ls[i] + fb); loc += ls[i]; }
        float incl = loc;
#pragma unroll
        for (int o = 1; o < 64; o <<= 1) { const float n = __shfl_up(incl, o); if (lane >= o) incl += n; }
        LAS float* wt = (LAS float*)lds;
        if (lane == 63) wt[P.wave] = incl;
        __syncthreads();
        float run = incl - loc;
        for (int w = 0; w < P.wave; ++w) run += wt[w];
        f32x4 o4[4];
#pragma unroll
        for (int i = 0; i < 16; ++i) { run += ls[i]; o4[i >> 2][i & 3] = -run * 11.313708498984761f; }
        float* fo = FG + (size_t)bh * SEQ + 16 * P.tid;
#pragma unroll
        for (int i = 0; i < 4; ++i) *(f32x4*)(fo + 4 * i) = o4[i];
        __syncthreads();
    }
    { const bf16* HMq = (const bf16*)(A->ws + WS_PROJ); gu32* nrm = (gu32*)(A->ws + WS_CTL) + CW_NRM + l * 64;
      for (int it = P.gw; it < 2 * BATCH * FOXH * (SEQ / 64); it += P.NGW) {
        const int part = it / (BATCH * FOXH * (SEQ / 64)), r = it % (BATCH * FOXH * (SEQ / 64)), bh = r / (SEQ / 64), c = r % (SEQ / 64);
        const v4u* row = (const v4u*)(HMq + hm_off(part == 0 ? HM_FQ : HM_FK, bh) + (size_t)(c * 64 + lane) * HD);
        float ss = 0.f;
#pragma unroll
        for (int j = 0; j < 16; ++j) { const v4u w = row[j];
            ss += (bflo(w.x) * bflo(w.x) + bfhi(w.x) * bfhi(w.x)) + (bflo(w.y) * bflo(w.y) + bfhi(w.y) * bfhi(w.y)) + (bflo(w.z) * bflo(w.z) + bfhi(w.z) * bfhi(w.z)) + (bflo(w.w) * bflo(w.w) + bfhi(w.w) * bfhi(w.w)); }
#pragma unroll
        for (int o = 1; o < 64; o <<= 1) ss = fmaxf(ss, __shfl_xor(ss, o));
        if (lane == 0) (void)__hip_atomic_fetch_max(nrm + part * (BATCH * FOXH) + bh, __float_as_uint(ss), __ATOMIC_RELAXED, __HIP_MEMORY_SCOPE_AGENT);
      } }
    { const float* cw = A->in[I_SCW] + (size_t)l * 3 * SCW;
      for (int idx = P.bid * 512 + P.tid; idx < M * (SCW / 8); idx += P.G * 512) {
        const int m = idx >> 7, c = (idx & 127) * 8, tp = m & (SEQ - 1);
        const bf16* row = SCB + (size_t)m * SCBW;
        const v4u bw = *(const v4u*)(row + c);
        float acc[8];
#pragma unroll
        for (int e = 0; e < 8; ++e) acc[e] = 0.f;
#pragma unroll
        for (int j = 0; j < 3; ++j) { const int dt = 2 - j;
            if (tp - dt >= 0) { const bf16* rj = row - (size_t)dt * SCBW; const v4u cwv = *(const v4u*)(rj + SCW + c), hw = *(const v4u*)(rj + 2 * SCW + c);
                const f32x4 w0 = *(const f32x4*)(cw + j * SCW + c), w1 = *(const f32x4*)(cw + j * SCW + c + 4);
                acc[0] += w0[0] * bflo(cwv.x) * bflo(hw.x); acc[1] += w0[1] * bfhi(cwv.x) * bfhi(hw.x); acc[2] += w0[2] * bflo(cwv.y) * bflo(hw.y); acc[3] += w0[3] * bfhi(cwv.y) * bfhi(hw.y);
                acc[4] += w1[0] * bflo(cwv.z) * bflo(hw.z); acc[5] += w1[1] * bfhi(cwv.z) * bfhi(hw.z); acc[6] += w1[2] * bflo(cwv.w) * bflo(hw.w); acc[7] += w1[3] * bfhi(cwv.w) * bfhi(hw.w); } }
        v4u o; o.x = pk2(acc[0] * bflo(bw.x), acc[1] * bfhi(bw.x)); o.y = pk2(acc[2] * bflo(bw.y), acc[3] * bfhi(bw.y)); o.z = pk2(acc[4] * bflo(bw.z), acc[5] * bfhi(bw.z)); o.w = pk2(acc[6] * bflo(bw.w), acc[7] * bfhi(bw.w));
        *(v4u*)(MIX + (size_t)m * DM + FOXW + c) = o; } }
}


#ifndef GP_REP_S1
#define GP_REP_S1 1
#endif
#ifndef GP_REP_S4
#define GP_REP_S4 1
#endif
constexpr int GD_OPS_BYTES = 57344;
constexpr int GD_F_WN = 0, GD_F_QD = 16, GD_F_AT = 32, GD_F_KT = 40;
constexpr int GD_NCH = SEQ / 64;
constexpr int GD_NCHH = BATCH * GDNH * GD_NCH;
constexpr size_t WS_GOPS = WS_Y, WS_GU = WS_Y + 168 * MiB, WS_GL = WS_Y + 264 * MiB, WS_GO2 = WS_Y + 266 * MiB;
constexpr int GP_QS = 0, GP_KS = 17408, GP_VS = 34816, GP_LT = 68608, GP_AT = 86016, GP_WM = 103424, GP_SM = 120832;
typedef float f32x2v __attribute__((ext_vector_type(2)));
typedef unsigned u32x2v __attribute__((ext_vector_type(2)));
typedef __bf16 bf16x2c_t __attribute__((ext_vector_type(2)));
__device__ __forceinline__ unsigned cvtpk_bf16(float lo, float hi) { const f32x2v v = {lo, hi}; const bf16x2c_t b = __builtin_convertvector(v, bf16x2c_t); return __builtin_bit_cast(unsigned, b); }


template <int N> __device__ __forceinline__ void fma_bcast(float& x, float l, float nxi) {
    asm volatile("v_fmac_f32_dpp %0, %1, %2 row_newbcast:%3 row_mask:0xf bank_mask:0xf" : "+v"(x) : "v"(l), "v"(nxi), "n"(N));
}
template <int I, int R> struct TriRow {
    static __device__ __forceinline__ void run(float (&x)[64], const float (&L)[4], float nxi) { fma_bcast<(R & 15)>(x[R], L[R >> 4], nxi); TriRow<I, R + 1>::run(x, L, nxi); }
};
template <int I> struct TriRow<I, 64> { static __device__ __forceinline__ void run(float (&)[64], const float (&)[4], float) {} };
template <int I> struct TriSolve {
    static __device__ __forceinline__ void run(float (&x)[64], const LAS float* ltb, float (&Lc)[4]) {
        float Ln[4] = {0.f, 0.f, 0.f, 0.f};
        if (I + 1 < 63) {
#pragma unroll
            for (int q = (I + 2) >> 4; q < 4; ++q) Ln[q] = ltb[(I + 1) * 68 + 16 * q]; }
        const float nxi = -x[I];
        asm volatile("s_nop 1" ::: "memory");
        TriRow<I, I + 1>::run(x, Lc, nxi);
#pragma unroll
        for (int q = 0; q < 4; ++q) Lc[q] = Ln[q];
        TriSolve<I + 1>::run(x, ltb, Lc);
    }
};
template <> struct TriSolve<63> { static __device__ __forceinline__ void run(float (&)[64], const LAS float*, float (&)[4]) {} };


template <int NT>
__device__ __forceinline__ void gp_s1(LAS unsigned char* lds, const bf16* HMG, const float* cw, int ch, int ltid) {
    const int bh = ch / GD_NCH, n = ch % GD_NCH, h = bh % GDNH;
    constexpr int NI = 3072 / NT, PER = NI / 3, ROWS = NT / 16, NB = (NT == 256 ? 4 : 3);
    const int c = (ltid & 15) * 8;
#pragma unroll
    for (int i0 = 0; i0 < NI; i0 += NB) {
        v4u xw[NB][4];
#pragma unroll
        for (int ib = 0; ib < NB; ++ib) { const int i = i0 + ib, part = i / PER, t = (i % PER) * ROWS + (ltid >> 4), tp = n * 64 + t;
            const bf16* src = HMG + hm_off(part, bh) + (size_t)(n * 64 + t) * HD + c;
#pragma unroll
            for (int j = 0; j < 4; ++j) { xw[ib][j] = (v4u){0u, 0u, 0u, 0u}; if (tp - (3 - j) >= 0) xw[ib][j] = *(const v4u*)(src - (size_t)(3 - j) * HD); } }
#pragma unroll
        for (int ib = 0; ib < NB; ++ib) { const int i = i0 + ib, part = i / PER, t = (i % PER) * ROWS + (ltid >> 4);
            const float* wp = cw + part * GDNW + h * HD + c;
            float acc[8];
#pragma unroll
            for (int e = 0; e < 8; ++e) acc[e] = 0.f;
#pragma unroll
            for (int j = 0; j < 4; ++j) { const v4u xv = xw[ib][j]; const f32x4 w0 = *(const f32x4*)(wp + j * (3 * GDNW)), w1 = *(const f32x4*)(wp + j * (3 * GDNW) + 4);
                acc[0] += w0[0] * bflo(xv.x); acc[1] += w0[1] * bfhi(xv.x); acc[2] += w0[2] * bflo(xv.y); acc[3] += w0[3] * bfhi(xv.y);
                acc[4] += w1[0] * bflo(xv.z); acc[5] += w1[1] * bfhi(xv.z); acc[6] += w1[2] * bflo(xv.w); acc[7] += w1[3] * bfhi(xv.w); }
            float ss = 0.f;
#pragma unroll
            for (int e = 0; e < 8; ++e) { acc[e] = acc[e] * __builtin_amdgcn_rcpf(1.0f + __builtin_amdgcn_exp2f(-1.4426950408889634f * acc[e])); ss += acc[e] * acc[e]; }
            if (part < 2) {
                ss += __shfl_xor(ss, 1); ss += __shfl_xor(ss, 2); ss += __shfl_xor(ss, 4); ss += __shfl_xor(ss, 8);
                const float r = (1.0f / sqrtf(ss + RMS_EPS)) * (part == 0 ? 0.08838834764831845f : 1.0f);
                v4u o; o.x = cvtpk_bf16(acc[0] * r, acc[1] * r); o.y = cvtpk_bf16(acc[2] * r, acc[3] * r); o.z = cvtpk_bf16(acc[4] * r, acc[5] * r); o.w = cvtpk_bf16(acc[6] * r, acc[7] * r);
                *(LAS v4u*)(lds + (part == 0 ? GP_QS : GP_KS) + (t * 136 + c) * 2) = o;
            } else {
                LAS float* vp = (LAS float*)(lds + GP_VS) + t * 132 + c;
                *(LAS f32x4*)vp = (f32x4){acc[0], acc[1], acc[2], acc[3]}; *(LAS f32x4*)(vp + 4) = (f32x4){acc[4], acc[5], acc[6], acc[7]};
            }
        }
    }
}
__device__ __forceinline__ void gp_s2(ArgsP A, LAS float* SMf, const float* SB, float* GL, int l, int ch, int lane) {
    const int bh = ch / GD_NCH, n = ch % GD_NCH, b = bh / GDNH, h = bh % GDNH;
    const size_t m = (size_t)b * SEQ + (size_t)n * 64 + lane;
    const float xb = SB[m * SBW + SB_GB + h], xa = SB[m * SBW + SB_GA + h] + A->in[I_GDNDTB][l * GDNH + h];
    const float bt = __builtin_amdgcn_rcpf(1.0f + __builtin_amdgcn_exp2f(-1.4426950408889634f * xb));
    const float sp = fmaxf(xa, 0.f) + 0.6931471805599453f * __builtin_amdgcn_logf(1.0f + __builtin_amdgcn_exp2f(-1.4426950408889634f * fabsf(xa)));
    const float gg = -__builtin_amdgcn_exp2f(1.4426950408889634f * A->in[I_GDNALOG][l * GDNH + h]) * sp;
    float gc = gg;
#pragma unroll
    for (int o = 1; o < 64; o <<= 1) { const float nb = __shfl_up(gc, o); if (lane >= o) gc += nb; }
    const float gtot = __shfl(gc, 63);
    SMf[lane] = bt; SMf[64 + lane] = gc; SMf[128 + lane] = __builtin_amdgcn_exp2f(1.4426950408889634f * gc); SMf[192 + lane] = __builtin_amdgcn_exp2f(1.4426950408889634f * (gtot - gc));
    if (lane == 63) GL[ch] = __builtin_amdgcn_exp2f(1.4426950408889634f * gtot);
}

__device__ __forceinline__ void gdn_prep(ArgsP ap0, LAS unsigned char* lds, int l) {
    const Ptrs P = fresh_ptrs(ap0); const ArgsP A = P.ap;
    const int tid = P.tid, lane = P.lane, wave = P.wave;
    const bf16* HMG = (const bf16*)(A->ws + WS_PROJ) + hm_off(HM_GQ, 0); const float* SB = (const float*)(A->ws + WS_SB);
    unsigned char* GOPS = A->ws + WS_GOPS; float* GU = (float*)(A->ws + WS_GU); float* GL = (float*)(A->ws + WS_GL);
    const float* cw = A->in[I_GDNCW] + (size_t)l * 4 * (3 * GDNW);
    LAS float* SMf = (LAS float*)(lds + GP_SM);
    LAS unsigned* hb = (LAS unsigned*)(lds + GP_SM + 1024); unsigned hb_epoch = 0u;
    if (tid == 0) *hb = 0u;
    if (P.bid < GD_NCHH) { gp_s1<512>(lds, HMG, cw, P.bid, tid); if (wave == 0) gp_s2(A, SMf, SB, GL, l, P.bid, lane); }
    for (int ch = P.bid; ch < GD_NCHH; ch += P.G) {
        const int bh = ch / GD_NCH, n = ch % GD_NCH, b = bh / GDNH, h = bh % GDNH;
        const size_t row0 = (size_t)b * SEQ + (size_t)n * 64;
        (void)b; (void)h; (void)row0; (void)n;
        __syncthreads();
        {
            const int mat = wave >> 2, mt = wave & 3, q4 = lane >> 4, m16 = lane & 15;
            f32x4 acc[4];
#pragma unroll
            for (int nt = 0; nt < 4; ++nt) acc[nt] = (f32x4){0.f, 0.f, 0.f, 0.f};
            const LAS unsigned char* abase = lds + (mat == 0 ? GP_KS : GP_QS) + ((16 * mt + m16) * 136 + 8 * q4) * 2;
            const LAS unsigned char* bbase = lds + GP_KS + (m16 * 136 + 8 * q4) * 2;
#pragma unroll
            for (int ks = 0; ks < 4; ++ks) { const bf16x8 a = *(const LAS bf16x8*)(abase + ks * 64);
#pragma unroll
                for (int nt = 0; nt < 4; ++nt) { const bf16x8 bb = *(const LAS bf16x8*)(bbase + nt * (16 * 136 * 2) + ks * 64); acc[nt] = __builtin_amdgcn_mfma_f32_16x16x32_bf16(a, bb, acc[nt], 0, 0, 0); } }
            const int c0 = 16 * mt + 4 * q4;
            const f32x4 gcc = *(const LAS f32x4*)(SMf + 64 + c0), btc = *(const LAS f32x4*)(SMf + c0);
#pragma unroll
            for (int nt = 0; nt < 4; ++nt) { const int s = 16 * nt + m16; const float gs = SMf[64 + s];
                if (mat == 0) { f32x4 o;
#pragma unroll
                    for (int r = 0; r < 4; ++r) o[r] = (s < c0 + r) ? btc[r] * acc[nt][r] * __builtin_amdgcn_exp2f(1.4426950408889634f * (gcc[r] - gs)) : 0.f;
                    *(LAS f32x4*)((LAS float*)(lds + GP_LT) + s * 68 + c0) = o;
                } else {
#pragma unroll
                    for (int r = 0; r < 4; ++r) ((LAS float*)(lds + GP_AT))[(c0 + r) * 68 + s] = (s <= c0 + r) ? acc[nt][r] * __builtin_amdgcn_exp2f(1.4426950408889634f * (gcc[r] - gs)) : 0.f;
                } }
        }
        __syncthreads();
        float x[64];
        if (tid < 256) {
            const int j = tid & 127, isw = tid >> 7;
            int vz = 0; asm volatile("" : "+v"(vz));
            const LAS float* SMv = SMf + vz;
#pragma unroll
            for (int r4 = 0; r4 < 16; ++r4) { const f32x4 bt = *(const LAS f32x4*)(SMv + 4 * r4), eg = *(const LAS f32x4*)(SMv + 128 + 4 * r4);
#pragma unroll
                for (int e = 0; e < 4; ++e) { const int r = 4 * r4 + e;
                    x[r] = isw ? __uint_as_float((unsigned)(*(const LAS unsigned short*)(lds + GP_KS + (r * 136 + j) * 2)) << 16) * (bt[e] * eg[e]) : ((const LAS float*)(lds + GP_VS))[r * 132 + j] * bt[e]; } }
        }
        __syncthreads();
        if (tid < 256) {
            const int j = tid & 127, isw = tid >> 7;
            { const LAS float* ltb = (const LAS float*)(lds + GP_LT) + (lane & 15);
              float Lc[4];
#pragma unroll
              for (int q = 0; q < 4; ++q) Lc[q] = ltb[16 * q];
              TriSolve<0>::run(x, ltb, Lc); }
            if (!isw) { float* up = GU + (size_t)ch * 8192 + (size_t)((j >> 4) * 4) * 256 + (j & 15) * 4;
#pragma unroll
                for (int mt = 0; mt < 4; ++mt)
#pragma unroll
                    for (int q4 = 0; q4 < 4; ++q4) *(f32x4*)(up + mt * 256 + q4 * 64) = (f32x4){x[16 * mt + 4 * q4], x[16 * mt + 4 * q4 + 1], x[16 * mt + 4 * q4 + 2], x[16 * mt + 4 * q4 + 3]};
            } else {
#pragma unroll
                for (int r = 0; r < 64; ++r) *(LAS unsigned short*)(lds + GP_WM + (r * 136 + j) * 2) = (unsigned short)f2bf(-x[r]);
            }
        } else {
            const int wv = wave - 4, q4 = lane >> 4, m16 = lane & 15;
            unsigned char* dst = GOPS + (size_t)ch * GD_OPS_BYTES + lane * 16;
            for (int f = wv; f < 40; f += 4) {
                v4u o;
                if (f < 16) { const int mt = f >> 2, ks = f & 3, row = 16 * mt + m16; const float eg = SMf[128 + row];
                    const LAS unsigned char* p = lds + GP_QS + (row * 136 + 32 * ks + 4 * q4) * 2;
                    const u32x2v a = *(const LAS u32x2v*)p, bq = *(const LAS u32x2v*)(p + 32);
                    o.x = cvtpk_bf16(bflo(a.x) * eg, bfhi(a.x) * eg); o.y = cvtpk_bf16(bflo(a.y) * eg, bfhi(a.y) * eg); o.z = cvtpk_bf16(bflo(bq.x) * eg, bfhi(bq.x) * eg); o.w = cvtpk_bf16(bflo(bq.y) * eg, bfhi(bq.y) * eg);
                    *(v4u*)(dst + (GD_F_QD + f) * 1024) = o;
                } else if (f < 24) { const int ff = f - 16, mt = ff >> 1, ks = ff & 1, row = 16 * mt + m16;
                    const LAS float* p = (const LAS float*)(lds + GP_AT) + row * 68 + 32 * ks + 4 * q4;
                    const f32x4 a = *(const LAS f32x4*)p, bq = *(const LAS f32x4*)(p + 16);
                    o.x = cvtpk_bf16(a[0], a[1]); o.y = cvtpk_bf16(a[2], a[3]); o.z = cvtpk_bf16(bq[0], bq[1]); o.w = cvtpk_bf16(bq[2], bq[3]);
                    *(v4u*)(dst + (GD_F_AT + ff) * 1024) = o;
                } else { const int ff = f - 24, mt = ff >> 1, ks = ff & 1, dk = 16 * mt + m16;
                    const int cA = 32 * ks + 4 * q4; const f32x4 ekA = *(const LAS f32x4*)(SMf + 192 + cA), ekB = *(const LAS f32x4*)(SMf + 192 + cA + 16);
                    float kv[8];
#pragma unroll
                    for (int e = 0; e < 4; ++e) { kv[e] = __uint_as_float((unsigned)(*(const LAS unsigned short*)(lds + GP_KS + ((cA + e) * 136 + dk) * 2)) << 16) * ekA[e];
                                                  kv[4 + e] = __uint_as_float((unsigned)(*(const LAS unsigned short*)(lds + GP_KS + ((cA + 16 + e) * 136 + dk) * 2)) << 16) * ekB[e]; }
                    o.x = cvtpk_bf16(kv[0], kv[1]); o.y = cvtpk_bf16(kv[2], kv[3]); o.z = cvtpk_bf16(kv[4], kv[5]); o.w = cvtpk_bf16(kv[6], kv[7]);
                    *(v4u*)(dst + (GD_F_KT + ff) * 1024) = o;
                }
            }
            if (ch + P.G < GD_NCHH) {
                asm volatile("s_waitcnt lgkmcnt(0)" ::: "memory");
                ++hb_epoch;
                if (lane == 0) (void)__hip_atomic_fetch_add(hb, 1u, __ATOMIC_RELAXED, __HIP_MEMORY_SCOPE_WORKGROUP);
                while (__hip_atomic_load(hb, __ATOMIC_RELAXED, __HIP_MEMORY_SCOPE_WORKGROUP) < 4u * hb_epoch) __builtin_amdgcn_s_sleep(1);
                asm volatile("" ::: "memory");
                gp_s1<256>(lds, HMG, cw, ch + P.G, tid - 256); if (wave == 4) gp_s2(A, SMf, SB, GL, l, ch + P.G, lane); }
        }
        __syncthreads();
        { const int q4 = lane >> 4, m16 = lane & 15;
#pragma unroll
          for (int k2 = 0; k2 < 2; ++k2) { const int f = wave * 2 + k2, mt = f >> 2, ks = f & 3, row = 16 * mt + m16;
            const LAS unsigned char* p = lds + GP_WM + (row * 136 + 32 * ks + 4 * q4) * 2;
            const u32x2v a = *(const LAS u32x2v*)p, bq = *(const LAS u32x2v*)(p + 32);
            v4u o; o.x = a.x; o.y = a.y; o.z = bq.x; o.w = bq.y;
            *(v4u*)(GOPS + (size_t)ch * GD_OPS_BYTES + (GD_F_WN + f) * 1024 + lane * 16) = o; } }
    }
    __syncthreads();
}

__device__ __forceinline__ void gdn_scan(ArgsP ap0, LAS unsigned char* lds) {
    const Ptrs P = fresh_ptrs(ap0); const ArgsP A = P.ap;
    const int lane = P.lane, wave = P.wave, bh = P.bid >> 1, b = bh / GDNH, h = bh % GDNH, q4 = lane >> 4, n16 = lane & 15;
    const int cs = (P.bid & 1) * 4 + (wave & 3);
    const bool comp = wave < 4;
    const unsigned char* ops = A->ws + WS_GOPS + (size_t)bh * GD_NCH * GD_OPS_BYTES;
    const float* Up = (const float*)(A->ws + WS_GU) + (size_t)bh * GD_NCH * 8192 + (size_t)(cs * 4) * 256 + lane * 4;
    const float* GLp = (const float*)(A->ws + WS_GL) + (size_t)bh * GD_NCH;
    float* GO = (float*)(A->ws + WS_GO2) + ((size_t)b * SEQ) * GDNW + h * HD + 16 * cs + n16;
    f32x4 S[8];
#pragma unroll
    for (int i = 0; i < 8; ++i) S[i] = (f32x4){0.f, 0.f, 0.f, 0.f};
    f32x4 Un[4]; float gln = 0.f;
#pragma unroll
    for (int i = 0; i < 4; ++i) Un[i] = (f32x4){0.f, 0.f, 0.f, 0.f};
#define GD_DMA(nn, buf) do { _Pragma("unroll") for (int i_ = 0; i_ < 7; ++i_) __builtin_amdgcn_global_load_lds((const unsigned*)(ops + (size_t)(nn) * GD_OPS_BYTES + (i_ * 8 + wave) * 1024 + lane * 16), \
        (LAS unsigned*)(lds + (buf) * GD_OPS_BYTES + (i_ * 8 + wave) * 1024), 16, 0, 0); } while (0)
#define GD_ULOAD(nn) do { if (comp) { _Pragma("unroll") for (int mt_ = 0; mt_ < 4; ++mt_) Un[mt_] = *(const f32x4*)(Up + (size_t)(nn) * 8192 + mt_ * 256); gln = GLp[nn]; } } while (0)
    GD_DMA(0, 0); GD_ULOAD(0);
    for (int n = 0; n < GD_NCH; ++n) {
        asm volatile("s_waitcnt vmcnt(0)" ::: "memory");
        __syncthreads();
        f32x4 Uc[4]; const float gl = gln;
#pragma unroll
        for (int mt = 0; mt < 4; ++mt) Uc[mt] = Un[mt];
        if (n + 1 < GD_NCH) { GD_DMA(n + 1, (n + 1) & 1); GD_ULOAD(n + 1); }
        if (comp) {
        const LAS unsigned char* fr = lds + (n & 1) * GD_OPS_BYTES + lane * 16;
#define GD_FRAG(f) (*(const LAS bf16x8*)(fr + (f) * 1024))
        bf16x8 Sb[4];
#pragma unroll
        for (int ks = 0; ks < 4; ++ks) { v4u w; w.x = cvtpk_bf16(S[2 * ks][0], S[2 * ks][1]); w.y = cvtpk_bf16(S[2 * ks][2], S[2 * ks][3]); w.z = cvtpk_bf16(S[2 * ks + 1][0], S[2 * ks + 1][1]); w.w = cvtpk_bf16(S[2 * ks + 1][2], S[2 * ks + 1][3]);
            Sb[ks] = __builtin_bit_cast(bf16x8, w); }
        f32x4 vn[4];
#pragma unroll
        for (int mt = 0; mt < 4; ++mt) { vn[mt] = Uc[mt];
#pragma unroll
            for (int ks = 0; ks < 4; ++ks) vn[mt] = __builtin_amdgcn_mfma_f32_16x16x32_bf16(GD_FRAG(GD_F_WN + mt * 4 + ks), Sb[ks], vn[mt], 0, 0, 0); }
        bf16x8 Vb[2];
#pragma unroll
        for (int ks = 0; ks < 2; ++ks) { v4u w; w.x = cvtpk_bf16(vn[2 * ks][0], vn[2 * ks][1]); w.y = cvtpk_bf16(vn[2 * ks][2], vn[2 * ks][3]); w.z = cvtpk_bf16(vn[2 * ks + 1][0], vn[2 * ks + 1][1]); w.w = cvtpk_bf16(vn[2 * ks + 1][2], vn[2 * ks + 1][3]);
            Vb[ks] = __builtin_bit_cast(bf16x8, w); }
        float* orow = GO + (size_t)(n * 64 + 4 * q4) * GDNW;
#pragma unroll
        for (int mt = 0; mt < 4; ++mt) { f32x4 o = (f32x4){0.f, 0.f, 0.f, 0.f};
#pragma unroll
            for (int ks = 0; ks < 4; ++ks) o = __builtin_amdgcn_mfma_f32_16x16x32_bf16(GD_FRAG(GD_F_QD + mt * 4 + ks), Sb[ks], o, 0, 0, 0);
#pragma unroll
            for (int ks = 0; ks < 2; ++ks) o = __builtin_amdgcn_mfma_f32_16x16x32_bf16(GD_FRAG(GD_F_AT + mt * 2 + ks), Vb[ks], o, 0, 0, 0);
#pragma unroll
            for (int r = 0; r < 4; ++r) orow[(size_t)(16 * mt + r) * GDNW] = o[r]; }
#pragma unroll
        for (int mt = 0; mt < 8; ++mt) { S[mt] = S[mt] * gl;
#pragma unroll
            for (int ks = 0; ks < 2; ++ks) S[mt] = __builtin_amdgcn_mfma_f32_16x16x32_bf16(GD_FRAG(GD_F_KT + mt * 2 + ks), Vb[ks], S[mt], 0, 0, 0); }
        }
    }
#undef GD_FRAG
#undef GD_DMA
#undef GD_ULOAD
    asm volatile("s_waitcnt vmcnt(0)" ::: "memory");
    __syncthreads();
}
__device__ __forceinline__ void p4_finalize(ArgsP ap0, int l) {
    const Ptrs P = fresh_ptrs(ap0); const ArgsP A = P.ap;
    const float* GO = (const float*)(A->ws + WS_GO2); const bf16* HMZ = (const bf16*)(A->ws + WS_PROJ) + hm_off(HM_GZ, 0);
    bf16* MIX = (bf16*)(A->ws + WS_MIX); const int lane = P.lane;
    typedef float f32x2 __attribute__((ext_vector_type(2)));
    const f32x2 gg = *(const f32x2*)(A->in[I_GDNON] + l * HD + 2 * lane);
    for (int m = P.gw; m < M; m += P.NGW) {
        const int b = m / SEQ, s = m % SEQ;
        f32x2 v[GDNH]; unsigned zw[GDNH];
#pragma unroll
        for (int h = 0; h < GDNH; ++h) { v[h] = *(const f32x2*)(GO + (size_t)m * GDNW + h * HD + 2 * lane); zw[h] = *(const unsigned*)(HMZ + ((size_t)(b * GDNH + h) * SEQ + s) * HD + 2 * lane); }
        float ss[GDNH];
#pragma unroll
        for (int h = 0; h < GDNH; ++h) ss[h] = v[h][0] * v[h][0] + v[h][1] * v[h][1];
#pragma unroll
        for (int o = 1; o < 64; o <<= 1) {
#pragma unroll
            for (int h = 0; h < GDNH; ++h) ss[h] += __shfl_xor(ss[h], o); }
#pragma unroll
        for (int h = 0; h < GDNH; ++h) { const float rr = 1.0f / sqrtf(ss[h] * (1.0f / HD) + RMS_EPS);
            *(unsigned*)(MIX + (size_t)m * DM + FOXW + SCW + h * HD + 2 * lane) = pk2(v[h][0] * rr * gg[0] * silu_acc(bflo(zw[h])), v[h][1] * rr * gg[1] * silu_acc(bfhi(zw[h]))); }
    }
}

constexpr int ATT_PER_X = 3 * (SEQ / attn::QB);
constexpr int ATT_SLOT_OFF = 69632;
static_assert(attn::LDS_BYTES <= ATT_SLOT_OFF, "attention LDS map");
typedef attn::BlockRef<attn::bf16, attn::bf16> FoxRef;
__device__ __forceinline__ int fox_jlo(ArgsP A, int l, int bh, int P0) {
    const float* FG = (const float*)(A->ws + WS_FG) + (size_t)bh * SEQ; const unsigned* nrm = (const unsigned*)(A->ws + WS_CTL) + CW_NRM + l * 64;
    const int lane = my_lane();
    const float f0 = FG[64 * lane + 63], f1 = FG[64 * (lane + 64) + 63];
    const float bound = 2.0f * sqrtf(__uint_as_float(nrm[bh]) * __uint_as_float(nrm[BATCH * FOXH + bh])) * 1.001f;
    const float thr = FG[P0] - bound - 600.0f;
    const int n = __builtin_popcountll(__ballot(f0 < thr)) + __builtin_popcountll(__ballot(f1 < thr));
    const int jd = P0 / attn::KVBLK;
    return __builtin_amdgcn_readfirstlane(n < jd ? n : jd);
}
__device__ __forceinline__ FoxRef fox_ref(ArgsP A, int id, int l) {
    const int qx = id / ATT_PER_X, i = id % ATT_PER_X, bh = 3 * qx + (i >> 5), qb = 31 - (i & 31);
    const int b = bh / FOXH, h = bh % FOXH; const size_t row0 = (size_t)b * SEQ;
    const attn::bf16* HM = (const attn::bf16*)(A->ws + WS_PROJ);
    FoxRef r;
    r.Q = HM + hm_off(HM_FQ, bh) + (size_t)qb * attn::QB * HD;
    r.K = HM + hm_off(HM_FK, bh); r.V = HM + hm_off(HM_FV, bh);
    r.F = (const float*)(A->ws + WS_FG) + (size_t)bh * SEQ;
    r.O = (attn::bf16*)(A->ws + WS_MIX) + (row0 + (size_t)qb * attn::QB) * DM + h * HD; r.P0 = qb * attn::QB; r.JLO = fox_jlo(A, l, bh, r.P0);
    return r;
}
__device__ __forceinline__ int att_claim(gu32* ctrs, volatile LAS int* st) {
    int qx = st[0], tried = st[1], r = -1;
    while (tried < 8) { const unsigned i = __hip_atomic_fetch_add(ctrs + qx * 64, 1u, __ATOMIC_RELAXED, __HIP_MEMORY_SCOPE_AGENT); if (i < (unsigned)ATT_PER_X) { r = qx * ATT_PER_X + (int)i; break; } qx = (qx + 1) & 7; ++tried; }
    st[0] = qx; st[1] = tried;
    return r;
}
__device__ __forceinline__ void p3_attention(ArgsP ap0, char* lds, int l, int rep = 0) {
    const ArgsP A = fresh(ap0);
    gu32* ctrs = (gu32*)(A->ws + WS_CTL) + CW_Q + (rep * 2 + l) * 8 * 64;
    volatile LAS int* slot = (volatile LAS int*)((LAS unsigned char*)lds + ATT_SLOT_OFF);
    if (ftid() == 0) { slot[4] = (int)(xb_xcc_id() & 7u); slot[5] = 0; slot[0] = att_claim(ctrs, slot + 4); slot[1] = att_claim(ctrs, slot + 4); }
    __syncthreads();
    int cur = __builtin_amdgcn_readfirstlane(slot[0]), nxt = __builtin_amdgcn_readfirstlane(slot[1]);
    if (cur < 0) return;
    FoxRef curR = fox_ref(A, cur, l);
    attn::Seam<attn::bf16> S;
    attn::causal_swa_prime<attn::bf16, attn::bf16>(curR, SEQ, lds, S);
    for (int k = 0;; ++k) {
        if (nxt >= 0 && ftid() == 0) slot[2 + (k & 1)] = att_claim(ctrs, slot + 4);
        const bool last = nxt < 0;
        const FoxRef nxtR = last ? curR : fox_ref(A, nxt, l);
        attn::causal_swa_block<attn::bf16, attn::bf16>(curR, nxtR, SEQ, SEQ, lds, S, &A->in[I_FOXON], l * HD);
        if (last) break;
        cur = nxt; curR = nxtR; nxt = __builtin_amdgcn_readfirstlane(slot[2 + (k & 1)]);
    }
}

constexpr int N_PHASES = 1 + 9 * DEPTH;

#ifndef PH_EN
#define PH_EN 0x3ff
#endif
#define IN(k) (lo <= (k) && (k) < hi)
#define EN(j) ((PH_EN >> (j)) & 1)
#ifndef REP_MASK
#define REP_MASK 0
#endif
#define REPS(j) (((REP_MASK >> (j)) & 1) ? 2 : 1)
#define SEAM(k) do { if (IN(k) && IN((k) + 1)) { XcdBarrier b_; b_.bar = (unsigned*)(fresh(ap0)->ws + WS_CTL) + CW_BAR; b_.x = xb_xcc_id(); b_.st = (volatile LAS unsigned*)((LAS unsigned char*)lds + MISC_OFF) + 8; xcd_barrier(b_); } } while (0)
#define WSP(T, off) ((T*)(A->ws + (off)))


template <int l>
__device__ __forceinline__ void layer_phases(ArgsP ap0, LAS unsigned char* ldsl, unsigned char* lds, int lo, int hi) {

        const int pb = 1 + 9 * l;
        if (EN(1) && IN(pb + 0)) {
            const Ptrs P = fresh_ptrs(ap0); const ArgsP A = P.ap;
            pg8::Gemm g{WSP(bf16, WS_XN), WSP(bf16, WS_W + WO_IN), M, NP, DM}; pg8::StaticOrder S; S.init(M, NP, P.G, P.bid);
            pg8::EpiProj E{WSP(bf16, WS_PROJ), WSP(bf16, WS_SCB), WSP(float, WS_SB)};
            for (int rep_ = 0; rep_ < REPS(1); ++rep_) pg8::gemm_phase<pg8::EpiProj, pg8::StaticOrder, true, true>(ldsl, g, S, E);
            convert_weights(ap0, ldsl, l, I_IN + I_OUT + I_GU, I_LAYER, (M / 256) * (NP / 256) % P.G);
            SEAM(pb + 0);
        }
        if (EN(2) && IN(pb + 1)) {
            for (int rep_ = 0; rep_ < REPS(11); ++rep_) p2_prep(ap0, ldsl, l);
            for (int rep_ = 0; rep_ < REPS(2); ++rep_) gdn_prep(ap0, ldsl, l);
            SEAM(pb + 1); }
        if (EN(3) && IN(pb + 2)) {
            for (int rep_ = 0; rep_ < REPS(10); ++rep_) if ((int)blockIdx.x < 2 * BATCH * GDNH) gdn_scan(ap0, ldsl);
            for (int rep_ = 0; rep_ < REPS(3); ++rep_) p3_attention(ap0, (char*)lds, l, rep_);
            SEAM(pb + 2);
        }
        if (EN(4) && IN(pb + 3)) { for (int rep_ = 0; rep_ < REPS(4); ++rep_) p4_finalize(ap0, l); SEAM(pb + 3); }
        if (EN(5) && IN(pb + 4)) {
            const Ptrs P = fresh_ptrs(ap0); const ArgsP A = P.ap;
            pg8::Gemm g{WSP(bf16, WS_MIX), WSP(bf16, WS_W + WO_OUT), M, DM, DM}; pg8::StaticOrder S; S.init(M, DM, P.G, P.bid);
            pg8::EpiY E{WSP(bf16, WS_Y), WSP(float, WS_SS)};
            for (int rep_ = 0; rep_ < REPS(5); ++rep_) pg8::gemm_phase<pg8::EpiY, pg8::StaticOrder, true, true>(ldsl, g, S, E);
            SEAM(pb + 4);
        }
        if (EN(6) && IN(pb + 5)) {
            const Ptrs P = fresh_ptrs(ap0); const ArgsP A = P.ap;
            const float* xin = l == 0 ? A->in[I_X] : (const float*)A->out;
            const float* gpost = A->in[I_MIXPOST] + l * DM; const float* gpre = A->in[I_FFNPRE] + l * DM;
            const bf16* Y = WSP(bf16, WS_Y); const float* SS = WSP(float, WS_SS); float* H = WSP(float, WS_H); bf16* XN = WSP(bf16, WS_XN);
            for (int rep_ = 0; rep_ < REPS(6); ++rep_)
            for (int m = P.gw; m < M; m += P.NGW)
                resid_norm_row(xin + (size_t)m * DM, Y + (size_t)m * DM, SS + (size_t)m * 64, gpost, H + (size_t)m * DM, gpre, XN + (size_t)m * DM, P.lane);
            SEAM(pb + 5);
        }
        if (EN(7) && IN(pb + 6)) {
            const Ptrs P = fresh_ptrs(ap0); const ArgsP A = P.ap;
            pg8::Gemm g{WSP(bf16, WS_XN), WSP(bf16, WS_W + WO_GU), M, NGU, DM}; pg8::StaticOrder S; S.init(M, NGU, P.G, P.bid);
            pg8::EpiSwiGLU E{WSP(bf16, WS_PROJ)};
            for (int rep_ = 0; rep_ < REPS(7); ++rep_) pg8::gemm_phase<pg8::EpiSwiGLU, pg8::StaticOrder, true, true>(ldsl, g, S, E);
            if (l + 1 < DEPTH) convert_weights(ap0, ldsl, l + 1, 0, I_IN + I_OUT, (M / 256) * (NGU / 256) % P.G);
            SEAM(pb + 6);
        }
        if (EN(8) && IN(pb + 7)) {
            const Ptrs P = fresh_ptrs(ap0); const ArgsP A = P.ap;
            pg8::Gemm g{WSP(bf16, WS_PROJ), WSP(bf16, WS_W + WO_DN), M, DM, FFN}; pg8::StaticOrder S; S.init(M, DM, P.G, P.bid);
            pg8::EpiY E{WSP(bf16, WS_Y), WSP(float, WS_SS)};
            for (int rep_ = 0; rep_ < REPS(8); ++rep_) pg8::gemm_phase<pg8::EpiY, pg8::StaticOrder, true, true>(ldsl, g, S, E);
            SEAM(pb + 7);
        }
        if (EN(9) && IN(pb + 8)) {
            const Ptrs P = fresh_ptrs(ap0); const ArgsP A = P.ap;
            const float* gnext = l + 1 < DEPTH ? A->in[I_MIXPRE] + (l + 1) * DM : nullptr; const float* gpost = A->in[I_FFNPOST] + l * DM;
            const bf16* Y = WSP(bf16, WS_Y); const float* SS = WSP(float, WS_SS); const float* H = WSP(float, WS_H); bf16* XN = WSP(bf16, WS_XN); float* outp = A->out;
            for (int rep_ = 0; rep_ < REPS(9); ++rep_) {
            for (int m = P.gw; m < M; m += P.NGW)
                resid_norm_row(H + (size_t)m * DM, Y + (size_t)m * DM, SS + (size_t)m * 64, gpost, outp + (size_t)m * DM, gnext, XN + (size_t)m * DM, P.lane);
            if (l + 1 < DEPTH) convert_weights(ap0, ldsl, l + 1, I_IN + I_OUT, I_IN + I_OUT + I_GU);
            }
            SEAM(pb + 8);
        }
    }

__global__ void __launch_bounds__(NWAVES * 64, 2) hybrid_fwd(Args args) {
    extern __shared__ __attribute__((aligned(16))) unsigned char lds[];
    LAS unsigned char* ldsl = (LAS unsigned char*)lds;
    volatile LAS unsigned* MISC = (volatile LAS unsigned*)(ldsl + MISC_OFF);
    const ArgsP ap0 = (ArgsP)__builtin_amdgcn_kernarg_segment_ptr();
    for (int u = threadIdx.x; u < (LDS_BYTES - LDSCTL_OFF) / 4; u += NWAVES * 64) ((LAS unsigned*)(ldsl + LDSCTL_OFF))[u] = 0u;
    __syncthreads();
    if ((threadIdx.x & 63) == 0) *(volatile LAS int*)(ldsl + TIDTAB_OFF + 4 * hw_slot()) = (int)(threadIdx.x >> 6);
    __syncthreads();
    const int lo = args.ph_lo, hi = args.ph_hi;
    if (hi - lo > 1) (void)xcd_barrier_post((unsigned*)(args.ws + WS_CTL) + CW_BAR, MISC + 8);
    if (EN(0) && IN(0)) { for (int rep_ = 0; rep_ < REPS(0); ++rep_) p0_prologue(ap0, ldsl); SEAM(0); }
    layer_phases<0>(ap0, ldsl, lds, lo, hi);
    layer_phases<1>(ap0, ldsl, lds, lo, hi);
}

#undef IN
#undef SEAM
extern "C" void kernel_launch(void* const* d_in, const int* in_sizes, int n_in, void* d_out, int out_size, void* d_ws, size_t ws_size, hipStream_t stream) {
    static int grid = 0;
    if (grid == 0) {
        if (n_in != 17 || in_sizes[0] != M * DM || out_size != M * DM || ws_size < WS_END) {
            fprintf(stderr, "kernel_launch: shape/workspace mismatch: n_in %d in0 %d out %d ws %zu (need %zu)\n", n_in, n_in > 0 ? in_sizes[0] : -1, out_size, ws_size, (size_t)WS_END); grid = -1; return; }
        int dev = 0, cus = 0, per_cu = 0;
        if (hipGetDevice(&dev) != hipSuccess || hipDeviceGetAttribute(&cus, hipDeviceAttributeMultiprocessorCount, dev) != hipSuccess) { fprintf(stderr, "kernel_launch: device query failed\n"); grid = -1; return; }
        if (hipFuncSetAttribute((const void*)hybrid_fwd, hipFuncAttributeMaxDynamicSharedMemorySize, LDS_BYTES) != hipSuccess) { fprintf(stderr, "kernel_launch: hipFuncSetAttribute failed\n"); grid = -1; return; }
        if (hipOccupancyMaxActiveBlocksPerMultiprocessor(&per_cu, (const void*)hybrid_fwd, NWAVES * 64, LDS_BYTES) != hipSuccess || per_cu < 1)
            fprintf(stderr, "kernel_launch: note: occupancy query reports %d workgroups per CU\n", per_cu);
        (void)hipGetLastError();
        grid = cus;
    }
    if (grid < 0) return;
    if (hipMemsetAsync((char*)d_ws + WS_CTL, 0, CTL_ZERO_BYTES, stream) != hipSuccess) { fprintf(stderr, "kernel_launch: memset failed\n"); return; }
    Args a{};
    for (int i = 0; i < 17; ++i) a.in[i] = (const float*)d_in[i];
    a.out = (float*)d_out; a.ws = (unsigned char*)d_ws;
#if MK_N_LAUNCHES == 1
    a.ph_lo = 0; a.ph_hi = N_PHASES;
    hipLaunchKernelGGL(hybrid_fwd, dim3(grid), dim3(NWAVES * 64), LDS_BYTES, stream, a);
#else
    for (int p = 0; p < N_PHASES; ++p) { a.ph_lo = p; a.ph_hi = p + 1; hipLaunchKernelGGL(hybrid_fwd, dim3(grid), dim3(NWAVES * 64), LDS_BYTES, stream, a); }
#endif
    const hipError_t le = hipPeekAtLastError();
    if (le != hipSuccess) fprintf(stderr, "kernel_launch: launch failed: %s\n", hipGetErrorName(le));
}
```

```cpp
#include <hip/hip_runtime.h>
#include <hip/hip_bf16.h>
#include <cstdio>
#include <cstdint>
#include <cmath>

#ifndef MK_N_LAUNCHES
#define MK_N_LAUNCHES 1
#endif

constexpr int BATCH = 2, SEQ = 8192, DM = 4096, M = BATCH * SEQ, DEPTH = 2;
constexpr int HD = 128, FOXH = 12, FOXW = FOXH * HD, SCW = 1024, GDNH = 12, GDNW = GDNH * HD;
constexpr int PROJ_SRC = 13860;
constexpr int NP = 14080;
constexpr int FFN = 11008, NGU = 2 * FFN;
constexpr float RMS_EPS = 1e-6f;
constexpr int PC_FQ = 0, PC_FK = 1536, PC_FV = 3072, PC_SB = 4608, PC_SC = 5632, PC_SH = 6656, PC_GQ = 7680, PC_GK = 9216, PC_GV = 10752, PC_GZ = 12288, PC_SMALL = 13824;
constexpr int SBW = 64, SB_FF = 0, SB_GA = 12, SB_GB = 24;
constexpr int SRC_FF = 4608, SRC_SB = 4620, SRC_GQ = 7692, SRC_GA = 12300, SRC_GB = 12312, SRC_GZ = 12324;

constexpr size_t MiB = 1u << 20;
constexpr size_t WS_CTL = 0, CTL_ZERO_BYTES = 1 * MiB;
constexpr size_t WS_W = 16 * MiB;
constexpr size_t WO_IN = 0, WO_OUT = 110 * MiB, WO_GU = 142 * MiB, WO_DN = 314 * MiB;
constexpr size_t WS_XN = 416 * MiB;
constexpr size_t WS_MIX = 544 * MiB;
constexpr size_t WS_Y = 672 * MiB;
constexpr size_t WS_H = 800 * MiB;
constexpr size_t WS_PROJ = 1056 * MiB;
constexpr size_t WS_SCB = WS_PROJ + 336 * MiB;
constexpr int HM_FQ = 0, HM_FK = 1, HM_FV = 2, HM_GQ = 3, HM_GZ = 6, SCBW = 3 * SCW;
__host__ __device__ constexpr size_t hm_off(int part, int bh) { return ((size_t)(part * (BATCH * FOXH) + bh) * SEQ) * HD; }
constexpr size_t WS_SB = 1496 * MiB;
constexpr size_t WS_SS = 1500 * MiB;
constexpr size_t WS_FG = 1504 * MiB;
constexpr size_t WS_TN = WS_FG + 1 * MiB;
constexpr size_t WS_END = 1506 * MiB;
constexpr size_t WS_AO = WS_XN;
constexpr size_t WS_GQ = WS_Y, WS_GK = WS_Y + 96 * MiB, WS_GV = WS_Y + 192 * MiB, WS_GO = WS_Y + 288 * MiB;
constexpr int CW_TMO = 0, CW_BAR = 4096, CW_Q = 16384, CW_NRM = 32768;

constexpr int NWAVES = 8;
constexpr int RING_BYTES = 131072, LDSCTL_OFF = RING_BYTES, MISC_OFF = LDSCTL_OFF + 320, LDS_BYTES = 147456;


extern __shared__ __attribute__((aligned(16))) unsigned char g_lds[];
constexpr int TIDTAB_OFF = LDSCTL_OFF + 512;
__device__ __forceinline__ unsigned hw_slot() { return (unsigned)__builtin_amdgcn_s_getreg((5 << 11) | 4) & 63u; }
__device__ __forceinline__ int my_lane() { int l; asm volatile("v_mbcnt_lo_u32_b32 %0, -1, 0\n\tv_mbcnt_hi_u32_b32 %0, -1, %0" : "=v"(l)); return l; }
__device__ __forceinline__ int my_wave() { return __builtin_amdgcn_readfirstlane(*(volatile __attribute__((address_space(3))) int*)((__attribute__((address_space(3))) unsigned char*)g_lds + TIDTAB_OFF + 4 * hw_slot())); }
__device__ __forceinline__ int my_tid() { return my_wave() * 64 + my_lane(); }

#define GAS __attribute__((address_space(1)))
#define LAS __attribute__((address_space(3)))
typedef unsigned short bf16;
typedef unsigned v4u __attribute__((ext_vector_type(4)));
typedef float f32x4 __attribute__((ext_vector_type(4)));
typedef short bf16x8 __attribute__((ext_vector_type(8)));
typedef GAS unsigned gu32;
typedef GAS unsigned long long gu64;
#define RLX_AGENT __ATOMIC_RELAXED, __HIP_MEMORY_SCOPE_AGENT
#define LDS_WAIT() asm volatile("s_waitcnt lgkmcnt(0)" ::: "memory")
#define VM_WAIT() asm volatile("s_waitcnt vmcnt(0)" ::: "memory")
__device__ __forceinline__ unsigned long long rt() { return __builtin_amdgcn_s_memrealtime(); }
__device__ __forceinline__ unsigned f2bf(float f) { unsigned u = __builtin_bit_cast(unsigned, f); return (u + 0x7fffu + ((u >> 16) & 1u)) >> 16; }
__device__ __forceinline__ unsigned pk2(float lo, float hi) { return f2bf(lo) | (f2bf(hi) << 16); }

#define XB_TMO      128
#define XB_XCNT(j)  (256  + 64 * (j))
#define XB_XSUB(j)  (1280 + 64 * (j))
#define XB_XGEN(j)  (2304 + 64 * (j))
#define XB_TOP      3328
#define XB_TOPGEN   3392
#define XCD_BAR_WORDS 3456
#define XB_SPIN_CAP (1u << 18)

__device__ __forceinline__ unsigned xb_ld(unsigned* p)              { return __hip_atomic_load(p, __ATOMIC_RELAXED, __HIP_MEMORY_SCOPE_AGENT); }
__device__ __forceinline__ unsigned xb_add(unsigned* p, unsigned v) { return __hip_atomic_fetch_add(p, v, __ATOMIC_RELAXED, __HIP_MEMORY_SCOPE_AGENT); }
__device__ __forceinline__ unsigned xb_xcc_id() { return (unsigned)__builtin_amdgcn_s_getreg((3 << 11) | 20) & 0xFu; }
#define XB_SPIN(cond, bar) do { unsigned _sp = 0; while (cond) { __builtin_amdgcn_s_sleep(1); \
    if ((++_sp & 255u) == 0u) { if (xb_ld(&(bar)[XB_TMO])) break; if (_sp > XB_SPIN_CAP) { atomicAdd(&(bar)[XB_TMO], 1u); break; } } } } while (0)

struct XcdBarrier {
    unsigned* bar; unsigned x;
    volatile LAS unsigned* st;
};

__device__ __forceinline__ XcdBarrier xcd_barrier_post(unsigned* bar, volatile LAS unsigned* st) {
    XcdBarrier b; b.bar = bar; b.x = xb_xcc_id(); b.st = st;
    if (my_tid() == 0) (void)xb_add(&bar[XB_XCNT(b.x)], 1u);
    return b;
}
__device__ __forceinline__ void xcd_barrier_complete(unsigned* bar, unsigned x, unsigned& nloc, unsigned& nx) {
    const unsigned G = gridDim.x * gridDim.y * gridDim.z;
    unsigned sum, cnt, mine, sp = 0u;
    for (;;) {
        sum = 0u; cnt = 0u; mine = 0u;
#pragma unroll
        for (unsigned j = 0; j < 16; ++j) { const unsigned c = xb_ld(&bar[XB_XCNT(j)]); sum += c; cnt += (c > 0u) ? 1u : 0u; mine = (j == x) ? c : mine; }
        if (sum == G) break;
        __builtin_amdgcn_s_sleep(1);
        if ((++sp & 255u) == 0u) { if (xb_ld(&bar[XB_TMO])) break; if (sp > XB_SPIN_CAP) { atomicAdd(&bar[XB_TMO], 1u); break; } }
    }
    nloc = mine > 0u ? mine : 1u; nx = cnt > 0u ? cnt : 1u;
}

__device__ __forceinline__ void xcd_barrier(const XcdBarrier& b) {
    asm volatile("s_waitcnt vmcnt(0)" ::: "memory");
    __syncthreads();
    if (my_tid() == 0) {
        unsigned* bar = b.bar;
        __builtin_amdgcn_s_waitcnt(0);
        unsigned nloc = b.st[0], nx = b.st[1];
        if (nloc == 0u) { xcd_barrier_complete(bar, b.x, nloc, nx); b.st[0] = nloc; b.st[1] = nx; }
        const unsigned old = xb_add(&bar[XB_XSUB(b.x)], 1u);
        const unsigned gen = old / nloc;
        if (old + 1u == (gen + 1u) * nloc) {
            __builtin_amdgcn_fence(__ATOMIC_RELEASE, "agent");
            asm volatile("s_waitcnt vmcnt(0)" ::: "memory");
            const unsigned og = xb_add(&bar[XB_TOP], 1u);
            const unsigned tg = og / nx;
            if (og + 1u == (tg + 1u) * nx) xb_add(&bar[XB_TOPGEN], 1u);
            else XB_SPIN(xb_ld(&bar[XB_TOPGEN]) == tg, bar);
            __builtin_amdgcn_fence(__ATOMIC_ACQUIRE, "agent");
            xb_add(&bar[XB_XGEN(b.x)], 1u);
            asm volatile("s_waitcnt vmcnt(0)" ::: "memory");
        } else {
            XB_SPIN(xb_ld(&bar[XB_XGEN(b.x)]) == gen, bar);
            __builtin_amdgcn_fence(__ATOMIC_ACQUIRE, "agent");
            asm volatile("s_waitcnt vmcnt(0)" ::: "memory");
        }
    }
    __syncthreads();
}

namespace pg8 {
#define PG8_LAS __attribute__((address_space(3)))
typedef unsigned short bf16_t;
typedef short bf16x8 __attribute__((ext_vector_type(8)));
typedef float f32x4 __attribute__((ext_vector_type(4)));
typedef unsigned u32x4 __attribute__((ext_vector_type(4)));
constexpr int BM = 256, BK = 64, HALF = 128, HTB = HALF * BK * 2  , STAGE_BYTES = 8 * HTB, NXCD = 8, WGM = 8;

__host__ __device__ __forceinline__ int lds_byte(int r, int c) { const int st = (r >> 4) * 2 + (c >> 5), rr = r & 15, cc = c & 31, ob = rr * 64 + cc * 2; return st * 1024 + (ob ^ (((ob >> 9) & 1) << 5)); }
__host__ __device__ __forceinline__ void stage_rc(int b, int& R, int& C) { const int st = b / 1024, sb = b % 1024, swz = sb ^ (((sb >> 9) & 1) << 5); R = (st >> 1) * 16 + swz / 64; C = (st & 1) * 32 + (swz % 64) / 2; }
__host__ __device__ __forceinline__ int perm32(int rho) { const int n = rho >> 4, i = rho & 15; return 8 * (i >> 2) + 4 * n + (i & 3); }

struct Unit { int pm, pn; };
struct Gemm { const bf16_t* A; const bf16_t* Bt; int M, N, K; };

struct StaticOrder {
    int nM, nN, nwg, G, c;
    __host__ __device__ void init(int M, int N, int G_, int c_) { nM = M / BM; nN = N / BM; nwg = nM * nN; G = G_; c = c_; }
    __host__ __device__ bool next(int i, Unit& u) const {
        const long L = (long)i * G + c; if (L >= nwg) return false;
        int wgid = (int)L; { const int q = nwg / NXCD, r = nwg % NXCD, xcd = wgid % NXCD, off = wgid / NXCD; wgid = (xcd < r ? xcd * (q + 1) : r * (q + 1) + (xcd - r) * q) + off; }
        const int nig = WGM * nN, gid = wgid / nig, fm = gid * WGM, gsz = (nM - fm) < WGM ? (nM - fm) : WGM;
        u.pm = fm + ((wgid % nig) % gsz); u.pn = (wgid % nig) / gsz; return true;
    }
    __device__ __forceinline__ void a_ready(const Unit&) const {}
    __device__ __forceinline__ void done(const Unit&) const {}
};


typedef float f32x2e __attribute__((ext_vector_type(2))); typedef __bf16 bf16x2e __attribute__((ext_vector_type(2)));
__device__ __forceinline__ unsigned cvt_pk_bf16(float lo, float hi) { const f32x2e v = {lo, hi}; const bf16x2e b = __builtin_convertvector(v, bf16x2e); return __builtin_bit_cast(unsigned, b); }
__device__ __forceinline__ u32x4 pack8_bf16(const f32x4 v0, const f32x4 v1) { u32x4 w; w.x = cvt_pk_bf16(v0[0], v0[1]); w.y = cvt_pk_bf16(v0[2], v0[3]); w.z = cvt_pk_bf16(v1[0], v1[1]); w.w = cvt_pk_bf16(v1[2], v1[3]); return w; }

struct EpiProj {
    static constexpr bool PERM = true, AFTER_DRAIN = false;
    bf16_t* HM; bf16_t* SCB; float* SBp;
    __device__ __forceinline__ void operator()(const f32x4 (&acc)[2][2][4][2], const Unit& u, int wr, int wc, int fr, int fq) const {
        const int row0 = u.pm * BM + wr * 64 + fr;
        if (u.pn * BM == PC_SMALL) {
            if (wc < 2) {
#pragma unroll
                for (int ai = 0; ai < 2; ++ai)
#pragma unroll
                    for (int m = 0; m < 4; ++m) { float* rp = SBp + (size_t)(row0 + ai * HALF + m * 16) * SBW + wc * 32 + 8 * fq;
                        *(f32x4*)rp = acc[ai][0][m][0]; *(f32x4*)(rp + 4) = acc[ai][0][m][1]; }
            }
            return;
        }
        const int b = (u.pm * BM) / SEQ, s0 = row0 - b * SEQ;
#pragma unroll
        for (int bj = 0; bj < 2; ++bj) { const int colbase = u.pn * BM + bj * HALF;
            bf16_t* dst; size_t pitch;
            if (colbase >= PC_SB && colbase < PC_GQ) { dst = SCB + (size_t)row0 * SCBW + (colbase - PC_SB) + wc * 32 + 8 * fq; pitch = SCBW; }
            else { const int hc = colbase < PC_SB ? colbase : colbase - (PC_GQ - PC_SB), part = hc / 1536, head = (hc % 1536) / HD;
                   dst = HM + hm_off(part, b * FOXH + head) + (size_t)s0 * HD + wc * 32 + 8 * fq; pitch = HD; }
#pragma unroll
            for (int ai = 0; ai < 2; ++ai)
#pragma unroll
                for (int m = 0; m < 4; ++m) *(u32x4*)(dst + (size_t)(ai * HALF + m * 16) * pitch) = pack8_bf16(acc[ai][bj][m][0], acc[ai][bj][m][1]); }
    }
};
struct EpiY {
    static constexpr bool PERM = true, AFTER_DRAIN = false;
    bf16_t* Y; float* SS;
    __device__ __forceinline__ void operator()(const f32x4 (&acc)[2][2][4][2], const Unit& u, int wr, int wc, int fr, int fq) const {
        const int row0 = u.pm * BM + wr * 64 + fr, col0 = u.pn * BM + wc * 32 + 8 * fq;
#pragma unroll
        for (int ai = 0; ai < 2; ++ai)
#pragma unroll
            for (int m = 0; m < 4; ++m) { const int row = row0 + ai * HALF + m * 16; bf16_t* rowp = Y + (size_t)row * DM + col0; float s = 0.f;
#pragma unroll
                for (int bj = 0; bj < 2; ++bj) { const f32x4 a = acc[ai][bj][m][0], b = acc[ai][bj][m][1];
                    s += (a[0] * a[0] + a[1] * a[1]) + (a[2] * a[2] + a[3] * a[3]) + (b[0] * b[0] + b[1] * b[1]) + (b[2] * b[2] + b[3] * b[3]);
                    *(u32x4*)(rowp + bj * HALF) = pack8_bf16(a, b); }
                s += __shfl_xor(s, 16); s += __shfl_xor(s, 32);
                if (fq == 0) SS[(size_t)row * 64 + u.pn * 4 + wc] = s; }
    }
};
__device__ __forceinline__ float silu_f(float x) { return x * __builtin_amdgcn_rcpf(1.0f + __builtin_amdgcn_exp2f(-1.4426950408889634f * x)); }
struct EpiSwiGLU {
    static constexpr bool PERM = true, AFTER_DRAIN = false;
    bf16_t* Hd;
    __device__ __forceinline__ void operator()(const f32x4 (&acc)[2][2][4][2], const Unit& u, int wr, int wc, int fr, int fq) const {
        const int row0 = u.pm * BM + wr * 64 + fr, col0 = u.pn * HALF + wc * 32 + 8 * fq;
#pragma unroll
        for (int ai = 0; ai < 2; ++ai)
#pragma unroll
            for (int m = 0; m < 4; ++m) { const f32x4 g0 = acc[ai][0][m][0], g1 = acc[ai][0][m][1], u0 = acc[ai][1][m][0], u1 = acc[ai][1][m][1]; f32x4 h0, h1;
#pragma unroll
                for (int e = 0; e < 4; ++e) { h0[e] = silu_f(g0[e]) * u0[e]; h1[e] = silu_f(g1[e]) * u1[e]; }
                *(u32x4*)(Hd + (size_t)(row0 + ai * HALF + m * 16) * FFN + col0) = pack8_bf16(h0, h1); }
    }
};
template <class Epi, class Sched, bool ALIGN_EPI = false, bool SP2 = false>
__device__ __forceinline__ void gemm_phase(PG8_LAS unsigned char* lds, const Gemm g, const Sched& S, const Epi& E) {
    int tid_ = my_tid(); asm volatile("" : "+v"(tid_));
    const int tid = tid_, wid = __builtin_amdgcn_readfirstlane(tid >> 6), lane = tid & 63, wr = wid >> 2, wc = wid & 3, fr = lane & 15, fq = lane >> 4;
    const int K = g.K, nt = K / BK;
    unsigned voffA[2], voffB[2];
#pragma unroll
    for (int i = 0; i < 2; ++i) { int R, C; stage_rc(tid * 16 + i * 8192, R, C); const int Rb = Epi::PERM ? ((R & ~31) + perm32(R & 31)) : R;
        voffA[i] = (unsigned)(R * K + C) * 2u; voffB[i] = (unsigned)(Rb * K + C) * 2u; }
    const size_t kstep = (size_t)(BK * 2);
    const size_t hstep = (size_t)HALF * K * 2;
    const size_t tstep = 2 * hstep;
    const unsigned ldsw = (unsigned)wid * 1024u;
    const int aoff = lds_byte(wr * 64 + fr, fq * 8), boff = lds_byte(wc * 32 + fr, fq * 8);
#define PG8_SA(b, h) (((b) * 2 + (h)) * HTB)
#define PG8_SB(b, h) ((4 + (b) * 2 + (h)) * HTB)
#define PG8_STAGE(bufoff, gbase, voff) do { _Pragma("unroll") for (int _i = 0; _i < 2; ++_i) \
        __builtin_amdgcn_global_load_lds((const unsigned*)((const char*)(gbase) + (voff)[_i]), (PG8_LAS unsigned*)(lds + (bufoff) + ldsw + _i * 8192), 16, 0, 0); } while (0)
#define PG8_LDA(dst, b, h) do { _Pragma("unroll") for (int m = 0; m < 4; ++m) _Pragma("unroll") for (int k = 0; k < 2; ++k) dst[m][k] = *(const PG8_LAS bf16x8*)(lds + PG8_SA(b, h) + aoff + m * 2048 + k * 1024); } while (0)
#define PG8_LDB(dst, b, h) do { _Pragma("unroll") for (int n = 0; n < 2; ++n) _Pragma("unroll") for (int k = 0; k < 2; ++k) dst[n][k] = *(const PG8_LAS bf16x8*)(lds + PG8_SB(b, h) + boff + n * 2048 + k * 1024); } while (0)
#define PG8_MMA(ai, bj, At, Bt) do { __builtin_amdgcn_s_setprio(1); _Pragma("unroll") for (int m = 0; m < 4; ++m) _Pragma("unroll") for (int n = 0; n < 2; ++n) _Pragma("unroll") for (int k = 0; k < 2; ++k) \
        acc[ai][bj][m][n] = __builtin_amdgcn_mfma_f32_16x16x32_bf16(Bt[n][k], At[m][k], acc[ai][bj][m][n], 0, 0, 0); __builtin_amdgcn_s_setprio(0); } while (0)
#define PG8_WAIT_V(n) asm volatile("s_waitcnt vmcnt(" #n ")" ::: "memory")
#define PG8_WAIT_L(n) asm volatile("s_waitcnt lgkmcnt(" #n ")" ::: "memory")
#define PG8_BAR __builtin_amdgcn_s_barrier()
#define PG8_SCHED __builtin_amdgcn_sched_barrier(0)
    Unit cur, nxt; int ui = 0;
    if (!S.next(0, cur)) return;
    f32x4 acc[2][2][4][2];
#pragma unroll
    for (int a = 0; a < 2; ++a)
#pragma unroll
        for (int b = 0; b < 2; ++b)
#pragma unroll
            for (int m = 0; m < 4; ++m)
#pragma unroll
                for (int n = 0; n < 2; ++n) acc[a][b][m][n] = (f32x4){0.f, 0.f, 0.f, 0.f};
    bf16x8 At[4][2], B0[2][2], B1[2][2];
    const char* cA = (const char*)g.A + (size_t)cur.pm * tstep; const char* cB = (const char*)g.Bt + (size_t)cur.pn * tstep;
    S.a_ready(cur);
    if constexpr (SP2) {
        PG8_STAGE(PG8_SB(0, 0), cB, voffB); PG8_STAGE(PG8_SB(0, 1), cB + hstep, voffB); PG8_STAGE(PG8_SA(0, 0), cA, voffA); PG8_STAGE(PG8_SA(0, 1), cA + hstep, voffA);
        if (wr == 1) PG8_BAR;
        PG8_WAIT_V(2); PG8_BAR;
        PG8_STAGE(PG8_SB(1, 0), cB + kstep, voffB); PG8_STAGE(PG8_SA(1, 0), cA + kstep, voffA); PG8_STAGE(PG8_SB(1, 1), cB + hstep + kstep, voffB);
        PG8_WAIT_V(6); PG8_BAR;
    } else {
        PG8_STAGE(PG8_SB(0, 0), cB, voffB); PG8_STAGE(PG8_SA(0, 0), cA, voffA); PG8_STAGE(PG8_SB(0, 1), cB + hstep, voffB); PG8_STAGE(PG8_SA(0, 1), cA + hstep, voffA);
        if (wr == 1) PG8_BAR;
        PG8_WAIT_V(4); PG8_BAR;
        PG8_STAGE(PG8_SB(1, 0), cB + kstep, voffB); PG8_STAGE(PG8_SA(1, 0), cA + kstep, voffA); PG8_STAGE(PG8_SB(1, 1), cB + hstep + kstep, voffB);
        PG8_WAIT_V(6); PG8_BAR;
    }
    for (;;) {
        const bool has_next = S.next(ui + 1, nxt);
        const char* nA = has_next ? (const char*)g.A + (size_t)nxt.pm * tstep : cA; const char* nB = has_next ? (const char*)g.Bt + (size_t)nxt.pn * tstep : cB;
        for (int t = 0; t < nt; t += 2) {
            const bool last = (t == nt - 2);
            const char* a1 = cA + (size_t)(t + 1) * kstep;
            const char* a2 = last ? nA : cA + (size_t)(t + 2) * kstep; const char* b2 = last ? nB : cB + (size_t)(t + 2) * kstep;
            const char* a3 = a2 + kstep; const char* b3 = b2 + kstep;
            if (last && has_next) S.a_ready(nxt);
            if constexpr (SP2) {
            PG8_LDB(B0, 0, 0); PG8_LDB(B1, 0, 1); PG8_SCHED; PG8_LDA(At, 0, 0); PG8_STAGE(PG8_SA(1, 1), a1 + hstep, voffA);
            PG8_WAIT_V(8); PG8_WAIT_L(0); PG8_BAR; PG8_MMA(0, 0, At, B0); PG8_MMA(0, 1, At, B1); PG8_BAR; PG8_SCHED;
            PG8_LDA(At, 0, 1); PG8_STAGE(PG8_SB(0, 0), b2, voffB); PG8_STAGE(PG8_SB(0, 1), b2 + hstep, voffB); PG8_STAGE(PG8_SA(0, 0), a2, voffA);
            PG8_WAIT_V(8); PG8_WAIT_L(0); PG8_BAR; PG8_MMA(1, 0, At, B0); PG8_MMA(1, 1, At, B1); PG8_BAR; PG8_SCHED;
            PG8_LDB(B0, 1, 0); PG8_LDB(B1, 1, 1); PG8_SCHED; PG8_LDA(At, 1, 0); PG8_STAGE(PG8_SA(0, 1), a2 + hstep, voffA);
            PG8_WAIT_V(8); PG8_WAIT_L(0); PG8_BAR; PG8_MMA(0, 0, At, B0); PG8_MMA(0, 1, At, B1); PG8_BAR; PG8_SCHED;
            PG8_LDA(At, 1, 1); PG8_STAGE(PG8_SB(1, 0), b3, voffB); PG8_STAGE(PG8_SB(1, 1), b3 + hstep, voffB); PG8_STAGE(PG8_SA(1, 0), a3, voffA);
            PG8_WAIT_V(8); PG8_WAIT_L(0); PG8_BAR; PG8_MMA(1, 0, At, B0); PG8_MMA(1, 1, At, B1); PG8_BAR; PG8_SCHED;
            } else {
            PG8_LDB(B0, 0, 0); PG8_SCHED; PG8_LDA(At, 0, 0); PG8_STAGE(PG8_SA(1, 1), a1 + hstep, voffA);
            PG8_WAIT_L(8); PG8_BAR; PG8_WAIT_L(0); PG8_MMA(0, 0, At, B0); PG8_BAR; PG8_SCHED;
            PG8_LDB(B1, 0, 1); PG8_STAGE(PG8_SB(0, 0), b2, voffB);
            PG8_BAR; PG8_WAIT_L(0); PG8_MMA(0, 1, At, B1); PG8_BAR;
            PG8_LDA(At, 0, 1); PG8_STAGE(PG8_SA(0, 0), a2, voffA);
            PG8_BAR; PG8_WAIT_L(0); PG8_MMA(1, 0, At, B0); PG8_BAR; PG8_SCHED;
            PG8_STAGE(PG8_SB(0, 1), b2 + hstep, voffB);
            PG8_WAIT_V(6); PG8_BAR; PG8_MMA(1, 1, At, B1); PG8_BAR;
            PG8_LDB(B0, 1, 0); PG8_SCHED; PG8_LDA(At, 1, 0); PG8_STAGE(PG8_SA(0, 1), a2 + hstep, voffA);
            PG8_WAIT_L(8); PG8_BAR; PG8_WAIT_L(0); PG8_MMA(0, 0, At, B0); PG8_BAR; PG8_SCHED;
            PG8_LDB(B1, 1, 1); PG8_STAGE(PG8_SB(1, 0), b3, voffB);
            PG8_BAR; PG8_WAIT_L(0); PG8_MMA(0, 1, At, B1); PG8_BAR;
            PG8_LDA(At, 1, 1); PG8_STAGE(PG8_SA(1, 0), a3, voffA);
            PG8_BAR; PG8_WAIT_L(0); PG8_MMA(1, 0, At, B0); PG8_BAR; PG8_SCHED;
            PG8_STAGE(PG8_SB(1, 1), b3 + hstep, voffB);
            PG8_WAIT_V(6); PG8_BAR; PG8_MMA(1, 1, At, B1); PG8_BAR;
            }
        }
        if constexpr (ALIGN_EPI) { if (wr == 0) PG8_BAR; }
        if constexpr (!Epi::AFTER_DRAIN) { E(acc, cur, wr, wc, fr, fq); S.done(cur); }
        if (!has_next) break;
#pragma unroll
        for (int a = 0; a < 2; ++a)
#pragma unroll
            for (int b = 0; b < 2; ++b)
#pragma unroll
                for (int m = 0; m < 4; ++m)
#pragma unroll
                    for (int n = 0; n < 2; ++n) acc[a][b][m][n] = (f32x4){0.f, 0.f, 0.f, 0.f};
        cur = nxt; cA = nA; cB = nB; ++ui;
        if constexpr (ALIGN_EPI) { if (wr == 1) PG8_BAR; }
    }
    PG8_WAIT_V(0);
    if constexpr (!ALIGN_EPI) { if (wr == 0) PG8_BAR; }
    PG8_BAR;
    if constexpr (Epi::AFTER_DRAIN) { E.fused(acc, cur, wr, wc, fr, fq, lds, wid, lane); S.done(cur); }
#undef PG8_SA
#undef PG8_SB
#undef PG8_STAGE
#undef PG8_LDA
#undef PG8_LDB
#undef PG8_MMA
#undef PG8_WAIT_V
#undef PG8_WAIT_L
#undef PG8_BAR
#undef PG8_SCHED
}
}

namespace attn {
constexpr int KVP = HD, OP = DM;
constexpr float SCALE = 0.08838834764831845f;
constexpr int D = 128;
constexpr int NW = 8, QBLK = 32, KVBLK = 64, QB = NW * QBLK;
constexpr int SHM_V = KVBLK * D * 2, SHM_K = KVBLK * D * 2;
constexpr int FB_OFF = 2 * SHM_V + 2 * SHM_K + NW * 64 * 4;
constexpr int LDS_BYTES = FB_OFF + 2 * 64 * 4;
constexpr bool WSKIP = false;
constexpr float THR = 16.f;

using bf16 = __hip_bfloat16;
typedef short bf16x8 __attribute__((ext_vector_type(8)));
typedef short s16x4 __attribute__((ext_vector_type(4)));
typedef float f32x16 __attribute__((ext_vector_type(16)));
typedef float f32x4 __attribute__((ext_vector_type(4)));
typedef unsigned u32x4 __attribute__((ext_vector_type(4)));
template <class A, class Bt> struct same_t { static constexpr bool v = false; };
template <class A> struct same_t<A, A> { static constexpr bool v = true; };

#define KSWZ(row, colB) ((row) * 256 + ((colB) ^ (((row) & 7) << 4)))
#define SBAR() __builtin_amdgcn_sched_barrier(0)
__device__ __forceinline__ int v_st(int k, int c) { const int kk = (k & ~0xC) | ((k & 4) << 1) | ((k & 8) >> 1); return ((kk >> 3) * 4 + (c >> 5)) * 512 + ((kk & 7) * 32 + (c & 31)) * 2; }
__device__ __forceinline__ int v_rd_base(int lane) { return ((lane & 3) << 3) | (((lane >> 2) & 3) << 6) | (((lane >> 4) & 1) << 5) | (((lane >> 5) & 1) << 8); }
constexpr int v_rd_off(int d0, int ks, int half) { return d0 * 512 + ks * 4096 + half * 2048; }
__device__ __forceinline__ int crow(int r, int hi) { return (r & 3) + 8 * (r >> 2) + 4 * hi; }
__device__ __forceinline__ unsigned cvtpk(float lo, float hi) {
    unsigned r; asm volatile("v_cvt_pk_bf16_f32 %0, %1, %2" : "=v"(r) : "v"(lo), "v"(hi)); return r;
}
__device__ __forceinline__ bf16x8 pack8(f32x4 a, f32x4 b) {
    u32x4 w = {cvtpk(a[0], a[1]), cvtpk(a[2], a[3]), cvtpk(b[0], b[1]), cvtpk(b[2], b[3])};
    return *reinterpret_cast<bf16x8*>(&w);
}
template <class T> __device__ __forceinline__ bf16x8 load8(const T* p) {
    if constexpr (same_t<T, float>::v) { return pack8(*(const f32x4*)p, *(const f32x4*)(p + 4)); }
    else { return *reinterpret_cast<const bf16x8*>(p); }
}
__device__ __forceinline__ void mask_tile(f32x16& p0, f32x16& p1, int dq, unsigned W) {
    const float NEG = -__builtin_inff();
#pragma unroll
    for (int r = 0; r < 16; ++r) {
        const int c = (r & 3) + 8 * (r >> 2);
        if ((unsigned)(dq - c) >= W) p0[r] = NEG;
        if ((unsigned)(dq - c - 32) >= W) p1[r] = NEG;
    }
}
__device__ __forceinline__ void partialSM(f32x16& p0, f32x16& p1, float& m_reg, float& mn, float& alpha) {
    float pmax = p0[0]; for (int r = 1; r < 16; ++r) pmax = fmaxf(pmax, p0[r]); for (int r = 0; r < 16; ++r) pmax = fmaxf(pmax, p1[r]);
    { auto rr = __builtin_amdgcn_permlane32_swap(__float_as_uint(pmax), __float_as_uint(pmax), false, false);
      pmax = fmaxf(__uint_as_float(rr[0]), __uint_as_float(rr[1])); }
    constexpr float C2 = 1.4426950408889634f * SCALE;
    if (__builtin_expect(__all((pmax - m_reg) * SCALE <= THR), 1)) { mn = m_reg; alpha = 1.f; }
    else { mn = fmaxf(m_reg, pmax); alpha = __builtin_amdgcn_exp2f((m_reg - mn) * C2); m_reg = mn; }
    const float mnL = -mn * C2;
    for (int r = 0; r < 16; ++r) p0[r] = fmaf(p0[r], C2, mnL); for (int r = 0; r < 16; ++r) p1[r] = fmaf(p1[r], C2, mnL);
    for (int r = 0; r < 16; ++r) p0[r] = __builtin_amdgcn_exp2f(p0[r]);
}
__device__ __forceinline__ void finishSM(f32x16& p0, f32x16& p1, float alpha, float& l_reg, bf16x8& pa0, bf16x8& pa1, bf16x8& pa2, bf16x8& pa3) {
    for (int r = 0; r < 16; ++r) p1[r] = __builtin_amdgcn_exp2f(p1[r]);
    float ps = 0; for (int r = 0; r < 16; ++r) ps += p0[r]; for (int r = 0; r < 16; ++r) ps += p1[r];
    { auto rr = __builtin_amdgcn_permlane32_swap(__float_as_uint(ps), __float_as_uint(ps), false, false);
      ps = __uint_as_float(rr[0]) + __uint_as_float(rr[1]); }
    l_reg = l_reg * alpha + ps;
#define PK4(P, B_, OUT) do { unsigned a0 = cvtpk(P[B_+0], P[B_+1]), a1 = cvtpk(P[B_+2], P[B_+3]);                          \
        unsigned b0 = cvtpk(P[B_+4], P[B_+5]), b1 = cvtpk(P[B_+6], P[B_+7]);                                             \
        auto r0 = __builtin_amdgcn_permlane32_swap(a0, b0, false, false); auto r1 = __builtin_amdgcn_permlane32_swap(a1, b1, false, false); \
        u32x4 w = {r0[0], r1[0], r0[1], r1[1]}; OUT = *reinterpret_cast<bf16x8*>(&w); } while (0)
    PK4(p0, 0, pa0); PK4(p0, 8, pa1); PK4(p1, 0, pa2); PK4(p1, 8, pa3);
#undef PK4
}
template <int KB, bool SK>
__device__ __forceinline__ void qkt(f32x16& p0, f32x16& p1, const char* K_lds, int r32, int hi, const bf16x8* qr, bool act) {
    if (SK && !act) { const float NEG = -__builtin_inff();
#pragma unroll
        for (int r = 0; r < 16; ++r) { p0[r] = NEG; p1[r] = NEG; } return; }
    { const char* fb = K_lds + 2 * SHM_K + NW * 64 * 4 + KB * 256 + hi * 16;
#pragma unroll
      for (int g = 0; g < 4; ++g) { const f32x4 a = *reinterpret_cast<const f32x4*>(fb + g * 32), b = *reinterpret_cast<const f32x4*>(fb + 128 + g * 32);
          p0[4 * g] = a[0]; p0[4 * g + 1] = a[1]; p0[4 * g + 2] = a[2]; p0[4 * g + 3] = a[3]; p1[4 * g] = b[0]; p1[4 * g + 1] = b[1]; p1[4 * g + 2] = b[2]; p1[4 * g + 3] = b[3]; } }
    const char* kb[4];
#pragma unroll
    for (int dd = 0; dd < 4; ++dd) kb[dd] = K_lds + KB * SHM_K + KSWZ(r32, (dd * 16 + hi * 8) * 2);
#pragma unroll
    for (int d0 = 0; d0 < 8; ++d0) { const char* a = kb[d0 & 3] + (d0 >> 2) * 128;
        bf16x8 b0 = *reinterpret_cast<const bf16x8*>(a);
        bf16x8 b1 = *reinterpret_cast<const bf16x8*>(a + 32 * 256);
        p0 = __builtin_amdgcn_mfma_f32_32x32x16_bf16(b0, qr[d0], p0, 0, 0, 0);
        p1 = __builtin_amdgcn_mfma_f32_32x32x16_bf16(b1, qr[d0], p1, 0, 0, 0); }
}
template <int VB, bool SK>
__device__ __forceinline__ void pv_tile(f32x16* o, int vb0, bf16x8 pa0, bf16x8 pa1, bf16x8 pa2, bf16x8 pa3, bool act) {
    if (SK && !act) return;
#define TRRD(dst, off) asm volatile("ds_read_b64_tr_b16 %0, %1 offset:%2" : "=&v"(dst) : "v"(vb0), "i"(off) : "memory")
#define PV_D0(d0) do { s16x4 l0, l1, l2, l3, h0, h1, h2, h3; constexpr int b_ = VB * SHM_V + v_rd_off(d0, 0, 0);     \
        TRRD(l0, b_); TRRD(h0, b_ + 2048); TRRD(l1, b_ + 4096); TRRD(h1, b_ + 6144); TRRD(l2, b_ + 8192); TRRD(h2, b_ + 10240); TRRD(l3, b_ + 12288); TRRD(h3, b_ + 14336); \
        asm volatile("s_waitcnt lgkmcnt(0)" ::: "memory"); SBAR();                 \
        o[d0] = __builtin_amdgcn_mfma_f32_32x32x16_bf16(pa0, (bf16x8){l0[0], l0[1], l0[2], l0[3], h0[0], h0[1], h0[2], h0[3]}, o[d0], 0, 0, 0);   \
        o[d0] = __builtin_amdgcn_mfma_f32_32x32x16_bf16(pa1, (bf16x8){l1[0], l1[1], l1[2], l1[3], h1[0], h1[1], h1[2], h1[3]}, o[d0], 0, 0, 0);   \
        o[d0] = __builtin_amdgcn_mfma_f32_32x32x16_bf16(pa2, (bf16x8){l2[0], l2[1], l2[2], l2[3], h2[0], h2[1], h2[2], h2[3]}, o[d0], 0, 0, 0);   \
        o[d0] = __builtin_amdgcn_mfma_f32_32x32x16_bf16(pa3, (bf16x8){l3[0], l3[1], l3[2], l3[3], h3[0], h3[1], h3[2], h3[3]}, o[d0], 0, 0, 0); } while (0)
    PV_D0(0); PV_D0(1); PV_D0(2); PV_D0(3);
#undef PV_D0
#undef TRRD
}

template <class TIn, class TOut> struct BlockRef { const TIn* Q; const TIn* K; const TIn* V; const float* F; TOut* O; int P0; int JLO; };
template <class TIn> struct Seam {
    bf16x8 qr[8];
    bf16x8 st_v0, st_v1, st_k0, st_k1; float st_f; f32x4 sf0, sf1, sf2, sf3;
    f32x4 tq[16];
};
__device__ __forceinline__ int swa_jlo(int P0, int W) { const int lowk = P0 - W + 1; return lowk > 0 ? lowk / KVBLK : 0; }
#define ROW(p, k0, rr) ((p) + (size_t)((k0) + (rr)) * KVP + sc)
#define VMW() asm volatile("s_waitcnt vmcnt(0)" ::: "memory")
#define VMWN(n) asm volatile("s_waitcnt vmcnt(%0)" :: "i"(n) : "memory")
#define SLOAD_H(Kp, Vp, Fp, k0) do { S.st_v0 = load8<TIn>(ROW(Vp, k0, sr)); S.st_v1 = load8<TIn>(ROW(Vp, k0, 32 + sr));              \
                         S.st_k0 = load8<TIn>(ROW(Kp, k0, sr)); S.st_k1 = load8<TIn>(ROW(Kp, k0, 32 + sr)); if (tid < 64) S.st_f = (Fp)[(k0) + tid]; } while (0)
#define SWRITE_HK(bf) do { *(bf16x8*)(K_lds + (bf) * SHM_K + kws) = S.st_k0; *(bf16x8*)(K_lds + (bf) * SHM_K + kws + 32 * 256) = S.st_k1; if (tid < 64) *(float*)(K_lds + 2 * SHM_K + NW * 64 * 4 + (bf) * 256 + tid * 4) = S.st_f; } while (0)
#define SWRITE_HV(bf) do { *(bf16x8*)(V_lds + (bf) * SHM_V + vst0) = S.st_v0; *(bf16x8*)(V_lds + (bf) * SHM_V + vst1) = S.st_v1; } while (0)
#define SWRITE_H(bf) do { SWRITE_HV(bf); SWRITE_HK(bf); } while (0)
#define SLOAD_F(p, k0) do { S.sf0 = *(const f32x4*)ROW(p, k0, sr); S.sf1 = *(const f32x4*)(ROW(p, k0, sr) + 4);                \
                            S.sf2 = *(const f32x4*)ROW(p, k0, 32 + sr); S.sf3 = *(const f32x4*)(ROW(p, k0, 32 + sr) + 4); } while (0)
#define SWRITE_KF(bf) do { *(bf16x8*)(K_lds + (bf) * SHM_K + kws) = pack8(S.sf0, S.sf1); *(bf16x8*)(K_lds + (bf) * SHM_K + kws + 32 * 256) = pack8(S.sf2, S.sf3); } while (0)
#define SWRITE_VF(bf) do { *(bf16x8*)(V_lds + (bf) * SHM_V + vst0) = pack8(S.sf0, S.sf1); *(bf16x8*)(V_lds + (bf) * SHM_V + vst1) = pack8(S.sf2, S.sf3); } while (0)
template <class TIn, class TOut>
__device__ __forceinline__ void causal_swa_prime(const BlockRef<TIn, TOut>& cur, int W, char* lds, Seam<TIn>& S) {
    constexpr bool F32 = same_t<TIn, float>::v;
    int tid_ = my_tid(); asm volatile("" : "+v"(tid_));
    const int tid = tid_, wid = __builtin_amdgcn_readfirstlane(tid >> 6), lane = tid & 63, r32 = lane & 31, hi = lane >> 5;
    const int sr = tid >> 4, sc = (tid & 15) * 8, kws = KSWZ(sr, sc * 2); char* K_lds = lds + 2 * SHM_V;
    const int kb0 = cur.JLO * KVBLK;
    for (int d0 = 0; d0 < 8; ++d0) S.qr[d0] = load8<TIn>(cur.Q + (size_t)(wid * QBLK + r32) * KVP + d0 * 16 + hi * 8);
    if constexpr (F32) { SLOAD_F((const float*)cur.K, kb0); VMW(); SWRITE_KF(0); SBAR(); SLOAD_F((const float*)cur.V, kb0); }
    else { SLOAD_H(cur.K, cur.V, cur.F, kb0); VMW(); SWRITE_HK(0); }
    __syncthreads();
}
template <class TIn, class TOut>
__device__ __forceinline__ void causal_swa_block(const BlockRef<TIn, TOut>& cur, const BlockRef<TIn, TOut>& nxt, int skv, int W, char* lds, Seam<TIn>& S, const float* const __attribute__((address_space(4)))* gslot, int goff) {
    constexpr bool F32 = same_t<TIn, float>::v;
    int tid_ = my_tid(); asm volatile("" : "+v"(tid_));
    const int tid = tid_, wid = __builtin_amdgcn_readfirstlane(tid >> 6), lane = tid & 63, r32 = lane & 31, hi = lane >> 5;
    const int j_lo = cur.JLO;
    int j_hi = (cur.P0 + QB - 1) / KVBLK + 1; if (j_hi > skv / KVBLK) j_hi = skv / KVBLK;
    const int NT = j_hi - j_lo;
    const int kbn = nxt.JLO * KVBLK;
    const int qlo = cur.P0 + wid * QBLK, qm = qlo + r32 - 4 * hi;
    char* V_lds = lds; char* K_lds = lds + 2 * SHM_V;
    float* ws = (float*)(lds + 2 * SHM_V + 2 * SHM_K) + wid * 64; float* li_l = ws, * al_l = ws + 32;
    float m_reg = -1e30f, l_reg = 0; f32x16 o[4] = {};
    const int sr = tid >> 4, sc = (tid & 15) * 8, vst0 = v_st(sr, sc), vst1 = v_st(32 + sr, sc), kws = KSWZ(sr, sc * 2);
    const int vb0 = (int)(uintptr_t)V_lds + v_rd_base(lane);
    const TIn* Kh = cur.K; const TIn* Vh = cur.V; const float* Fh = cur.F;
#define RESC(a) do { if (__any((a) < 1.f)) { if (hi == 0) al_l[r32] = (a); asm volatile("s_waitcnt lgkmcnt(0)" ::: "memory");              \
                     for (int d_ = 0; d_ < 4; ++d_) for (int r = 0; r < 16; ++r) o[d_][r] *= al_l[crow(r, hi)]; } } while (0)
#define KBASE(t) ((j_lo + (t)) * KVBLK)
#define ACT(t) (KBASE(t) <= qlo + QBLK - 1 && KBASE(t) + KVBLK - 1 >= qlo - W + 1)
#define MASKT(P0_, P1_, t) do { const int kb_ = KBASE(t); if ((!SK || ACT(t)) && (kb_ + KVBLK - 1 > qlo || kb_ <= qlo + QBLK - 1 - W)) mask_tile(P0_, P1_, qm - kb_, (unsigned)W); } while (0)
    constexpr int NQL = F32 ? 16 : 8;
    constexpr bool SK = WSKIP && !F32;
#define SEAM_K0() do { VMWN(NQL); if constexpr (F32) { SWRITE_KF(0); SBAR(); SLOAD_F((const float*)nxt.V, kbn); } else { SWRITE_HK(0); } SBAR(); } while (0)
    f32x16 pA0, pA1, pB0, pB1; float mnA, mnB, alA, alB; bf16x8 pa0, pa1, pa2, pa3;
    if constexpr (F32) { VMW(); SWRITE_VF(0); SBAR(); } else { SWRITE_HV(0); SBAR(); }
    if (NT > 1) { if constexpr (F32) SLOAD_F((const float*)Kh, KBASE(1)); else SLOAD_H(Kh, Vh, Fh, KBASE(1)); }
    SBAR(); qkt<0, SK>(pA0, pA1, K_lds, r32, hi, S.qr, ACT(0));
    if constexpr (F32) { if (NT > 1) { VMW(); SWRITE_KF(1); SBAR(); SLOAD_F((const float*)Vh, KBASE(1)); } }
    MASKT(pA0, pA1, 0); partialSM(pA0, pA1, m_reg, mnA, alA);
    if (NT > 1) { VMW(); if constexpr (F32) { SWRITE_VF(1); SBAR(); if (NT > 2) SLOAD_F((const float*)Kh, KBASE(2)); } else SWRITE_H(1); }
    __syncthreads();
#define HALF_STEP(PX0, PX1, mnX, alX, PY0, PY1, alY, t, KB, VB, SB) do {                                                      \
        SBAR(); qkt<KB, SK>(PX0, PX1, K_lds, r32, hi, S.qr, ACT(t));                                             \
        finishSM(PY0, PY1, alY, l_reg, pa0, pa1, pa2, pa3); SBAR();                                                           \
        if ((t) + 1 < NT) { if constexpr (F32) { VMW(); SWRITE_KF(SB); SBAR(); SLOAD_F((const float*)Vh, KBASE((t) + 1)); }  \
                            else { SLOAD_H(Kh, Vh, Fh, KBASE((t) + 1)); } SBAR(); }                                               \
        pv_tile<VB, SK>(o, vb0, pa0, pa1, pa2, pa3, ACT((t) - 1)); MASKT(PX0, PX1, (t)); partialSM(PX0, PX1, m_reg, mnX, alX);                                        \
        __syncthreads();                                                                                                      \
        if ((t) + 1 < NT) { VMW(); if constexpr (F32) { SWRITE_VF(SB); SBAR(); if ((t) + 2 < NT) SLOAD_F((const float*)Kh, KBASE((t) + 2)); } \
                            else { SWRITE_H(SB); } }                                                                          \
        RESC(alX); __syncthreads(); } while (0)
    for (int t = 1; t + 1 < NT; t += 2) {
        HALF_STEP(pB0, pB1, mnB, alB, pA0, pA1, alA, t, 1, 0, 0);
        HALF_STEP(pA0, pA1, mnA, alA, pB0, pB1, alB, t + 1, 0, 1, 1);
    }
    const bool even = (NT & 1) == 0;
    if (even) { SBAR(); qkt<1, SK>(pB0, pB1, K_lds, r32, hi, S.qr, ACT(NT - 1)); SBAR(); }
#define QROW(e) (nxt.Q + (size_t)(wid * QBLK + r32) * KVP + ((e) >> 1) * 16 + hi * 8 + ((e) & 1) * 4)
    if constexpr (F32) { SLOAD_F((const float*)nxt.K, kbn); SBAR();
#pragma unroll
        for (int e = 0; e < 8; ++e) S.tq[e] = *(const f32x4*)QROW(e); }
    else { SLOAD_H(nxt.K, nxt.V, nxt.F, kbn); SBAR();
#pragma unroll
        for (int d0 = 0; d0 < 8; ++d0) S.qr[d0] = load8<TIn>(nxt.Q + (size_t)(wid * QBLK + r32) * KVP + d0 * 16 + hi * 8); }
    SBAR();
    finishSM(pA0, pA1, alA, l_reg, pa0, pa1, pa2, pa3); SBAR();
    if constexpr (F32) {
#pragma unroll
        for (int e = 8; e < 16; ++e) S.tq[e] = *(const f32x4*)QROW(e); SBAR(); }
#undef QROW
    pv_tile<0, SK>(o, vb0, pa0, pa1, pa2, pa3, ACT(even ? NT - 2 : NT - 1));
    if (even) { MASKT(pB0, pB1, NT - 1); partialSM(pB0, pB1, m_reg, mnB, alB); __syncthreads(); RESC(alB);
        finishSM(pB0, pB1, alB, l_reg, pa0, pa1, pa2, pa3); SBAR(); pv_tile<1, SK>(o, vb0, pa0, pa1, pa2, pa3, ACT(NT - 1)); }
    SBAR(); SEAM_K0();
    if (hi == 0) li_l[r32] = l_reg; asm volatile("s_waitcnt lgkmcnt(0)" ::: "memory");
    float rli[16];
#pragma unroll
    for (int r = 0; r < 16; ++r) rli[r] = __builtin_amdgcn_rcpf(li_l[crow(r, hi)]);
    TOut* Ow = cur.O + (size_t)(wid * QBLK) * OP;
    float gn[4];
    { const float* G = *gslot + goff;
#pragma unroll
    for (int d0 = 0; d0 < 4; ++d0) gn[d0] = G[d0 * 32 + r32]; }
#pragma unroll
    for (int r = 0; r < 16; ++r) { const int orow = crow(r, hi);
        float y[4]; float ss = 0.f;
#pragma unroll
        for (int d0 = 0; d0 < 4; ++d0) { y[d0] = o[d0][r] * rli[r]; ss += y[d0] * y[d0]; }
        ss += __shfl_xor(ss, 1); ss += __shfl_xor(ss, 2); ss += __shfl_xor(ss, 4); ss += __shfl_xor(ss, 8); ss += __shfl_xor(ss, 16);
        const float rs = __builtin_amdgcn_rsqf(ss * (1.0f / 128.0f) + 1e-6f);
#pragma unroll
        for (int d0 = 0; d0 < 4; ++d0) { const float v = y[d0] * rs * gn[d0];
            if constexpr (same_t<TOut, float>::v) { Ow[(size_t)orow * OP + d0 * 32 + r32] = v; }
            else { const float vn = __shfl_xor(v, 1);
                   if ((r32 & 1) == 0) *(unsigned*)(Ow + (size_t)orow * OP + d0 * 32 + r32) = cvtpk(v, vn); } }
        SBAR(); }
    if constexpr (F32) {
#pragma unroll
        for (int d0 = 0; d0 < 8; ++d0) S.qr[d0] = pack8(S.tq[2 * d0], S.tq[2 * d0 + 1]); }
    __syncthreads();
#undef RESC
#undef KBASE
#undef ACT
#undef MASKT
#undef SEAM_K0
#undef HALF_STEP
}
#undef ROW
#undef VMW
#undef VMWN
#undef SLOAD_H
#undef SWRITE_HK
#undef SWRITE_HV
#undef SWRITE_H
#undef SLOAD_F
#undef SWRITE_KF
#undef SWRITE_VF


}

__device__ __forceinline__ float bflo(unsigned w) { return __uint_as_float(w << 16); }
__device__ __forceinline__ float bfhi(unsigned w) { return __uint_as_float(w & 0xffff0000u); }
__device__ __forceinline__ float wave_sum(float v) {
#pragma unroll
    for (int o = 1; o < 64; o <<= 1) v += __shfl_xor(v, o);
    return v;
}
__device__ __forceinline__ float sigmoid_f(float x) { return 1.0f / (1.0f + __expf(-x)); }
__device__ __forceinline__ float silu_acc(float x) { return x / (1.0f + __expf(-x)); }
__device__ __forceinline__ float softplus_f(float x) { return fmaxf(x, 0.f) + log1pf(__expf(-fabsf(x))); }
__device__ __forceinline__ float logsigmoid_f(float x) { return fminf(x, 0.f) - log1pf(__expf(-fabsf(x))); }

struct Args { const float* in[17]; float* out; unsigned char* ws; int ph_lo, ph_hi; };
typedef const __attribute__((address_space(4))) Args* ArgsP;
enum { I_X = 0, I_MIXPRE, I_WIN, I_FOXFB, I_FOXON, I_SCW, I_GDNCW, I_GDNALOG, I_GDNDTB, I_GDNON, I_WOUT, I_MIXPOST, I_FFNPRE, I_WGATE, I_WUP, I_WDOWN, I_FFNPOST };
struct Ptrs {
    ArgsP ap;
    int tid, lane, wave, gw, NGW, G, bid;
};
__device__ __forceinline__ Ptrs fresh_ptrs(ArgsP ap0);
__device__ __forceinline__ int ftid() { int t = my_tid(); asm volatile("" : "+v"(t)); return t; }
__device__ __forceinline__ int fbid() { int b = blockIdx.x; asm volatile("" : "+s"(b)); return b; }
__device__ __forceinline__ ArgsP fresh(ArgsP a) { asm volatile("" : "+s"(a)); return a; }
__device__ __forceinline__ Ptrs fresh_ptrs(ArgsP ap0) { Ptrs P; P.ap = fresh(ap0); P.tid = ftid(); P.lane = P.tid & 63; P.wave = __builtin_amdgcn_readfirstlane(P.tid >> 6); P.bid = fbid();
    P.G = gridDim.x; P.gw = P.bid * NWAVES + P.wave; P.NGW = P.G * NWAVES; return P; }

__device__ __forceinline__ int win_src4(int d) {
    if (d < PC_SB) return d;
    if (d < PC_GQ) return d - PC_SB + SRC_SB;
    if (d < PC_GZ) return d - PC_GQ + SRC_GQ;
    if (d < PC_SMALL) return d - PC_GZ + SRC_GZ;
    const int e = d - PC_SMALL;
    if (e < 12) return SRC_FF + e;
    if (e < 24) return SRC_GA + e - 12;
    if (e < 36) return SRC_GB + e - 24;
    return -1;
}
__device__ __forceinline__ void tr_item(const float* __restrict__ W, int Ns, int scol, int k0, bf16* WT, int K, int dn0, LAS float* scr, int lane) {
    const int sub = lane >> 3, g = lane & 7;
    f32x4 v[8];
#pragma unroll
    for (int i = 0; i < 8; ++i) { const int kk = 8 * i + sub; v[i] = (f32x4){0.f, 0.f, 0.f, 0.f}; if (scol >= 0) v[i] = *(const f32x4*)(W + (size_t)(k0 + kk) * Ns + scol); }
#pragma unroll
    for (int i = 0; i < 8; ++i) { const int kk = 8 * i + sub; LAS float* s = scr + kk * 33 + 4 * g; s[0] = v[i][0]; s[1] = v[i][1]; s[2] = v[i][2]; s[3] = v[i][3]; }
    LDS_WAIT(); asm volatile("" ::: "memory");
    const int c = lane & 7;
#pragma unroll
    for (int j = 0; j < 4; ++j) { const int n = (lane >> 3) + 8 * j; const LAS float* s = scr + (8 * c) * 33 + n;
        v4u o; o.x = pk2(s[0 * 33], s[1 * 33]); o.y = pk2(s[2 * 33], s[3 * 33]); o.z = pk2(s[4 * 33], s[5 * 33]); o.w = pk2(s[6 * 33], s[7 * 33]);
        *(v4u*)(WT + (size_t)(dn0 + n) * K + k0 + 8 * c) = o; }
    LDS_WAIT(); asm volatile("" ::: "memory");
}
constexpr int I_IN = 64 * (NP / 32), I_OUT = 64 * (DM / 32), I_GU = 64 * (NGU / 32), I_DN = (FFN / 64) * (DM / 32), I_LAYER = I_IN + I_OUT + I_GU + I_DN;

typedef unsigned u32x2t __attribute__((ext_vector_type(2)));
__device__ __forceinline__ float sq4(const f32x4 v) { return (v[0] * v[0] + v[1] * v[1]) + (v[2] * v[2] + v[3] * v[3]); }
__device__ __forceinline__ void rms_row_to_bf16(const float* xrow, const float* gain, bf16* orow, int lane) {
    f32x4 a[16]; float ss = 0.f;
#pragma unroll
    for (int j = 0; j < 16; ++j) { a[j] = *(const f32x4*)(xrow + 256 * j + 4 * lane); ss += sq4(a[j]); }
    const float r = 1.0f / sqrtf(wave_sum(ss) * (1.0f / DM) + RMS_EPS);
#pragma unroll
    for (int j = 0; j < 16; ++j) { const f32x4 g = *(const f32x4*)(gain + 256 * j + 4 * lane);
        u32x2t o; o.x = pk2(a[j][0] * r * g[0], a[j][1] * r * g[1]); o.y = pk2(a[j][2] * r * g[2], a[j][3] * r * g[3]);
        *(u32x2t*)(orow + 256 * j + 4 * lane) = o; }
}
__device__ __forceinline__ void resid_norm_row(const float* base_row, const bf16* yrow, const float* ssrow, const float* gpost, float* out_row, const float* gnext, bf16* xn_row, int lane) {
    const float ry = 1.0f / sqrtf(wave_sum(ssrow[lane]) * (1.0f / DM) + RMS_EPS);
    f32x4 a[16]; float ss = 0.f;
#pragma unroll
    for (int j = 0; j < 16; ++j) { const int c = 256 * j + 4 * lane; const u32x2t yw = *(const u32x2t*)(yrow + c);
        const f32x4 x0 = *(const f32x4*)(base_row + c), g0 = *(const f32x4*)(gpost + c);
        a[j][0] = x0[0] + bflo(yw.x) * ry * g0[0]; a[j][1] = x0[1] + bfhi(yw.x) * ry * g0[1]; a[j][2] = x0[2] + bflo(yw.y) * ry * g0[2]; a[j][3] = x0[3] + bfhi(yw.y) * ry * g0[3];
        *(f32x4*)(out_row + c) = a[j]; ss += sq4(a[j]); }
    if (gnext) {
        const float r = 1.0f / sqrtf(wave_sum(ss) * (1.0f / DM) + RMS_EPS);
#pragma unroll
        for (int j = 0; j < 16; ++j) { const f32x4 g = *(const f32x4*)(gnext + 256 * j + 4 * lane);
            u32x2t o; o.x = pk2(a[j][0] * r * g[0], a[j][1] * r * g[1]); o.y = pk2(a[j][2] * r * g[2], a[j][3] * r * g[3]);
            *(u32x2t*)(xn_row + 256 * j + 4 * lane) = o; }
    }
}

__device__ __forceinline__ void convert_weights(ArgsP ap0, LAS unsigned char* lds, int l, int lo = 0, int hi = I_LAYER, int wg_lo = 0) {
    const Ptrs P = fresh_ptrs(ap0); const ArgsP A = P.ap;
    if (P.bid < wg_lo) return;
    LAS float* scr = (LAS float*)(lds + P.wave * 16384);
    const int g = P.lane & 7;
    bf16* wl = (bf16*)(A->ws + WS_W);
    for (int it = lo + (P.bid - wg_lo) * NWAVES + P.wave; it < hi; it += (P.G - wg_lo) * NWAVES) {
        int r = it;
        if (r < I_IN) { const int kb = r / (NP / 32), nb = r % (NP / 32);
            tr_item(A->in[I_WIN] + (size_t)l * DM * PROJ_SRC, PROJ_SRC, win_src4(32 * nb + 4 * g), 64 * kb, (bf16*)((unsigned char*)wl + WO_IN), DM, 32 * nb, scr, P.lane); continue; }
        r -= I_IN;
        if (r < I_OUT) { const int kb = r / (DM / 32), nb = r % (DM / 32);
            tr_item(A->in[I_WOUT] + (size_t)l * DM * DM, DM, 32 * nb + 4 * g, 64 * kb, (bf16*)((unsigned char*)wl + WO_OUT), DM, 32 * nb, scr, P.lane); continue; }
        r -= I_OUT;
        if (r < I_GU) { const int kb = r / (NGU / 32), nb = r % (NGU / 32), dn0 = 32 * nb, j = dn0 >> 8, w = dn0 & 255;
            const float* src = (w < 128 ? A->in[I_WGATE] : A->in[I_WUP]) + (size_t)l * DM * FFN;
            tr_item(src, FFN, 128 * j + (w & 127) + 4 * g, 64 * kb, (bf16*)((unsigned char*)wl + WO_GU), DM, dn0, scr, P.lane); continue; }
        r -= I_GU;
        { const int kb = r / (DM / 32), nb = r % (DM / 32);
            tr_item(A->in[I_WDOWN] + (size_t)l * FFN * DM, DM, 32 * nb + 4 * g, 64 * kb, (bf16*)((unsigned char*)wl + WO_DN), FFN, 32 * nb, scr, P.lane); }
    }
}
__device__ __forceinline__ void p0_prologue(ArgsP ap0, LAS unsigned char* lds) {
    convert_weights(ap0, lds, 0, 0, I_IN + I_OUT + I_GU);
    const Ptrs P = fresh_ptrs(ap0); const ArgsP A = P.ap;
    bf16* XN = (bf16*)(A->ws + WS_XN);
    for (int m = P.gw; m < M; m += P.NGW) rms_row_to_bf16(A->in[I_X] + (size_t)m * DM, A->in[I_MIXPRE], XN + (size_t)m * DM, P.lane);
}

__device__ __forceinline__ void p2_prep(ArgsP ap0, LAS unsigned char* lds, int l) {
    const Ptrs P = fresh_ptrs(ap0); const ArgsP A = P.ap;
    const bf16* SCB = (const bf16*)(A->ws + WS_SCB); const float* SB = (const float*)(A->ws + WS_SB);
    bf16* MIX = (bf16*)(A->ws + WS_MIX); float* FG = (float*)(A->ws + WS_FG);
    const int lane = P.lane;
    if (P.bid < BATCH * FOXH) {
        const int bh = P.bid, b = bh / FOXH, h = bh % FOXH; const float fb = A->in[I_FOXFB][l * FOXH + h];
        const float* sb = SB + ((size_t)(b * SEQ) + 16 * P.tid) * SBW + SB_FF + h;
        float ls[16]; float loc = 0.f;
#pragma unroll
        for (int i = 0; i < 16; ++i) ls[i] = sb[(size_t)i * SBW];
#pragma unroll
        for (int i = 0; i < 16; ++i) { ls[i] = logsigmoid_f(ls[i] + fb); loc += ls[i]; }
        float incl = loc;
#pragma unroll
        for (int o = 1; o < 64; o <<= 1) { const float n = __shfl_up(incl, o); if (lane >= o) incl += n; }
        LAS float* wt = (LAS float*)lds;
        if (lane == 63) wt[P.wave] = incl;
        __syncthreads();
        float run = incl - loc;
        for (int w = 0; w < P.wave; ++w) run += wt[w];
        f32x4 o4[4];
#pragma unroll
        for (int i = 0; i < 16; ++i) { run += ls[i]; o4[i >> 2][i & 3] = -run * 11.313708498984761f; }
        float* fo = FG + (size_t)bh * SEQ + 16 * P.tid;
#pragma unroll
        for (int i = 0; i < 4; ++i) *(f32x4*)(fo + 4 * i) = o4[i];
        __syncthreads();
    }
    { const bf16* HMq = (const bf16*)(A->ws + WS_PROJ); float* TN = (float*)(A->ws + WS_TN);
      constexpr int NT_ = BATCH * FOXH * (SEQ / 64);
      for (int it = P.gw; it < NT_; it += P.NGW) {
        const int bh = it / (SEQ / 64), c = it % (SEQ / 64);
        const v4u* qrow = (const v4u*)(HMq + hm_off(HM_FQ, bh) + (size_t)(c * 64 + lane) * HD); const v4u* krow = (const v4u*)(HMq + hm_off(HM_FK, bh) + (size_t)(c * 64 + lane) * HD);
        v4u qv[16], kv[16];
#pragma unroll
        for (int j = 0; j < 16; ++j) { qv[j] = qrow[j]; kv[j] = krow[j]; }
        float sq = 0.f, sk = 0.f, d = 0.f;
#pragma unroll
        for (int j = 0; j < 16; ++j) {
#pragma unroll
            for (int e4 = 0; e4 < 4; ++e4) { const unsigned a = e4 == 0 ? qv[j].x : e4 == 1 ? qv[j].y : e4 == 2 ? qv[j].z : qv[j].w, b = e4 == 0 ? kv[j].x : e4 == 1 ? kv[j].y : e4 == 2 ? kv[j].z : kv[j].w;
                const float a0 = bflo(a), a1 = bfhi(a), b0 = bflo(b), b1 = bfhi(b); sq += a0 * a0 + a1 * a1; sk += b0 * b0 + b1 * b1; d += a0 * b0 + a1 * b1; } }
#pragma unroll
        for (int o = 1; o < 64; o <<= 1) { sq = fmaxf(sq, __shfl_xor(sq, o)); sk = fmaxf(sk, __shfl_xor(sk, o)); d = fminf(d, __shfl_xor(d, o)); }
        if (lane == 0) { TN[it] = sq; TN[NT_ + it] = sk; TN[2 * NT_ + it] = d; }
      } }
    { const float* cw = A->in[I_SCW] + (size_t)l * 3 * SCW;
      for (int idx = P.bid * 512 + P.tid; idx < M * (SCW / 8); idx += P.G * 512) {
        const int m = idx >> 7, c = (idx & 127) * 8, tp = m & (SEQ - 1);
        const bf16* row = SCB + (size_t)m * SCBW;
        const v4u bw = *(const v4u*)(row + c);
        float acc[8];
#pragma unroll
        for (int e = 0; e < 8; ++e) acc[e] = 0.f;
#pragma unroll
        for (int j = 0; j < 3; ++j) { const int dt = 2 - j;
            if (tp - dt >= 0) { const bf16* rj = row - (size_t)dt * SCBW; const v4u cwv = *(const v4u*)(rj + SCW + c), hw = *(const v4u*)(rj + 2 * SCW + c);
                const f32x4 w0 = *(const f32x4*)(cw + j * SCW + c), w1 = *(const f32x4*)(cw + j * SCW + c + 4);
                acc[0] += w0[0] * bflo(cwv.x) * bflo(hw.x); acc[1] += w0[1] * bfhi(cwv.x) * bfhi(hw.x); acc[2] += w0[2] * bflo(cwv.y) * bflo(hw.y); acc[3] += w0[3] * bfhi(cwv.y) * bfhi(hw.y);
                acc[4] += w1[0] * bflo(cwv.z) * bflo(hw.z); acc[5] += w1[1] * bfhi(cwv.z) * bfhi(hw.z); acc[6] += w1[2] * bflo(cwv.w) * bflo(hw.w); acc[7] += w1[3] * bfhi(cwv.w) * bfhi(hw.w); } }
        v4u o; o.x = pk2(acc[0] * bflo(bw.x), acc[1] * bfhi(bw.x)); o.y = pk2(acc[2] * bflo(bw.y), acc[3] * bfhi(bw.y)); o.z = pk2(acc[4] * bflo(bw.z), acc[5] * bfhi(bw.z)); o.w = pk2(acc[6] * bflo(bw.w), acc[7] * bfhi(bw.w));
        *(v4u*)(MIX + (size_t)m * DM + FOXW + c) = o; } }
}


#ifndef GP_REP_S1
#define GP_REP_S1 1
#endif
#ifndef GP_REP_S4
#define GP_REP_S4 1
#endif
constexpr int GD_OPS_BYTES = 57344;
constexpr int GD_F_WN = 0, GD_F_QD = 16, GD_F_AT = 32, GD_F_KT = 40;
constexpr int GD_NCH = SEQ / 64;
constexpr int GD_NCHH = BATCH * GDNH * GD_NCH;
constexpr size_t WS_GOPS = WS_Y, WS_GU = WS_Y + 168 * MiB, WS_GL = WS_Y + 264 * MiB, WS_GO2 = WS_Y + 266 * MiB;
constexpr int GP_QS = 0, GP_KS = 17408, GP_VS = 34816, GP_LT = 68608, GP_AT = 86016, GP_WM = 103424, GP_SM = 120832;
typedef float f32x2v __attribute__((ext_vector_type(2)));
typedef unsigned u32x2v __attribute__((ext_vector_type(2)));
typedef __bf16 bf16x2c_t __attribute__((ext_vector_type(2)));
__device__ __forceinline__ unsigned cvtpk_bf16(float lo, float hi) { const f32x2v v = {lo, hi}; const bf16x2c_t b = __builtin_convertvector(v, bf16x2c_t); return __builtin_bit_cast(unsigned, b); }


template <int N> __device__ __forceinline__ void fma_bcast(float& x, float l, float nxi) {
    asm volatile("v_fmac_f32_dpp %0, %1, %2 row_newbcast:%3 row_mask:0xf bank_mask:0xf" : "+v"(x) : "v"(l), "v"(nxi), "n"(N));
}
template <int I, int R> struct TriRow {
    static __device__ __forceinline__ void run(float (&x)[64], const float (&L)[4], float nxi) { fma_bcast<(R & 15)>(x[R], L[R >> 4], nxi); TriRow<I, R + 1>::run(x, L, nxi); }
};
template <int I> struct TriRow<I, 64> { static __device__ __forceinline__ void run(float (&)[64], const float (&)[4], float) {} };
template <int I> struct TriSolve {
    static __device__ __forceinline__ void run(float (&x)[64], const LAS float* ltb, float (&Lc)[4]) {
        float Ln[4] = {0.f, 0.f, 0.f, 0.f};
        if (I + 1 < 63) {
#pragma unroll
            for (int q = (I + 2) >> 4; q < 4; ++q) Ln[q] = ltb[(I + 1) * 68 + 16 * q]; }
        const float nxi = -x[I];
        asm volatile("s_nop 1" ::: "memory");
        TriRow<I, I + 1>::run(x, Lc, nxi);
#pragma unroll
        for (int q = 0; q < 4; ++q) Lc[q] = Ln[q];
        TriSolve<I + 1>::run(x, ltb, Lc);
    }
};
template <> struct TriSolve<63> { static __device__ __forceinline__ void run(float (&)[64], const LAS float*, float (&)[4]) {} };


template <int NT>
__device__ __forceinline__ void gp_s1(LAS unsigned char* lds, const bf16* HMG, const float* cw, int ch, int ltid) {
    const int bh = ch / GD_NCH, n = ch % GD_NCH, h = bh % GDNH;
    constexpr int NI = 3072 / NT, PER = NI / 3, ROWS = NT / 16, NB = (NT == 256 ? 4 : 3);
    const int c = (ltid & 15) * 8;
#pragma unroll
    for (int i0 = 0; i0 < NI; i0 += NB) {
        v4u xw[NB][4];
#pragma unroll
        for (int ib = 0; ib < NB; ++ib) { const int i = i0 + ib, part = i / PER, t = (i % PER) * ROWS + (ltid >> 4), tp = n * 64 + t;
            const bf16* src = HMG + hm_off(part, bh) + (size_t)(n * 64 + t) * HD + c;
#pragma unroll
            for (int j = 0; j < 4; ++j) { xw[ib][j] = (v4u){0u, 0u, 0u, 0u}; if (tp - (3 - j) >= 0) xw[ib][j] = *(const v4u*)(src - (size_t)(3 - j) * HD); } }
#pragma unroll
        for (int ib = 0; ib < NB; ++ib) { const int i = i0 + ib, part = i / PER, t = (i % PER) * ROWS + (ltid >> 4);
            const float* wp = cw + part * GDNW + h * HD + c;
            float acc[8];
#pragma unroll
            for (int e = 0; e < 8; ++e) acc[e] = 0.f;
#pragma unroll
            for (int j = 0; j < 4; ++j) { const v4u xv = xw[ib][j]; const f32x4 w0 = *(const f32x4*)(wp + j * (3 * GDNW)), w1 = *(const f32x4*)(wp + j * (3 * GDNW) + 4);
                acc[0] += w0[0] * bflo(xv.x); acc[1] += w0[1] * bfhi(xv.x); acc[2] += w0[2] * bflo(xv.y); acc[3] += w0[3] * bfhi(xv.y);
                acc[4] += w1[0] * bflo(xv.z); acc[5] += w1[1] * bfhi(xv.z); acc[6] += w1[2] * bflo(xv.w); acc[7] += w1[3] * bfhi(xv.w); }
            float ss = 0.f;
#pragma unroll
            for (int e = 0; e < 8; ++e) { acc[e] = acc[e] * __builtin_amdgcn_rcpf(1.0f + __builtin_amdgcn_exp2f(-1.4426950408889634f * acc[e])); ss += acc[e] * acc[e]; }
            if (part < 2) {
                ss += __shfl_xor(ss, 1); ss += __shfl_xor(ss, 2); ss += __shfl_xor(ss, 4); ss += __shfl_xor(ss, 8);
                const float r = (1.0f / sqrtf(ss + RMS_EPS)) * (part == 0 ? 0.08838834764831845f : 1.0f);
                v4u o; o.x = cvtpk_bf16(acc[0] * r, acc[1] * r); o.y = cvtpk_bf16(acc[2] * r, acc[3] * r); o.z = cvtpk_bf16(acc[4] * r, acc[5] * r); o.w = cvtpk_bf16(acc[6] * r, acc[7] * r);
                *(LAS v4u*)(lds + (part == 0 ? GP_QS : GP_KS) + (t * 136 + c) * 2) = o;
            } else {
                LAS float* vp = (LAS float*)(lds + GP_VS) + t * 132 + c;
                *(LAS f32x4*)vp = (f32x4){acc[0], acc[1], acc[2], acc[3]}; *(LAS f32x4*)(vp + 4) = (f32x4){acc[4], acc[5], acc[6], acc[7]};
            }
        }
    }
}
__device__ __forceinline__ void gp_s2(ArgsP A, LAS float* SMf, const float* SB, float* GL, int l, int ch, int lane) {
    const int bh = ch / GD_NCH, n = ch % GD_NCH, b = bh / GDNH, h = bh % GDNH;
    const size_t m = (size_t)b * SEQ + (size_t)n * 64 + lane;
    const float xb = SB[m * SBW + SB_GB + h], xa = SB[m * SBW + SB_GA + h] + A->in[I_GDNDTB][l * GDNH + h];
    const float bt = __builtin_amdgcn_rcpf(1.0f + __builtin_amdgcn_exp2f(-1.4426950408889634f * xb));
    const float sp = fmaxf(xa, 0.f) + 0.6931471805599453f * __builtin_amdgcn_logf(1.0f + __builtin_amdgcn_exp2f(-1.4426950408889634f * fabsf(xa)));
    const float gg = -__builtin_amdgcn_exp2f(1.4426950408889634f * A->in[I_GDNALOG][l * GDNH + h]) * sp;
    float gc = gg;
#pragma unroll
    for (int o = 1; o < 64; o <<= 1) { const float nb = __shfl_up(gc, o); if (lane >= o) gc += nb; }
    const float gtot = __shfl(gc, 63);
    SMf[lane] = bt; SMf[64 + lane] = gc; SMf[128 + lane] = __builtin_amdgcn_exp2f(1.4426950408889634f * gc); SMf[192 + lane] = __builtin_amdgcn_exp2f(1.4426950408889634f * (gtot - gc));
    if (lane == 63) GL[ch] = __builtin_amdgcn_exp2f(1.4426950408889634f * gtot);
}

__device__ __forceinline__ void gdn_prep(ArgsP ap0, LAS unsigned char* lds, int l) {
    const Ptrs P = fresh_ptrs(ap0); const ArgsP A = P.ap;
    const int tid = P.tid, lane = P.lane, wave = P.wave;
    const bf16* HMG = (const bf16*)(A->ws + WS_PROJ) + hm_off(HM_GQ, 0); const float* SB = (const float*)(A->ws + WS_SB);
    unsigned char* GOPS = A->ws + WS_GOPS; float* GU = (float*)(A->ws + WS_GU); float* GL = (float*)(A->ws + WS_GL);
    const float* cw = A->in[I_GDNCW] + (size_t)l * 4 * (3 * GDNW);
    LAS float* SMf = (LAS float*)(lds + GP_SM);
    LAS unsigned* hb = (LAS unsigned*)(lds + GP_SM + 1024); unsigned hb_epoch = 0u;
    if (tid == 0) *hb = 0u;
    if (P.bid < GD_NCHH) { gp_s1<512>(lds, HMG, cw, P.bid, tid); if (wave == 0) gp_s2(A, SMf, SB, GL, l, P.bid, lane); }
    for (int ch = P.bid; ch < GD_NCHH; ch += P.G) {
        const int bh = ch / GD_NCH, n = ch % GD_NCH, b = bh / GDNH, h = bh % GDNH;
        const size_t row0 = (size_t)b * SEQ + (size_t)n * 64;
        (void)b; (void)h; (void)row0; (void)n;
        __syncthreads();
        {
            const int mat = wave >> 2, mt = wave & 3, q4 = lane >> 4, m16 = lane & 15;
            f32x4 acc[4];
#pragma unroll
            for (int nt = 0; nt < 4; ++nt) acc[nt] = (f32x4){0.f, 0.f, 0.f, 0.f};
            const LAS unsigned char* abase = lds + (mat == 0 ? GP_KS : GP_QS) + ((16 * mt + m16) * 136 + 8 * q4) * 2;
            const LAS unsigned char* bbase = lds + GP_KS + (m16 * 136 + 8 * q4) * 2;
#pragma unroll
            for (int ks = 0; ks < 4; ++ks) { const bf16x8 a = *(const LAS bf16x8*)(abase + ks * 64);
#pragma unroll
                for (int nt = 0; nt < 4; ++nt) { const bf16x8 bb = *(const LAS bf16x8*)(bbase + nt * (16 * 136 * 2) + ks * 64); acc[nt] = __builtin_amdgcn_mfma_f32_16x16x32_bf16(a, bb, acc[nt], 0, 0, 0); } }
            const int c0 = 16 * mt + 4 * q4;
            const f32x4 gcc = *(const LAS f32x4*)(SMf + 64 + c0), btc = *(const LAS f32x4*)(SMf + c0);
#pragma unroll
            for (int nt = 0; nt < 4; ++nt) { const int s = 16 * nt + m16; const float gs = SMf[64 + s];
                if (mat == 0) { f32x4 o;
#pragma unroll
                    for (int r = 0; r < 4; ++r) o[r] = (s < c0 + r) ? btc[r] * acc[nt][r] * __builtin_amdgcn_exp2f(1.4426950408889634f * (gcc[r] - gs)) : 0.f;
                    *(LAS f32x4*)((LAS float*)(lds + GP_LT) + s * 68 + c0) = o;
                } else {
#pragma unroll
                    for (int r = 0; r < 4; ++r) ((LAS float*)(lds + GP_AT))[(c0 + r) * 68 + s] = (s <= c0 + r) ? acc[nt][r] * __builtin_amdgcn_exp2f(1.4426950408889634f * (gcc[r] - gs)) : 0.f;
                } }
        }
        __syncthreads();
        float x[64];
        if (tid < 256) {
            const int j = tid & 127, isw = tid >> 7;
            int vz = 0; asm volatile("" : "+v"(vz));
            const LAS float* SMv = SMf + vz;
#pragma unroll
            for (int r4 = 0; r4 < 16; ++r4) { const f32x4 bt = *(const LAS f32x4*)(SMv + 4 * r4), eg = *(const LAS f32x4*)(SMv + 128 + 4 * r4);
#pragma unroll
                for (int e = 0; e < 4; ++e) { const int r = 4 * r4 + e;
                    x[r] = isw ? __uint_as_float((unsigned)(*(const LAS unsigned short*)(lds + GP_KS + (r * 136 + j) * 2)) << 16) * (bt[e] * eg[e]) : ((const LAS float*)(lds + GP_VS))[r * 132 + j] * bt[e]; } }
        }
        __syncthreads();
        if (tid < 256) {
            const int j = tid & 127, isw = tid >> 7;
            { const LAS float* ltb = (const LAS float*)(lds + GP_LT) + (lane & 15);
              float Lc[4];
#pragma unroll
              for (int q = 0; q < 4; ++q) Lc[q] = ltb[16 * q];
              TriSolve<0>::run(x, ltb, Lc); }
            if (!isw) { float* up = GU + (size_t)ch * 8192 + (size_t)((j >> 4) * 4) * 256 + (j & 15) * 4;
#pragma unroll
                for (int mt = 0; mt < 4; ++mt)
#pragma unroll
                    for (int q4 = 0; q4 < 4; ++q4) *(f32x4*)(up + mt * 256 + q4 * 64) = (f32x4){x[16 * mt + 4 * q4], x[16 * mt + 4 * q4 + 1], x[16 * mt + 4 * q4 + 2], x[16 * mt + 4 * q4 + 3]};
            } else {
#pragma unroll
                for (int r = 0; r < 64; ++r) *(LAS unsigned short*)(lds + GP_WM + (r * 136 + j) * 2) = (unsigned short)f2bf(-x[r]);
            }
        } else {
            const int wv = wave - 4, q4 = lane >> 4, m16 = lane & 15;
            unsigned char* dst = GOPS + (size_t)ch * GD_OPS_BYTES + lane * 16;
            for (int f = wv; f < 40; f += 4) {
                v4u o;
                if (f < 16) { const int mt = f >> 2, ks = f & 3, row = 16 * mt + m16; const float eg = SMf[128 + row];
                    const LAS unsigned char* p = lds + GP_QS + (row * 136 + 32 * ks + 4 * q4) * 2;
                    const u32x2v a = *(const LAS u32x2v*)p, bq = *(const LAS u32x2v*)(p + 32);
                    o.x = cvtpk_bf16(bflo(a.x) * eg, bfhi(a.x) * eg); o.y = cvtpk_bf16(bflo(a.y) * eg, bfhi(a.y) * eg); o.z = cvtpk_bf16(bflo(bq.x) * eg, bfhi(bq.x) * eg); o.w = cvtpk_bf16(bflo(bq.y) * eg, bfhi(bq.y) * eg);
                    *(v4u*)(dst + (GD_F_QD + f) * 1024) = o;
                } else if (f < 24) { const int ff = f - 16, mt = ff >> 1, ks = ff & 1, row = 16 * mt + m16;
                    const LAS float* p = (const LAS float*)(lds + GP_AT) + row * 68 + 32 * ks + 4 * q4;
                    const f32x4 a = *(const LAS f32x4*)p, bq = *(const LAS f32x4*)(p + 16);
                    o.x = cvtpk_bf16(a[0], a[1]); o.y = cvtpk_bf16(a[2], a[3]); o.z = cvtpk_bf16(bq[0], bq[1]); o.w = cvtpk_bf16(bq[2], bq[3]);
                    *(v4u*)(dst + (GD_F_AT + ff) * 1024) = o;
                } else { const int ff = f - 24, mt = ff >> 1, ks = ff & 1, dk = 16 * mt + m16;
                    const int cA = 32 * ks + 4 * q4; const f32x4 ekA = *(const LAS f32x4*)(SMf + 192 + cA), ekB = *(const LAS f32x4*)(SMf + 192 + cA + 16);
                    float kv[8];
#pragma unroll
                    for (int e = 0; e < 4; ++e) { kv[e] = __uint_as_float((unsigned)(*(const LAS unsigned short*)(lds + GP_KS + ((cA + e) * 136 + dk) * 2)) << 16) * ekA[e];
                                                  kv[4 + e] = __uint_as_float((unsigned)(*(const LAS unsigned short*)(lds + GP_KS + ((cA + 16 + e) * 136 + dk) * 2)) << 16) * ekB[e]; }
                    o.x = cvtpk_bf16(kv[0], kv[1]); o.y = cvtpk_bf16(kv[2], kv[3]); o.z = cvtpk_bf16(kv[4], kv[5]); o.w = cvtpk_bf16(kv[6], kv[7]);
                    *(v4u*)(dst + (GD_F_KT + ff) * 1024) = o;
                }
            }
            if (ch + P.G < GD_NCHH) {
                asm volatile("s_waitcnt lgkmcnt(0)" ::: "memory");
                ++hb_epoch;
                if (lane == 0) (void)__hip_atomic_fetch_add(hb, 1u, __ATOMIC_RELAXED, __HIP_MEMORY_SCOPE_WORKGROUP);
                while (__hip_atomic_load(hb, __ATOMIC_RELAXED, __HIP_MEMORY_SCOPE_WORKGROUP) < 4u * hb_epoch) __builtin_amdgcn_s_sleep(1);
                asm volatile("" ::: "memory");
                gp_s1<256>(lds, HMG, cw, ch + P.G, tid - 256); if (wave == 4) gp_s2(A, SMf, SB, GL, l, ch + P.G, lane); }
        }
        __syncthreads();
        { const int q4 = lane >> 4, m16 = lane & 15;
#pragma unroll
          for (int k2 = 0; k2 < 2; ++k2) { const int f = wave * 2 + k2, mt = f >> 2, ks = f & 3, row = 16 * mt + m16;
            const LAS unsigned char* p = lds + GP_WM + (row * 136 + 32 * ks + 4 * q4) * 2;
            const u32x2v a = *(const LAS u32x2v*)p, bq = *(const LAS u32x2v*)(p + 32);
            v4u o; o.x = a.x; o.y = a.y; o.z = bq.x; o.w = bq.y;
            *(v4u*)(GOPS + (size_t)ch * GD_OPS_BYTES + (GD_F_WN + f) * 1024 + lane * 16) = o; } }
    }
    __syncthreads();
}

__device__ __forceinline__ void gdn_scan(ArgsP ap0, LAS unsigned char* lds) {
    const Ptrs P = fresh_ptrs(ap0); const ArgsP A = P.ap;
    const int lane = P.lane, wave = P.wave, bh = P.bid >> 1, b = bh / GDNH, h = bh % GDNH, q4 = lane >> 4, n16 = lane & 15;
    const int cs = (P.bid & 1) * 4 + (wave & 3);
    const bool comp = wave < 4;
    const unsigned char* ops = A->ws + WS_GOPS + (size_t)bh * GD_NCH * GD_OPS_BYTES;
    const float* Up = (const float*)(A->ws + WS_GU) + (size_t)bh * GD_NCH * 8192 + (size_t)(cs * 4) * 256 + lane * 4;
    const float* GLp = (const float*)(A->ws + WS_GL) + (size_t)bh * GD_NCH;
    float* GO = (float*)(A->ws + WS_GO2) + ((size_t)b * SEQ) * GDNW + h * HD + 16 * cs + n16;
    f32x4 S[8];
#pragma unroll
    for (int i = 0; i < 8; ++i) S[i] = (f32x4){0.f, 0.f, 0.f, 0.f};
    f32x4 Un[4]; float gln = 0.f;
#pragma unroll
    for (int i = 0; i < 4; ++i) Un[i] = (f32x4){0.f, 0.f, 0.f, 0.f};
#define GD_DMA(nn, buf) do { _Pragma("unroll") for (int i_ = 0; i_ < 7; ++i_) __builtin_amdgcn_global_load_lds((const unsigned*)(ops + (size_t)(nn) * GD_OPS_BYTES + (i_ * 8 + wave) * 1024 + lane * 16), \
        (LAS unsigned*)(lds + (buf) * GD_OPS_BYTES + (i_ * 8 + wave) * 1024), 16, 0, 0); } while (0)
#define GD_ULOAD(nn) do { if (comp) { _Pragma("unroll") for (int mt_ = 0; mt_ < 4; ++mt_) Un[mt_] = *(const f32x4*)(Up + (size_t)(nn) * 8192 + mt_ * 256); gln = GLp[nn]; } } while (0)
    GD_DMA(0, 0); GD_ULOAD(0);
    for (int n = 0; n < GD_NCH; ++n) {
        asm volatile("s_waitcnt vmcnt(0)" ::: "memory");
        __syncthreads();
        f32x4 Uc[4]; const float gl = gln;
#pragma unroll
        for (int mt = 0; mt < 4; ++mt) Uc[mt] = Un[mt];
        if (n + 1 < GD_NCH) { GD_DMA(n + 1, (n + 1) & 1); GD_ULOAD(n + 1); }
        if (comp) {
        const LAS unsigned char* fr = lds + (n & 1) * GD_OPS_BYTES + lane * 16;
#define GD_FRAG(f) (*(const LAS bf16x8*)(fr + (f) * 1024))
        bf16x8 Sb[4];
#pragma unroll
        for (int ks = 0; ks < 4; ++ks) { v4u w; w.x = cvtpk_bf16(S[2 * ks][0], S[2 * ks][1]); w.y = cvtpk_bf16(S[2 * ks][2], S[2 * ks][3]); w.z = cvtpk_bf16(S[2 * ks + 1][0], S[2 * ks + 1][1]); w.w = cvtpk_bf16(S[2 * ks + 1][2], S[2 * ks + 1][3]);
            Sb[ks] = __builtin_bit_cast(bf16x8, w); }
        f32x4 vn[4];
#pragma unroll
        for (int mt = 0; mt < 4; ++mt) { vn[mt] = Uc[mt];
#pragma unroll
            for (int ks = 0; ks < 4; ++ks) vn[mt] = __builtin_amdgcn_mfma_f32_16x16x32_bf16(GD_FRAG(GD_F_WN + mt * 4 + ks), Sb[ks], vn[mt], 0, 0, 0); }
        bf16x8 Vb[2];
#pragma unroll
        for (int ks = 0; ks < 2; ++ks) { v4u w; w.x = cvtpk_bf16(vn[2 * ks][0], vn[2 * ks][1]); w.y = cvtpk_bf16(vn[2 * ks][2], vn[2 * ks][3]); w.z = cvtpk_bf16(vn[2 * ks + 1][0], vn[2 * ks + 1][1]); w.w = cvtpk_bf16(vn[2 * ks + 1][2], vn[2 * ks + 1][3]);
            Vb[ks] = __builtin_bit_cast(bf16x8, w); }
        float* orow = GO + (size_t)(n * 64 + 4 * q4) * GDNW;
#pragma unroll
        for (int mt = 0; mt < 4; ++mt) { f32x4 o = (f32x4){0.f, 0.f, 0.f, 0.f};
#pragma unroll
            for (int ks = 0; ks < 4; ++ks) o = __builtin_amdgcn_mfma_f32_16x16x32_bf16(GD_FRAG(GD_F_QD + mt * 4 + ks), Sb[ks], o, 0, 0, 0);
#pragma unroll
            for (int ks = 0; ks < 2; ++ks) o = __builtin_amdgcn_mfma_f32_16x16x32_bf16(GD_FRAG(GD_F_AT + mt * 2 + ks), Vb[ks], o, 0, 0, 0);
#pragma unroll
            for (int r = 0; r < 4; ++r) orow[(size_t)(16 * mt + r) * GDNW] = o[r]; }
#pragma unroll
        for (int mt = 0; mt < 8; ++mt) { S[mt] = S[mt] * gl;
#pragma unroll
            for (int ks = 0; ks < 2; ++ks) S[mt] = __builtin_amdgcn_mfma_f32_16x16x32_bf16(GD_FRAG(GD_F_KT + mt * 2 + ks), Vb[ks], S[mt], 0, 0, 0); }
        }
    }
#undef GD_FRAG
#undef GD_DMA
#undef GD_ULOAD
    asm volatile("s_waitcnt vmcnt(0)" ::: "memory");
    __syncthreads();
}
__device__ __forceinline__ void p4_finalize(ArgsP ap0, int l) {
    const Ptrs P = fresh_ptrs(ap0); const ArgsP A = P.ap;
    const float* GO = (const float*)(A->ws + WS_GO2); const bf16* HMZ = (const bf16*)(A->ws + WS_PROJ) + hm_off(HM_GZ, 0);
    bf16* MIX = (bf16*)(A->ws + WS_MIX); const int lane = P.lane;
    typedef float f32x2 __attribute__((ext_vector_type(2)));
    const f32x2 gg = *(const f32x2*)(A->in[I_GDNON] + l * HD + 2 * lane);
    for (int m = P.gw; m < M; m += P.NGW) {
        const int b = m / SEQ, s = m % SEQ;
        f32x2 v[GDNH]; unsigned zw[GDNH];
#pragma unroll
        for (int h = 0; h < GDNH; ++h) { v[h] = *(const f32x2*)(GO + (size_t)m * GDNW + h * HD + 2 * lane); zw[h] = *(const unsigned*)(HMZ + ((size_t)(b * GDNH + h) * SEQ + s) * HD + 2 * lane); }
        float ss[GDNH];
#pragma unroll
        for (int h = 0; h < GDNH; ++h) ss[h] = v[h][0] * v[h][0] + v[h][1] * v[h][1];
#pragma unroll
        for (int o = 1; o < 64; o <<= 1) {
#pragma unroll
            for (int h = 0; h < GDNH; ++h) ss[h] += __shfl_xor(ss[h], o); }
#pragma unroll
        for (int h = 0; h < GDNH; ++h) { const float rr = 1.0f / sqrtf(ss[h] * (1.0f / HD) + RMS_EPS);
            *(unsigned*)(MIX + (size_t)m * DM + FOXW + SCW + h * HD + 2 * lane) = pk2(v[h][0] * rr * gg[0] * silu_acc(bflo(zw[h])), v[h][1] * rr * gg[1] * silu_acc(bfhi(zw[h]))); }
    }
}

constexpr int ATT_PER_X = 3 * (SEQ / attn::QB);
constexpr int ATT_SLOT_OFF = 69632;
static_assert(attn::LDS_BYTES <= ATT_SLOT_OFF, "attention LDS map");
typedef attn::BlockRef<attn::bf16, attn::bf16> FoxRef;
__device__ __forceinline__ int fox_jlo(ArgsP A, int l, int bh, int P0) {
    (void)l;
    const float* FG = (const float*)(A->ws + WS_FG) + (size_t)bh * SEQ; const float* TN = (const float*)(A->ws + WS_TN);
    constexpr int NT_ = BATCH * FOXH * (SEQ / 64);
    const int lane = my_lane(), jd = P0 / attn::KVBLK, tb = bh * (SEQ / 64);
    float qn2 = 0.f, lb = 3.0e38f;
#pragma unroll
    for (int i = 0; i < 4; ++i) { qn2 = fmaxf(qn2, TN[tb + jd + i]); lb = fminf(lb, TN[2 * NT_ + tb + jd + i] + FG[64 * (jd + i)]); }
    const float qnb = sqrtf(qn2) * 1.001f;
    const bool s0 = qnb * sqrtf(TN[NT_ + tb + lane]) + FG[64 * lane + 63] - lb < -600.0f, s1 = qnb * sqrtf(TN[NT_ + tb + lane + 64]) + FG[64 * (lane + 64) + 63] - lb < -600.0f;
    const unsigned long long n0 = ~__ballot(s0), n1 = ~__ballot(s1);
    const int n = n0 ? __builtin_ctzll(n0) : 64 + (n1 ? __builtin_ctzll(n1) : 64);
    return __builtin_amdgcn_readfirstlane(n < jd ? n : jd);
}
__device__ __forceinline__ FoxRef fox_ref(ArgsP A, int id, int l) {
    const int qx = id / ATT_PER_X, i = id % ATT_PER_X, bh = 3 * qx + (i >> 5), qb = 31 - (i & 31);
    const int b = bh / FOXH, h = bh % FOXH; const size_t row0 = (size_t)b * SEQ;
    const attn::bf16* HM = (const attn::bf16*)(A->ws + WS_PROJ);
    FoxRef r;
    r.Q = HM + hm_off(HM_FQ, bh) + (size_t)qb * attn::QB * HD;
    r.K = HM + hm_off(HM_FK, bh); r.V = HM + hm_off(HM_FV, bh);
    r.F = (const float*)(A->ws + WS_FG) + (size_t)bh * SEQ;
    r.O = (attn::bf16*)(A->ws + WS_MIX) + (row0 + (size_t)qb * attn::QB) * DM + h * HD; r.P0 = qb * attn::QB; r.JLO = fox_jlo(A, l, bh, r.P0);
    return r;
}
__device__ __forceinline__ int att_claim(gu32* ctrs, volatile LAS int* st) {
    int qx = st[0], tried = st[1], r = -1;
    while (tried < 8) { const unsigned i = __hip_atomic_fetch_add(ctrs + qx * 64, 1u, __ATOMIC_RELAXED, __HIP_MEMORY_SCOPE_AGENT); if (i < (unsigned)ATT_PER_X) { r = qx * ATT_PER_X + (int)i; break; } qx = (qx + 1) & 7; ++tried; }
    st[0] = qx; st[1] = tried;
    return r;
}
__device__ __forceinline__ void p3_attention(ArgsP ap0, char* lds, int l, int rep = 0) {
    const ArgsP A = fresh(ap0);
    gu32* ctrs = (gu32*)(A->ws + WS_CTL) + CW_Q + (rep * 2 + l) * 8 * 64;
    volatile LAS int* slot = (volatile LAS int*)((LAS unsigned char*)lds + ATT_SLOT_OFF);
    if (ftid() == 0) { slot[4] = (int)(xb_xcc_id() & 7u); slot[5] = 0; slot[0] = att_claim(ctrs, slot + 4); slot[1] = att_claim(ctrs, slot + 4); }
    __syncthreads();
    int cur = __builtin_amdgcn_readfirstlane(slot[0]), nxt = __builtin_amdgcn_readfirstlane(slot[1]);
    if (cur < 0) return;
    FoxRef curR = fox_ref(A, cur, l);
    attn::Seam<attn::bf16> S;
    attn::causal_swa_prime<attn::bf16, attn::bf16>(curR, SEQ, lds, S);
    for (int k = 0;; ++k) {
        if (nxt >= 0 && ftid() == 0) slot[2 + (k & 1)] = att_claim(ctrs, slot + 4);
        const bool last = nxt < 0;
        const FoxRef nxtR = last ? curR : fox_ref(A, nxt, l);
        attn::causal_swa_block<attn::bf16, attn::bf16>(curR, nxtR, SEQ, SEQ, lds, S, &A->in[I_FOXON], l * HD);
        if (last) break;
        cur = nxt; curR = nxtR; nxt = __builtin_amdgcn_readfirstlane(slot[2 + (k & 1)]);
    }
}

constexpr int N_PHASES = 1 + 9 * DEPTH;

#ifndef PH_EN
#define PH_EN 0x3ff
#endif
#define IN(k) (lo <= (k) && (k) < hi)
#define EN(j) ((PH_EN >> (j)) & 1)
#ifndef REP_MASK
#define REP_MASK 0
#endif
#define REPS(j) (((REP_MASK >> (j)) & 1) ? 2 : 1)
#define SEAM(k) do { if (IN(k) && IN((k) + 1)) { XcdBarrier b_; b_.bar = (unsigned*)(fresh(ap0)->ws + WS_CTL) + CW_BAR; b_.x = xb_xcc_id(); b_.st = (volatile LAS unsigned*)((LAS unsigned char*)lds + MISC_OFF) + 8; xcd_barrier(b_); } } while (0)
#define WSP(T, off) ((T*)(A->ws + (off)))


template <int l>
__device__ __forceinline__ void layer_phases(ArgsP ap0, LAS unsigned char* ldsl, unsigned char* lds, int lo, int hi) {

        const int pb = 1 + 9 * l;
        if (EN(1) && IN(pb + 0)) {
            const Ptrs P = fresh_ptrs(ap0); const ArgsP A = P.ap;
            pg8::Gemm g{WSP(bf16, WS_XN), WSP(bf16, WS_W + WO_IN), M, NP, DM}; pg8::StaticOrder S; S.init(M, NP, P.G, P.bid);
            pg8::EpiProj E{WSP(bf16, WS_PROJ), WSP(bf16, WS_SCB), WSP(float, WS_SB)};
            for (int rep_ = 0; rep_ < REPS(1); ++rep_) pg8::gemm_phase<pg8::EpiProj, pg8::StaticOrder, true, true>(ldsl, g, S, E);
            convert_weights(ap0, ldsl, l, I_IN + I_OUT + I_GU, I_LAYER, (M / 256) * (NP / 256) % P.G);
            SEAM(pb + 0);
        }
        if (EN(2) && IN(pb + 1)) {
            for (int rep_ = 0; rep_ < REPS(11); ++rep_) p2_prep(ap0, ldsl, l);
            for (int rep_ = 0; rep_ < REPS(2); ++rep_) gdn_prep(ap0, ldsl, l);
            SEAM(pb + 1); }
        if (EN(3) && IN(pb + 2)) {
            for (int rep_ = 0; rep_ < REPS(10); ++rep_) if ((int)blockIdx.x < 2 * BATCH * GDNH) gdn_scan(ap0, ldsl);
            for (int rep_ = 0; rep_ < REPS(3); ++rep_) p3_attention(ap0, (char*)lds, l, rep_);
            SEAM(pb + 2);
        }
        if (EN(4) && IN(pb + 3)) { for (int rep_ = 0; rep_ < REPS(4); ++rep_) p4_finalize(ap0, l); SEAM(pb + 3); }
        if (EN(5) && IN(pb + 4)) {
            const Ptrs P = fresh_ptrs(ap0); const ArgsP A = P.ap;
            pg8::Gemm g{WSP(bf16, WS_MIX), WSP(bf16, WS_W + WO_OUT), M, DM, DM}; pg8::StaticOrder S; S.init(M, DM, P.G, P.bid);
            pg8::EpiY E{WSP(bf16, WS_Y), WSP(float, WS_SS)};
            for (int rep_ = 0; rep_ < REPS(5); ++rep_) pg8::gemm_phase<pg8::EpiY, pg8::StaticOrder, true, true>(ldsl, g, S, E);
            SEAM(pb + 4);
        }
        if (EN(6) && IN(pb + 5)) {
            const Ptrs P = fresh_ptrs(ap0); const ArgsP A = P.ap;
            const float* xin = l == 0 ? A->in[I_X] : (const float*)A->out;
            const float* gpost = A->in[I_MIXPOST] + l * DM; const float* gpre = A->in[I_FFNPRE] + l * DM;
            const bf16* Y = WSP(bf16, WS_Y); const float* SS = WSP(float, WS_SS); float* H = WSP(float, WS_H); bf16* XN = WSP(bf16, WS_XN);
            for (int rep_ = 0; rep_ < REPS(6); ++rep_)
            for (int m = P.gw; m < M; m += P.NGW)
                resid_norm_row(xin + (size_t)m * DM, Y + (size_t)m * DM, SS + (size_t)m * 64, gpost, H + (size_t)m * DM, gpre, XN + (size_t)m * DM, P.lane);
            SEAM(pb + 5);
        }
        if (EN(7) && IN(pb + 6)) {
            const Ptrs P = fresh_ptrs(ap0); const ArgsP A = P.ap;
            pg8::Gemm g{WSP(bf16, WS_XN), WSP(bf16, WS_W + WO_GU), M, NGU, DM}; pg8::StaticOrder S; S.init(M, NGU, P.G, P.bid);
            pg8::EpiSwiGLU E{WSP(bf16, WS_PROJ)};
            for (int rep_ = 0; rep_ < REPS(7); ++rep_) pg8::gemm_phase<pg8::EpiSwiGLU, pg8::StaticOrder, true, true>(ldsl, g, S, E);
            if (l + 1 < DEPTH) convert_weights(ap0, ldsl, l + 1, 0, I_IN + I_OUT, (M / 256) * (NGU / 256) % P.G);
            SEAM(pb + 6);
        }
        if (EN(8) && IN(pb + 7)) {
            const Ptrs P = fresh_ptrs(ap0); const ArgsP A = P.ap;
            pg8::Gemm g{WSP(bf16, WS_PROJ), WSP(bf16, WS_W + WO_DN), M, DM, FFN}; pg8::StaticOrder S; S.init(M, DM, P.G, P.bid);
            pg8::EpiY E{WSP(bf16, WS_Y), WSP(float, WS_SS)};
            for (int rep_ = 0; rep_ < REPS(8); ++rep_) pg8::gemm_phase<pg8::EpiY, pg8::StaticOrder, true, true>(ldsl, g, S, E);
            SEAM(pb + 7);
        }
        if (EN(9) && IN(pb + 8)) {
            const Ptrs P = fresh_ptrs(ap0); const ArgsP A = P.ap;
            const float* gnext = l + 1 < DEPTH ? A->in[I_MIXPRE] + (l + 1) * DM : nullptr; const float* gpost = A->in[I_FFNPOST] + l * DM;
            const bf16* Y = WSP(bf16, WS_Y); const float* SS = WSP(float, WS_SS); const float* H = WSP(float, WS_H); bf16* XN = WSP(bf16, WS_XN); float* outp = A->out;
            for (int rep_ = 0; rep_ < REPS(9); ++rep_) {
            for (int m = P.gw; m < M; m += P.NGW)
                resid_norm_row(H + (size_t)m * DM, Y + (size_t)m * DM, SS + (size_t)m * 64, gpost, outp + (size_t)m * DM, gnext, XN + (size_t)m * DM, P.lane);
            if (l + 1 < DEPTH) convert_weights(ap0, ldsl, l + 1, I_IN + I_OUT, I_IN + I_OUT + I_GU);
            }
            SEAM(pb + 8);
        }
    }

__global__ void __launch_bounds__(NWAVES * 64, 2) hybrid_fwd(Args args) {
    extern __shared__ __attribute__((aligned(16))) unsigned char lds[];
    LAS unsigned char* ldsl = (LAS unsigned char*)lds;
    volatile LAS unsigned* MISC = (volatile LAS unsigned*)(ldsl + MISC_OFF);
    const ArgsP ap0 = (ArgsP)__builtin_amdgcn_kernarg_segment_ptr();
    for (int u = threadIdx.x; u < (LDS_BYTES - LDSCTL_OFF) / 4; u += NWAVES * 64) ((LAS unsigned*)(ldsl + LDSCTL_OFF))[u] = 0u;
    __syncthreads();
    if ((threadIdx.x & 63) == 0) *(volatile LAS int*)(ldsl + TIDTAB_OFF + 4 * hw_slot()) = (int)(threadIdx.x >> 6);
    __syncthreads();
    const int lo = args.ph_lo, hi = args.ph_hi;
    if (hi - lo > 1) (void)xcd_barrier_post((unsigned*)(args.ws + WS_CTL) + CW_BAR, MISC + 8);
    if (EN(0) && IN(0)) { for (int rep_ = 0; rep_ < REPS(0); ++rep_) p0_prologue(ap0, ldsl); SEAM(0); }
    layer_phases<0>(ap0, ldsl, lds, lo, hi);
    layer_phases<1>(ap0, ldsl, lds, lo, hi);
}

#undef IN
#undef SEAM
extern "C" void kernel_launch(void* const* d_in, const int* in_sizes, int n_in, void* d_out, int out_size, void* d_ws, size_t ws_size, hipStream_t stream) {
    static int grid = 0;
    if (grid == 0) {
        if (n_in != 17 || in_sizes[0] != M * DM || out_size != M * DM || ws_size < WS_END) {
            fprintf(stderr, "kernel_launch: shape/workspace mismatch: n_in %d in0 %d out %d ws %zu (need %zu)\n", n_in, n_in > 0 ? in_sizes[0] : -1, out_size, ws_size, (size_t)WS_END); grid = -1; return; }
        int dev = 0, cus = 0, per_cu = 0;
        if (hipGetDevice(&dev) != hipSuccess || hipDeviceGetAttribute(&cus, hipDeviceAttributeMultiprocessorCount, dev) != hipSuccess) { fprintf(stderr, "kernel_launch: device query failed\n"); grid = -1; return; }
        if (hipFuncSetAttribute((const void*)hybrid_fwd, hipFuncAttributeMaxDynamicSharedMemorySize, LDS_BYTES) != hipSuccess) { fprintf(stderr, "kernel_launch: hipFuncSetAttribute failed\n"); grid = -1; return; }
        if (hipOccupancyMaxActiveBlocksPerMultiprocessor(&per_cu, (const void*)hybrid_fwd, NWAVES * 64, LDS_BYTES) != hipSuccess || per_cu < 1)
            fprintf(stderr, "kernel_launch: note: occupancy query reports %d workgroups per CU\n", per_cu);
        (void)hipGetLastError();
        grid = cus;
    }
    if (grid < 0) return;
    if (hipMemsetAsync((char*)d_ws + WS_CTL, 0, CTL_ZERO_BYTES, stream) != hipSuccess) { fprintf(stderr, "kernel_launch: memset failed\n"); return; }
    Args a{};
    for (int i = 0; i < 17; ++i) a.in[i] = (const float*)d_in[i];
    a.out = (float*)d_out; a.ws = (unsigned char*)d_ws;
#if MK_N_LAUNCHES == 1
    a.ph_lo = 0; a.ph_hi = N_PHASES;
    hipLaunchKernelGGL(hybrid_fwd, dim3(grid), dim3(NWAVES * 64), LDS_BYTES, stream, a);
#else
    for (int p = 0; p < N_PHASES; ++p) { a.ph_lo = p; a.ph_hi = p + 1; hipLaunchKernelGGL(hybrid_fwd, dim3(grid), dim3(NWAVES * 64), LDS_BYTES, stream, a); }
#endif
    const hipError_t le = hipPeekAtLastError();
    if (le != hipSuccess) fprintf(stderr, "kernel_launch: launch failed: %s\n", hipGetErrorName(le));
}
```

```cpp
#include <hip/hip_runtime.h>
#include <hip/hip_bf16.h>
#include <cstdio>
#include <cstdint>
#include <cmath>

#ifndef MK_N_LAUNCHES
#define MK_N_LAUNCHES 1
#endif

constexpr int BATCH = 2, SEQ = 8192, DM = 4096, M = BATCH * SEQ, DEPTH = 2;
constexpr int HD = 128, FOXH = 12, FOXW = FOXH * HD, SCW = 1024, GDNH = 12, GDNW = GDNH * HD;
constexpr int PROJ_SRC = 13860;
constexpr int NP = 14080;
constexpr int FFN = 11008, NGU = 2 * FFN;
constexpr float RMS_EPS = 1e-6f;
constexpr int PC_FQ = 0, PC_FK = 1536, PC_FV = 3072, PC_SB = 4608, PC_SC = 5632, PC_SH = 6656, PC_GQ = 7680, PC_GK = 9216, PC_GV = 10752, PC_GZ = 12288, PC_SMALL = 13824;
constexpr int SBW = 64, SB_FF = 0, SB_GA = 12, SB_GB = 24;
constexpr int SRC_FF = 4608, SRC_SB = 4620, SRC_GQ = 7692, SRC_GA = 12300, SRC_GB = 12312, SRC_GZ = 12324;

constexpr size_t MiB = 1u << 20;
constexpr size_t WS_CTL = 0, CTL_ZERO_BYTES = 1 * MiB;
constexpr size_t WS_W = 16 * MiB;
constexpr size_t WO_IN = 0, WO_OUT = 110 * MiB, WO_GU = 142 * MiB, WO_DN = 314 * MiB;
constexpr size_t WS_XN = 416 * MiB;
constexpr size_t WS_MIX = 544 * MiB;
constexpr size_t WS_Y = 672 * MiB;
constexpr size_t WS_H = 800 * MiB;
constexpr size_t WS_PROJ = 1056 * MiB;
constexpr size_t WS_SCB = WS_PROJ + 336 * MiB;
constexpr int HM_FQ = 0, HM_FK = 1, HM_FV = 2, HM_GQ = 3, HM_GZ = 6, SCBW = 3 * SCW;
__host__ __device__ constexpr size_t hm_off(int part, int bh) { return ((size_t)(part * (BATCH * FOXH) + bh) * SEQ) * HD; }
constexpr size_t WS_SB = 1496 * MiB;
constexpr size_t WS_SS = 1500 * MiB;
constexpr size_t WS_FG = 1504 * MiB;
constexpr size_t WS_TN = WS_FG + 1 * MiB;
constexpr size_t WS_END = 1506 * MiB;
constexpr int CW_TMO = 0, CW_BAR = 4096, CW_Q = 16384;

constexpr int NWAVES = 8;
constexpr int RING_BYTES = 131072, LDSCTL_OFF = RING_BYTES, MISC_OFF = LDSCTL_OFF + 320, LDS_BYTES = 147456;


extern __shared__ __attribute__((aligned(16))) unsigned char g_lds[];
constexpr int TIDTAB_OFF = LDSCTL_OFF + 512;
__device__ __forceinline__ unsigned hw_slot() { return (unsigned)__builtin_amdgcn_s_getreg((5 << 11) | 4) & 63u; }
__device__ __forceinline__ int my_lane() { int l; asm volatile("v_mbcnt_lo_u32_b32 %0, -1, 0\n\tv_mbcnt_hi_u32_b32 %0, -1, %0" : "=v"(l)); return l; }
__device__ __forceinline__ int my_wave() { return __builtin_amdgcn_readfirstlane(*(volatile __attribute__((address_space(3))) int*)((__attribute__((address_space(3))) unsigned char*)g_lds + TIDTAB_OFF + 4 * hw_slot())); }
__device__ __forceinline__ int my_tid() { return my_wave() * 64 + my_lane(); }

#define GAS __attribute__((address_space(1)))
#define LAS __attribute__((address_space(3)))
typedef unsigned short bf16;
typedef unsigned v4u __attribute__((ext_vector_type(4)));
typedef float f32x4 __attribute__((ext_vector_type(4)));
typedef short bf16x8 __attribute__((ext_vector_type(8)));
typedef GAS unsigned gu32;
typedef GAS unsigned long long gu64;
#define RLX_AGENT __ATOMIC_RELAXED, __HIP_MEMORY_SCOPE_AGENT
#define LDS_WAIT() asm volatile("s_waitcnt lgkmcnt(0)" ::: "memory")
#define VM_WAIT() asm volatile("s_waitcnt vmcnt(0)" ::: "memory")
__device__ __forceinline__ unsigned long long rt() { return __builtin_amdgcn_s_memrealtime(); }
__device__ __forceinline__ unsigned f2bf(float f) { unsigned u = __builtin_bit_cast(unsigned, f); return (u + 0x7fffu + ((u >> 16) & 1u)) >> 16; }
__device__ __forceinline__ unsigned pk2(float lo, float hi) { return f2bf(lo) | (f2bf(hi) << 16); }

#define XB_TMO      128
#define XB_XCNT(j)  (256  + 64 * (j))
#define XB_XSUB(j)  (1280 + 64 * (j))
#define XB_XGEN(j)  (2304 + 64 * (j))
#define XB_TOP      3328
#define XB_TOPGEN   3392
#define XCD_BAR_WORDS 3456
#define XB_SPIN_CAP (1u << 18)

__device__ __forceinline__ unsigned xb_ld(unsigned* p)              { return __hip_atomic_load(p, __ATOMIC_RELAXED, __HIP_MEMORY_SCOPE_AGENT); }
__device__ __forceinline__ unsigned xb_add(unsigned* p, unsigned v) { return __hip_atomic_fetch_add(p, v, __ATOMIC_RELAXED, __HIP_MEMORY_SCOPE_AGENT); }
__device__ __forceinline__ unsigned xb_xcc_id() { return (unsigned)__builtin_amdgcn_s_getreg((3 << 11) | 20) & 0xFu; }
#define XB_SPIN(cond, bar) do { unsigned _sp = 0; while (cond) { __builtin_amdgcn_s_sleep(1); \
    if ((++_sp & 255u) == 0u) { if (xb_ld(&(bar)[XB_TMO])) break; if (_sp > XB_SPIN_CAP) { atomicAdd(&(bar)[XB_TMO], 1u); break; } } } } while (0)

struct XcdBarrier {
    unsigned* bar; unsigned x;
    volatile LAS unsigned* st;
};

__device__ __forceinline__ XcdBarrier xcd_barrier_post(unsigned* bar, volatile LAS unsigned* st) {
    XcdBarrier b; b.bar = bar; b.x = xb_xcc_id(); b.st = st;
    if (my_tid() == 0) (void)xb_add(&bar[XB_XCNT(b.x)], 1u);
    return b;
}
__device__ __forceinline__ void xcd_barrier_complete(unsigned* bar, unsigned x, unsigned& nloc, unsigned& nx) {
    const unsigned G = gridDim.x * gridDim.y * gridDim.z;
    unsigned sum, cnt, mine, sp = 0u;
    for (;;) {
        sum = 0u; cnt = 0u; mine = 0u;
#pragma unroll
        for (unsigned j = 0; j < 16; ++j) { const unsigned c = xb_ld(&bar[XB_XCNT(j)]); sum += c; cnt += (c > 0u) ? 1u : 0u; mine = (j == x) ? c : mine; }
        if (sum == G) break;
        __builtin_amdgcn_s_sleep(1);
        if ((++sp & 255u) == 0u) { if (xb_ld(&bar[XB_TMO])) break; if (sp > XB_SPIN_CAP) { atomicAdd(&bar[XB_TMO], 1u); break; } }
    }
    nloc = mine > 0u ? mine : 1u; nx = cnt > 0u ? cnt : 1u;
}

__device__ __forceinline__ void xcd_barrier(const XcdBarrier& b) {
    asm volatile("s_waitcnt vmcnt(0)" ::: "memory");
    __syncthreads();
    if (my_tid() == 0) {
        unsigned* bar = b.bar;
        __builtin_amdgcn_s_waitcnt(0);
        unsigned nloc = b.st[0], nx = b.st[1];
        if (nloc == 0u) { xcd_barrier_complete(bar, b.x, nloc, nx); b.st[0] = nloc; b.st[1] = nx; }
        const unsigned old = xb_add(&bar[XB_XSUB(b.x)], 1u);
        const unsigned gen = old / nloc;
        if (old + 1u == (gen + 1u) * nloc) {
            __builtin_amdgcn_fence(__ATOMIC_RELEASE, "agent");
            asm volatile("s_waitcnt vmcnt(0)" ::: "memory");
            const unsigned og = xb_add(&bar[XB_TOP], 1u);
            const unsigned tg = og / nx;
            if (og + 1u == (tg + 1u) * nx) xb_add(&bar[XB_TOPGEN], 1u);
            else XB_SPIN(xb_ld(&bar[XB_TOPGEN]) == tg, bar);
            __builtin_amdgcn_fence(__ATOMIC_ACQUIRE, "agent");
            xb_add(&bar[XB_XGEN(b.x)], 1u);
            asm volatile("s_waitcnt vmcnt(0)" ::: "memory");
        } else {
            XB_SPIN(xb_ld(&bar[XB_XGEN(b.x)]) == gen, bar);
            __builtin_amdgcn_fence(__ATOMIC_ACQUIRE, "agent");
            asm volatile("s_waitcnt vmcnt(0)" ::: "memory");
        }
    }
    __syncthreads();
}

namespace pg8 {
#define PG8_LAS __attribute__((address_space(3)))
typedef unsigned short bf16_t;
typedef short bf16x8 __attribute__((ext_vector_type(8)));
typedef float f32x4 __attribute__((ext_vector_type(4)));
typedef unsigned u32x4 __attribute__((ext_vector_type(4)));
constexpr int BM = 256, BK = 64, HALF = 128, HTB = HALF * BK * 2  , STAGE_BYTES = 8 * HTB, NXCD = 8, WGM = 8;

__host__ __device__ __forceinline__ int lds_byte(int r, int c) { const int st = (r >> 4) * 2 + (c >> 5), rr = r & 15, cc = c & 31, ob = rr * 64 + cc * 2; return st * 1024 + (ob ^ (((ob >> 9) & 1) << 5)); }
__host__ __device__ __forceinline__ void stage_rc(int b, int& R, int& C) { const int st = b / 1024, sb = b % 1024, swz = sb ^ (((sb >> 9) & 1) << 5); R = (st >> 1) * 16 + swz / 64; C = (st & 1) * 32 + (swz % 64) / 2; }
__host__ __device__ __forceinline__ int perm32(int rho) { const int n = rho >> 4, i = rho & 15; return 8 * (i >> 2) + 4 * n + (i & 3); }

struct Unit { int pm, pn; };
struct Gemm { const bf16_t* A; const bf16_t* Bt; int M, N, K; };

struct StaticOrder {
    int nM, nN, nwg, G, c;
    __host__ __device__ void init(int M, int N, int G_, int c_) { nM = M / BM; nN = N / BM; nwg = nM * nN; G = G_; c = c_; }
    __host__ __device__ bool next(int i, Unit& u) const {
        const long L = (long)i * G + c; if (L >= nwg) return false;
        int wgid = (int)L; { const int q = nwg / NXCD, r = nwg % NXCD, xcd = wgid % NXCD, off = wgid / NXCD; wgid = (xcd < r ? xcd * (q + 1) : r * (q + 1) + (xcd - r) * q) + off; }
        const int nig = WGM * nN, gid = wgid / nig, fm = gid * WGM, gsz = (nM - fm) < WGM ? (nM - fm) : WGM;
        u.pm = fm + ((wgid % nig) % gsz); u.pn = (wgid % nig) / gsz; return true;
    }
    __device__ __forceinline__ void a_ready(const Unit&) const {}
    __device__ __forceinline__ void done(const Unit&) const {}
};


typedef float f32x2e __attribute__((ext_vector_type(2))); typedef __bf16 bf16x2e __attribute__((ext_vector_type(2)));
__device__ __forceinline__ unsigned cvt_pk_bf16(float lo, float hi) { const f32x2e v = {lo, hi}; const bf16x2e b = __builtin_convertvector(v, bf16x2e); return __builtin_bit_cast(unsigned, b); }
__device__ __forceinline__ u32x4 pack8_bf16(const f32x4 v0, const f32x4 v1) { u32x4 w; w.x = cvt_pk_bf16(v0[0], v0[1]); w.y = cvt_pk_bf16(v0[2], v0[3]); w.z = cvt_pk_bf16(v1[0], v1[1]); w.w = cvt_pk_bf16(v1[2], v1[3]); return w; }

struct EpiProj {
    static constexpr bool PERM = true, AFTER_DRAIN = false;
    bf16_t* HM; bf16_t* SCB; float* SBp;
    __device__ __forceinline__ void operator()(const f32x4 (&acc)[2][2][4][2], const Unit& u, int wr, int wc, int fr, int fq) const {
        const int row0 = u.pm * BM + wr * 64 + fr;
        if (u.pn * BM == PC_SMALL) {
            if (wc < 2) {
#pragma unroll
                for (int ai = 0; ai < 2; ++ai)
#pragma unroll
                    for (int m = 0; m < 4; ++m) { float* rp = SBp + (size_t)(row0 + ai * HALF + m * 16) * SBW + wc * 32 + 8 * fq;
                        *(f32x4*)rp = acc[ai][0][m][0]; *(f32x4*)(rp + 4) = acc[ai][0][m][1]; }
            }
            return;
        }
        const int b = (u.pm * BM) / SEQ, s0 = row0 - b * SEQ;
#pragma unroll
        for (int bj = 0; bj < 2; ++bj) { const int colbase = u.pn * BM + bj * HALF;
            bf16_t* dst; size_t pitch;
            if (colbase >= PC_SB && colbase < PC_GQ) { dst = SCB + (size_t)row0 * SCBW + (colbase - PC_SB) + wc * 32 + 8 * fq; pitch = SCBW; }
            else { const int hc = colbase < PC_SB ? colbase : colbase - (PC_GQ - PC_SB), part = hc / 1536, head = (hc % 1536) / HD;
                   dst = HM + hm_off(part, b * FOXH + head) + (size_t)s0 * HD + wc * 32 + 8 * fq; pitch = HD; }
#pragma unroll
            for (int ai = 0; ai < 2; ++ai)
#pragma unroll
                for (int m = 0; m < 4; ++m) *(u32x4*)(dst + (size_t)(ai * HALF + m * 16) * pitch) = pack8_bf16(acc[ai][bj][m][0], acc[ai][bj][m][1]); }
    }
};
struct EpiY {
    static constexpr bool PERM = true, AFTER_DRAIN = false;
    bf16_t* Y; float* SS;
    __device__ __forceinline__ void operator()(const f32x4 (&acc)[2][2][4][2], const Unit& u, int wr, int wc, int fr, int fq) const {
        const int row0 = u.pm * BM + wr * 64 + fr, col0 = u.pn * BM + wc * 32 + 8 * fq;
#pragma unroll
        for (int ai = 0; ai < 2; ++ai)
#pragma unroll
            for (int m = 0; m < 4; ++m) { const int row = row0 + ai * HALF + m * 16; bf16_t* rowp = Y + (size_t)row * DM + col0; float s = 0.f;
#pragma unroll
                for (int bj = 0; bj < 2; ++bj) { const f32x4 a = acc[ai][bj][m][0], b = acc[ai][bj][m][1];
                    s += (a[0] * a[0] + a[1] * a[1]) + (a[2] * a[2] + a[3] * a[3]) + (b[0] * b[0] + b[1] * b[1]) + (b[2] * b[2] + b[3] * b[3]);
                    *(u32x4*)(rowp + bj * HALF) = pack8_bf16(a, b); }
                s += __shfl_xor(s, 16); s += __shfl_xor(s, 32);
                if (fq == 0) SS[(size_t)row * 64 + u.pn * 4 + wc] = s; }
    }
};
__device__ __forceinline__ float silu_f(float x) { return x * __builtin_amdgcn_rcpf(1.0f + __builtin_amdgcn_exp2f(-1.4426950408889634f * x)); }
struct EpiSwiGLU {
    static constexpr bool PERM = true, AFTER_DRAIN = false;
    bf16_t* Hd;
    __device__ __forceinline__ void operator()(const f32x4 (&acc)[2][2][4][2], const Unit& u, int wr, int wc, int fr, int fq) const {
        const int row0 = u.pm * BM + wr * 64 + fr, col0 = u.pn * HALF + wc * 32 + 8 * fq;
#pragma unroll
        for (int ai = 0; ai < 2; ++ai)
#pragma unroll
            for (int m = 0; m < 4; ++m) { const f32x4 g0 = acc[ai][0][m][0], g1 = acc[ai][0][m][1], u0 = acc[ai][1][m][0], u1 = acc[ai][1][m][1]; f32x4 h0, h1;
#pragma unroll
                for (int e = 0; e < 4; ++e) { h0[e] = silu_f(g0[e]) * u0[e]; h1[e] = silu_f(g1[e]) * u1[e]; }
                *(u32x4*)(Hd + (size_t)(row0 + ai * HALF + m * 16) * FFN + col0) = pack8_bf16(h0, h1); }
    }
};
template <class Epi, class Sched, bool ALIGN_EPI = false, bool SP2 = false>
__device__ __forceinline__ void gemm_phase(PG8_LAS unsigned char* lds, const Gemm g, const Sched& S, const Epi& E) {
    int tid_ = my_tid(); asm volatile("" : "+v"(tid_));
    const int tid = tid_, wid = __builtin_amdgcn_readfirstlane(tid >> 6), lane = tid & 63, wr = wid >> 2, wc = wid & 3, fr = lane & 15, fq = lane >> 4;
    const int K = g.K, nt = K / BK;
    unsigned voffA[2], voffB[2];
#pragma unroll
    for (int i = 0; i < 2; ++i) { int R, C; stage_rc(tid * 16 + i * 8192, R, C); const int Rb = Epi::PERM ? ((R & ~31) + perm32(R & 31)) : R;
        voffA[i] = (unsigned)(R * K + C) * 2u; voffB[i] = (unsigned)(Rb * K + C) * 2u; }
    const size_t kstep = (size_t)(BK * 2);
    const size_t hstep = (size_t)HALF * K * 2;
    const size_t tstep = 2 * hstep;
    const unsigned ldsw = (unsigned)wid * 1024u;
    const int aoff = lds_byte(wr * 64 + fr, fq * 8), boff = lds_byte(wc * 32 + fr, fq * 8);
#define PG8_SA(b, h) (((b) * 2 + (h)) * HTB)
#define PG8_SB(b, h) ((4 + (b) * 2 + (h)) * HTB)
#define PG8_STAGE(bufoff, gbase, voff) do { _Pragma("unroll") for (int _i = 0; _i < 2; ++_i) \
        __builtin_amdgcn_global_load_lds((const unsigned*)((const char*)(gbase) + (voff)[_i]), (PG8_LAS unsigned*)(lds + (bufoff) + ldsw + _i * 8192), 16, 0, 0); } while (0)
#define PG8_LDA(dst, b, h) do { _Pragma("unroll") for (int m = 0; m < 4; ++m) _Pragma("unroll") for (int k = 0; k < 2; ++k) dst[m][k] = *(const PG8_LAS bf16x8*)(lds + PG8_SA(b, h) + aoff + m * 2048 + k * 1024); } while (0)
#define PG8_LDB(dst, b, h) do { _Pragma("unroll") for (int n = 0; n < 2; ++n) _Pragma("unroll") for (int k = 0; k < 2; ++k) dst[n][k] = *(const PG8_LAS bf16x8*)(lds + PG8_SB(b, h) + boff + n * 2048 + k * 1024); } while (0)
#define PG8_MMA(ai, bj, At, Bt) do { __builtin_amdgcn_s_setprio(1); _Pragma("unroll") for (int m = 0; m < 4; ++m) _Pragma("unroll") for (int n = 0; n < 2; ++n) _Pragma("unroll") for (int k = 0; k < 2; ++k) \
        acc[ai][bj][m][n] = __builtin_amdgcn_mfma_f32_16x16x32_bf16(Bt[n][k], At[m][k], acc[ai][bj][m][n], 0, 0, 0); __builtin_amdgcn_s_setprio(0); } while (0)
#define PG8_WAIT_V(n) asm volatile("s_waitcnt vmcnt(" #n ")" ::: "memory")
#define PG8_WAIT_L(n) asm volatile("s_waitcnt lgkmcnt(" #n ")" ::: "memory")
#define PG8_BAR __builtin_amdgcn_s_barrier()
#define PG8_SCHED __builtin_amdgcn_sched_barrier(0)
    Unit cur, nxt; int ui = 0;
    if (!S.next(0, cur)) return;
    f32x4 acc[2][2][4][2];
#pragma unroll
    for (int a = 0; a < 2; ++a)
#pragma unroll
        for (int b = 0; b < 2; ++b)
#pragma unroll
            for (int m = 0; m < 4; ++m)
#pragma unroll
                for (int n = 0; n < 2; ++n) acc[a][b][m][n] = (f32x4){0.f, 0.f, 0.f, 0.f};
    bf16x8 At[4][2], B0[2][2], B1[2][2];
    const char* cA = (const char*)g.A + (size_t)cur.pm * tstep; const char* cB = (const char*)g.Bt + (size_t)cur.pn * tstep;
    S.a_ready(cur);
    if constexpr (SP2) {
        PG8_STAGE(PG8_SB(0, 0), cB, voffB); PG8_STAGE(PG8_SB(0, 1), cB + hstep, voffB); PG8_STAGE(PG8_SA(0, 0), cA, voffA); PG8_STAGE(PG8_SA(0, 1), cA + hstep, voffA);
        if (wr == 1) PG8_BAR;
        PG8_WAIT_V(2); PG8_BAR;
        PG8_STAGE(PG8_SB(1, 0), cB + kstep, voffB); PG8_STAGE(PG8_SA(1, 0), cA + kstep, voffA); PG8_STAGE(PG8_SB(1, 1), cB + hstep + kstep, voffB);
        PG8_WAIT_V(6); PG8_BAR;
    } else {
        PG8_STAGE(PG8_SB(0, 0), cB, voffB); PG8_STAGE(PG8_SA(0, 0), cA, voffA); PG8_STAGE(PG8_SB(0, 1), cB + hstep, voffB); PG8_STAGE(PG8_SA(0, 1), cA + hstep, voffA);
        if (wr == 1) PG8_BAR;
        PG8_WAIT_V(4); PG8_BAR;
        PG8_STAGE(PG8_SB(1, 0), cB + kstep, voffB); PG8_STAGE(PG8_SA(1, 0), cA + kstep, voffA); PG8_STAGE(PG8_SB(1, 1), cB + hstep + kstep, voffB);
        PG8_WAIT_V(6); PG8_BAR;
    }
    for (;;) {
        const bool has_next = S.next(ui + 1, nxt);
        const char* nA = has_next ? (const char*)g.A + (size_t)nxt.pm * tstep : cA; const char* nB = has_next ? (const char*)g.Bt + (size_t)nxt.pn * tstep : cB;
        for (int t = 0; t < nt; t += 2) {
            const bool last = (t == nt - 2);
            const char* a1 = cA + (size_t)(t + 1) * kstep;
            const char* a2 = last ? nA : cA + (size_t)(t + 2) * kstep; const char* b2 = last ? nB : cB + (size_t)(t + 2) * kstep;
            const char* a3 = a2 + kstep; const char* b3 = b2 + kstep;
            if (last && has_next) S.a_ready(nxt);
            if constexpr (SP2) {
            PG8_LDB(B0, 0, 0); PG8_LDB(B1, 0, 1); PG8_SCHED; PG8_LDA(At, 0, 0); PG8_STAGE(PG8_SA(1, 1), a1 + hstep, voffA);
            PG8_WAIT_V(8); PG8_WAIT_L(0); PG8_BAR; PG8_MMA(0, 0, At, B0); PG8_MMA(0, 1, At, B1); PG8_BAR; PG8_SCHED;
            PG8_LDA(At, 0, 1); PG8_STAGE(PG8_SB(0, 0), b2, voffB); PG8_STAGE(PG8_SB(0, 1), b2 + hstep, voffB); PG8_STAGE(PG8_SA(0, 0), a2, voffA);
            PG8_WAIT_V(8); PG8_WAIT_L(0); PG8_BAR; PG8_MMA(1, 0, At, B0); PG8_MMA(1, 1, At, B1); PG8_BAR; PG8_SCHED;
            PG8_LDB(B0, 1, 0); PG8_LDB(B1, 1, 1); PG8_SCHED; PG8_LDA(At, 1, 0); PG8_STAGE(PG8_SA(0, 1), a2 + hstep, voffA);
            PG8_WAIT_V(8); PG8_WAIT_L(0); PG8_BAR; PG8_MMA(0, 0, At, B0); PG8_MMA(0, 1, At, B1); PG8_BAR; PG8_SCHED;
            PG8_LDA(At, 1, 1); PG8_STAGE(PG8_SB(1, 0), b3, voffB); PG8_STAGE(PG8_SB(1, 1), b3 + hstep, voffB); PG8_STAGE(PG8_SA(1, 0), a3, voffA);
            PG8_WAIT_V(8); PG8_WAIT_L(0); PG8_BAR; PG8_MMA(1, 0, At, B0); PG8_MMA(1, 1, At, B1); PG8_BAR; PG8_SCHED;
            } else {
            PG8_LDB(B0, 0, 0); PG8_SCHED; PG8_LDA(At, 0, 0); PG8_STAGE(PG8_SA(1, 1), a1 + hstep, voffA);
            PG8_WAIT_L(8); PG8_BAR; PG8_WAIT_L(0); PG8_MMA(0, 0, At, B0); PG8_BAR; PG8_SCHED;
            PG8_LDB(B1, 0, 1); PG8_STAGE(PG8_SB(0, 0), b2, voffB);
            PG8_BAR; PG8_WAIT_L(0); PG8_MMA(0, 1, At, B1); PG8_BAR;
            PG8_LDA(At, 0, 1); PG8_STAGE(PG8_SA(0, 0), a2, voffA);
            PG8_BAR; PG8_WAIT_L(0); PG8_MMA(1, 0, At, B0); PG8_BAR; PG8_SCHED;
            PG8_STAGE(PG8_SB(0, 1), b2 + hstep, voffB);
            PG8_WAIT_V(6); PG8_BAR; PG8_MMA(1, 1, At, B1); PG8_BAR;
            PG8_LDB(B0, 1, 0); PG8_SCHED; PG8_LDA(At, 1, 0); PG8_STAGE(PG8_SA(0, 1), a2 + hstep, voffA);
            PG8_WAIT_L(8); PG8_BAR; PG8_WAIT_L(0); PG8_MMA(0, 0, At, B0); PG8_BAR; PG8_SCHED;
            PG8_LDB(B1, 1, 1); PG8_STAGE(PG8_SB(1, 0), b3, voffB);
            PG8_BAR; PG8_WAIT_L(0); PG8_MMA(0, 1, At, B1); PG8_BAR;
            PG8_LDA(At, 1, 1); PG8_STAGE(PG8_SA(1, 0), a3, voffA);
            PG8_BAR; PG8_WAIT_L(0); PG8_MMA(1, 0, At, B0); PG8_BAR; PG8_SCHED;
            PG8_STAGE(PG8_SB(1, 1), b3 + hstep, voffB);
            PG8_WAIT_V(6); PG8_BAR; PG8_MMA(1, 1, At, B1); PG8_BAR;
            }
        }
        if constexpr (ALIGN_EPI) { if (wr == 0) PG8_BAR; }
        if constexpr (!Epi::AFTER_DRAIN) { E(acc, cur, wr, wc, fr, fq); S.done(cur); }
        if (!has_next) break;
#pragma unroll
        for (int a = 0; a < 2; ++a)
#pragma unroll
            for (int b = 0; b < 2; ++b)
#pragma unroll
                for (int m = 0; m < 4; ++m)
#pragma unroll
                    for (int n = 0; n < 2; ++n) acc[a][b][m][n] = (f32x4){0.f, 0.f, 0.f, 0.f};
        cur = nxt; cA = nA; cB = nB; ++ui;
        if constexpr (ALIGN_EPI) { if (wr == 1) PG8_BAR; }
    }
    PG8_WAIT_V(0);
    if constexpr (!ALIGN_EPI) { if (wr == 0) PG8_BAR; }
    PG8_BAR;
    if constexpr (Epi::AFTER_DRAIN) { E.fused(acc, cur, wr, wc, fr, fq, lds, wid, lane); S.done(cur); }
#undef PG8_SA
#undef PG8_SB
#undef PG8_STAGE
#undef PG8_LDA
#undef PG8_LDB
#undef PG8_MMA
#undef PG8_WAIT_V
#undef PG8_WAIT_L
#undef PG8_BAR
#undef PG8_SCHED
}
}

namespace attn {
constexpr int KVP = HD, OP = DM;
constexpr float SCALE = 0.08838834764831845f;
constexpr int D = 128;
constexpr int NW = 8, QBLK = 32, KVBLK = 64, QB = NW * QBLK;
constexpr int SHM_V = KVBLK * D * 2, SHM_K = KVBLK * D * 2;
constexpr int FB_OFF = 2 * SHM_V + 2 * SHM_K + NW * 64 * 4;
constexpr int LDS_BYTES = FB_OFF + 2 * 64 * 4;
constexpr bool WSKIP = false;
constexpr float THR = 16.f;

using bf16 = __hip_bfloat16;
typedef short bf16x8 __attribute__((ext_vector_type(8)));
typedef short s16x4 __attribute__((ext_vector_type(4)));
typedef float f32x16 __attribute__((ext_vector_type(16)));
typedef float f32x4 __attribute__((ext_vector_type(4)));
typedef unsigned u32x4 __attribute__((ext_vector_type(4)));
template <class A, class Bt> struct same_t { static constexpr bool v = false; };
template <class A> struct same_t<A, A> { static constexpr bool v = true; };

#define KSWZ(row, colB) ((row) * 256 + ((colB) ^ (((row) & 7) << 4)))
#define SBAR() __builtin_amdgcn_sched_barrier(0)
__device__ __forceinline__ int v_st(int k, int c) { const int kk = (k & ~0xC) | ((k & 4) << 1) | ((k & 8) >> 1); return ((kk >> 3) * 4 + (c >> 5)) * 512 + ((kk & 7) * 32 + (c & 31)) * 2; }
__device__ __forceinline__ int v_rd_base(int lane) { return ((lane & 3) << 3) | (((lane >> 2) & 3) << 6) | (((lane >> 4) & 1) << 5) | (((lane >> 5) & 1) << 8); }
constexpr int v_rd_off(int d0, int ks, int half) { return d0 * 512 + ks * 4096 + half * 2048; }
__device__ __forceinline__ int crow(int r, int hi) { return (r & 3) + 8 * (r >> 2) + 4 * hi; }
__device__ __forceinline__ unsigned cvtpk(float lo, float hi) {
    unsigned r; asm volatile("v_cvt_pk_bf16_f32 %0, %1, %2" : "=v"(r) : "v"(lo), "v"(hi)); return r;
}
__device__ __forceinline__ bf16x8 pack8(f32x4 a, f32x4 b) {
    u32x4 w = {cvtpk(a[0], a[1]), cvtpk(a[2], a[3]), cvtpk(b[0], b[1]), cvtpk(b[2], b[3])};
    return *reinterpret_cast<bf16x8*>(&w);
}
template <class T> __device__ __forceinline__ bf16x8 load8(const T* p) {
    if constexpr (same_t<T, float>::v) { return pack8(*(const f32x4*)p, *(const f32x4*)(p + 4)); }
    else { return *reinterpret_cast<const bf16x8*>(p); }
}
__device__ __forceinline__ void mask_tile(f32x16& p0, f32x16& p1, int dq, unsigned W) {
    const float NEG = -__builtin_inff();
#pragma unroll
    for (int r = 0; r < 16; ++r) {
        const int c = (r & 3) + 8 * (r >> 2);
        if ((unsigned)(dq - c) >= W) p0[r] = NEG;
        if ((unsigned)(dq - c - 32) >= W) p1[r] = NEG;
    }
}
__device__ __forceinline__ void partialSM(f32x16& p0, f32x16& p1, float& m_reg, float& mn, float& alpha) {
    float pmax = p0[0]; for (int r = 1; r < 16; ++r) pmax = fmaxf(pmax, p0[r]); for (int r = 0; r < 16; ++r) pmax = fmaxf(pmax, p1[r]);
    { auto rr = __builtin_amdgcn_permlane32_swap(__float_as_uint(pmax), __float_as_uint(pmax), false, false);
      pmax = fmaxf(__uint_as_float(rr[0]), __uint_as_float(rr[1])); }
    constexpr float C2 = 1.4426950408889634f * SCALE;
    if (__builtin_expect(__all((pmax - m_reg) * SCALE <= THR), 1)) { mn = m_reg; alpha = 1.f; }
    else { mn = fmaxf(m_reg, pmax); alpha = __builtin_amdgcn_exp2f((m_reg - mn) * C2); m_reg = mn; }
    const float mnL = -mn * C2;
    for (int r = 0; r < 16; ++r) p0[r] = fmaf(p0[r], C2, mnL); for (int r = 0; r < 16; ++r) p1[r] = fmaf(p1[r], C2, mnL);
    for (int r = 0; r < 16; ++r) p0[r] = __builtin_amdgcn_exp2f(p0[r]);
}
__device__ __forceinline__ void finishSM(f32x16& p0, f32x16& p1, float alpha, float& l_reg, bf16x8& pa0, bf16x8& pa1, bf16x8& pa2, bf16x8& pa3) {
    for (int r = 0; r < 16; ++r) p1[r] = __builtin_amdgcn_exp2f(p1[r]);
    float ps = 0; for (int r = 0; r < 16; ++r) ps += p0[r]; for (int r = 0; r < 16; ++r) ps += p1[r];
    { auto rr = __builtin_amdgcn_permlane32_swap(__float_as_uint(ps), __float_as_uint(ps), false, false);
      ps = __uint_as_float(rr[0]) + __uint_as_float(rr[1]); }
    l_reg = l_reg * alpha + ps;
#define PK4(P, B_, OUT) do { unsigned a0 = cvtpk(P[B_+0], P[B_+1]), a1 = cvtpk(P[B_+2], P[B_+3]);                          \
        unsigned b0 = cvtpk(P[B_+4], P[B_+5]), b1 = cvtpk(P[B_+6], P[B_+7]);                                             \
        auto r0 = __builtin_amdgcn_permlane32_swap(a0, b0, false, false); auto r1 = __builtin_amdgcn_permlane32_swap(a1, b1, false, false); \
        u32x4 w = {r0[0], r1[0], r0[1], r1[1]}; OUT = *reinterpret_cast<bf16x8*>(&w); } while (0)
    PK4(p0, 0, pa0); PK4(p0, 8, pa1); PK4(p1, 0, pa2); PK4(p1, 8, pa3);
#undef PK4
}
template <int KB, bool SK>
__device__ __forceinline__ void qkt(f32x16& p0, f32x16& p1, const char* K_lds, int r32, int hi, const bf16x8* qr, bool act) {
    if (SK && !act) { const float NEG = -__builtin_inff();
#pragma unroll
        for (int r = 0; r < 16; ++r) { p0[r] = NEG; p1[r] = NEG; } return; }
    { const char* fb = K_lds + 2 * SHM_K + NW * 64 * 4 + KB * 256 + hi * 16;
#pragma unroll
      for (int g = 0; g < 4; ++g) { const f32x4 a = *reinterpret_cast<const f32x4*>(fb + g * 32), b = *reinterpret_cast<const f32x4*>(fb + 128 + g * 32);
          p0[4 * g] = a[0]; p0[4 * g + 1] = a[1]; p0[4 * g + 2] = a[2]; p0[4 * g + 3] = a[3]; p1[4 * g] = b[0]; p1[4 * g + 1] = b[1]; p1[4 * g + 2] = b[2]; p1[4 * g + 3] = b[3]; } }
    const char* kb[4];
#pragma unroll
    for (int dd = 0; dd < 4; ++dd) kb[dd] = K_lds + KB * SHM_K + KSWZ(r32, (dd * 16 + hi * 8) * 2);
#pragma unroll
    for (int d0 = 0; d0 < 8; ++d0) { const char* a = kb[d0 & 3] + (d0 >> 2) * 128;
        bf16x8 b0 = *reinterpret_cast<const bf16x8*>(a);
        bf16x8 b1 = *reinterpret_cast<const bf16x8*>(a + 32 * 256);
        p0 = __builtin_amdgcn_mfma_f32_32x32x16_bf16(b0, qr[d0], p0, 0, 0, 0);
        p1 = __builtin_amdgcn_mfma_f32_32x32x16_bf16(b1, qr[d0], p1, 0, 0, 0); }
}
template <int VB, bool SK>
__device__ __forceinline__ void pv_tile(f32x16* o, int vb0, bf16x8 pa0, bf16x8 pa1, bf16x8 pa2, bf16x8 pa3, bool act) {
    if (SK && !act) return;
#define TRRD(dst, off) asm volatile("ds_read_b64_tr_b16 %0, %1 offset:%2" : "=&v"(dst) : "v"(vb0), "i"(off) : "memory")
#define PV_D0(d0) do { s16x4 l0, l1, l2, l3, h0, h1, h2, h3; constexpr int b_ = VB * SHM_V + v_rd_off(d0, 0, 0);     \
        TRRD(l0, b_); TRRD(h0, b_ + 2048); TRRD(l1, b_ + 4096); TRRD(h1, b_ + 6144); TRRD(l2, b_ + 8192); TRRD(h2, b_ + 10240); TRRD(l3, b_ + 12288); TRRD(h3, b_ + 14336); \
        asm volatile("s_waitcnt lgkmcnt(0)" ::: "memory"); SBAR();                 \
        o[d0] = __builtin_amdgcn_mfma_f32_32x32x16_bf16(pa0, (bf16x8){l0[0], l0[1], l0[2], l0[3], h0[0], h0[1], h0[2], h0[3]}, o[d0], 0, 0, 0);   \
        o[d0] = __builtin_amdgcn_mfma_f32_32x32x16_bf16(pa1, (bf16x8){l1[0], l1[1], l1[2], l1[3], h1[0], h1[1], h1[2], h1[3]}, o[d0], 0, 0, 0);   \
        o[d0] = __builtin_amdgcn_mfma_f32_32x32x16_bf16(pa2, (bf16x8){l2[0], l2[1], l2[2], l2[3], h2[0], h2[1], h2[2], h2[3]}, o[d0], 0, 0, 0);   \
        o[d0] = __builtin_amdgcn_mfma_f32_32x32x16_bf16(pa3, (bf16x8){l3[0], l3[1], l3[2], l3[3], h3[0], h3[1], h3[2], h3[3]}, o[d0], 0, 0, 0); } while (0)
    PV_D0(0); PV_D0(1); PV_D0(2); PV_D0(3);
#undef PV_D0
#undef TRRD
}

template <class TIn, class TOut> struct BlockRef { const TIn* Q; const TIn* K; const TIn* V; const float* F; TOut* O; int P0; int JLO; };
template <class TIn> struct Seam {
    bf16x8 qr[8];
    bf16x8 st_v0, st_v1, st_k0, st_k1; float st_f; f32x4 sf0, sf1, sf2, sf3;
    f32x4 tq[16];
};
__device__ __forceinline__ int swa_jlo(int P0, int W) { const int lowk = P0 - W + 1; return lowk > 0 ? lowk / KVBLK : 0; }
#define ROW(p, k0, rr) ((p) + (size_t)((k0) + (rr)) * KVP + sc)
#define VMW() asm volatile("s_waitcnt vmcnt(0)" ::: "memory")
#define VMWN(n) asm volatile("s_waitcnt vmcnt(%0)" :: "i"(n) : "memory")
#define SLOAD_H(Kp, Vp, Fp, k0) do { S.st_v0 = load8<TIn>(ROW(Vp, k0, sr)); S.st_v1 = load8<TIn>(ROW(Vp, k0, 32 + sr));              \
                         S.st_k0 = load8<TIn>(ROW(Kp, k0, sr)); S.st_k1 = load8<TIn>(ROW(Kp, k0, 32 + sr)); if (tid < 64) S.st_f = (Fp)[(k0) + tid]; } while (0)
#define SWRITE_HK(bf) do { *(bf16x8*)(K_lds + (bf) * SHM_K + kws) = S.st_k0; *(bf16x8*)(K_lds + (bf) * SHM_K + kws + 32 * 256) = S.st_k1; if (tid < 64) *(float*)(K_lds + 2 * SHM_K + NW * 64 * 4 + (bf) * 256 + tid * 4) = S.st_f; } while (0)
#define SWRITE_HV(bf) do { *(bf16x8*)(V_lds + (bf) * SHM_V + vst0) = S.st_v0; *(bf16x8*)(V_lds + (bf) * SHM_V + vst1) = S.st_v1; } while (0)
#define SWRITE_H(bf) do { SWRITE_HV(bf); SWRITE_HK(bf); } while (0)
#define SLOAD_F(p, k0) do { S.sf0 = *(const f32x4*)ROW(p, k0, sr); S.sf1 = *(const f32x4*)(ROW(p, k0, sr) + 4);                \
                            S.sf2 = *(const f32x4*)ROW(p, k0, 32 + sr); S.sf3 = *(const f32x4*)(ROW(p, k0, 32 + sr) + 4); } while (0)
#define SWRITE_KF(bf) do { *(bf16x8*)(K_lds + (bf) * SHM_K + kws) = pack8(S.sf0, S.sf1); *(bf16x8*)(K_lds + (bf) * SHM_K + kws + 32 * 256) = pack8(S.sf2, S.sf3); } while (0)
#define SWRITE_VF(bf) do { *(bf16x8*)(V_lds + (bf) * SHM_V + vst0) = pack8(S.sf0, S.sf1); *(bf16x8*)(V_lds + (bf) * SHM_V + vst1) = pack8(S.sf2, S.sf3); } while (0)
template <class TIn, class TOut>
__device__ __forceinline__ void causal_swa_prime(const BlockRef<TIn, TOut>& cur, int W, char* lds, Seam<TIn>& S) {
    constexpr bool F32 = same_t<TIn, float>::v;
    int tid_ = my_tid(); asm volatile("" : "+v"(tid_));
    const int tid = tid_, wid = __builtin_amdgcn_readfirstlane(tid >> 6), lane = tid & 63, r32 = lane & 31, hi = lane >> 5;
    const int sr = tid >> 4, sc = (tid & 15) * 8, kws = KSWZ(sr, sc * 2); char* K_lds = lds + 2 * SHM_V;
    const int kb0 = cur.JLO * KVBLK;
    for (int d0 = 0; d0 < 8; ++d0) S.qr[d0] = load8<TIn>(cur.Q + (size_t)(wid * QBLK + r32) * KVP + d0 * 16 + hi * 8);
    if constexpr (F32) { SLOAD_F((const float*)cur.K, kb0); VMW(); SWRITE_KF(0); SBAR(); SLOAD_F((const float*)cur.V, kb0); }
    else { SLOAD_H(cur.K, cur.V, cur.F, kb0); VMW(); SWRITE_HK(0); }
    __syncthreads();
}
template <class TIn, class TOut>
__device__ __forceinline__ void causal_swa_block(const BlockRef<TIn, TOut>& cur, const BlockRef<TIn, TOut>& nxt, int skv, int W, char* lds, Seam<TIn>& S, const float* const __attribute__((address_space(4)))* gslot, int goff) {
    constexpr bool F32 = same_t<TIn, float>::v;
    int tid_ = my_tid(); asm volatile("" : "+v"(tid_));
    const int tid = tid_, wid = __builtin_amdgcn_readfirstlane(tid >> 6), lane = tid & 63, r32 = lane & 31, hi = lane >> 5;
    const int j_lo = cur.JLO;
    int j_hi = (cur.P0 + QB - 1) / KVBLK + 1; if (j_hi > skv / KVBLK) j_hi = skv / KVBLK;
    const int NT = j_hi - j_lo;
    const int kbn = nxt.JLO * KVBLK;
    const int qlo = cur.P0 + wid * QBLK, qm = qlo + r32 - 4 * hi;
    char* V_lds = lds; char* K_lds = lds + 2 * SHM_V;
    float* ws = (float*)(lds + 2 * SHM_V + 2 * SHM_K) + wid * 64; float* li_l = ws, * al_l = ws + 32;
    float m_reg = -1e30f, l_reg = 0; f32x16 o[4] = {};
    const int sr = tid >> 4, sc = (tid & 15) * 8, vst0 = v_st(sr, sc), vst1 = v_st(32 + sr, sc), kws = KSWZ(sr, sc * 2);
    const int vb0 = (int)(uintptr_t)V_lds + v_rd_base(lane);
    const TIn* Kh = cur.K; const TIn* Vh = cur.V; const float* Fh = cur.F;
#define RESC(a) do { if (__any((a) < 1.f)) { if (hi == 0) al_l[r32] = (a); asm volatile("s_waitcnt lgkmcnt(0)" ::: "memory");              \
                     for (int d_ = 0; d_ < 4; ++d_) for (int r = 0; r < 16; ++r) o[d_][r] *= al_l[crow(r, hi)]; } } while (0)
#define KBASE(t) ((j_lo + (t)) * KVBLK)
#define ACT(t) (KBASE(t) <= qlo + QBLK - 1 && KBASE(t) + KVBLK - 1 >= qlo - W + 1)
#define MASKT(P0_, P1_, t) do { const int kb_ = KBASE(t); if ((!SK || ACT(t)) && (kb_ + KVBLK - 1 > qlo || kb_ <= qlo + QBLK - 1 - W)) mask_tile(P0_, P1_, qm - kb_, (unsigned)W); } while (0)
    constexpr int NQL = F32 ? 16 : 8;
    constexpr bool SK = WSKIP && !F32;
#define SEAM_K0() do { VMWN(NQL); if constexpr (F32) { SWRITE_KF(0); SBAR(); SLOAD_F((const float*)nxt.V, kbn); } else { SWRITE_HK(0); } SBAR(); } while (0)
    f32x16 pA0, pA1, pB0, pB1; float mnA, mnB, alA, alB; bf16x8 pa0, pa1, pa2, pa3;
    if constexpr (F32) { VMW(); SWRITE_VF(0); SBAR(); } else { SWRITE_HV(0); SBAR(); }
    if (NT > 1) { if constexpr (F32) SLOAD_F((const float*)Kh, KBASE(1)); else SLOAD_H(Kh, Vh, Fh, KBASE(1)); }
    SBAR(); qkt<0, SK>(pA0, pA1, K_lds, r32, hi, S.qr, ACT(0));
    if constexpr (F32) { if (NT > 1) { VMW(); SWRITE_KF(1); SBAR(); SLOAD_F((const float*)Vh, KBASE(1)); } }
    MASKT(pA0, pA1, 0); partialSM(pA0, pA1, m_reg, mnA, alA);
    if (NT > 1) { VMW(); if constexpr (F32) { SWRITE_VF(1); SBAR(); if (NT > 2) SLOAD_F((const float*)Kh, KBASE(2)); } else SWRITE_H(1); }
    __syncthreads();
#define HALF_STEP(PX0, PX1, mnX, alX, PY0, PY1, alY, t, KB, VB, SB) do {                                                      \
        SBAR(); qkt<KB, SK>(PX0, PX1, K_lds, r32, hi, S.qr, ACT(t));                                             \
        finishSM(PY0, PY1, alY, l_reg, pa0, pa1, pa2, pa3); SBAR();                                                           \
        if ((t) + 1 < NT) { if constexpr (F32) { VMW(); SWRITE_KF(SB); SBAR(); SLOAD_F((const float*)Vh, KBASE((t) + 1)); }  \
                            else { SLOAD_H(Kh, Vh, Fh, KBASE((t) + 1)); } SBAR(); }                                               \
        pv_tile<VB, SK>(o, vb0, pa0, pa1, pa2, pa3, ACT((t) - 1)); MASKT(PX0, PX1, (t)); partialSM(PX0, PX1, m_reg, mnX, alX);                                        \
        __syncthreads();                                                                                                      \
        if ((t) + 1 < NT) { VMW(); if constexpr (F32) { SWRITE_VF(SB); SBAR(); if ((t) + 2 < NT) SLOAD_F((const float*)Kh, KBASE((t) + 2)); } \
                            else { SWRITE_H(SB); } }                                                                          \
        RESC(alX); __syncthreads(); } while (0)
    for (int t = 1; t + 1 < NT; t += 2) {
        HALF_STEP(pB0, pB1, mnB, alB, pA0, pA1, alA, t, 1, 0, 0);
        HALF_STEP(pA0, pA1, mnA, alA, pB0, pB1, alB, t + 1, 0, 1, 1);
    }
    const bool even = (NT & 1) == 0;
    if (even) { SBAR(); qkt<1, SK>(pB0, pB1, K_lds, r32, hi, S.qr, ACT(NT - 1)); SBAR(); }
#define QROW(e) (nxt.Q + (size_t)(wid * QBLK + r32) * KVP + ((e) >> 1) * 16 + hi * 8 + ((e) & 1) * 4)
    if constexpr (F32) { SLOAD_F((const float*)nxt.K, kbn); SBAR();
#pragma unroll
        for (int e = 0; e < 8; ++e) S.tq[e] = *(const f32x4*)QROW(e); }
    else { SLOAD_H(nxt.K, nxt.V, nxt.F, kbn); SBAR();
#pragma unroll
        for (int d0 = 0; d0 < 8; ++d0) S.qr[d0] = load8<TIn>(nxt.Q + (size_t)(wid * QBLK + r32) * KVP + d0 * 16 + hi * 8); }
    SBAR();
    finishSM(pA0, pA1, alA, l_reg, pa0, pa1, pa2, pa3); SBAR();
    if constexpr (F32) {
#pragma unroll
        for (int e = 8; e < 16; ++e) S.tq[e] = *(const f32x4*)QROW(e); SBAR(); }
#undef QROW
    pv_tile<0, SK>(o, vb0, pa0, pa1, pa2, pa3, ACT(even ? NT - 2 : NT - 1));
    if (even) { MASKT(pB0, pB1, NT - 1); partialSM(pB0, pB1, m_reg, mnB, alB); __syncthreads(); RESC(alB);
        finishSM(pB0, pB1, alB, l_reg, pa0, pa1, pa2, pa3); SBAR(); pv_tile<1, SK>(o, vb0, pa0, pa1, pa2, pa3, ACT(NT - 1)); }
    SBAR(); SEAM_K0();
    if (hi == 0) li_l[r32] = l_reg; asm volatile("s_waitcnt lgkmcnt(0)" ::: "memory");
    float rli[16];
#pragma unroll
    for (int r = 0; r < 16; ++r) rli[r] = __builtin_amdgcn_rcpf(li_l[crow(r, hi)]);
    TOut* Ow = cur.O + (size_t)(wid * QBLK) * OP;
    float gn[4];
    { const float* G = *gslot + goff;
#pragma unroll
    for (int d0 = 0; d0 < 4; ++d0) gn[d0] = G[d0 * 32 + r32]; }
#pragma unroll
    for (int r = 0; r < 16; ++r) { const int orow = crow(r, hi);
        float y[4]; float ss = 0.f;
#pragma unroll
        for (int d0 = 0; d0 < 4; ++d0) { y[d0] = o[d0][r] * rli[r]; ss += y[d0] * y[d0]; }
        ss += __shfl_xor(ss, 1); ss += __shfl_xor(ss, 2); ss += __shfl_xor(ss, 4); ss += __shfl_xor(ss, 8); ss += __shfl_xor(ss, 16);
        const float rs = __builtin_amdgcn_rsqf(ss * (1.0f / 128.0f) + 1e-6f);
#pragma unroll
        for (int d0 = 0; d0 < 4; ++d0) { const float v = y[d0] * rs * gn[d0];
            if constexpr (same_t<TOut, float>::v) { Ow[(size_t)orow * OP + d0 * 32 + r32] = v; }
            else { const float vn = __shfl_xor(v, 1);
                   if ((r32 & 1) == 0) *(unsigned*)(Ow + (size_t)orow * OP + d0 * 32 + r32) = cvtpk(v, vn); } }
        SBAR(); }
    if constexpr (F32) {
#pragma unroll
        for (int d0 = 0; d0 < 8; ++d0) S.qr[d0] = pack8(S.tq[2 * d0], S.tq[2 * d0 + 1]); }
    __syncthreads();
#undef RESC
#undef KBASE
#undef ACT
#undef MASKT
#undef SEAM_K0
#undef HALF_STEP
}
#undef ROW
#undef VMW
#undef VMWN
#undef SLOAD_H
#undef SWRITE_HK
#undef SWRITE_HV
#undef SWRITE_H
#undef SLOAD_F
#undef SWRITE_KF
#undef SWRITE_VF


}

__device__ __forceinline__ float bflo(unsigned w) { return __uint_as_float(w << 16); }
__device__ __forceinline__ float bfhi(unsigned w) { return __uint_as_float(w & 0xffff0000u); }
__device__ __forceinline__ float wave_sum(float v) {
#pragma unroll
    for (int o = 1; o < 64; o <<= 1) v += __shfl_xor(v, o);
    return v;
}
__device__ __forceinline__ float sigmoid_f(float x) { return 1.0f / (1.0f + __expf(-x)); }
__device__ __forceinline__ float silu_acc(float x) { return x / (1.0f + __expf(-x)); }
__device__ __forceinline__ float softplus_f(float x) { return fmaxf(x, 0.f) + log1pf(__expf(-fabsf(x))); }
__device__ __forceinline__ float logsigmoid_f(float x) { return fminf(x, 0.f) - log1pf(__expf(-fabsf(x))); }

struct Args { const float* in[17]; float* out; unsigned char* ws; int ph_lo, ph_hi; };
typedef const __attribute__((address_space(4))) Args* ArgsP;
enum { I_X = 0, I_MIXPRE, I_WIN, I_FOXFB, I_FOXON, I_SCW, I_GDNCW, I_GDNALOG, I_GDNDTB, I_GDNON, I_WOUT, I_MIXPOST, I_FFNPRE, I_WGATE, I_WUP, I_WDOWN, I_FFNPOST };
struct Ptrs {
    ArgsP ap;
    int tid, lane, wave, gw, NGW, G, bid;
};
__device__ __forceinline__ Ptrs fresh_ptrs(ArgsP ap0);
__device__ __forceinline__ int ftid() { int t = my_tid(); asm volatile("" : "+v"(t)); return t; }
__device__ __forceinline__ int fbid() { int b = blockIdx.x; asm volatile("" : "+s"(b)); return b; }
__device__ __forceinline__ ArgsP fresh(ArgsP a) { asm volatile("" : "+s"(a)); return a; }
__device__ __forceinline__ Ptrs fresh_ptrs(ArgsP ap0) { Ptrs P; P.ap = fresh(ap0); P.tid = ftid(); P.lane = P.tid & 63; P.wave = __builtin_amdgcn_readfirstlane(P.tid >> 6); P.bid = fbid();
    P.G = gridDim.x; P.gw = P.bid * NWAVES + P.wave; P.NGW = P.G * NWAVES; return P; }

__device__ __forceinline__ int win_src4(int d) {
    if (d < PC_SB) return d;
    if (d < PC_GQ) return d - PC_SB + SRC_SB;
    if (d < PC_GZ) return d - PC_GQ + SRC_GQ;
    if (d < PC_SMALL) return d - PC_GZ + SRC_GZ;
    const int e = d - PC_SMALL;
    if (e < 12) return SRC_FF + e;
    if (e < 24) return SRC_GA + e - 12;
    if (e < 36) return SRC_GB + e - 24;
    return -1;
}
__device__ __forceinline__ void tr_item(const float* __restrict__ W, int Ns, int scol, int k0, bf16* WT, int K, int dn0, LAS float* scr, int lane) {
    const int sub = lane >> 3, g = lane & 7;
    f32x4 v[8];
#pragma unroll
    for (int i = 0; i < 8; ++i) { const int kk = 8 * i + sub; v[i] = (f32x4){0.f, 0.f, 0.f, 0.f}; if (scol >= 0) v[i] = *(const f32x4*)(W + (size_t)(k0 + kk) * Ns + scol); }
#pragma unroll
    for (int i = 0; i < 8; ++i) { const int kk = 8 * i + sub; LAS float* s = scr + kk * 33 + 4 * g; s[0] = v[i][0]; s[1] = v[i][1]; s[2] = v[i][2]; s[3] = v[i][3]; }
    LDS_WAIT(); asm volatile("" ::: "memory");
    const int c = lane & 7;
#pragma unroll
    for (int j = 0; j < 4; ++j) { const int n = (lane >> 3) + 8 * j; const LAS float* s = scr + (8 * c) * 33 + n;
        v4u o; o.x = pk2(s[0 * 33], s[1 * 33]); o.y = pk2(s[2 * 33], s[3 * 33]); o.z = pk2(s[4 * 33], s[5 * 33]); o.w = pk2(s[6 * 33], s[7 * 33]);
        *(v4u*)(WT + (size_t)(dn0 + n) * K + k0 + 8 * c) = o; }
    LDS_WAIT(); asm volatile("" ::: "memory");
}
constexpr int I_IN = 64 * (NP / 32), I_OUT = 64 * (DM / 32), I_GU = 64 * (NGU / 32), I_DN = (FFN / 64) * (DM / 32), I_LAYER = I_IN + I_OUT + I_GU + I_DN;

typedef unsigned u32x2t __attribute__((ext_vector_type(2)));
__device__ __forceinline__ float sq4(const f32x4 v) { return (v[0] * v[0] + v[1] * v[1]) + (v[2] * v[2] + v[3] * v[3]); }
__device__ __forceinline__ void rms_row_to_bf16(const float* xrow, const float* gain, bf16* orow, int lane) {
    f32x4 a[16]; float ss = 0.f;
#pragma unroll
    for (int j = 0; j < 16; ++j) { a[j] = *(const f32x4*)(xrow + 256 * j + 4 * lane); ss += sq4(a[j]); }
    const float r = 1.0f / sqrtf(wave_sum(ss) * (1.0f / DM) + RMS_EPS);
#pragma unroll
    for (int j = 0; j < 16; ++j) { const f32x4 g = *(const f32x4*)(gain + 256 * j + 4 * lane);
        u32x2t o; o.x = pk2(a[j][0] * r * g[0], a[j][1] * r * g[1]); o.y = pk2(a[j][2] * r * g[2], a[j][3] * r * g[3]);
        *(u32x2t*)(orow + 256 * j + 4 * lane) = o; }
}
__device__ __forceinline__ void resid_norm_row(const float* base_row, const bf16* yrow, const float* ssrow, const float* gpost, float* out_row, const float* gnext, bf16* xn_row, int lane) {
    const float ry = 1.0f / sqrtf(wave_sum(ssrow[lane]) * (1.0f / DM) + RMS_EPS);
    f32x4 a[16]; float ss = 0.f;
#pragma unroll
    for (int j = 0; j < 16; ++j) { const int c = 256 * j + 4 * lane; const u32x2t yw = *(const u32x2t*)(yrow + c);
        const f32x4 x0 = *(const f32x4*)(base_row + c), g0 = *(const f32x4*)(gpost + c);
        a[j][0] = x0[0] + bflo(yw.x) * ry * g0[0]; a[j][1] = x0[1] + bfhi(yw.x) * ry * g0[1]; a[j][2] = x0[2] + bflo(yw.y) * ry * g0[2]; a[j][3] = x0[3] + bfhi(yw.y) * ry * g0[3];
        *(f32x4*)(out_row + c) = a[j]; ss += sq4(a[j]); }
    if (gnext) {
        const float r = 1.0f / sqrtf(wave_sum(ss) * (1.0f / DM) + RMS_EPS);
#pragma unroll
        for (int j = 0; j < 16; ++j) { const f32x4 g = *(const f32x4*)(gnext + 256 * j + 4 * lane);
            u32x2t o; o.x = pk2(a[j][0] * r * g[0], a[j][1] * r * g[1]); o.y = pk2(a[j][2] * r * g[2], a[j][3] * r * g[3]);
            *(u32x2t*)(xn_row + 256 * j + 4 * lane) = o; }
    }
}

__device__ __forceinline__ void convert_weights(ArgsP ap0, LAS unsigned char* lds, int l, int lo = 0, int hi = I_LAYER, int wg_lo = 0) {
    const Ptrs P = fresh_ptrs(ap0); const ArgsP A = P.ap;
    if (P.bid < wg_lo) return;
    LAS float* scr = (LAS float*)(lds + P.wave * 16384);
    const int g = P.lane & 7;
    bf16* wl = (bf16*)(A->ws + WS_W);
    for (int it = lo + (P.bid - wg_lo) * NWAVES + P.wave; it < hi; it += (P.G - wg_lo) * NWAVES) {
        int r = it;
        if (r < I_IN) { const int kb = r / (NP / 32), nb = r % (NP / 32);
            tr_item(A->in[I_WIN] + (size_t)l * DM * PROJ_SRC, PROJ_SRC, win_src4(32 * nb + 4 * g), 64 * kb, (bf16*)((unsigned char*)wl + WO_IN), DM, 32 * nb, scr, P.lane); continue; }
        r -= I_IN;
        if (r < I_OUT) { const int kb = r / (DM / 32), nb = r % (DM / 32);
            tr_item(A->in[I_WOUT] + (size_t)l * DM * DM, DM, 32 * nb + 4 * g, 64 * kb, (bf16*)((unsigned char*)wl + WO_OUT), DM, 32 * nb, scr, P.lane); continue; }
        r -= I_OUT;
        if (r < I_GU) { const int kb = r / (NGU / 32), nb = r % (NGU / 32), dn0 = 32 * nb, j = dn0 >> 8, w = dn0 & 255;
            const float* src = (w < 128 ? A->in[I_WGATE] : A->in[I_WUP]) + (size_t)l * DM * FFN;
            tr_item(src, FFN, 128 * j + (w & 127) + 4 * g, 64 * kb, (bf16*)((unsigned char*)wl + WO_GU), DM, dn0, scr, P.lane); continue; }
        r -= I_GU;
        { const int kb = r / (DM / 32), nb = r % (DM / 32);
            tr_item(A->in[I_WDOWN] + (size_t)l * FFN * DM, DM, 32 * nb + 4 * g, 64 * kb, (bf16*)((unsigned char*)wl + WO_DN), FFN, 32 * nb, scr, P.lane); }
    }
}
__device__ __forceinline__ void p0_prologue(ArgsP ap0, LAS unsigned char* lds) {
    convert_weights(ap0, lds, 0, 0, I_IN + I_OUT + I_GU);
    const Ptrs P = fresh_ptrs(ap0); const ArgsP A = P.ap;
    bf16* XN = (bf16*)(A->ws + WS_XN);
    for (int m = P.gw; m < M; m += P.NGW) rms_row_to_bf16(A->in[I_X] + (size_t)m * DM, A->in[I_MIXPRE], XN + (size_t)m * DM, P.lane);
}

__device__ __forceinline__ void p2_prep(ArgsP ap0, LAS unsigned char* lds, int l) {
    const Ptrs P = fresh_ptrs(ap0); const ArgsP A = P.ap;
    const bf16* SCB = (const bf16*)(A->ws + WS_SCB); const float* SB = (const float*)(A->ws + WS_SB);
    bf16* MIX = (bf16*)(A->ws + WS_MIX); float* FG = (float*)(A->ws + WS_FG);
    const int lane = P.lane;
    if (P.bid < BATCH * FOXH) {
        const int bh = P.bid, b = bh / FOXH, h = bh % FOXH; const float fb = A->in[I_FOXFB][l * FOXH + h];
        const float* sb = SB + ((size_t)(b * SEQ) + 16 * P.tid) * SBW + SB_FF + h;
        float ls[16]; float loc = 0.f;
#pragma unroll
        for (int i = 0; i < 16; ++i) ls[i] = sb[(size_t)i * SBW];
#pragma unroll
        for (int i = 0; i < 16; ++i) { ls[i] = logsigmoid_f(ls[i] + fb); loc += ls[i]; }
        float incl = loc;
#pragma unroll
        for (int o = 1; o < 64; o <<= 1) { const float n = __shfl_up(incl, o); if (lane >= o) incl += n; }
        LAS float* wt = (LAS float*)lds;
        if (lane == 63) wt[P.wave] = incl;
        __syncthreads();
        float run = incl - loc;
        for (int w = 0; w < P.wave; ++w) run += wt[w];
        f32x4 o4[4];
#pragma unroll
        for (int i = 0; i < 16; ++i) { run += ls[i]; o4[i >> 2][i & 3] = -run * 11.313708498984761f; }
        float* fo = FG + (size_t)bh * SEQ + 16 * P.tid;
#pragma unroll
        for (int i = 0; i < 4; ++i) *(f32x4*)(fo + 4 * i) = o4[i];
        __syncthreads();
    }
    { const bf16* HMq = (const bf16*)(A->ws + WS_PROJ); float* TN = (float*)(A->ws + WS_TN);
      constexpr int NT_ = BATCH * FOXH * (SEQ / 64);
      for (int it = P.gw; it < NT_; it += P.NGW) {
        const int bh = it / (SEQ / 64), c = it % (SEQ / 64);
        const v4u* qrow = (const v4u*)(HMq + hm_off(HM_FQ, bh) + (size_t)(c * 64 + lane) * HD); const v4u* krow = (const v4u*)(HMq + hm_off(HM_FK, bh) + (size_t)(c * 64 + lane) * HD);
        v4u qv[16], kv[16];
#pragma unroll
        for (int j = 0; j < 16; ++j) { qv[j] = qrow[j]; kv[j] = krow[j]; }
        float sq = 0.f, sk = 0.f, d = 0.f;
#pragma unroll
        for (int j = 0; j < 16; ++j) {
#pragma unroll
            for (int e4 = 0; e4 < 4; ++e4) { const unsigned a = e4 == 0 ? qv[j].x : e4 == 1 ? qv[j].y : e4 == 2 ? qv[j].z : qv[j].w, b = e4 == 0 ? kv[j].x : e4 == 1 ? kv[j].y : e4 == 2 ? kv[j].z : kv[j].w;
                const float a0 = bflo(a), a1 = bfhi(a), b0 = bflo(b), b1 = bfhi(b); sq += a0 * a0 + a1 * a1; sk += b0 * b0 + b1 * b1; d += a0 * b0 + a1 * b1; } }
#pragma unroll
        for (int o = 1; o < 64; o <<= 1) { sq = fmaxf(sq, __shfl_xor(sq, o)); sk = fmaxf(sk, __shfl_xor(sk, o)); d = fminf(d, __shfl_xor(d, o)); }
        if (lane == 0) { TN[it] = sq; TN[NT_ + it] = sk; TN[2 * NT_ + it] = d; }
      } }
    { const float* cw = A->in[I_SCW] + (size_t)l * 3 * SCW;
      for (int idx = P.bid * 512 + P.tid; idx < M * (SCW / 8); idx += P.G * 512) {
        const int m = idx >> 7, c = (idx & 127) * 8, tp = m & (SEQ - 1);
        const bf16* row = SCB + (size_t)m * SCBW;
        const v4u bw = *(const v4u*)(row + c);
        float acc[8];
#pragma unroll
        for (int e = 0; e < 8; ++e) acc[e] = 0.f;
#pragma unroll
        for (int j = 0; j < 3; ++j) { const int dt = 2 - j;
            if (tp - dt >= 0) { const bf16* rj = row - (size_t)dt * SCBW; const v4u cwv = *(const v4u*)(rj + SCW + c), hw = *(const v4u*)(rj + 2 * SCW + c);
                const f32x4 w0 = *(const f32x4*)(cw + j * SCW + c), w1 = *(const f32x4*)(cw + j * SCW + c + 4);
                acc[0] += w0[0] * bflo(cwv.x) * bflo(hw.x); acc[1] += w0[1] * bfhi(cwv.x) * bfhi(hw.x); acc[2] += w0[2] * bflo(cwv.y) * bflo(hw.y); acc[3] += w0[3] * bfhi(cwv.y) * bfhi(hw.y);
                acc[4] += w1[0] * bflo(cwv.z) * bflo(hw.z); acc[5] += w1[1] * bfhi(cwv.z) * bfhi(hw.z); acc[6] += w1[2] * bflo(cwv.w) * bflo(hw.w); acc[7] += w1[3] * bfhi(cwv.w) * bfhi(hw.w); } }
        v4u o; o.x = pk2(acc[0] * bflo(bw.x), acc[1] * bfhi(bw.x)); o.y = pk2(acc[2] * bflo(bw.y), acc[3] * bfhi(bw.y)); o.z = pk2(acc[4] * bflo(bw.z), acc[5] * bfhi(bw.z)); o.w = pk2(acc[6] * bflo(bw.w), acc[7] * bfhi(bw.w));
        *(v4u*)(MIX + (size_t)m * DM + FOXW + c) = o; } }
}


#ifndef GP_REP_S1
#define GP_REP_S1 1
#endif
#ifndef GP_REP_S4
#define GP_REP_S4 1
#endif
constexpr int GD_OPS_BYTES = 57344;
constexpr int GD_F_WN = 0, GD_F_QD = 16, GD_F_AT = 32, GD_F_KT = 40;
constexpr int GD_NCH = SEQ / 64;
constexpr int GD_NCHH = BATCH * GDNH * GD_NCH;
constexpr size_t WS_GOPS = WS_Y, WS_GU = WS_Y + 168 * MiB, WS_GL = WS_Y + 264 * MiB, WS_GO2 = WS_Y + 266 * MiB;
constexpr int GP_QS = 0, GP_KS = 17408, GP_VS = 34816, GP_LT = 68608, GP_AT = 86016, GP_WM = 103424, GP_SM = 120832;
typedef float f32x2v __attribute__((ext_vector_type(2)));
typedef unsigned u32x2v __attribute__((ext_vector_type(2)));
typedef __bf16 bf16x2c_t __attribute__((ext_vector_type(2)));
__device__ __forceinline__ unsigned cvtpk_bf16(float lo, float hi) { const f32x2v v = {lo, hi}; const bf16x2c_t b = __builtin_convertvector(v, bf16x2c_t); return __builtin_bit_cast(unsigned, b); }


template <int N> __device__ __forceinline__ void fma_bcast(float& x, float l, float nxi) {
    asm volatile("v_fmac_f32_dpp %0, %1, %2 row_newbcast:%3 row_mask:0xf bank_mask:0xf" : "+v"(x) : "v"(l), "v"(nxi), "n"(N));
}
template <int I, int R> struct TriRow {
    static __device__ __forceinline__ void run(float (&x)[64], const float (&L)[4], float nxi) { fma_bcast<(R & 15)>(x[R], L[R >> 4], nxi); TriRow<I, R + 1>::run(x, L, nxi); }
};
template <int I> struct TriRow<I, 64> { static __device__ __forceinline__ void run(float (&)[64], const float (&)[4], float) {} };
template <int I> struct TriSolve {
    static __device__ __forceinline__ void run(float (&x)[64], const LAS float* ltb, float (&Lc)[4]) {
        float Ln[4] = {0.f, 0.f, 0.f, 0.f};
        if (I + 1 < 63) {
#pragma unroll
            for (int q = (I + 2) >> 4; q < 4; ++q) Ln[q] = ltb[(I + 1) * 68 + 16 * q]; }
        const float nxi = -x[I];
        asm volatile("s_nop 1" ::: "memory");
        TriRow<I, I + 1>::run(x, Lc, nxi);
#pragma unroll
        for (int q = 0; q < 4; ++q) Lc[q] = Ln[q];
        TriSolve<I + 1>::run(x, ltb, Lc);
    }
};
template <> struct TriSolve<63> { static __device__ __forceinline__ void run(float (&)[64], const LAS float*, float (&)[4]) {} };


template <int NT>
__device__ __forceinline__ void gp_s1(LAS unsigned char* lds, const bf16* HMG, const float* cw, int ch, int ltid) {
    const int bh = ch / GD_NCH, n = ch % GD_NCH, h = bh % GDNH;
    constexpr int NI = 3072 / NT, PER = NI / 3, ROWS = NT / 16, NB = (NT == 256 ? 4 : 3);
    const int c = (ltid & 15) * 8;
#pragma unroll
    for (int i0 = 0; i0 < NI; i0 += NB) {
        v4u xw[NB][4];
#pragma unroll
        for (int ib = 0; ib < NB; ++ib) { const int i = i0 + ib, part = i / PER, t = (i % PER) * ROWS + (ltid >> 4), tp = n * 64 + t;
            const bf16* src = HMG + hm_off(part, bh) + (size_t)(n * 64 + t) * HD + c;
#pragma unroll
            for (int j = 0; j < 4; ++j) { xw[ib][j] = (v4u){0u, 0u, 0u, 0u}; if (tp - (3 - j) >= 0) xw[ib][j] = *(const v4u*)(src - (size_t)(3 - j) * HD); } }
#pragma unroll
        for (int ib = 0; ib < NB; ++ib) { const int i = i0 + ib, part = i / PER, t = (i % PER) * ROWS + (ltid >> 4);
            const float* wp = cw + part * GDNW + h * HD + c;
            float acc[8];
#pragma unroll
            for (int e = 0; e < 8; ++e) acc[e] = 0.f;
#pragma unroll
            for (int j = 0; j < 4; ++j) { const v4u xv = xw[ib][j]; const f32x4 w0 = *(const f32x4*)(wp + j * (3 * GDNW)), w1 = *(const f32x4*)(wp + j * (3 * GDNW) + 4);
                acc[0] += w0[0] * bflo(xv.x); acc[1] += w0[1] * bfhi(xv.x); acc[2] += w0[2] * bflo(xv.y); acc[3] += w0[3] * bfhi(xv.y);
                acc[4] += w1[0] * bflo(xv.z); acc[5] += w1[1] * bfhi(xv.z); acc[6] += w1[2] * bflo(xv.w); acc[7] += w1[3] * bfhi(xv.w); }
            float ss = 0.f;
#pragma unroll
            for (int e = 0; e < 8; ++e) { acc[e] = acc[e] * __builtin_amdgcn_rcpf(1.0f + __builtin_amdgcn_exp2f(-1.4426950408889634f * acc[e])); ss += acc[e] * acc[e]; }
            if (part < 2) {
                ss += __shfl_xor(ss, 1); ss += __shfl_xor(ss, 2); ss += __shfl_xor(ss, 4); ss += __shfl_xor(ss, 8);
                const float r = (1.0f / sqrtf(ss + RMS_EPS)) * (part == 0 ? 0.08838834764831845f : 1.0f);
                v4u o; o.x = cvtpk_bf16(acc[0] * r, acc[1] * r); o.y = cvtpk_bf16(acc[2] * r, acc[3] * r); o.z = cvtpk_bf16(acc[4] * r, acc[5] * r); o.w = cvtpk_bf16(acc[6] * r, acc[7] * r);
                *(LAS v4u*)(lds + (part == 0 ? GP_QS : GP_KS) + (t * 136 + c) * 2) = o;
            } else {
                LAS float* vp = (LAS float*)(lds + GP_VS) + t * 132 + c;
                *(LAS f32x4*)vp = (f32x4){acc[0], acc[1], acc[2], acc[3]}; *(LAS f32x4*)(vp + 4) = (f32x4){acc[4], acc[5], acc[6], acc[7]};
            }
        }
    }
}
__device__ __forceinline__ void gp_s2(ArgsP A, LAS float* SMf, const float* SB, float* GL, int l, int ch, int lane) {
    const int bh = ch / GD_NCH, n = ch % GD_NCH, b = bh / GDNH, h = bh % GDNH;
    const size_t m = (size_t)b * SEQ + (size_t)n * 64 + lane;
    const float xb = SB[m * SBW + SB_GB + h], xa = SB[m * SBW + SB_GA + h] + A->in[I_GDNDTB][l * GDNH + h];
    const float bt = __builtin_amdgcn_rcpf(1.0f + __builtin_amdgcn_exp2f(-1.4426950408889634f * xb));
    const float sp = fmaxf(xa, 0.f) + 0.6931471805599453f * __builtin_amdgcn_logf(1.0f + __builtin_amdgcn_exp2f(-1.4426950408889634f * fabsf(xa)));
    const float gg = -__builtin_amdgcn_exp2f(1.4426950408889634f * A->in[I_GDNALOG][l * GDNH + h]) * sp;
    float gc = gg;
#pragma unroll
    for (int o = 1; o < 64; o <<= 1) { const float nb = __shfl_up(gc, o); if (lane >= o) gc += nb; }
    const float gtot = __shfl(gc, 63);
    SMf[lane] = bt; SMf[64 + lane] = gc; SMf[128 + lane] = __builtin_amdgcn_exp2f(1.4426950408889634f * gc); SMf[192 + lane] = __builtin_amdgcn_exp2f(1.4426950408889634f * (gtot - gc));
    if (lane == 63) GL[ch] = __builtin_amdgcn_exp2f(1.4426950408889634f * gtot);
}

__device__ __forceinline__ void gdn_prep(ArgsP ap0, LAS unsigned char* lds, int l) {
    const Ptrs P = fresh_ptrs(ap0); const ArgsP A = P.ap;
    const int tid = P.tid, lane = P.lane, wave = P.wave;
    const bf16* HMG = (const bf16*)(A->ws + WS_PROJ) + hm_off(HM_GQ, 0); const float* SB = (const float*)(A->ws + WS_SB);
    unsigned char* GOPS = A->ws + WS_GOPS; float* GU = (float*)(A->ws + WS_GU); float* GL = (float*)(A->ws + WS_GL);
    const float* cw = A->in[I_GDNCW] + (size_t)l * 4 * (3 * GDNW);
    LAS float* SMf = (LAS float*)(lds + GP_SM);
    LAS unsigned* hb = (LAS unsigned*)(lds + GP_SM + 1024); unsigned hb_epoch = 0u;
    if (tid == 0) *hb = 0u;
    if (P.bid < GD_NCHH) { gp_s1<512>(lds, HMG, cw, P.bid, tid); if (wave == 0) gp_s2(A, SMf, SB, GL, l, P.bid, lane); }
    for (int ch = P.bid; ch < GD_NCHH; ch += P.G) {
        const int bh = ch / GD_NCH, n = ch % GD_NCH, b = bh / GDNH, h = bh % GDNH;
        const size_t row0 = (size_t)b * SEQ + (size_t)n * 64;
        (void)b; (void)h; (void)row0; (void)n;
        __syncthreads();
        {
            const int mat = wave >> 2, mt = wave & 3, q4 = lane >> 4, m16 = lane & 15;
            f32x4 acc[4];
#pragma unroll
            for (int nt = 0; nt < 4; ++nt) acc[nt] = (f32x4){0.f, 0.f, 0.f, 0.f};
            const LAS unsigned char* abase = lds + (mat == 0 ? GP_KS : GP_QS) + ((16 * mt + m16) * 136 + 8 * q4) * 2;
            const LAS unsigned char* bbase = lds + GP_KS + (m16 * 136 + 8 * q4) * 2;
#pragma unroll
            for (int ks = 0; ks < 4; ++ks) { const bf16x8 a = *(const LAS bf16x8*)(abase + ks * 64);
#pragma unroll
                for (int nt = 0; nt < 4; ++nt) { const bf16x8 bb = *(const LAS bf16x8*)(bbase + nt * (16 * 136 * 2) + ks * 64); acc[nt] = __builtin_amdgcn_mfma_f32_16x16x32_bf16(a, bb, acc[nt], 0, 0, 0); } }
            const int c0 = 16 * mt + 4 * q4;
            const f32x4 gcc = *(const LAS f32x4*)(SMf + 64 + c0), btc = *(const LAS f32x4*)(SMf + c0);
#pragma unroll
            for (int nt = 0; nt < 4; ++nt) { const int s = 16 * nt + m16; const float gs = SMf[64 + s];
                if (mat == 0) { f32x4 o;
#pragma unroll
                    for (int r = 0; r < 4; ++r) o[r] = (s < c0 + r) ? btc[r] * acc[nt][r] * __builtin_amdgcn_exp2f(1.4426950408889634f * (gcc[r] - gs)) : 0.f;
                    *(LAS f32x4*)((LAS float*)(lds + GP_LT) + s * 68 + c0) = o;
                } else {
#pragma unroll
                    for (int r = 0; r < 4; ++r) ((LAS float*)(lds + GP_AT))[(c0 + r) * 68 + s] = (s <= c0 + r) ? acc[nt][r] * __builtin_amdgcn_exp2f(1.4426950408889634f * (gcc[r] - gs)) : 0.f;
                } }
        }
        __syncthreads();
        float x[64];
        if (tid < 256) {
            const int j = tid & 127, isw = tid >> 7;
            int vz = 0; asm volatile("" : "+v"(vz));
            const LAS float* SMv = SMf + vz;
#pragma unroll
            for (int r4 = 0; r4 < 16; ++r4) { const f32x4 bt = *(const LAS f32x4*)(SMv + 4 * r4), eg = *(const LAS f32x4*)(SMv + 128 + 4 * r4);
#pragma unroll
                for (int e = 0; e < 4; ++e) { const int r = 4 * r4 + e;
                    x[r] = isw ? __uint_as_float((unsigned)(*(const LAS unsigned short*)(lds + GP_KS + (r * 136 + j) * 2)) << 16) * (bt[e] * eg[e]) : ((const LAS float*)(lds + GP_VS))[r * 132 + j] * bt[e]; } }
        }
        __syncthreads();
        if (tid < 256) {
            const int j = tid & 127, isw = tid >> 7;
            { const LAS float* ltb = (const LAS float*)(lds + GP_LT) + (lane & 15);
              float Lc[4];
#pragma unroll
              for (int q = 0; q < 4; ++q) Lc[q] = ltb[16 * q];
              TriSolve<0>::run(x, ltb, Lc); }
            if (!isw) { float* up = GU + (size_t)ch * 8192 + (size_t)((j >> 4) * 4) * 256 + (j & 15) * 4;
#pragma unroll
                for (int mt = 0; mt < 4; ++mt)
#pragma unroll
                    for (int q4 = 0; q4 < 4; ++q4) *(f32x4*)(up + mt * 256 + q4 * 64) = (f32x4){x[16 * mt + 4 * q4], x[16 * mt + 4 * q4 + 1], x[16 * mt + 4 * q4 + 2], x[16 * mt + 4 * q4 + 3]};
            } else {
#pragma unroll
                for (int r = 0; r < 64; ++r) *(LAS unsigned short*)(lds + GP_WM + (r * 136 + j) * 2) = (unsigned short)f2bf(-x[r]);
            }
        } else {
            const int wv = wave - 4, q4 = lane >> 4, m16 = lane & 15;
            unsigned char* dst = GOPS + (size_t)ch * GD_OPS_BYTES + lane * 16;
            for (int f = wv; f < 40; f += 4) {
                v4u o;
                if (f < 16) { const int mt = f >> 2, ks = f & 3, row = 16 * mt + m16; const float eg = SMf[128 + row];
                    const LAS unsigned char* p = lds + GP_QS + (row * 136 + 32 * ks + 4 * q4) * 2;
                    const u32x2v a = *(const LAS u32x2v*)p, bq = *(const LAS u32x2v*)(p + 32);
                    o.x = cvtpk_bf16(bflo(a.x) * eg, bfhi(a.x) * eg); o.y = cvtpk_bf16(bflo(a.y) * eg, bfhi(a.y) * eg); o.z = cvtpk_bf16(bflo(bq.x) * eg, bfhi(bq.x) * eg); o.w = cvtpk_bf16(bflo(bq.y) * eg, bfhi(bq.y) * eg);
                    *(v4u*)(dst + (GD_F_QD + f) * 1024) = o;
                } else if (f < 24) { const int ff = f - 16, mt = ff >> 1, ks = ff & 1, row = 16 * mt + m16;
                    const LAS float* p = (const LAS float*)(lds + GP_AT) + row * 68 + 32 * ks + 4 * q4;
                    const f32x4 a = *(const LAS f32x4*)p, bq = *(const LAS f32x4*)(p + 16);
                    o.x = cvtpk_bf16(a[0], a[1]); o.y = cvtpk_bf16(a[2], a[3]); o.z = cvtpk_bf16(bq[0], bq[1]); o.w = cvtpk_bf16(bq[2], bq[3]);
                    *(v4u*)(dst + (GD_F_AT + ff) * 1024) = o;
                } else { const int ff = f - 24, mt = ff >> 1, ks = ff & 1, dk = 16 * mt + m16;
                    const int cA = 32 * ks + 4 * q4; const f32x4 ekA = *(const LAS f32x4*)(SMf + 192 + cA), ekB = *(const LAS f32x4*)(SMf + 192 + cA + 16);
                    float kv[8];
#pragma unroll
                    for (int e = 0; e < 4; ++e) { kv[e] = __uint_as_float((unsigned)(*(const LAS unsigned short*)(lds + GP_KS + ((cA + e) * 136 + dk) * 2)) << 16) * ekA[e];
                                                  kv[4 + e] = __uint_as_float((unsigned)(*(const LAS unsigned short*)(lds + GP_KS + ((cA + 16 + e) * 136 + dk) * 2)) << 16) * ekB[e]; }
                    o.x = cvtpk_bf16(kv[0], kv[1]); o.y = cvtpk_bf16(kv[2], kv[3]); o.z = cvtpk_bf16(kv[4], kv[5]); o.w = cvtpk_bf16(kv[6], kv[7]);
                    *(v4u*)(dst + (GD_F_KT + ff) * 1024) = o;
                }
            }
            if (ch + P.G < GD_NCHH) {
                asm volatile("s_waitcnt lgkmcnt(0)" ::: "memory");
                ++hb_epoch;
                if (lane == 0) (void)__hip_atomic_fetch_add(hb, 1u, __ATOMIC_RELAXED, __HIP_MEMORY_SCOPE_WORKGROUP);
                while (__hip_atomic_load(hb, __ATOMIC_RELAXED, __HIP_MEMORY_SCOPE_WORKGROUP) < 4u * hb_epoch) __builtin_amdgcn_s_sleep(1);
                asm volatile("" ::: "memory");
                gp_s1<256>(lds, HMG, cw, ch + P.G, tid - 256); if (wave == 4) gp_s2(A, SMf, SB, GL, l, ch + P.G, lane); }
        }
        __syncthreads();
        { const int q4 = lane >> 4, m16 = lane & 15;
#pragma unroll
          for (int k2 = 0; k2 < 2; ++k2) { const int f = wave * 2 + k2, mt = f >> 2, ks = f & 3, row = 16 * mt + m16;
            const LAS unsigned char* p = lds + GP_WM + (row * 136 + 32 * ks + 4 * q4) * 2;
            const u32x2v a = *(const LAS u32x2v*)p, bq = *(const LAS u32x2v*)(p + 32);
            v4u o; o.x = a.x; o.y = a.y; o.z = bq.x; o.w = bq.y;
            *(v4u*)(GOPS + (size_t)ch * GD_OPS_BYTES + (GD_F_WN + f) * 1024 + lane * 16) = o; } }
    }
    __syncthreads();
}

__device__ __forceinline__ void gdn_scan(ArgsP ap0, LAS unsigned char* lds) {
    const Ptrs P = fresh_ptrs(ap0); const ArgsP A = P.ap;
    const int lane = P.lane, wave = P.wave, bh = P.bid >> 1, b = bh / GDNH, h = bh % GDNH, q4 = lane >> 4, n16 = lane & 15;
    const int cs = (P.bid & 1) * 4 + (wave & 3);
    const bool comp = wave < 4;
    const unsigned char* ops = A->ws + WS_GOPS + (size_t)bh * GD_NCH * GD_OPS_BYTES;
    const float* Up = (const float*)(A->ws + WS_GU) + (size_t)bh * GD_NCH * 8192 + (size_t)(cs * 4) * 256 + lane * 4;
    const float* GLp = (const float*)(A->ws + WS_GL) + (size_t)bh * GD_NCH;
    float* GO = (float*)(A->ws + WS_GO2) + ((size_t)b * SEQ) * GDNW + h * HD + 16 * cs + n16;
    f32x4 S[8];
#pragma unroll
    for (int i = 0; i < 8; ++i) S[i] = (f32x4){0.f, 0.f, 0.f, 0.f};
    f32x4 Un[4]; float gln = 0.f;
#pragma unroll
    for (int i = 0; i < 4; ++i) Un[i] = (f32x4){0.f, 0.f, 0.f, 0.f};
#define GD_DMA(nn, buf) do { _Pragma("unroll") for (int i_ = 0; i_ < 7; ++i_) __builtin_amdgcn_global_load_lds((const unsigned*)(ops + (size_t)(nn) * GD_OPS_BYTES + (i_ * 8 + wave) * 1024 + lane * 16), \
        (LAS unsigned*)(lds + (buf) * GD_OPS_BYTES + (i_ * 8 + wave) * 1024), 16, 0, 0); } while (0)
#define GD_ULOAD(nn) do { if (comp) { _Pragma("unroll") for (int mt_ = 0; mt_ < 4; ++mt_) Un[mt_] = *(const f32x4*)(Up + (size_t)(nn) * 8192 + mt_ * 256); gln = GLp[nn]; } } while (0)
    GD_DMA(0, 0); GD_ULOAD(0);
    for (int n = 0; n < GD_NCH; ++n) {
        asm volatile("s_waitcnt vmcnt(0)" ::: "memory");
        __syncthreads();
        f32x4 Uc[4]; const float gl = gln;
#pragma unroll
        for (int mt = 0; mt < 4; ++mt) Uc[mt] = Un[mt];
        if (n + 1 < GD_NCH) { GD_DMA(n + 1, (n + 1) & 1); GD_ULOAD(n + 1); }
        if (comp) {
        const LAS unsigned char* fr = lds + (n & 1) * GD_OPS_BYTES + lane * 16;
#define GD_FRAG(f) (*(const LAS bf16x8*)(fr + (f) * 1024))
        bf16x8 Sb[4];
#pragma unroll
        for (int ks = 0; ks < 4; ++ks) { v4u w; w.x = cvtpk_bf16(S[2 * ks][0], S[2 * ks][1]); w.y = cvtpk_bf16(S[2 * ks][2], S[2 * ks][3]); w.z = cvtpk_bf16(S[2 * ks + 1][0], S[2 * ks + 1][1]); w.w = cvtpk_bf16(S[2 * ks + 1][2], S[2 * ks + 1][3]);
            Sb[ks] = __builtin_bit_cast(bf16x8, w); }
        f32x4 vn[4];
#pragma unroll
        for (int mt = 0; mt < 4; ++mt) { vn[mt] = Uc[mt];
#pragma unroll
            for (int ks = 0; ks < 4; ++ks) vn[mt] = __builtin_amdgcn_mfma_f32_16x16x32_bf16(GD_FRAG(GD_F_WN + mt * 4 + ks), Sb[ks], vn[mt], 0, 0, 0); }
        bf16x8 Vb[2];
#pragma unroll
        for (int ks = 0; ks < 2; ++ks) { v4u w; w.x = cvtpk_bf16(vn[2 * ks][0], vn[2 * ks][1]); w.y = cvtpk_bf16(vn[2 * ks][2], vn[2 * ks][3]); w.z = cvtpk_bf16(vn[2 * ks + 1][0], vn[2 * ks + 1][1]); w.w = cvtpk_bf16(vn[2 * ks + 1][2], vn[2 * ks + 1][3]);
            Vb[ks] = __builtin_bit_cast(bf16x8, w); }
        float* orow = GO + (size_t)(n * 64 + 4 * q4) * GDNW;
#pragma unroll
        for (int mt = 0; mt < 4; ++mt) { f32x4 o = (f32x4){0.f, 0.f, 0.f, 0.f};
#pragma unroll
            for (int ks = 0; ks < 4; ++ks) o = __builtin_amdgcn_mfma_f32_16x16x32_bf16(GD_FRAG(GD_F_QD + mt * 4 + ks), Sb[ks], o, 0, 0, 0);
#pragma unroll
            for (int ks = 0; ks < 2; ++ks) o = __builtin_amdgcn_mfma_f32_16x16x32_bf16(GD_FRAG(GD_F_AT + mt * 2 + ks), Vb[ks], o, 0, 0, 0);
#pragma unroll
            for (int r = 0; r < 4; ++r) orow[(size_t)(16 * mt + r) * GDNW] = o[r]; }
#pragma unroll
        for (int mt = 0; mt < 8; ++mt) { S[mt] = S[mt] * gl;
#pragma unroll
            for (int ks = 0; ks < 2; ++ks) S[mt] = __builtin_amdgcn_mfma_f32_16x16x32_bf16(GD_FRAG(GD_F_KT + mt * 2 + ks), Vb[ks], S[mt], 0, 0, 0); }
        }
    }
#undef GD_FRAG
#undef GD_DMA
#undef GD_ULOAD
    asm volatile("s_waitcnt vmcnt(0)" ::: "memory");
    __syncthreads();
}
__device__ __forceinline__ void p4_finalize(ArgsP ap0, int l) {
    const Ptrs P = fresh_ptrs(ap0); const ArgsP A = P.ap;
    const float* GO = (const float*)(A->ws + WS_GO2); const bf16* HMZ = (const bf16*)(A->ws + WS_PROJ) + hm_off(HM_GZ, 0);
    bf16* MIX = (bf16*)(A->ws + WS_MIX); const int lane = P.lane;
    typedef float f32x2 __attribute__((ext_vector_type(2)));
    const f32x2 gg = *(const f32x2*)(A->in[I_GDNON] + l * HD + 2 * lane);
    for (int m = P.gw; m < M; m += P.NGW) {
        const int b = m / SEQ, s = m % SEQ;
        f32x2 v[GDNH]; unsigned zw[GDNH];
#pragma unroll
        for (int h = 0; h < GDNH; ++h) { v[h] = *(const f32x2*)(GO + (size_t)m * GDNW + h * HD + 2 * lane); zw[h] = *(const unsigned*)(HMZ + ((size_t)(b * GDNH + h) * SEQ + s) * HD + 2 * lane); }
        float ss[GDNH];
#pragma unroll
        for (int h = 0; h < GDNH; ++h) ss[h] = v[h][0] * v[h][0] + v[h][1] * v[h][1];
#pragma unroll
        for (int o = 1; o < 64; o <<= 1) {
#pragma unroll
            for (int h = 0; h < GDNH; ++h) ss[h] += __shfl_xor(ss[h], o); }
#pragma unroll
        for (int h = 0; h < GDNH; ++h) { const float rr = 1.0f / sqrtf(ss[h] * (1.0f / HD) + RMS_EPS);
            *(unsigned*)(MIX + (size_t)m * DM + FOXW + SCW + h * HD + 2 * lane) = pk2(v[h][0] * rr * gg[0] * silu_acc(bflo(zw[h])), v[h][1] * rr * gg[1] * silu_acc(bfhi(zw[h]))); }
    }
}

constexpr int ATT_PER_X = 3 * (SEQ / attn::QB);
constexpr int ATT_SLOT_OFF = 69632;
static_assert(attn::LDS_BYTES <= ATT_SLOT_OFF, "attention LDS map");
typedef attn::BlockRef<attn::bf16, attn::bf16> FoxRef;
__device__ __forceinline__ int fox_jlo(ArgsP A, int l, int bh, int P0) {
    (void)l;
    const float* FG = (const float*)(A->ws + WS_FG) + (size_t)bh * SEQ; const float* TN = (const float*)(A->ws + WS_TN);
    constexpr int NT_ = BATCH * FOXH * (SEQ / 64);
    const int lane = my_lane(), jd = P0 / attn::KVBLK, tb = bh * (SEQ / 64);
    float qn2 = 0.f, lb = 3.0e38f;
#pragma unroll
    for (int i = 0; i < 4; ++i) { qn2 = fmaxf(qn2, TN[tb + jd + i]); lb = fminf(lb, TN[2 * NT_ + tb + jd + i] + FG[64 * (jd + i)]); }
    const float qnb = sqrtf(qn2) * 1.001f;
    const bool s0 = qnb * sqrtf(TN[NT_ + tb + lane]) + FG[64 * lane + 63] - lb < -600.0f, s1 = qnb * sqrtf(TN[NT_ + tb + lane + 64]) + FG[64 * (lane + 64) + 63] - lb < -600.0f;
    const unsigned long long n0 = ~__ballot(s0), n1 = ~__ballot(s1);
    const int n = n0 ? __builtin_ctzll(n0) : 64 + (n1 ? __builtin_ctzll(n1) : 64);
    return __builtin_amdgcn_readfirstlane(n < jd ? n : jd);
}
__device__ __forceinline__ FoxRef fox_ref(ArgsP A, int id, int l) {
    const int qx = id / ATT_PER_X, i = id % ATT_PER_X, bh = 3 * qx + (i >> 5), qb = 31 - (i & 31);
    const int b = bh / FOXH, h = bh % FOXH; const size_t row0 = (size_t)b * SEQ;
    const attn::bf16* HM = (const attn::bf16*)(A->ws + WS_PROJ);
    FoxRef r;
    r.Q = HM + hm_off(HM_FQ, bh) + (size_t)qb * attn::QB * HD;
    r.K = HM + hm_off(HM_FK, bh); r.V = HM + hm_off(HM_FV, bh);
    r.F = (const float*)(A->ws + WS_FG) + (size_t)bh * SEQ;
    r.O = (attn::bf16*)(A->ws + WS_MIX) + (row0 + (size_t)qb * attn::QB) * DM + h * HD; r.P0 = qb * attn::QB; r.JLO = fox_jlo(A, l, bh, r.P0);
    return r;
}
__device__ __forceinline__ int att_claim(gu32* ctrs, volatile LAS int* st) {
    int qx = st[0], tried = st[1], r = -1;
    while (tried < 8) { const unsigned i = __hip_atomic_fetch_add(ctrs + qx * 64, 1u, __ATOMIC_RELAXED, __HIP_MEMORY_SCOPE_AGENT); if (i < (unsigned)ATT_PER_X) { r = qx * ATT_PER_X + (int)i; break; } qx = (qx + 1) & 7; ++tried; }
    st[0] = qx; st[1] = tried;
    return r;
}
__device__ __forceinline__ void p3_attention(ArgsP ap0, char* lds, int l, int rep = 0) {
    const ArgsP A = fresh(ap0);
    gu32* ctrs = (gu32*)(A->ws + WS_CTL) + CW_Q + (rep * 2 + l) * 8 * 64;
    volatile LAS int* slot = (volatile LAS int*)((LAS unsigned char*)lds + ATT_SLOT_OFF);
    if (ftid() == 0) { slot[4] = (int)(xb_xcc_id() & 7u); slot[5] = 0; slot[0] = att_claim(ctrs, slot + 4); slot[1] = att_claim(ctrs, slot + 4); }
    __syncthreads();
    int cur = __builtin_amdgcn_readfirstlane(slot[0]), nxt = __builtin_amdgcn_readfirstlane(slot[1]);
    if (cur < 0) return;
    FoxRef curR = fox_ref(A, cur, l);
    attn::Seam<attn::bf16> S;
    attn::causal_swa_prime<attn::bf16, attn::bf16>(curR, SEQ, lds, S);
    for (int k = 0;; ++k) {
        if (nxt >= 0 && ftid() == 0) slot[2 + (k & 1)] = att_claim(ctrs, slot + 4);
        const bool last = nxt < 0;
        const FoxRef nxtR = last ? curR : fox_ref(A, nxt, l);
        attn::causal_swa_block<attn::bf16, attn::bf16>(curR, nxtR, SEQ, SEQ, lds, S, &A->in[I_FOXON], l * HD);
        if (last) break;
        cur = nxt; curR = nxtR; nxt = __builtin_amdgcn_readfirstlane(slot[2 + (k & 1)]);
    }
}

constexpr int N_PHASES = 1 + 9 * DEPTH;

#ifndef PH_EN
#define PH_EN 0x3ff
#endif
#define IN(k) (lo <= (k) && (k) < hi)
#define EN(j) ((PH_EN >> (j)) & 1)
#ifndef REP_MASK
#define REP_MASK 0
#endif
#define REPS(j) (((REP_MASK >> (j)) & 1) ? 2 : 1)
#define SEAM(k) do { if (IN(k) && IN((k) + 1)) { XcdBarrier b_; b_.bar = (unsigned*)(fresh(ap0)->ws + WS_CTL) + CW_BAR; b_.x = xb_xcc_id(); b_.st = (volatile LAS unsigned*)((LAS unsigned char*)lds + MISC_OFF) + 8; xcd_barrier(b_); } } while (0)
#define WSP(T, off) ((T*)(A->ws + (off)))


template <int l>
__device__ __forceinline__ void layer_phases(ArgsP ap0, LAS unsigned char* ldsl, unsigned char* lds, int lo, int hi) {

        const int pb = 1 + 9 * l;
        if (EN(1) && IN(pb + 0)) {
            const Ptrs P = fresh_ptrs(ap0); const ArgsP A = P.ap;
            pg8::Gemm g{WSP(bf16, WS_XN), WSP(bf16, WS_W + WO_IN), M, NP, DM}; pg8::StaticOrder S; S.init(M, NP, P.G, P.bid);
            pg8::EpiProj E{WSP(bf16, WS_PROJ), WSP(bf16, WS_SCB), WSP(float, WS_SB)};
            for (int rep_ = 0; rep_ < REPS(1); ++rep_) pg8::gemm_phase<pg8::EpiProj, pg8::StaticOrder, true, true>(ldsl, g, S, E);
            convert_weights(ap0, ldsl, l, I_IN + I_OUT + I_GU, I_LAYER, (M / 256) * (NP / 256) % P.G);
            SEAM(pb + 0);
        }
        if (EN(2) && IN(pb + 1)) {
            for (int rep_ = 0; rep_ < REPS(11); ++rep_) p2_prep(ap0, ldsl, l);
            for (int rep_ = 0; rep_ < REPS(2); ++rep_) gdn_prep(ap0, ldsl, l);
            SEAM(pb + 1); }
        if (EN(3) && IN(pb + 2)) {
            for (int rep_ = 0; rep_ < REPS(10); ++rep_) if ((int)blockIdx.x < 2 * BATCH * GDNH) gdn_scan(ap0, ldsl);
            for (int rep_ = 0; rep_ < REPS(3); ++rep_) p3_attention(ap0, (char*)lds, l, rep_);
            SEAM(pb + 2);
        }
        if (EN(4) && IN(pb + 3)) { for (int rep_ = 0; rep_ < REPS(4); ++rep_) p4_finalize(ap0, l); SEAM(pb + 3); }
        if (EN(5) && IN(pb + 4)) {
            const Ptrs P = fresh_ptrs(ap0); const ArgsP A = P.ap;
            pg8::Gemm g{WSP(bf16, WS_MIX), WSP(bf16, WS_W + WO_OUT), M, DM, DM}; pg8::StaticOrder S; S.init(M, DM, P.G, P.bid);
            pg8::EpiY E{WSP(bf16, WS_Y), WSP(float, WS_SS)};
            for (int rep_ = 0; rep_ < REPS(5); ++rep_) pg8::gemm_phase<pg8::EpiY, pg8::StaticOrder, true, true>(ldsl, g, S, E);
            SEAM(pb + 4);
        }
        if (EN(6) && IN(pb + 5)) {
            const Ptrs P = fresh_ptrs(ap0); const ArgsP A = P.ap;
            const float* xin = l == 0 ? A->in[I_X] : (const float*)A->out;
            const float* gpost = A->in[I_MIXPOST] + l * DM; const float* gpre = A->in[I_FFNPRE] + l * DM;
            const bf16* Y = WSP(bf16, WS_Y); const float* SS = WSP(float, WS_SS); float* H = WSP(float, WS_H); bf16* XN = WSP(bf16, WS_XN);
            for (int rep_ = 0; rep_ < REPS(6); ++rep_)
            for (int m = P.gw; m < M; m += P.NGW)
                resid_norm_row(xin + (size_t)m * DM, Y + (size_t)m * DM, SS + (size_t)m * 64, gpost, H + (size_t)m * DM, gpre, XN + (size_t)m * DM, P.lane);
            SEAM(pb + 5);
        }
        if (EN(7) && IN(pb + 6)) {
            const Ptrs P = fresh_ptrs(ap0); const ArgsP A = P.ap;
            pg8::Gemm g{WSP(bf16, WS_XN), WSP(bf16, WS_W + WO_GU), M, NGU, DM}; pg8::StaticOrder S; S.init(M, NGU, P.G, P.bid);
            pg8::EpiSwiGLU E{WSP(bf16, WS_PROJ)};
            for (int rep_ = 0; rep_ < REPS(7); ++rep_) pg8::gemm_phase<pg8::EpiSwiGLU, pg8::StaticOrder, true, true>(ldsl, g, S, E);
            if (l + 1 < DEPTH) convert_weights(ap0, ldsl, l + 1, 0, I_IN + I_OUT, (M / 256) * (NGU / 256) % P.G);
            SEAM(pb + 6);
        }
        if (EN(8) && IN(pb + 7)) {
            const Ptrs P = fresh_ptrs(ap0); const ArgsP A = P.ap;
            pg8::Gemm g{WSP(bf16, WS_PROJ), WSP(bf16, WS_W + WO_DN), M, DM, FFN}; pg8::StaticOrder S; S.init(M, DM, P.G, P.bid);
            pg8::EpiY E{WSP(bf16, WS_Y), WSP(float, WS_SS)};
            for (int rep_ = 0; rep_ < REPS(8); ++rep_) pg8::gemm_phase<pg8::EpiY, pg8::StaticOrder, true, true>(ldsl, g, S, E);
            SEAM(pb + 7);
        }
        if (EN(9) && IN(pb + 8)) {
            const Ptrs P = fresh_ptrs(ap0); const ArgsP A = P.ap;
            const float* gnext = l + 1 < DEPTH ? A->in[I_MIXPRE] + (l + 1) * DM : nullptr; const float* gpost = A->in[I_FFNPOST] + l * DM;
            const bf16* Y = WSP(bf16, WS_Y); const float* SS = WSP(float, WS_SS); const float* H = WSP(float, WS_H); bf16* XN = WSP(bf16, WS_XN); float* outp = A->out;
            for (int rep_ = 0; rep_ < REPS(9); ++rep_) {
            for (int m = P.gw; m < M; m += P.NGW)
                resid_norm_row(H + (size_t)m * DM, Y + (size_t)m * DM, SS + (size_t)m * 64, gpost, outp + (size_t)m * DM, gnext, XN + (size_t)m * DM, P.lane);
            if (l + 1 < DEPTH) convert_weights(ap0, ldsl, l + 1, I_IN + I_OUT, I_IN + I_OUT + I_GU);
            }
            SEAM(pb + 8);
        }
    }

__global__ void __launch_bounds__(NWAVES * 64, 2) hybrid_fwd(Args args) {
    extern __shared__ __attribute__((aligned(16))) unsigned char lds[];
    LAS unsigned char* ldsl = (LAS unsigned char*)lds;
    volatile LAS unsigned* MISC = (volatile LAS unsigned*)(ldsl + MISC_OFF);
    const ArgsP ap0 = (ArgsP)__builtin_amdgcn_kernarg_segment_ptr();
    for (int u = threadIdx.x; u < (LDS_BYTES - LDSCTL_OFF) / 4; u += NWAVES * 64) ((LAS unsigned*)(ldsl + LDSCTL_OFF))[u] = 0u;
    __syncthreads();
    if ((threadIdx.x & 63) == 0) *(volatile LAS int*)(ldsl + TIDTAB_OFF + 4 * hw_slot()) = (int)(threadIdx.x >> 6);
    __syncthreads();
    const int lo = args.ph_lo, hi = args.ph_hi;
    if (hi - lo > 1) (void)xcd_barrier_post((unsigned*)(args.ws + WS_CTL) + CW_BAR, MISC + 8);
    if (EN(0) && IN(0)) { for (int rep_ = 0; rep_ < REPS(0); ++rep_) p0_prologue(ap0, ldsl); SEAM(0); }
    layer_phases<0>(ap0, ldsl, lds, lo, hi);
    layer_phases<1>(ap0, ldsl, lds, lo, hi);
}

#undef IN
#undef SEAM
extern "C" void kernel_launch(void* const* d_in, const int* in_sizes, int n_in, void* d_out, int out_size, void* d_ws, size_t ws_size, hipStream_t stream) {
    static int grid = 0;
    if (grid == 0) {
        if (n_in != 17 || in_sizes[0] != M * DM || out_size != M * DM || ws_size < WS_END) {
            fprintf(stderr, "kernel_launch: shape/workspace mismatch: n_in %d in0 %d out %d ws %zu (need %zu)\n", n_in, n_in > 0 ? in_sizes[0] : -1, out_size, ws_size, (size_t)WS_END); grid = -1; return; }
        int dev = 0, cus = 0, per_cu = 0;
        if (hipGetDevice(&dev) != hipSuccess || hipDeviceGetAttribute(&cus, hipDeviceAttributeMultiprocessorCount, dev) != hipSuccess) { fprintf(stderr, "kernel_launch: device query failed\n"); grid = -1; return; }
        if (hipFuncSetAttribute((const void*)hybrid_fwd, hipFuncAttributeMaxDynamicSharedMemorySize, LDS_BYTES) != hipSuccess) { fprintf(stderr, "kernel_launch: hipFuncSetAttribute failed\n"); grid = -1; return; }
        if (hipOccupancyMaxActiveBlocksPerMultiprocessor(&per_cu, (const void*)hybrid_fwd, NWAVES * 64, LDS_BYTES) != hipSuccess || per_cu < 1)
            fprintf(stderr, "kernel_launch: note: occupancy query reports %d workgroups per CU\n", per_cu);
        (void)hipGetLastError();
        grid = cus;
    }
    if (grid < 0) return;
    if (hipMemsetAsync((char*)d_ws + WS_CTL, 0, CTL_ZERO_BYTES, stream) != hipSuccess) { fprintf(stderr, "kernel_launch: memset failed\n"); return; }
    Args a{};
    for (int i = 0; i < 17; ++i) a.in[i] = (const float*)d_in[i];
    a.out = (float*)d_out; a.ws = (unsigned char*)d_ws;
#if MK_N_LAUNCHES == 1
    a.ph_lo = 0; a.ph_hi = N_PHASES;
    hipLaunchKernelGGL(hybrid_fwd, dim3(grid), dim3(NWAVES * 64), LDS_BYTES, stream, a);
#else
    for (int p = 0; p < N_PHASES; ++p) { a.ph_lo = p; a.ph_hi = p + 1; hipLaunchKernelGGL(hybrid_fwd, dim3(grid), dim3(NWAVES * 64), LDS_BYTES, stream, a); }
#endif
    const hipError_t le = hipPeekAtLastError();
    if (le != hipSuccess) fprintf(stderr, "kernel_launch: launch failed: %s\n", hipGetErrorName(le));
}
```

```cpp
#include <hip/hip_runtime.h>
#include <hip/hip_bf16.h>
#include <cstdio>
#include <cstdint>
#include <cmath>

#ifndef MK_N_LAUNCHES
#define MK_N_LAUNCHES 1
#endif

constexpr int BATCH = 2, SEQ = 8192, DM = 4096, M = BATCH * SEQ, DEPTH = 2;
constexpr int HD = 128, FOXH = 12, FOXW = FOXH * HD, SCW = 1024, GDNH = 12, GDNW = GDNH * HD;
constexpr int PROJ_SRC = 13860;
constexpr int NP = 14080;
constexpr int FFN = 11008, NGU = 2 * FFN;
constexpr float RMS_EPS = 1e-6f;
constexpr int PC_FQ = 0, PC_FK = 1536, PC_FV = 3072, PC_SB = 4608, PC_SC = 5632, PC_SH = 6656, PC_GQ = 7680, PC_GK = 9216, PC_GV = 10752, PC_GZ = 12288, PC_SMALL = 13824;
constexpr int SBW = 64, SB_FF = 0, SB_GA = 12, SB_GB = 24;
constexpr int SRC_FF = 4608, SRC_SB = 4620, SRC_GQ = 7692, SRC_GA = 12300, SRC_GB = 12312, SRC_GZ = 12324;

constexpr size_t MiB = 1u << 20;
constexpr size_t WS_CTL = 0, CTL_ZERO_BYTES = 1 * MiB;
constexpr size_t WS_W = 16 * MiB;
constexpr size_t WO_IN = 0, WO_OUT = 110 * MiB, WO_GU = 142 * MiB, WO_DN = 314 * MiB;
constexpr size_t WS_XN = 416 * MiB;
constexpr size_t WS_MIX = 544 * MiB;
constexpr size_t WS_Y = 672 * MiB;
constexpr size_t WS_H = 800 * MiB;
constexpr size_t WS_PROJ = 1056 * MiB;
constexpr size_t WS_SCB = WS_PROJ + 336 * MiB;
constexpr int HM_FQ = 0, HM_FK = 1, HM_FV = 2, HM_GQ = 3, HM_GZ = 6, SCBW = 3 * SCW;
__host__ __device__ constexpr size_t hm_off(int part, int bh) { return ((size_t)(part * (BATCH * FOXH) + bh) * SEQ) * HD; }
constexpr size_t WS_SB = 1496 * MiB;
constexpr size_t WS_SS = 1500 * MiB;
constexpr size_t WS_FG = 1504 * MiB;
constexpr size_t WS_TN = WS_FG + 1 * MiB;
constexpr size_t WS_END = 1506 * MiB;
constexpr int CW_TMO = 0, CW_BAR = 4096, CW_Q = 16384;

constexpr int NWAVES = 8;
constexpr int RING_BYTES = 131072, LDSCTL_OFF = RING_BYTES, MISC_OFF = LDSCTL_OFF + 320, LDS_BYTES = 147456;


extern __shared__ __attribute__((aligned(16))) unsigned char g_lds[];
constexpr int TIDTAB_OFF = LDSCTL_OFF + 512;
__device__ __forceinline__ unsigned hw_slot() { return (unsigned)__builtin_amdgcn_s_getreg((5 << 11) | 4) & 63u; }
__device__ __forceinline__ int my_lane() { int l; asm volatile("v_mbcnt_lo_u32_b32 %0, -1, 0\n\tv_mbcnt_hi_u32_b32 %0, -1, %0" : "=v"(l)); return l; }
__device__ __forceinline__ int my_wave() { return __builtin_amdgcn_readfirstlane(*(volatile __attribute__((address_space(3))) int*)((__attribute__((address_space(3))) unsigned char*)g_lds + TIDTAB_OFF + 4 * hw_slot())); }
__device__ __forceinline__ int my_tid() { return my_wave() * 64 + my_lane(); }

#define GAS __attribute__((address_space(1)))
#define LAS __attribute__((address_space(3)))
typedef unsigned short bf16;
typedef unsigned v4u __attribute__((ext_vector_type(4)));
typedef float f32x4 __attribute__((ext_vector_type(4)));
typedef short bf16x8 __attribute__((ext_vector_type(8)));
typedef GAS unsigned gu32;
typedef GAS unsigned long long gu64;
#define RLX_AGENT __ATOMIC_RELAXED, __HIP_MEMORY_SCOPE_AGENT
#define LDS_WAIT() asm volatile("s_waitcnt lgkmcnt(0)" ::: "memory")
#define VM_WAIT() asm volatile("s_waitcnt vmcnt(0)" ::: "memory")
__device__ __forceinline__ unsigned long long rt() { return __builtin_amdgcn_s_memrealtime(); }
__device__ __forceinline__ unsigned f2bf(float f) { unsigned u = __builtin_bit_cast(unsigned, f); return (u + 0x7fffu + ((u >> 16) & 1u)) >> 16; }
__device__ __forceinline__ unsigned pk2(float lo, float hi) { return f2bf(lo) | (f2bf(hi) << 16); }

#define XB_TMO      128
#define XB_XCNT(j)  (256  + 64 * (j))
#define XB_XSUB(j)  (1280 + 64 * (j))
#define XB_XGEN(j)  (2304 + 64 * (j))
#define XB_TOP      3328
#define XB_TOPGEN   3392
#define XCD_BAR_WORDS 3456
#define XB_SPIN_CAP (1u << 18)

__device__ __forceinline__ unsigned xb_ld(unsigned* p)              { return __hip_atomic_load(p, __ATOMIC_RELAXED, __HIP_MEMORY_SCOPE_AGENT); }
__device__ __forceinline__ unsigned xb_add(unsigned* p, unsigned v) { return __hip_atomic_fetch_add(p, v, __ATOMIC_RELAXED, __HIP_MEMORY_SCOPE_AGENT); }
__device__ __forceinline__ unsigned xb_xcc_id() { return (unsigned)__builtin_amdgcn_s_getreg((3 << 11) | 20) & 0xFu; }
#define XB_SPIN(cond, bar) do { unsigned _sp = 0; while (cond) { __builtin_amdgcn_s_sleep(1); \
    if ((++_sp & 255u) == 0u) { if (xb_ld(&(bar)[XB_TMO])) break; if (_sp > XB_SPIN_CAP) { atomicAdd(&(bar)[XB_TMO], 1u); break; } } } } while (0)

struct XcdBarrier {
    unsigned* bar; unsigned x;
    volatile LAS unsigned* st;
};

__device__ __forceinline__ XcdBarrier xcd_barrier_post(unsigned* bar, volatile LAS unsigned* st) {
    XcdBarrier b; b.bar = bar; b.x = xb_xcc_id(); b.st = st;
    if (my_tid() == 0) (void)xb_add(&bar[XB_XCNT(b.x)], 1u);
    return b;
}
__device__ __forceinline__ void xcd_barrier_complete(unsigned* bar, unsigned x, unsigned& nloc, unsigned& nx) {
    const unsigned G = gridDim.x * gridDim.y * gridDim.z;
    unsigned sum, cnt, mine, sp = 0u;
    for (;;) {
        sum = 0u; cnt = 0u; mine = 0u;
#pragma unroll
        for (unsigned j = 0; j < 16; ++j) { const unsigned c = xb_ld(&bar[XB_XCNT(j)]); sum += c; cnt += (c > 0u) ? 1u : 0u; mine = (j == x) ? c : mine; }
        if (sum == G) break;
        __builtin_amdgcn_s_sleep(1);
        if ((++sp & 255u) == 0u) { if (xb_ld(&bar[XB_TMO])) break; if (sp > XB_SPIN_CAP) { atomicAdd(&bar[XB_TMO], 1u); break; } }
    }
    nloc = mine > 0u ? mine : 1u; nx = cnt > 0u ? cnt : 1u;
}

__device__ __forceinline__ void xcd_barrier(const XcdBarrier& b) {
    asm volatile("s_waitcnt vmcnt(0)" ::: "memory");
    __syncthreads();
    if (my_tid() == 0) {
        unsigned* bar = b.bar;
        __builtin_amdgcn_s_waitcnt(0);
        unsigned nloc = b.st[0], nx = b.st[1];
        if (nloc == 0u) { xcd_barrier_complete(bar, b.x, nloc, nx); b.st[0] = nloc; b.st[1] = nx; }
        const unsigned old = xb_add(&bar[XB_XSUB(b.x)], 1u);
        const unsigned gen = old / nloc;
        if (old + 1u == (gen + 1u) * nloc) {
            __builtin_amdgcn_fence(__ATOMIC_RELEASE, "agent");
            asm volatile("s_waitcnt vmcnt(0)" ::: "memory");
            const unsigned og = xb_add(&bar[XB_TOP], 1u);
            const unsigned tg = og / nx;
            if (og + 1u == (tg + 1u) * nx) xb_add(&bar[XB_TOPGEN], 1u);
            else XB_SPIN(xb_ld(&bar[XB_TOPGEN]) == tg, bar);
            __builtin_amdgcn_fence(__ATOMIC_ACQUIRE, "agent");
            xb_add(&bar[XB_XGEN(b.x)], 1u);
            asm volatile("s_waitcnt vmcnt(0)" ::: "memory");
        } else {
            XB_SPIN(xb_ld(&bar[XB_XGEN(b.x)]) == gen, bar);
            __builtin_amdgcn_fence(__ATOMIC_ACQUIRE, "agent");
            asm volatile("s_waitcnt vmcnt(0)" ::: "memory");
        }
    }
    __syncthreads();
}

namespace pg8 {
#define PG8_LAS __attribute__((address_space(3)))
typedef unsigned short bf16_t;
typedef short bf16x8 __attribute__((ext_vector_type(8)));
typedef float f32x4 __attribute__((ext_vector_type(4)));
typedef unsigned u32x4 __attribute__((ext_vector_type(4)));
constexpr int BM = 256, BK = 64, HALF = 128, HTB = HALF * BK * 2  , STAGE_BYTES = 8 * HTB, NXCD = 8, WGM = 8;

__host__ __device__ __forceinline__ int lds_byte(int r, int c) { const int st = (r >> 4) * 2 + (c >> 5), rr = r & 15, cc = c & 31, ob = rr * 64 + cc * 2; return st * 1024 + (ob ^ (((ob >> 9) & 1) << 5)); }
__host__ __device__ __forceinline__ void stage_rc(int b, int& R, int& C) { const int st = b / 1024, sb = b % 1024, swz = sb ^ (((sb >> 9) & 1) << 5); R = (st >> 1) * 16 + swz / 64; C = (st & 1) * 32 + (swz % 64) / 2; }
__host__ __device__ __forceinline__ int perm32(int rho) { const int n = rho >> 4, i = rho & 15; return 8 * (i >> 2) + 4 * n + (i & 3); }

struct Unit { int pm, pn; };
struct Gemm { const bf16_t* A; const bf16_t* Bt; int M, N, K; };

struct StaticOrder {
    int nM, nN, nwg, G, c;
    __host__ __device__ void init(int M, int N, int G_, int c_) { nM = M / BM; nN = N / BM; nwg = nM * nN; G = G_; c = c_; }
    __host__ __device__ bool next(int i, Unit& u) const {
        const long L = (long)i * G + c; if (L >= nwg) return false;
        int wgid = (int)L; { const int q = nwg / NXCD, r = nwg % NXCD, xcd = wgid % NXCD, off = wgid / NXCD; wgid = (xcd < r ? xcd * (q + 1) : r * (q + 1) + (xcd - r) * q) + off; }
        const int nig = WGM * nN, gid = wgid / nig, fm = gid * WGM, gsz = (nM - fm) < WGM ? (nM - fm) : WGM;
        u.pm = fm + ((wgid % nig) % gsz); u.pn = (wgid % nig) / gsz; return true;
    }
    __device__ __forceinline__ void a_ready(const Unit&) const {}
    __device__ __forceinline__ void done(const Unit&) const {}
};


typedef float f32x2e __attribute__((ext_vector_type(2))); typedef __bf16 bf16x2e __attribute__((ext_vector_type(2)));
__device__ __forceinline__ unsigned cvt_pk_bf16(float lo, float hi) { const f32x2e v = {lo, hi}; const bf16x2e b = __builtin_convertvector(v, bf16x2e); return __builtin_bit_cast(unsigned, b); }
__device__ __forceinline__ u32x4 pack8_bf16(const f32x4 v0, const f32x4 v1) { u32x4 w; w.x = cvt_pk_bf16(v0[0], v0[1]); w.y = cvt_pk_bf16(v0[2], v0[3]); w.z = cvt_pk_bf16(v1[0], v1[1]); w.w = cvt_pk_bf16(v1[2], v1[3]); return w; }

struct EpiProj {
    static constexpr bool PERM = true, AFTER_DRAIN = false;
    bf16_t* HM; bf16_t* SCB; float* SBp;
    __device__ __forceinline__ void operator()(const f32x4 (&acc)[2][2][4][2], const Unit& u, int wr, int wc, int fr, int fq) const {
        const int row0 = u.pm * BM + wr * 64 + fr;
        if (u.pn * BM == PC_SMALL) {
            if (wc < 2) {
#pragma unroll
                for (int ai = 0; ai < 2; ++ai)
#pragma unroll
                    for (int m = 0; m < 4; ++m) { float* rp = SBp + (size_t)(row0 + ai * HALF + m * 16) * SBW + wc * 32 + 8 * fq;
                        *(f32x4*)rp = acc[ai][0][m][0]; *(f32x4*)(rp + 4) = acc[ai][0][m][1]; }
            }
            return;
        }
        const int b = (u.pm * BM) / SEQ, s0 = row0 - b * SEQ;
#pragma unroll
        for (int bj = 0; bj < 2; ++bj) { const int colbase = u.pn * BM + bj * HALF;
            bf16_t* dst; size_t pitch;
            if (colbase >= PC_SB && colbase < PC_GQ) { dst = SCB + (size_t)row0 * SCBW + (colbase - PC_SB) + wc * 32 + 8 * fq; pitch = SCBW; }
            else { const int hc = colbase < PC_SB ? colbase : colbase - (PC_GQ - PC_SB), part = hc / 1536, head = (hc % 1536) / HD;
                   dst = HM + hm_off(part, b * FOXH + head) + (size_t)s0 * HD + wc * 32 + 8 * fq; pitch = HD; }
#pragma unroll
            for (int ai = 0; ai < 2; ++ai)
#pragma unroll
                for (int m = 0; m < 4; ++m) *(u32x4*)(dst + (size_t)(ai * HALF + m * 16) * pitch) = pack8_bf16(acc[ai][bj][m][0], acc[ai][bj][m][1]); }
    }
};
struct EpiY {
    static constexpr bool PERM = true, AFTER_DRAIN = false;
    bf16_t* Y; float* SS;
    __device__ __forceinline__ void operator()(const f32x4 (&acc)[2][2][4][2], const Unit& u, int wr, int wc, int fr, int fq) const {
        const int row0 = u.pm * BM + wr * 64 + fr, col0 = u.pn * BM + wc * 32 + 8 * fq;
#pragma unroll
        for (int ai = 0; ai < 2; ++ai)
#pragma unroll
            for (int m = 0; m < 4; ++m) { const int row = row0 + ai * HALF + m * 16; bf16_t* rowp = Y + (size_t)row * DM + col0; float s = 0.f;
#pragma unroll
                for (int bj = 0; bj < 2; ++bj) { const f32x4 a = acc[ai][bj][m][0], b = acc[ai][bj][m][1];
                    s += (a[0] * a[0] + a[1] * a[1]) + (a[2] * a[2] + a[3] * a[3]) + (b[0] * b[0] + b[1] * b[1]) + (b[2] * b[2] + b[3] * b[3]);
                    *(u32x4*)(rowp + bj * HALF) = pack8_bf16(a, b); }
                s += __shfl_xor(s, 16); s += __shfl_xor(s, 32);
                if (fq == 0) SS[(size_t)row * 64 + u.pn * 4 + wc] = s; }
    }
};
__device__ __forceinline__ float silu_f(float x) { return x * __builtin_amdgcn_rcpf(1.0f + __builtin_amdgcn_exp2f(-1.4426950408889634f * x)); }
struct EpiSwiGLU {
    static constexpr bool PERM = true, AFTER_DRAIN = false;
    bf16_t* Hd;
    __device__ __forceinline__ void operator()(const f32x4 (&acc)[2][2][4][2], const Unit& u, int wr, int wc, int fr, int fq) const {
        const int row0 = u.pm * BM + wr * 64 + fr, col0 = u.pn * HALF + wc * 32 + 8 * fq;
#pragma unroll
        for (int ai = 0; ai < 2; ++ai)
#pragma unroll
            for (int m = 0; m < 4; ++m) { const f32x4 g0 = acc[ai][0][m][0], g1 = acc[ai][0][m][1], u0 = acc[ai][1][m][0], u1 = acc[ai][1][m][1]; f32x4 h0, h1;
#pragma unroll
                for (int e = 0; e < 4; ++e) { h0[e] = silu_f(g0[e]) * u0[e]; h1[e] = silu_f(g1[e]) * u1[e]; }
                *(u32x4*)(Hd + (size_t)(row0 + ai * HALF + m * 16) * FFN + col0) = pack8_bf16(h0, h1); }
    }
};

struct PanelOrder {
    int c, nround;
    __device__ __forceinline__ bool next(int i, Unit& u) const { if (i >= nround) return false; const int x = c & 7, k = c >> 3; u.pm = 16 * i + 2 * x + (k >> 4); u.pn = k & 15; return true; }
    __device__ __forceinline__ void a_ready(const Unit&) const {}
    __device__ __forceinline__ void done(const Unit&) const {}
};
template <class Epi, class Sched, bool ALIGN_EPI = false, bool SP2 = false>
__device__ __forceinline__ void gemm_phase(PG8_LAS unsigned char* lds, const Gemm g, const Sched& S, const Epi& E) {
    int tid_ = my_tid(); asm volatile("" : "+v"(tid_));
    const int tid = tid_, wid = __builtin_amdgcn_readfirstlane(tid >> 6), lane = tid & 63, wr = wid >> 2, wc = wid & 3, fr = lane & 15, fq = lane >> 4;
    const int K = g.K, nt = K / BK;
    unsigned voffA[2], voffB[2];
#pragma unroll
    for (int i = 0; i < 2; ++i) { int R, C; stage_rc(tid * 16 + i * 8192, R, C); const int Rb = Epi::PERM ? ((R & ~31) + perm32(R & 31)) : R;
        voffA[i] = (unsigned)(R * K + C) * 2u; voffB[i] = (unsigned)(Rb * K + C) * 2u; }
    const size_t kstep = (size_t)(BK * 2);
    const size_t hstep = (size_t)HALF * K * 2;
    const size_t tstep = 2 * hstep;
    const unsigned ldsw = (unsigned)wid * 1024u;
    const int aoff = lds_byte(wr * 64 + fr, fq * 8), boff = lds_byte(wc * 32 + fr, fq * 8);
#define PG8_SA(b, h) (((b) * 2 + (h)) * HTB)
#define PG8_SB(b, h) ((4 + (b) * 2 + (h)) * HTB)
#define PG8_STAGE(bufoff, gbase, voff) do { _Pragma("unroll") for (int _i = 0; _i < 2; ++_i) \
        __builtin_amdgcn_global_load_lds((const unsigned*)((const char*)(gbase) + (voff)[_i]), (PG8_LAS unsigned*)(lds + (bufoff) + ldsw + _i * 8192), 16, 0, 0); } while (0)
#define PG8_LDA(dst, b, h) do { _Pragma("unroll") for (int m = 0; m < 4; ++m) _Pragma("unroll") for (int k = 0; k < 2; ++k) dst[m][k] = *(const PG8_LAS bf16x8*)(lds + PG8_SA(b, h) + aoff + m * 2048 + k * 1024); } while (0)
#define PG8_LDB(dst, b, h) do { _Pragma("unroll") for (int n = 0; n < 2; ++n) _Pragma("unroll") for (int k = 0; k < 2; ++k) dst[n][k] = *(const PG8_LAS bf16x8*)(lds + PG8_SB(b, h) + boff + n * 2048 + k * 1024); } while (0)
#define PG8_MMA(ai, bj, At, Bt) do { __builtin_amdgcn_s_setprio(1); _Pragma("unroll") for (int m = 0; m < 4; ++m) _Pragma("unroll") for (int n = 0; n < 2; ++n) _Pragma("unroll") for (int k = 0; k < 2; ++k) \
        acc[ai][bj][m][n] = __builtin_amdgcn_mfma_f32_16x16x32_bf16(Bt[n][k], At[m][k], acc[ai][bj][m][n], 0, 0, 0); __builtin_amdgcn_s_setprio(0); } while (0)
#define PG8_WAIT_V(n) asm volatile("s_waitcnt vmcnt(" #n ")" ::: "memory")
#define PG8_WAIT_L(n) asm volatile("s_waitcnt lgkmcnt(" #n ")" ::: "memory")
#define PG8_BAR __builtin_amdgcn_s_barrier()
#define PG8_SCHED __builtin_amdgcn_sched_barrier(0)
    Unit cur, nxt; int ui = 0;
    if (!S.next(0, cur)) return;
    f32x4 acc[2][2][4][2];
#pragma unroll
    for (int a = 0; a < 2; ++a)
#pragma unroll
        for (int b = 0; b < 2; ++b)
#pragma unroll
            for (int m = 0; m < 4; ++m)
#pragma unroll
                for (int n = 0; n < 2; ++n) acc[a][b][m][n] = (f32x4){0.f, 0.f, 0.f, 0.f};
    bf16x8 At[4][2], B0[2][2], B1[2][2];
    const char* cA = (const char*)g.A + (size_t)cur.pm * tstep; const char* cB = (const char*)g.Bt + (size_t)cur.pn * tstep;
    S.a_ready(cur);
    if constexpr (SP2) {
        PG8_STAGE(PG8_SB(0, 0), cB, voffB); PG8_STAGE(PG8_SB(0, 1), cB + hstep, voffB); PG8_STAGE(PG8_SA(0, 0), cA, voffA); PG8_STAGE(PG8_SA(0, 1), cA + hstep, voffA);
        if (wr == 1) PG8_BAR;
        PG8_WAIT_V(2); PG8_BAR;
        PG8_STAGE(PG8_SB(1, 0), cB + kstep, voffB); PG8_STAGE(PG8_SA(1, 0), cA + kstep, voffA); PG8_STAGE(PG8_SB(1, 1), cB + hstep + kstep, voffB);
        PG8_WAIT_V(6); PG8_BAR;
    } else {
        PG8_STAGE(PG8_SB(0, 0), cB, voffB); PG8_STAGE(PG8_SA(0, 0), cA, voffA); PG8_STAGE(PG8_SB(0, 1), cB + hstep, voffB); PG8_STAGE(PG8_SA(0, 1), cA + hstep, voffA);
        if (wr == 1) PG8_BAR;
        PG8_WAIT_V(4); PG8_BAR;
        PG8_STAGE(PG8_SB(1, 0), cB + kstep, voffB); PG8_STAGE(PG8_SA(1, 0), cA + kstep, voffA); PG8_STAGE(PG8_SB(1, 1), cB + hstep + kstep, voffB);
        PG8_WAIT_V(6); PG8_BAR;
    }
    for (;;) {
        const bool has_next = S.next(ui + 1, nxt);
        const char* nA = has_next ? (const char*)g.A + (size_t)nxt.pm * tstep : cA; const char* nB = has_next ? (const char*)g.Bt + (size_t)nxt.pn * tstep : cB;
        for (int t = 0; t < nt; t += 2) {
            const bool last = (t == nt - 2);
            const char* a1 = cA + (size_t)(t + 1) * kstep;
            const char* a2 = last ? nA : cA + (size_t)(t + 2) * kstep; const char* b2 = last ? nB : cB + (size_t)(t + 2) * kstep;
            const char* a3 = a2 + kstep; const char* b3 = b2 + kstep;
            if (last && has_next) S.a_ready(nxt);
            if constexpr (SP2) {
            PG8_LDB(B0, 0, 0); PG8_LDB(B1, 0, 1); PG8_SCHED; PG8_LDA(At, 0, 0); PG8_STAGE(PG8_SA(1, 1), a1 + hstep, voffA);
            PG8_WAIT_V(8); PG8_WAIT_L(0); PG8_BAR; PG8_MMA(0, 0, At, B0); PG8_MMA(0, 1, At, B1); PG8_BAR; PG8_SCHED;
            PG8_LDA(At, 0, 1); PG8_STAGE(PG8_SB(0, 0), b2, voffB); PG8_STAGE(PG8_SB(0, 1), b2 + hstep, voffB); PG8_STAGE(PG8_SA(0, 0), a2, voffA);
            PG8_WAIT_V(8); PG8_WAIT_L(0); PG8_BAR; PG8_MMA(1, 0, At, B0); PG8_MMA(1, 1, At, B1); PG8_BAR; PG8_SCHED;
            PG8_LDB(B0, 1, 0); PG8_LDB(B1, 1, 1); PG8_SCHED; PG8_LDA(At, 1, 0); PG8_STAGE(PG8_SA(0, 1), a2 + hstep, voffA);
            PG8_WAIT_V(8); PG8_WAIT_L(0); PG8_BAR; PG8_MMA(0, 0, At, B0); PG8_MMA(0, 1, At, B1); PG8_BAR; PG8_SCHED;
            PG8_LDA(At, 1, 1); PG8_STAGE(PG8_SB(1, 0), b3, voffB); PG8_STAGE(PG8_SB(1, 1), b3 + hstep, voffB); PG8_STAGE(PG8_SA(1, 0), a3, voffA);
            PG8_WAIT_V(8); PG8_WAIT_L(0); PG8_BAR; PG8_MMA(1, 0, At, B0); PG8_MMA(1, 1, At, B1); PG8_BAR; PG8_SCHED;
            } else {
            PG8_LDB(B0, 0, 0); PG8_SCHED; PG8_LDA(At, 0, 0); PG8_STAGE(PG8_SA(1, 1), a1 + hstep, voffA);
            PG8_WAIT_L(8); PG8_BAR; PG8_WAIT_L(0); PG8_MMA(0, 0, At, B0); PG8_BAR; PG8_SCHED;
            PG8_LDB(B1, 0, 1); PG8_STAGE(PG8_SB(0, 0), b2, voffB);
            PG8_BAR; PG8_WAIT_L(0); PG8_MMA(0, 1, At, B1); PG8_BAR;
            PG8_LDA(At, 0, 1); PG8_STAGE(PG8_SA(0, 0), a2, voffA);
            PG8_BAR; PG8_WAIT_L(0); PG8_MMA(1, 0, At, B0); PG8_BAR; PG8_SCHED;
            PG8_STAGE(PG8_SB(0, 1), b2 + hstep, voffB);
            PG8_WAIT_V(6); PG8_BAR; PG8_MMA(1, 1, At, B1); PG8_BAR;
            PG8_LDB(B0, 1, 0); PG8_SCHED; PG8_LDA(At, 1, 0); PG8_STAGE(PG8_SA(0, 1), a2 + hstep, voffA);
            PG8_WAIT_L(8); PG8_BAR; PG8_WAIT_L(0); PG8_MMA(0, 0, At, B0); PG8_BAR; PG8_SCHED;
            PG8_LDB(B1, 1, 1); PG8_STAGE(PG8_SB(1, 0), b3, voffB);
            PG8_BAR; PG8_WAIT_L(0); PG8_MMA(0, 1, At, B1); PG8_BAR;
            PG8_LDA(At, 1, 1); PG8_STAGE(PG8_SA(1, 0), a3, voffA);
            PG8_BAR; PG8_WAIT_L(0); PG8_MMA(1, 0, At, B0); PG8_BAR; PG8_SCHED;
            PG8_STAGE(PG8_SB(1, 1), b3 + hstep, voffB);
            PG8_WAIT_V(6); PG8_BAR; PG8_MMA(1, 1, At, B1); PG8_BAR;
            }
        }
        if constexpr (ALIGN_EPI) { if (wr == 0) PG8_BAR; }
        if constexpr (!Epi::AFTER_DRAIN) { E(acc, cur, wr, wc, fr, fq); S.done(cur); }
        if (!has_next) break;
#pragma unroll
        for (int a = 0; a < 2; ++a)
#pragma unroll
            for (int b = 0; b < 2; ++b)
#pragma unroll
                for (int m = 0; m < 4; ++m)
#pragma unroll
                    for (int n = 0; n < 2; ++n) acc[a][b][m][n] = (f32x4){0.f, 0.f, 0.f, 0.f};
        cur = nxt; cA = nA; cB = nB; ++ui;
        if constexpr (ALIGN_EPI) { if (wr == 1) PG8_BAR; }
    }
    PG8_WAIT_V(0);
    if constexpr (!ALIGN_EPI) { if (wr == 0) PG8_BAR; }
    PG8_BAR;
    if constexpr (Epi::AFTER_DRAIN) { E.fused(acc, cur, wr, wc, fr, fq, lds, wid, lane); S.done(cur); }
#undef PG8_SA
#undef PG8_SB
#undef PG8_STAGE
#undef PG8_LDA
#undef PG8_LDB
#undef PG8_MMA
#undef PG8_WAIT_V
#undef PG8_WAIT_L
#undef PG8_BAR
#undef PG8_SCHED
}
}

namespace attn {
constexpr int KVP = HD, OP = DM;
constexpr float SCALE = 0.08838834764831845f;
constexpr int D = 128;
constexpr int NW = 8, QBLK = 32, KVBLK = 64, QB = NW * QBLK;
constexpr int SHM_V = KVBLK * D * 2, SHM_K = KVBLK * D * 2;
constexpr int FB_OFF = 2 * SHM_V + 2 * SHM_K + NW * 64 * 4;
constexpr int LDS_BYTES = FB_OFF + 2 * 64 * 4;
constexpr bool WSKIP = false;
constexpr float THR = 16.f;

using bf16 = __hip_bfloat16;
typedef short bf16x8 __attribute__((ext_vector_type(8)));
typedef short s16x4 __attribute__((ext_vector_type(4)));
typedef float f32x16 __attribute__((ext_vector_type(16)));
typedef float f32x4 __attribute__((ext_vector_type(4)));
typedef unsigned u32x4 __attribute__((ext_vector_type(4)));
template <class A, class Bt> struct same_t { static constexpr bool v = false; };
template <class A> struct same_t<A, A> { static constexpr bool v = true; };

#define KSWZ(row, colB) ((row) * 256 + ((colB) ^ (((row) & 7) << 4)))
#define SBAR() __builtin_amdgcn_sched_barrier(0)
__device__ __forceinline__ int v_st(int k, int c) { const int kk = (k & ~0xC) | ((k & 4) << 1) | ((k & 8) >> 1); return ((kk >> 3) * 4 + (c >> 5)) * 512 + ((kk & 7) * 32 + (c & 31)) * 2; }
__device__ __forceinline__ int v_rd_base(int lane) { return ((lane & 3) << 3) | (((lane >> 2) & 3) << 6) | (((lane >> 4) & 1) << 5) | (((lane >> 5) & 1) << 8); }
constexpr int v_rd_off(int d0, int ks, int half) { return d0 * 512 + ks * 4096 + half * 2048; }
__device__ __forceinline__ int crow(int r, int hi) { return (r & 3) + 8 * (r >> 2) + 4 * hi; }
__device__ __forceinline__ unsigned cvtpk(float lo, float hi) {
    unsigned r; asm volatile("v_cvt_pk_bf16_f32 %0, %1, %2" : "=v"(r) : "v"(lo), "v"(hi)); return r;
}
__device__ __forceinline__ bf16x8 pack8(f32x4 a, f32x4 b) {
    u32x4 w = {cvtpk(a[0], a[1]), cvtpk(a[2], a[3]), cvtpk(b[0], b[1]), cvtpk(b[2], b[3])};
    return *reinterpret_cast<bf16x8*>(&w);
}
template <class T> __device__ __forceinline__ bf16x8 load8(const T* p) {
    if constexpr (same_t<T, float>::v) { return pack8(*(const f32x4*)p, *(const f32x4*)(p + 4)); }
    else { return *reinterpret_cast<const bf16x8*>(p); }
}
__device__ __forceinline__ void mask_tile(f32x16& p0, f32x16& p1, int dq, unsigned W) {
    const float NEG = -__builtin_inff();
#pragma unroll
    for (int r = 0; r < 16; ++r) {
        const int c = (r & 3) + 8 * (r >> 2);
        if ((unsigned)(dq - c) >= W) p0[r] = NEG;
        if ((unsigned)(dq - c - 32) >= W) p1[r] = NEG;
    }
}
__device__ __forceinline__ void partialSM(f32x16& p0, f32x16& p1, float& m_reg, float& mn, float& alpha) {
    float pmax = p0[0]; for (int r = 1; r < 16; ++r) pmax = fmaxf(pmax, p0[r]); for (int r = 0; r < 16; ++r) pmax = fmaxf(pmax, p1[r]);
    { auto rr = __builtin_amdgcn_permlane32_swap(__float_as_uint(pmax), __float_as_uint(pmax), false, false);
      pmax = fmaxf(__uint_as_float(rr[0]), __uint_as_float(rr[1])); }
    constexpr float C2 = 1.4426950408889634f * SCALE;
    if (__builtin_expect(__all((pmax - m_reg) * SCALE <= THR), 1)) { mn = m_reg; alpha = 1.f; }
    else { mn = fmaxf(m_reg, pmax); alpha = __builtin_amdgcn_exp2f((m_reg - mn) * C2); m_reg = mn; }
    const float mnL = -mn * C2;
    for (int r = 0; r < 16; ++r) p0[r] = fmaf(p0[r], C2, mnL); for (int r = 0; r < 16; ++r) p1[r] = fmaf(p1[r], C2, mnL);
    for (int r = 0; r < 16; ++r) p0[r] = __builtin_amdgcn_exp2f(p0[r]);
}
__device__ __forceinline__ void finishSM(f32x16& p0, f32x16& p1, float alpha, float& l_reg, bf16x8& pa0, bf16x8& pa1, bf16x8& pa2, bf16x8& pa3) {
    for (int r = 0; r < 16; ++r) p1[r] = __builtin_amdgcn_exp2f(p1[r]);
    float ps = 0; for (int r = 0; r < 16; ++r) ps += p0[r]; for (int r = 0; r < 16; ++r) ps += p1[r];
    { auto rr = __builtin_amdgcn_permlane32_swap(__float_as_uint(ps), __float_as_uint(ps), false, false);
      ps = __uint_as_float(rr[0]) + __uint_as_float(rr[1]); }
    l_reg = l_reg * alpha + ps;
#define PK4(P, B_, OUT) do { unsigned a0 = cvtpk(P[B_+0], P[B_+1]), a1 = cvtpk(P[B_+2], P[B_+3]);                          \
        unsigned b0 = cvtpk(P[B_+4], P[B_+5]), b1 = cvtpk(P[B_+6], P[B_+7]);                                             \
        auto r0 = __builtin_amdgcn_permlane32_swap(a0, b0, false, false); auto r1 = __builtin_amdgcn_permlane32_swap(a1, b1, false, false); \
        u32x4 w = {r0[0], r1[0], r0[1], r1[1]}; OUT = *reinterpret_cast<bf16x8*>(&w); } while (0)
    PK4(p0, 0, pa0); PK4(p0, 8, pa1); PK4(p1, 0, pa2); PK4(p1, 8, pa3);
#undef PK4
}
template <int KB, bool SK>
__device__ __forceinline__ void qkt(f32x16& p0, f32x16& p1, const char* K_lds, int r32, int hi, const bf16x8* qr, bool act) {
    if (SK && !act) { const float NEG = -__builtin_inff();
#pragma unroll
        for (int r = 0; r < 16; ++r) { p0[r] = NEG; p1[r] = NEG; } return; }
    { const char* fb = K_lds + 2 * SHM_K + NW * 64 * 4 + KB * 256 + hi * 16;
#pragma unroll
      for (int g = 0; g < 4; ++g) { const f32x4 a = *reinterpret_cast<const f32x4*>(fb + g * 32), b = *reinterpret_cast<const f32x4*>(fb + 128 + g * 32);
          p0[4 * g] = a[0]; p0[4 * g + 1] = a[1]; p0[4 * g + 2] = a[2]; p0[4 * g + 3] = a[3]; p1[4 * g] = b[0]; p1[4 * g + 1] = b[1]; p1[4 * g + 2] = b[2]; p1[4 * g + 3] = b[3]; } }
    const char* kb[4];
#pragma unroll
    for (int dd = 0; dd < 4; ++dd) kb[dd] = K_lds + KB * SHM_K + KSWZ(r32, (dd * 16 + hi * 8) * 2);
#pragma unroll
    for (int d0 = 0; d0 < 8; ++d0) { const char* a = kb[d0 & 3] + (d0 >> 2) * 128;
        bf16x8 b0 = *reinterpret_cast<const bf16x8*>(a);
        bf16x8 b1 = *reinterpret_cast<const bf16x8*>(a + 32 * 256);
        p0 = __builtin_amdgcn_mfma_f32_32x32x16_bf16(b0, qr[d0], p0, 0, 0, 0);
        p1 = __builtin_amdgcn_mfma_f32_32x32x16_bf16(b1, qr[d0], p1, 0, 0, 0); }
}
template <int VB, bool SK>
__device__ __forceinline__ void pv_tile(f32x16* o, int vb0, bf16x8 pa0, bf16x8 pa1, bf16x8 pa2, bf16x8 pa3, bool act) {
    if (SK && !act) return;
#define TRRD(dst, off) asm volatile("ds_read_b64_tr_b16 %0, %1 offset:%2" : "=&v"(dst) : "v"(vb0), "i"(off) : "memory")
#define PV_D0(d0) do { s16x4 l0, l1, l2, l3, h0, h1, h2, h3; constexpr int b_ = VB * SHM_V + v_rd_off(d0, 0, 0);     \
        TRRD(l0, b_); TRRD(h0, b_ + 2048); TRRD(l1, b_ + 4096); TRRD(h1, b_ + 6144); TRRD(l2, b_ + 8192); TRRD(h2, b_ + 10240); TRRD(l3, b_ + 12288); TRRD(h3, b_ + 14336); \
        asm volatile("s_waitcnt lgkmcnt(0)" ::: "memory"); SBAR();                 \
        o[d0] = __builtin_amdgcn_mfma_f32_32x32x16_bf16(pa0, (bf16x8){l0[0], l0[1], l0[2], l0[3], h0[0], h0[1], h0[2], h0[3]}, o[d0], 0, 0, 0);   \
        o[d0] = __builtin_amdgcn_mfma_f32_32x32x16_bf16(pa1, (bf16x8){l1[0], l1[1], l1[2], l1[3], h1[0], h1[1], h1[2], h1[3]}, o[d0], 0, 0, 0);   \
        o[d0] = __builtin_amdgcn_mfma_f32_32x32x16_bf16(pa2, (bf16x8){l2[0], l2[1], l2[2], l2[3], h2[0], h2[1], h2[2], h2[3]}, o[d0], 0, 0, 0);   \
        o[d0] = __builtin_amdgcn_mfma_f32_32x32x16_bf16(pa3, (bf16x8){l3[0], l3[1], l3[2], l3[3], h3[0], h3[1], h3[2], h3[3]}, o[d0], 0, 0, 0); } while (0)
    PV_D0(0); PV_D0(1); PV_D0(2); PV_D0(3);
#undef PV_D0
#undef TRRD
}

template <class TIn, class TOut> struct BlockRef { const TIn* Q; const TIn* K; const TIn* V; const float* F; TOut* O; int P0; int JLO; };
template <class TIn> struct Seam {
    bf16x8 qr[8];
    bf16x8 st_v0, st_v1, st_k0, st_k1; float st_f; f32x4 sf0, sf1, sf2, sf3;
    f32x4 tq[16];
};
__device__ __forceinline__ int swa_jlo(int P0, int W) { const int lowk = P0 - W + 1; return lowk > 0 ? lowk / KVBLK : 0; }
#define ROW(p, k0, rr) ((p) + (size_t)((k0) + (rr)) * KVP + sc)
#define VMW() asm volatile("s_waitcnt vmcnt(0)" ::: "memory")
#define VMWN(n) asm volatile("s_waitcnt vmcnt(%0)" :: "i"(n) : "memory")
#define SLOAD_H(Kp, Vp, Fp, k0) do { S.st_v0 = load8<TIn>(ROW(Vp, k0, sr)); S.st_v1 = load8<TIn>(ROW(Vp, k0, 32 + sr));              \
                         S.st_k0 = load8<TIn>(ROW(Kp, k0, sr)); S.st_k1 = load8<TIn>(ROW(Kp, k0, 32 + sr)); if (tid < 64) S.st_f = (Fp)[(k0) + tid]; } while (0)
#define SWRITE_HK(bf) do { *(bf16x8*)(K_lds + (bf) * SHM_K + kws) = S.st_k0; *(bf16x8*)(K_lds + (bf) * SHM_K + kws + 32 * 256) = S.st_k1; if (tid < 64) *(float*)(K_lds + 2 * SHM_K + NW * 64 * 4 + (bf) * 256 + tid * 4) = S.st_f; } while (0)
#define SWRITE_HV(bf) do { *(bf16x8*)(V_lds + (bf) * SHM_V + vst0) = S.st_v0; *(bf16x8*)(V_lds + (bf) * SHM_V + vst1) = S.st_v1; } while (0)
#define SWRITE_H(bf) do { SWRITE_HV(bf); SWRITE_HK(bf); } while (0)
#define SLOAD_F(p, k0) do { S.sf0 = *(const f32x4*)ROW(p, k0, sr); S.sf1 = *(const f32x4*)(ROW(p, k0, sr) + 4);                \
                            S.sf2 = *(const f32x4*)ROW(p, k0, 32 + sr); S.sf3 = *(const f32x4*)(ROW(p, k0, 32 + sr) + 4); } while (0)
#define SWRITE_KF(bf) do { *(bf16x8*)(K_lds + (bf) * SHM_K + kws) = pack8(S.sf0, S.sf1); *(bf16x8*)(K_lds + (bf) * SHM_K + kws + 32 * 256) = pack8(S.sf2, S.sf3); } while (0)
#define SWRITE_VF(bf) do { *(bf16x8*)(V_lds + (bf) * SHM_V + vst0) = pack8(S.sf0, S.sf1); *(bf16x8*)(V_lds + (bf) * SHM_V + vst1) = pack8(S.sf2, S.sf3); } while (0)
template <class TIn, class TOut>
__device__ __forceinline__ void causal_swa_prime(const BlockRef<TIn, TOut>& cur, int W, char* lds, Seam<TIn>& S) {
    constexpr bool F32 = same_t<TIn, float>::v;
    int tid_ = my_tid(); asm volatile("" : "+v"(tid_));
    const int tid = tid_, wid = __builtin_amdgcn_readfirstlane(tid >> 6), lane = tid & 63, r32 = lane & 31, hi = lane >> 5;
    const int sr = tid >> 4, sc = (tid & 15) * 8, kws = KSWZ(sr, sc * 2); char* K_lds = lds + 2 * SHM_V;
    const int kb0 = cur.JLO * KVBLK;
    for (int d0 = 0; d0 < 8; ++d0) S.qr[d0] = load8<TIn>(cur.Q + (size_t)(wid * QBLK + r32) * KVP + d0 * 16 + hi * 8);
    if constexpr (F32) { SLOAD_F((const float*)cur.K, kb0); VMW(); SWRITE_KF(0); SBAR(); SLOAD_F((const float*)cur.V, kb0); }
    else { SLOAD_H(cur.K, cur.V, cur.F, kb0); VMW(); SWRITE_HK(0); }
    __syncthreads();
}
template <class TIn, class TOut>
__device__ __forceinline__ void causal_swa_block(const BlockRef<TIn, TOut>& cur, const BlockRef<TIn, TOut>& nxt, int skv, int W, char* lds, Seam<TIn>& S, const float* const __attribute__((address_space(4)))* gslot, int goff) {
    constexpr bool F32 = same_t<TIn, float>::v;
    int tid_ = my_tid(); asm volatile("" : "+v"(tid_));
    const int tid = tid_, wid = __builtin_amdgcn_readfirstlane(tid >> 6), lane = tid & 63, r32 = lane & 31, hi = lane >> 5;
    const int j_lo = cur.JLO;
    int j_hi = (cur.P0 + QB - 1) / KVBLK + 1; if (j_hi > skv / KVBLK) j_hi = skv / KVBLK;
    const int NT = j_hi - j_lo;
    const int kbn = nxt.JLO * KVBLK;
    const int qlo = cur.P0 + wid * QBLK, qm = qlo + r32 - 4 * hi;
    char* V_lds = lds; char* K_lds = lds + 2 * SHM_V;
    float* ws = (float*)(lds + 2 * SHM_V + 2 * SHM_K) + wid * 64; float* li_l = ws, * al_l = ws + 32;
    float m_reg = -1e30f, l_reg = 0; f32x16 o[4] = {};
    const int sr = tid >> 4, sc = (tid & 15) * 8, vst0 = v_st(sr, sc), vst1 = v_st(32 + sr, sc), kws = KSWZ(sr, sc * 2);
    const int vb0 = (int)(uintptr_t)V_lds + v_rd_base(lane);
    const TIn* Kh = cur.K; const TIn* Vh = cur.V; const float* Fh = cur.F;
#define RESC(a) do { if (__any((a) < 1.f)) { if (hi == 0) al_l[r32] = (a); asm volatile("s_waitcnt lgkmcnt(0)" ::: "memory");              \
                     for (int d_ = 0; d_ < 4; ++d_) for (int r = 0; r < 16; ++r) o[d_][r] *= al_l[crow(r, hi)]; } } while (0)
#define KBASE(t) ((j_lo + (t)) * KVBLK)
#define ACT(t) (KBASE(t) <= qlo + QBLK - 1 && KBASE(t) + KVBLK - 1 >= qlo - W + 1)
#define MASKT(P0_, P1_, t) do { const int kb_ = KBASE(t); if ((!SK || ACT(t)) && (kb_ + KVBLK - 1 > qlo || kb_ <= qlo + QBLK - 1 - W)) mask_tile(P0_, P1_, qm - kb_, (unsigned)W); } while (0)
    constexpr int NQL = F32 ? 16 : 8;
    constexpr bool SK = WSKIP && !F32;
#define SEAM_K0() do { VMWN(NQL); if constexpr (F32) { SWRITE_KF(0); SBAR(); SLOAD_F((const float*)nxt.V, kbn); } else { SWRITE_HK(0); } SBAR(); } while (0)
    f32x16 pA0, pA1, pB0, pB1; float mnA, mnB, alA, alB; bf16x8 pa0, pa1, pa2, pa3;
    if constexpr (F32) { VMW(); SWRITE_VF(0); SBAR(); } else { SWRITE_HV(0); SBAR(); }
    if (NT > 1) { if constexpr (F32) SLOAD_F((const float*)Kh, KBASE(1)); else SLOAD_H(Kh, Vh, Fh, KBASE(1)); }
    SBAR(); qkt<0, SK>(pA0, pA1, K_lds, r32, hi, S.qr, ACT(0));
    if constexpr (F32) { if (NT > 1) { VMW(); SWRITE_KF(1); SBAR(); SLOAD_F((const float*)Vh, KBASE(1)); } }
    MASKT(pA0, pA1, 0); partialSM(pA0, pA1, m_reg, mnA, alA);
    if (NT > 1) { VMW(); if constexpr (F32) { SWRITE_VF(1); SBAR(); if (NT > 2) SLOAD_F((const float*)Kh, KBASE(2)); } else SWRITE_H(1); }
    __syncthreads();
#define HALF_STEP(PX0, PX1, mnX, alX, PY0, PY1, alY, t, KB, VB, SB) do {                                                      \
        SBAR(); qkt<KB, SK>(PX0, PX1, K_lds, r32, hi, S.qr, ACT(t));                                             \
        finishSM(PY0, PY1, alY, l_reg, pa0, pa1, pa2, pa3); SBAR();                                                           \
        if ((t) + 1 < NT) { if constexpr (F32) { VMW(); SWRITE_KF(SB); SBAR(); SLOAD_F((const float*)Vh, KBASE((t) + 1)); }  \
                            else { SLOAD_H(Kh, Vh, Fh, KBASE((t) + 1)); } SBAR(); }                                               \
        pv_tile<VB, SK>(o, vb0, pa0, pa1, pa2, pa3, ACT((t) - 1)); MASKT(PX0, PX1, (t)); partialSM(PX0, PX1, m_reg, mnX, alX);                                        \
        __syncthreads();                                                                                                      \
        if ((t) + 1 < NT) { VMW(); if constexpr (F32) { SWRITE_VF(SB); SBAR(); if ((t) + 2 < NT) SLOAD_F((const float*)Kh, KBASE((t) + 2)); } \
                            else { SWRITE_H(SB); } }                                                                          \
        RESC(alX); __syncthreads(); } while (0)
    for (int t = 1; t + 1 < NT; t += 2) {
        HALF_STEP(pB0, pB1, mnB, alB, pA0, pA1, alA, t, 1, 0, 0);
        HALF_STEP(pA0, pA1, mnA, alA, pB0, pB1, alB, t + 1, 0, 1, 1);
    }
    const bool even = (NT & 1) == 0;
    if (even) { SBAR(); qkt<1, SK>(pB0, pB1, K_lds, r32, hi, S.qr, ACT(NT - 1)); SBAR(); }
#define QROW(e) (nxt.Q + (size_t)(wid * QBLK + r32) * KVP + ((e) >> 1) * 16 + hi * 8 + ((e) & 1) * 4)
    if constexpr (F32) { SLOAD_F((const float*)nxt.K, kbn); SBAR();
#pragma unroll
        for (int e = 0; e < 8; ++e) S.tq[e] = *(const f32x4*)QROW(e); }
    else { SLOAD_H(nxt.K, nxt.V, nxt.F, kbn); SBAR();
#pragma unroll
        for (int d0 = 0; d0 < 8; ++d0) S.qr[d0] = load8<TIn>(nxt.Q + (size_t)(wid * QBLK + r32) * KVP + d0 * 16 + hi * 8); }
    SBAR();
    finishSM(pA0, pA1, alA, l_reg, pa0, pa1, pa2, pa3); SBAR();
    if constexpr (F32) {
#pragma unroll
        for (int e = 8; e < 16; ++e) S.tq[e] = *(const f32x4*)QROW(e); SBAR(); }
#undef QROW
    pv_tile<0, SK>(o, vb0, pa0, pa1, pa2, pa3, ACT(even ? NT - 2 : NT - 1));
    if (even) { MASKT(pB0, pB1, NT - 1); partialSM(pB0, pB1, m_reg, mnB, alB); __syncthreads(); RESC(alB);
        finishSM(pB0, pB1, alB, l_reg, pa0, pa1, pa2, pa3); SBAR(); pv_tile<1, SK>(o, vb0, pa0, pa1, pa2, pa3, ACT(NT - 1)); }
    SBAR(); SEAM_K0();
    if (hi == 0) li_l[r32] = l_reg; asm volatile("s_waitcnt lgkmcnt(0)" ::: "memory");
    float rli[16];
#pragma unroll
    for (int r = 0; r < 16; ++r) rli[r] = __builtin_amdgcn_rcpf(li_l[crow(r, hi)]);
    TOut* Ow = cur.O + (size_t)(wid * QBLK) * OP;
    float gn[4];
    { const float* G = *gslot + goff;
#pragma unroll
    for (int d0 = 0; d0 < 4; ++d0) gn[d0] = G[d0 * 32 + r32]; }
#pragma unroll
    for (int r = 0; r < 16; ++r) { const int orow = crow(r, hi);
        float y[4]; float ss = 0.f;
#pragma unroll
        for (int d0 = 0; d0 < 4; ++d0) { y[d0] = o[d0][r] * rli[r]; ss += y[d0] * y[d0]; }
        ss += __shfl_xor(ss, 1); ss += __shfl_xor(ss, 2); ss += __shfl_xor(ss, 4); ss += __shfl_xor(ss, 8); ss += __shfl_xor(ss, 16);
        const float rs = __builtin_amdgcn_rsqf(ss * (1.0f / 128.0f) + 1e-6f);
#pragma unroll
        for (int d0 = 0; d0 < 4; ++d0) { const float v = y[d0] * rs * gn[d0];
            if constexpr (same_t<TOut, float>::v) { Ow[(size_t)orow * OP + d0 * 32 + r32] = v; }
            else { const float vn = __shfl_xor(v, 1);
                   if ((r32 & 1) == 0) *(unsigned*)(Ow + (size_t)orow * OP + d0 * 32 + r32) = cvtpk(v, vn); } }
        SBAR(); }
    if constexpr (F32) {
#pragma unroll
        for (int d0 = 0; d0 < 8; ++d0) S.qr[d0] = pack8(S.tq[2 * d0], S.tq[2 * d0 + 1]); }
    __syncthreads();
#undef RESC
#undef KBASE
#undef ACT
#undef MASKT
#undef SEAM_K0
#undef HALF_STEP
}
#undef ROW
#undef VMW
#undef VMWN
#undef SLOAD_H
#undef SWRITE_HK
#undef SWRITE_HV
#undef SWRITE_H
#undef SLOAD_F
#undef SWRITE_KF
#undef SWRITE_VF


}

__device__ __forceinline__ float bflo(unsigned w) { return __uint_as_float(w << 16); }
__device__ __forceinline__ float bfhi(unsigned w) { return __uint_as_float(w & 0xffff0000u); }
__device__ __forceinline__ float wave_sum(float v) {
#pragma unroll
    for (int o = 1; o < 64; o <<= 1) v += __shfl_xor(v, o);
    return v;
}
__device__ __forceinline__ float sigmoid_f(float x) { return 1.0f / (1.0f + __expf(-x)); }
__device__ __forceinline__ float silu_acc(float x) { return x / (1.0f + __expf(-x)); }
__device__ __forceinline__ float softplus_f(float x) { return fmaxf(x, 0.f) + log1pf(__expf(-fabsf(x))); }
__device__ __forceinline__ float logsigmoid_f(float x) { return fminf(x, 0.f) - log1pf(__expf(-fabsf(x))); }

struct Args { const float* in[17]; float* out; unsigned char* ws; int ph_lo, ph_hi; };
typedef const __attribute__((address_space(4))) Args* ArgsP;
enum { I_X = 0, I_MIXPRE, I_WIN, I_FOXFB, I_FOXON, I_SCW, I_GDNCW, I_GDNALOG, I_GDNDTB, I_GDNON, I_WOUT, I_MIXPOST, I_FFNPRE, I_WGATE, I_WUP, I_WDOWN, I_FFNPOST };
struct Ptrs {
    ArgsP ap;
    int tid, lane, wave, gw, NGW, G, bid;
};
__device__ __forceinline__ Ptrs fresh_ptrs(ArgsP ap0);
__device__ __forceinline__ int ftid() { int t = my_tid(); asm volatile("" : "+v"(t)); return t; }
__device__ __forceinline__ int fbid() { int b = blockIdx.x; asm volatile("" : "+s"(b)); return b; }
__device__ __forceinline__ ArgsP fresh(ArgsP a) { asm volatile("" : "+s"(a)); return a; }
__device__ __forceinline__ Ptrs fresh_ptrs(ArgsP ap0) { Ptrs P; P.ap = fresh(ap0); P.tid = ftid(); P.lane = P.tid & 63; P.wave = __builtin_amdgcn_readfirstlane(P.tid >> 6); P.bid = fbid();
    P.G = gridDim.x; P.gw = P.bid * NWAVES + P.wave; P.NGW = P.G * NWAVES; return P; }

__device__ __forceinline__ int win_src4(int d) {
    if (d < PC_SB) return d;
    if (d < PC_GQ) return d - PC_SB + SRC_SB;
    if (d < PC_GZ) return d - PC_GQ + SRC_GQ;
    if (d < PC_SMALL) return d - PC_GZ + SRC_GZ;
    const int e = d - PC_SMALL;
    if (e < 12) return SRC_FF + e;
    if (e < 24) return SRC_GA + e - 12;
    if (e < 36) return SRC_GB + e - 24;
    return -1;
}
__device__ __forceinline__ void tr_item(const float* __restrict__ W, int Ns, int scol, int k0, bf16* WT, int K, int dn0, LAS float* scr, int lane) {
    const int sub = lane >> 3, g = lane & 7;
    f32x4 v[8];
#pragma unroll
    for (int i = 0; i < 8; ++i) { const int kk = 8 * i + sub; v[i] = (f32x4){0.f, 0.f, 0.f, 0.f}; if (scol >= 0) v[i] = *(const f32x4*)(W + (size_t)(k0 + kk) * Ns + scol); }
#pragma unroll
    for (int i = 0; i < 8; ++i) { const int kk = 8 * i + sub; LAS float* s = scr + kk * 33 + 4 * g; s[0] = v[i][0]; s[1] = v[i][1]; s[2] = v[i][2]; s[3] = v[i][3]; }
    LDS_WAIT(); asm volatile("" ::: "memory");
    const int c = lane & 7;
#pragma unroll
    for (int j = 0; j < 4; ++j) { const int n = (lane >> 3) + 8 * j; const LAS float* s = scr + (8 * c) * 33 + n;
        v4u o; o.x = pk2(s[0 * 33], s[1 * 33]); o.y = pk2(s[2 * 33], s[3 * 33]); o.z = pk2(s[4 * 33], s[5 * 33]); o.w = pk2(s[6 * 33], s[7 * 33]);
        *(v4u*)(WT + (size_t)(dn0 + n) * K + k0 + 8 * c) = o; }
    LDS_WAIT(); asm volatile("" ::: "memory");
}
constexpr int I_IN = 64 * (NP / 32), I_OUT = 64 * (DM / 32), I_GU = 64 * (NGU / 32), I_DN = (FFN / 64) * (DM / 32), I_LAYER = I_IN + I_OUT + I_GU + I_DN;

typedef unsigned u32x2t __attribute__((ext_vector_type(2)));
__device__ __forceinline__ float sq4(const f32x4 v) { return (v[0] * v[0] + v[1] * v[1]) + (v[2] * v[2] + v[3] * v[3]); }
__device__ __forceinline__ void rms_row_to_bf16(const float* xrow, const float* gain, bf16* orow, int lane) {
    f32x4 a[16]; float ss = 0.f;
#pragma unroll
    for (int j = 0; j < 16; ++j) { a[j] = *(const f32x4*)(xrow + 256 * j + 4 * lane); ss += sq4(a[j]); }
    const float r = 1.0f / sqrtf(wave_sum(ss) * (1.0f / DM) + RMS_EPS);
#pragma unroll
    for (int j = 0; j < 16; ++j) { const f32x4 g = *(const f32x4*)(gain + 256 * j + 4 * lane);
        u32x2t o; o.x = pk2(a[j][0] * r * g[0], a[j][1] * r * g[1]); o.y = pk2(a[j][2] * r * g[2], a[j][3] * r * g[3]);
        *(u32x2t*)(orow + 256 * j + 4 * lane) = o; }
}
__device__ __forceinline__ void resid_norm_row(const float* base_row, const bf16* yrow, const float* ssrow, const float* gpost, float* out_row, const float* gnext, bf16* xn_row, int lane) {
    const float ry = 1.0f / sqrtf(wave_sum(ssrow[lane]) * (1.0f / DM) + RMS_EPS);
    f32x4 a[16]; float ss = 0.f;
#pragma unroll
    for (int j = 0; j < 16; ++j) { const int c = 256 * j + 4 * lane; const u32x2t yw = *(const u32x2t*)(yrow + c);
        const f32x4 x0 = *(const f32x4*)(base_row + c), g0 = *(const f32x4*)(gpost + c);
        a[j][0] = x0[0] + bflo(yw.x) * ry * g0[0]; a[j][1] = x0[1] + bfhi(yw.x) * ry * g0[1]; a[j][2] = x0[2] + bflo(yw.y) * ry * g0[2]; a[j][3] = x0[3] + bfhi(yw.y) * ry * g0[3];
        *(f32x4*)(out_row + c) = a[j]; ss += sq4(a[j]); }
    if (gnext) {
        const float r = 1.0f / sqrtf(wave_sum(ss) * (1.0f / DM) + RMS_EPS);
#pragma unroll
        for (int j = 0; j < 16; ++j) { const f32x4 g = *(const f32x4*)(gnext + 256 * j + 4 * lane);
            u32x2t o; o.x = pk2(a[j][0] * r * g[0], a[j][1] * r * g[1]); o.y = pk2(a[j][2] * r * g[2], a[j][3] * r * g[3]);
            *(u32x2t*)(xn_row + 256 * j + 4 * lane) = o; }
    }
}

__device__ __forceinline__ void convert_weights(ArgsP ap0, LAS unsigned char* lds, int l, int lo = 0, int hi = I_LAYER, int wg_lo = 0) {
    const Ptrs P = fresh_ptrs(ap0); const ArgsP A = P.ap;
    if (P.bid < wg_lo) return;
    LAS float* scr = (LAS float*)(lds + P.wave * 16384);
    const int g = P.lane & 7;
    bf16* wl = (bf16*)(A->ws + WS_W);
    for (int it = lo + (P.bid - wg_lo) * NWAVES + P.wave; it < hi; it += (P.G - wg_lo) * NWAVES) {
        int r = it;
        if (r < I_IN) { const int kb = r / (NP / 32), nb = r % (NP / 32);
            tr_item(A->in[I_WIN] + (size_t)l * DM * PROJ_SRC, PROJ_SRC, win_src4(32 * nb + 4 * g), 64 * kb, (bf16*)((unsigned char*)wl + WO_IN), DM, 32 * nb, scr, P.lane); continue; }
        r -= I_IN;
        if (r < I_OUT) { const int kb = r / (DM / 32), nb = r % (DM / 32);
            tr_item(A->in[I_WOUT] + (size_t)l * DM * DM, DM, 32 * nb + 4 * g, 64 * kb, (bf16*)((unsigned char*)wl + WO_OUT), DM, 32 * nb, scr, P.lane); continue; }
        r -= I_OUT;
        if (r < I_GU) { const int kb = r / (NGU / 32), nb = r % (NGU / 32), dn0 = 32 * nb, j = dn0 >> 8, w = dn0 & 255;
            const float* src = (w < 128 ? A->in[I_WGATE] : A->in[I_WUP]) + (size_t)l * DM * FFN;
            tr_item(src, FFN, 128 * j + (w & 127) + 4 * g, 64 * kb, (bf16*)((unsigned char*)wl + WO_GU), DM, dn0, scr, P.lane); continue; }
        r -= I_GU;
        { const int kb = r / (DM / 32), nb = r % (DM / 32);
            tr_item(A->in[I_WDOWN] + (size_t)l * FFN * DM, DM, 32 * nb + 4 * g, 64 * kb, (bf16*)((unsigned char*)wl + WO_DN), FFN, 32 * nb, scr, P.lane); }
    }
}
__device__ __forceinline__ void p0_prologue(ArgsP ap0, LAS unsigned char* lds) {
    convert_weights(ap0, lds, 0, 0, I_IN + I_OUT + I_GU);
    const Ptrs P = fresh_ptrs(ap0); const ArgsP A = P.ap;
    bf16* XN = (bf16*)(A->ws + WS_XN);
    for (int m = P.gw; m < M; m += P.NGW) rms_row_to_bf16(A->in[I_X] + (size_t)m * DM, A->in[I_MIXPRE], XN + (size_t)m * DM, P.lane);
}

__device__ __forceinline__ void p2_prep(ArgsP ap0, LAS unsigned char* lds, int l) {
    const Ptrs P = fresh_ptrs(ap0); const ArgsP A = P.ap;
    const bf16* SCB = (const bf16*)(A->ws + WS_SCB); const float* SB = (const float*)(A->ws + WS_SB);
    bf16* MIX = (bf16*)(A->ws + WS_MIX); float* FG = (float*)(A->ws + WS_FG);
    const int lane = P.lane;
    if (P.bid < BATCH * FOXH) {
        const int bh = P.bid, b = bh / FOXH, h = bh % FOXH; const float fb = A->in[I_FOXFB][l * FOXH + h];
        const float* sb = SB + ((size_t)(b * SEQ) + 16 * P.tid) * SBW + SB_FF + h;
        float ls[16]; float loc = 0.f;
#pragma unroll
        for (int i = 0; i < 16; ++i) ls[i] = sb[(size_t)i * SBW];
#pragma unroll
        for (int i = 0; i < 16; ++i) { ls[i] = logsigmoid_f(ls[i] + fb); loc += ls[i]; }
        float incl = loc;
#pragma unroll
        for (int o = 1; o < 64; o <<= 1) { const float n = __shfl_up(incl, o); if (lane >= o) incl += n; }
        LAS float* wt = (LAS float*)lds;
        if (lane == 63) wt[P.wave] = incl;
        __syncthreads();
        float run = incl - loc;
        for (int w = 0; w < P.wave; ++w) run += wt[w];
        f32x4 o4[4];
#pragma unroll
        for (int i = 0; i < 16; ++i) { run += ls[i]; o4[i >> 2][i & 3] = -run * 11.313708498984761f; }
        float* fo = FG + (size_t)bh * SEQ + 16 * P.tid;
#pragma unroll
        for (int i = 0; i < 4; ++i) *(f32x4*)(fo + 4 * i) = o4[i];
        __syncthreads();
    }
    { const bf16* HMq = (const bf16*)(A->ws + WS_PROJ); float* TN = (float*)(A->ws + WS_TN);
      constexpr int NT_ = BATCH * FOXH * (SEQ / 64);
      for (int it = P.gw; it < NT_; it += P.NGW) {
        const int bh = it / (SEQ / 64), c = it % (SEQ / 64);
        const v4u* qrow = (const v4u*)(HMq + hm_off(HM_FQ, bh) + (size_t)(c * 64 + lane) * HD); const v4u* krow = (const v4u*)(HMq + hm_off(HM_FK, bh) + (size_t)(c * 64 + lane) * HD);
        v4u qv[16], kv[16];
#pragma unroll
        for (int j = 0; j < 16; ++j) { qv[j] = qrow[j]; kv[j] = krow[j]; }
        float sq = 0.f, sk = 0.f, d = 0.f;
#pragma unroll
        for (int j = 0; j < 16; ++j) {
#pragma unroll
            for (int e4 = 0; e4 < 4; ++e4) { const unsigned a = e4 == 0 ? qv[j].x : e4 == 1 ? qv[j].y : e4 == 2 ? qv[j].z : qv[j].w, b = e4 == 0 ? kv[j].x : e4 == 1 ? kv[j].y : e4 == 2 ? kv[j].z : kv[j].w;
                const float a0 = bflo(a), a1 = bfhi(a), b0 = bflo(b), b1 = bfhi(b); sq += a0 * a0 + a1 * a1; sk += b0 * b0 + b1 * b1; d += a0 * b0 + a1 * b1; } }
#pragma unroll
        for (int o = 1; o < 64; o <<= 1) { sq = fmaxf(sq, __shfl_xor(sq, o)); sk = fmaxf(sk, __shfl_xor(sk, o)); d = fminf(d, __shfl_xor(d, o)); }
        if (lane == 0) { TN[it] = sq; TN[NT_ + it] = sk; TN[2 * NT_ + it] = d; }
      } }
    { const float* cw = A->in[I_SCW] + (size_t)l * 3 * SCW;
      for (int idx = P.bid * 512 + P.tid; idx < M * (SCW / 8); idx += P.G * 512) {
        const int m = idx >> 7, c = (idx & 127) * 8, tp = m & (SEQ - 1);
        const bf16* row = SCB + (size_t)m * SCBW;
        const v4u bw = *(const v4u*)(row + c);
        float acc[8];
#pragma unroll
        for (int e = 0; e < 8; ++e) acc[e] = 0.f;
#pragma unroll
        for (int j = 0; j < 3; ++j) { const int dt = 2 - j;
            if (tp - dt >= 0) { const bf16* rj = row - (size_t)dt * SCBW; const v4u cwv = *(const v4u*)(rj + SCW + c), hw = *(const v4u*)(rj + 2 * SCW + c);
                const f32x4 w0 = *(const f32x4*)(cw + j * SCW + c), w1 = *(const f32x4*)(cw + j * SCW + c + 4);
                acc[0] += w0[0] * bflo(cwv.x) * bflo(hw.x); acc[1] += w0[1] * bfhi(cwv.x) * bfhi(hw.x); acc[2] += w0[2] * bflo(cwv.y) * bflo(hw.y); acc[3] += w0[3] * bfhi(cwv.y) * bfhi(hw.y);
                acc[4] += w1[0] * bflo(cwv.z) * bflo(hw.z); acc[5] += w1[1] * bfhi(cwv.z) * bfhi(hw.z); acc[6] += w1[2] * bflo(cwv.w) * bflo(hw.w); acc[7] += w1[3] * bfhi(cwv.w) * bfhi(hw.w); } }
        v4u o; o.x = pk2(acc[0] * bflo(bw.x), acc[1] * bfhi(bw.x)); o.y = pk2(acc[2] * bflo(bw.y), acc[3] * bfhi(bw.y)); o.z = pk2(acc[4] * bflo(bw.z), acc[5] * bfhi(bw.z)); o.w = pk2(acc[6] * bflo(bw.w), acc[7] * bfhi(bw.w));
        *(v4u*)(MIX + (size_t)m * DM + FOXW + c) = o; } }
}


#ifndef GP_REP_S1
#define GP_REP_S1 1
#endif
#ifndef GP_REP_S4
#define GP_REP_S4 1
#endif
constexpr int GD_OPS_BYTES = 57344;
constexpr int GD_F_WN = 0, GD_F_QD = 16, GD_F_AT = 32, GD_F_KT = 40;
constexpr int GD_NCH = SEQ / 64;
constexpr int GD_NCHH = BATCH * GDNH * GD_NCH;
constexpr size_t WS_GOPS = WS_Y, WS_GU = WS_Y + 168 * MiB, WS_GL = WS_Y + 264 * MiB, WS_GO2 = WS_Y + 266 * MiB;
constexpr int GP_QS = 0, GP_KS = 17408, GP_VS = 34816, GP_LT = 68608, GP_AT = 86016, GP_WM = 103424, GP_SM = 120832;
typedef float f32x2v __attribute__((ext_vector_type(2)));
typedef unsigned u32x2v __attribute__((ext_vector_type(2)));
typedef __bf16 bf16x2c_t __attribute__((ext_vector_type(2)));
__device__ __forceinline__ unsigned cvtpk_bf16(float lo, float hi) { const f32x2v v = {lo, hi}; const bf16x2c_t b = __builtin_convertvector(v, bf16x2c_t); return __builtin_bit_cast(unsigned, b); }


template <int N> __device__ __forceinline__ void fma_bcast(float& x, float l, float nxi) {
    asm volatile("v_fmac_f32_dpp %0, %1, %2 row_newbcast:%3 row_mask:0xf bank_mask:0xf" : "+v"(x) : "v"(l), "v"(nxi), "n"(N));
}
template <int I, int R> struct TriRow {
    static __device__ __forceinline__ void run(float (&x)[64], const float (&L)[4], float nxi) { fma_bcast<(R & 15)>(x[R], L[R >> 4], nxi); TriRow<I, R + 1>::run(x, L, nxi); }
};
template <int I> struct TriRow<I, 64> { static __device__ __forceinline__ void run(float (&)[64], const float (&)[4], float) {} };
template <int I> struct TriSolve {
    static __device__ __forceinline__ void run(float (&x)[64], const LAS float* ltb, float (&Lc)[4]) {
        float Ln[4] = {0.f, 0.f, 0.f, 0.f};
        if (I + 1 < 63) {
#pragma unroll
            for (int q = (I + 2) >> 4; q < 4; ++q) Ln[q] = ltb[(I + 1) * 68 + 16 * q]; }
        const float nxi = -x[I];
        asm volatile("s_nop 1" ::: "memory");
        TriRow<I, I + 1>::run(x, Lc, nxi);
#pragma unroll
        for (int q = 0; q < 4; ++q) Lc[q] = Ln[q];
        TriSolve<I + 1>::run(x, ltb, Lc);
    }
};
template <> struct TriSolve<63> { static __device__ __forceinline__ void run(float (&)[64], const LAS float*, float (&)[4]) {} };


template <int NT>
__device__ __forceinline__ void gp_s1(LAS unsigned char* lds, const bf16* HMG, const float* cw, int ch, int ltid) {
    const int bh = ch / GD_NCH, n = ch % GD_NCH, h = bh % GDNH;
    constexpr int NI = 3072 / NT, PER = NI / 3, ROWS = NT / 16, NB = (NT == 256 ? 4 : 3);
    const int c = (ltid & 15) * 8;
#pragma unroll
    for (int i0 = 0; i0 < NI; i0 += NB) {
        v4u xw[NB][4];
#pragma unroll
        for (int ib = 0; ib < NB; ++ib) { const int i = i0 + ib, part = i / PER, t = (i % PER) * ROWS + (ltid >> 4), tp = n * 64 + t;
            const bf16* src = HMG + hm_off(part, bh) + (size_t)(n * 64 + t) * HD + c;
#pragma unroll
            for (int j = 0; j < 4; ++j) { xw[ib][j] = (v4u){0u, 0u, 0u, 0u}; if (tp - (3 - j) >= 0) xw[ib][j] = *(const v4u*)(src - (size_t)(3 - j) * HD); } }
#pragma unroll
        for (int ib = 0; ib < NB; ++ib) { const int i = i0 + ib, part = i / PER, t = (i % PER) * ROWS + (ltid >> 4);
            const float* wp = cw + part * GDNW + h * HD + c;
            float acc[8];
#pragma unroll
            for (int e = 0; e < 8; ++e) acc[e] = 0.f;
#pragma unroll
            for (int j = 0; j < 4; ++j) { const v4u xv = xw[ib][j]; const f32x4 w0 = *(const f32x4*)(wp + j * (3 * GDNW)), w1 = *(const f32x4*)(wp + j * (3 * GDNW) + 4);
                acc[0] += w0[0] * bflo(xv.x); acc[1] += w0[1] * bfhi(xv.x); acc[2] += w0[2] * bflo(xv.y); acc[3] += w0[3] * bfhi(xv.y);
                acc[4] += w1[0] * bflo(xv.z); acc[5] += w1[1] * bfhi(xv.z); acc[6] += w1[2] * bflo(xv.w); acc[7] += w1[3] * bfhi(xv.w); }
            float ss = 0.f;
#pragma unroll
            for (int e = 0; e < 8; ++e) { acc[e] = acc[e] * __builtin_amdgcn_rcpf(1.0f + __builtin_amdgcn_exp2f(-1.4426950408889634f * acc[e])); ss += acc[e] * acc[e]; }
            if (part < 2) {
                ss += __shfl_xor(ss, 1); ss += __shfl_xor(ss, 2); ss += __shfl_xor(ss, 4); ss += __shfl_xor(ss, 8);
                const float r = (1.0f / sqrtf(ss + RMS_EPS)) * (part == 0 ? 0.08838834764831845f : 1.0f);
                v4u o; o.x = cvtpk_bf16(acc[0] * r, acc[1] * r); o.y = cvtpk_bf16(acc[2] * r, acc[3] * r); o.z = cvtpk_bf16(acc[4] * r, acc[5] * r); o.w = cvtpk_bf16(acc[6] * r, acc[7] * r);
                *(LAS v4u*)(lds + (part == 0 ? GP_QS : GP_KS) + (t * 136 + c) * 2) = o;
            } else {
                LAS float* vp = (LAS float*)(lds + GP_VS) + t * 132 + c;
                *(LAS f32x4*)vp = (f32x4){acc[0], acc[1], acc[2], acc[3]}; *(LAS f32x4*)(vp + 4) = (f32x4){acc[4], acc[5], acc[6], acc[7]};
            }
        }
    }
}
__device__ __forceinline__ void gp_s2(ArgsP A, LAS float* SMf, const float* SB, float* GL, int l, int ch, int lane) {
    const int bh = ch / GD_NCH, n = ch % GD_NCH, b = bh / GDNH, h = bh % GDNH;
    const size_t m = (size_t)b * SEQ + (size_t)n * 64 + lane;
    const float xb = SB[m * SBW + SB_GB + h], xa = SB[m * SBW + SB_GA + h] + A->in[I_GDNDTB][l * GDNH + h];
    const float bt = __builtin_amdgcn_rcpf(1.0f + __builtin_amdgcn_exp2f(-1.4426950408889634f * xb));
    const float sp = fmaxf(xa, 0.f) + 0.6931471805599453f * __builtin_amdgcn_logf(1.0f + __builtin_amdgcn_exp2f(-1.4426950408889634f * fabsf(xa)));
    const float gg = -__builtin_amdgcn_exp2f(1.4426950408889634f * A->in[I_GDNALOG][l * GDNH + h]) * sp;
    float gc = gg;
#pragma unroll
    for (int o = 1; o < 64; o <<= 1) { const float nb = __shfl_up(gc, o); if (lane >= o) gc += nb; }
    const float gtot = __shfl(gc, 63);
    SMf[lane] = bt; SMf[64 + lane] = gc; SMf[128 + lane] = __builtin_amdgcn_exp2f(1.4426950408889634f * gc); SMf[192 + lane] = __builtin_amdgcn_exp2f(1.4426950408889634f * (gtot - gc));
    if (lane == 63) GL[ch] = __builtin_amdgcn_exp2f(1.4426950408889634f * gtot);
}

__device__ __forceinline__ void gdn_prep(ArgsP ap0, LAS unsigned char* lds, int l) {
    const Ptrs P = fresh_ptrs(ap0); const ArgsP A = P.ap;
    const int tid = P.tid, lane = P.lane, wave = P.wave;
    const bf16* HMG = (const bf16*)(A->ws + WS_PROJ) + hm_off(HM_GQ, 0); const float* SB = (const float*)(A->ws + WS_SB);
    unsigned char* GOPS = A->ws + WS_GOPS; float* GU = (float*)(A->ws + WS_GU); float* GL = (float*)(A->ws + WS_GL);
    const float* cw = A->in[I_GDNCW] + (size_t)l * 4 * (3 * GDNW);
    LAS float* SMf = (LAS float*)(lds + GP_SM);
    LAS unsigned* hb = (LAS unsigned*)(lds + GP_SM + 1024); unsigned hb_epoch = 0u;
    if (tid == 0) *hb = 0u;
    if (P.bid < GD_NCHH) { gp_s1<512>(lds, HMG, cw, P.bid, tid); if (wave == 0) gp_s2(A, SMf, SB, GL, l, P.bid, lane); }
    for (int ch = P.bid; ch < GD_NCHH; ch += P.G) {
        const int bh = ch / GD_NCH, n = ch % GD_NCH, b = bh / GDNH, h = bh % GDNH;
        const size_t row0 = (size_t)b * SEQ + (size_t)n * 64;
        (void)b; (void)h; (void)row0; (void)n;
        __syncthreads();
        {
            const int mat = wave >> 2, mt = wave & 3, q4 = lane >> 4, m16 = lane & 15;
            f32x4 acc[4];
#pragma unroll
            for (int nt = 0; nt < 4; ++nt) acc[nt] = (f32x4){0.f, 0.f, 0.f, 0.f};
            const LAS unsigned char* abase = lds + (mat == 0 ? GP_KS : GP_QS) + ((16 * mt + m16) * 136 + 8 * q4) * 2;
            const LAS unsigned char* bbase = lds + GP_KS + (m16 * 136 + 8 * q4) * 2;
#pragma unroll
            for (int ks = 0; ks < 4; ++ks) { const bf16x8 a = *(const LAS bf16x8*)(abase + ks * 64);
#pragma unroll
                for (int nt = 0; nt < 4; ++nt) { const bf16x8 bb = *(const LAS bf16x8*)(bbase + nt * (16 * 136 * 2) + ks * 64); acc[nt] = __builtin_amdgcn_mfma_f32_16x16x32_bf16(a, bb, acc[nt], 0, 0, 0); } }
            const int c0 = 16 * mt + 4 * q4;
            const f32x4 gcc = *(const LAS f32x4*)(SMf + 64 + c0), btc = *(const LAS f32x4*)(SMf + c0);
#pragma unroll
            for (int nt = 0; nt < 4; ++nt) { const int s = 16 * nt + m16; const float gs = SMf[64 + s];
                if (mat == 0) { f32x4 o;
#pragma unroll
                    for (int r = 0; r < 4; ++r) o[r] = (s < c0 + r) ? btc[r] * acc[nt][r] * __builtin_amdgcn_exp2f(1.4426950408889634f * (gcc[r] - gs)) : 0.f;
                    *(LAS f32x4*)((LAS float*)(lds + GP_LT) + s * 68 + c0) = o;
                } else {
#pragma unroll
                    for (int r = 0; r < 4; ++r) ((LAS float*)(lds + GP_AT))[(c0 + r) * 68 + s] = (s <= c0 + r) ? acc[nt][r] * __builtin_amdgcn_exp2f(1.4426950408889634f * (gcc[r] - gs)) : 0.f;
                } }
        }
        __syncthreads();
        float x[64];
        if (tid < 256) {
            const int j = tid & 127, isw = tid >> 7;
            int vz = 0; asm volatile("" : "+v"(vz));
            const LAS float* SMv = SMf + vz;
#pragma unroll
            for (int r4 = 0; r4 < 16; ++r4) { const f32x4 bt = *(const LAS f32x4*)(SMv + 4 * r4), eg = *(const LAS f32x4*)(SMv + 128 + 4 * r4);
#pragma unroll
                for (int e = 0; e < 4; ++e) { const int r = 4 * r4 + e;
                    x[r] = isw ? __uint_as_float((unsigned)(*(const LAS unsigned short*)(lds + GP_KS + (r * 136 + j) * 2)) << 16) * (bt[e] * eg[e]) : ((const LAS float*)(lds + GP_VS))[r * 132 + j] * bt[e]; } }
        }
        __syncthreads();
        if (tid < 256) {
            const int j = tid & 127, isw = tid >> 7;
            { const LAS float* ltb = (const LAS float*)(lds + GP_LT) + (lane & 15);
              float Lc[4];
#pragma unroll
              for (int q = 0; q < 4; ++q) Lc[q] = ltb[16 * q];
              TriSolve<0>::run(x, ltb, Lc); }
            if (!isw) { float* up = GU + (size_t)ch * 8192 + (size_t)((j >> 4) * 4) * 256 + (j & 15) * 4;
#pragma unroll
                for (int mt = 0; mt < 4; ++mt)
#pragma unroll
                    for (int q4 = 0; q4 < 4; ++q4) *(f32x4*)(up + mt * 256 + q4 * 64) = (f32x4){x[16 * mt + 4 * q4], x[16 * mt + 4 * q4 + 1], x[16 * mt + 4 * q4 + 2], x[16 * mt + 4 * q4 + 3]};
            } else {
#pragma unroll
                for (int r = 0; r < 64; ++r) *(LAS unsigned short*)(lds + GP_WM + (r * 136 + j) * 2) = (unsigned short)f2bf(-x[r]);
            }
        } else {
            const int wv = wave - 4, q4 = lane >> 4, m16 = lane & 15;
            unsigned char* dst = GOPS + (size_t)ch * GD_OPS_BYTES + lane * 16;
            for (int f = wv; f < 40; f += 4) {
                v4u o;
                if (f < 16) { const int mt = f >> 2, ks = f & 3, row = 16 * mt + m16; const float eg = SMf[128 + row];
                    const LAS unsigned char* p = lds + GP_QS + (row * 136 + 32 * ks + 4 * q4) * 2;
                    const u32x2v a = *(const LAS u32x2v*)p, bq = *(const LAS u32x2v*)(p + 32);
                    o.x = cvtpk_bf16(bflo(a.x) * eg, bfhi(a.x) * eg); o.y = cvtpk_bf16(bflo(a.y) * eg, bfhi(a.y) * eg); o.z = cvtpk_bf16(bflo(bq.x) * eg, bfhi(bq.x) * eg); o.w = cvtpk_bf16(bflo(bq.y) * eg, bfhi(bq.y) * eg);
                    *(v4u*)(dst + (GD_F_QD + f) * 1024) = o;
                } else if (f < 24) { const int ff = f - 16, mt = ff >> 1, ks = ff & 1, row = 16 * mt + m16;
                    const LAS float* p = (const LAS float*)(lds + GP_AT) + row * 68 + 32 * ks + 4 * q4;
                    const f32x4 a = *(const LAS f32x4*)p, bq = *(const LAS f32x4*)(p + 16);
                    o.x = cvtpk_bf16(a[0], a[1]); o.y = cvtpk_bf16(a[2], a[3]); o.z = cvtpk_bf16(bq[0], bq[1]); o.w = cvtpk_bf16(bq[2], bq[3]);
                    *(v4u*)(dst + (GD_F_AT + ff) * 1024) = o;
                } else { const int ff = f - 24, mt = ff >> 1, ks = ff & 1, dk = 16 * mt + m16;
                    const int cA = 32 * ks + 4 * q4; const f32x4 ekA = *(const LAS f32x4*)(SMf + 192 + cA), ekB = *(const LAS f32x4*)(SMf + 192 + cA + 16);
                    float kv[8];
#pragma unroll
                    for (int e = 0; e < 4; ++e) { kv[e] = __uint_as_float((unsigned)(*(const LAS unsigned short*)(lds + GP_KS + ((cA + e) * 136 + dk) * 2)) << 16) * ekA[e];
                                                  kv[4 + e] = __uint_as_float((unsigned)(*(const LAS unsigned short*)(lds + GP_KS + ((cA + 16 + e) * 136 + dk) * 2)) << 16) * ekB[e]; }
                    o.x = cvtpk_bf16(kv[0], kv[1]); o.y = cvtpk_bf16(kv[2], kv[3]); o.z = cvtpk_bf16(kv[4], kv[5]); o.w = cvtpk_bf16(kv[6], kv[7]);
                    *(v4u*)(dst + (GD_F_KT + ff) * 1024) = o;
                }
            }
            if (ch + P.G < GD_NCHH) {
                asm volatile("s_waitcnt lgkmcnt(0)" ::: "memory");
                ++hb_epoch;
                if (lane == 0) (void)__hip_atomic_fetch_add(hb, 1u, __ATOMIC_RELAXED, __HIP_MEMORY_SCOPE_WORKGROUP);
                while (__hip_atomic_load(hb, __ATOMIC_RELAXED, __HIP_MEMORY_SCOPE_WORKGROUP) < 4u * hb_epoch) __builtin_amdgcn_s_sleep(1);
                asm volatile("" ::: "memory");
                gp_s1<256>(lds, HMG, cw, ch + P.G, tid - 256); if (wave == 4) gp_s2(A, SMf, SB, GL, l, ch + P.G, lane); }
        }
        __syncthreads();
        { const int q4 = lane >> 4, m16 = lane & 15;
#pragma unroll
          for (int k2 = 0; k2 < 2; ++k2) { const int f = wave * 2 + k2, mt = f >> 2, ks = f & 3, row = 16 * mt + m16;
            const LAS unsigned char* p = lds + GP_WM + (row * 136 + 32 * ks + 4 * q4) * 2;
            const u32x2v a = *(const LAS u32x2v*)p, bq = *(const LAS u32x2v*)(p + 32);
            v4u o; o.x = a.x; o.y = a.y; o.z = bq.x; o.w = bq.y;
            *(v4u*)(GOPS + (size_t)ch * GD_OPS_BYTES + (GD_F_WN + f) * 1024 + lane * 16) = o; } }
    }
    __syncthreads();
}

__device__ __forceinline__ void gdn_scan(ArgsP ap0, LAS unsigned char* lds) {
    const Ptrs P = fresh_ptrs(ap0); const ArgsP A = P.ap;
    const int lane = P.lane, wave = P.wave, bh = P.bid >> 1, b = bh / GDNH, h = bh % GDNH, q4 = lane >> 4, n16 = lane & 15;
    const int cs = (P.bid & 1) * 4 + (wave & 3);
    const bool comp = wave < 4;
    const unsigned char* ops = A->ws + WS_GOPS + (size_t)bh * GD_NCH * GD_OPS_BYTES;
    const float* Up = (const float*)(A->ws + WS_GU) + (size_t)bh * GD_NCH * 8192 + (size_t)(cs * 4) * 256 + lane * 4;
    const float* GLp = (const float*)(A->ws + WS_GL) + (size_t)bh * GD_NCH;
    float* GO = (float*)(A->ws + WS_GO2) + ((size_t)b * SEQ) * GDNW + h * HD + 16 * cs + n16;
    f32x4 S[8];
#pragma unroll
    for (int i = 0; i < 8; ++i) S[i] = (f32x4){0.f, 0.f, 0.f, 0.f};
    f32x4 Un[4]; float gln = 0.f;
#pragma unroll
    for (int i = 0; i < 4; ++i) Un[i] = (f32x4){0.f, 0.f, 0.f, 0.f};
#define GD_DMA(nn, buf) do { _Pragma("unroll") for (int i_ = 0; i_ < 7; ++i_) __builtin_amdgcn_global_load_lds((const unsigned*)(ops + (size_t)(nn) * GD_OPS_BYTES + (i_ * 8 + wave) * 1024 + lane * 16), \
        (LAS unsigned*)(lds + (buf) * GD_OPS_BYTES + (i_ * 8 + wave) * 1024), 16, 0, 0); } while (0)
#define GD_ULOAD(nn) do { if (comp) { _Pragma("unroll") for (int mt_ = 0; mt_ < 4; ++mt_) Un[mt_] = *(const f32x4*)(Up + (size_t)(nn) * 8192 + mt_ * 256); gln = GLp[nn]; } } while (0)
    GD_DMA(0, 0); GD_ULOAD(0);
    for (int n = 0; n < GD_NCH; ++n) {
        asm volatile("s_waitcnt vmcnt(0)" ::: "memory");
        __syncthreads();
        f32x4 Uc[4]; const float gl = gln;
#pragma unroll
        for (int mt = 0; mt < 4; ++mt) Uc[mt] = Un[mt];
        if (n + 1 < GD_NCH) { GD_DMA(n + 1, (n + 1) & 1); GD_ULOAD(n + 1); }
        if (comp) {
        const LAS unsigned char* fr = lds + (n & 1) * GD_OPS_BYTES + lane * 16;
#define GD_FRAG(f) (*(const LAS bf16x8*)(fr + (f) * 1024))
        bf16x8 Sb[4];
#pragma unroll
        for (int ks = 0; ks < 4; ++ks) { v4u w; w.x = cvtpk_bf16(S[2 * ks][0], S[2 * ks][1]); w.y = cvtpk_bf16(S[2 * ks][2], S[2 * ks][3]); w.z = cvtpk_bf16(S[2 * ks + 1][0], S[2 * ks + 1][1]); w.w = cvtpk_bf16(S[2 * ks + 1][2], S[2 * ks + 1][3]);
            Sb[ks] = __builtin_bit_cast(bf16x8, w); }
        f32x4 vn[4];
#pragma unroll
        for (int mt = 0; mt < 4; ++mt) { vn[mt] = Uc[mt];
#pragma unroll
            for (int ks = 0; ks < 4; ++ks) vn[mt] = __builtin_amdgcn_mfma_f32_16x16x32_bf16(GD_FRAG(GD_F_WN + mt * 4 + ks), Sb[ks], vn[mt], 0, 0, 0); }
        bf16x8 Vb[2];
#pragma unroll
        for (int ks = 0; ks < 2; ++ks) { v4u w; w.x = cvtpk_bf16(vn[2 * ks][0], vn[2 * ks][1]); w.y = cvtpk_bf16(vn[2 * ks][2], vn[2 * ks][3]); w.z = cvtpk_bf16(vn[2 * ks + 1][0], vn[2 * ks + 1][1]); w.w = cvtpk_bf16(vn[2 * ks + 1][2], vn[2 * ks + 1][3]);
            Vb[ks] = __builtin_bit_cast(bf16x8, w); }
        float* orow = GO + (size_t)(n * 64 + 4 * q4) * GDNW;
#pragma unroll
        for (int mt = 0; mt < 4; ++mt) { f32x4 o = (f32x4){0.f, 0.f, 0.f, 0.f};
#pragma unroll
            for (int ks = 0; ks < 4; ++ks) o = __builtin_amdgcn_mfma_f32_16x16x32_bf16(GD_FRAG(GD_F_QD + mt * 4 + ks), Sb[ks], o, 0, 0, 0);
#pragma unroll
            for (int ks = 0; ks < 2; ++ks) o = __builtin_amdgcn_mfma_f32_16x16x32_bf16(GD_FRAG(GD_F_AT + mt * 2 + ks), Vb[ks], o, 0, 0, 0);
#pragma unroll
            for (int r = 0; r < 4; ++r) orow[(size_t)(16 * mt + r) * GDNW] = o[r]; }
#pragma unroll
        for (int mt = 0; mt < 8; ++mt) { S[mt] = S[mt] * gl;
#pragma unroll
            for (int ks = 0; ks < 2; ++ks) S[mt] = __builtin_amdgcn_mfma_f32_16x16x32_bf16(GD_FRAG(GD_F_KT + mt * 2 + ks), Vb[ks], S[mt], 0, 0, 0); }
        }
    }
#undef GD_FRAG
#undef GD_DMA
#undef GD_ULOAD
    asm volatile("s_waitcnt vmcnt(0)" ::: "memory");
    __syncthreads();
}
__device__ __forceinline__ void p4_finalize(ArgsP ap0, int l) {
    const Ptrs P = fresh_ptrs(ap0); const ArgsP A = P.ap;
    const float* GO = (const float*)(A->ws + WS_GO2); const bf16* HMZ = (const bf16*)(A->ws + WS_PROJ) + hm_off(HM_GZ, 0);
    bf16* MIX = (bf16*)(A->ws + WS_MIX); const int lane = P.lane;
    typedef float f32x2 __attribute__((ext_vector_type(2)));
    const f32x2 gg = *(const f32x2*)(A->in[I_GDNON] + l * HD + 2 * lane);
    for (int m = P.gw; m < M; m += P.NGW) {
        const int b = m / SEQ, s = m % SEQ;
        f32x2 v[GDNH]; unsigned zw[GDNH];
#pragma unroll
        for (int h = 0; h < GDNH; ++h) { v[h] = *(const f32x2*)(GO + (size_t)m * GDNW + h * HD + 2 * lane); zw[h] = *(const unsigned*)(HMZ + ((size_t)(b * GDNH + h) * SEQ + s) * HD + 2 * lane); }
        float ss[GDNH];
#pragma unroll
        for (int h = 0; h < GDNH; ++h) ss[h] = v[h][0] * v[h][0] + v[h][1] * v[h][1];
#pragma unroll
        for (int o = 1; o < 64; o <<= 1) {
#pragma unroll
            for (int h = 0; h < GDNH; ++h) ss[h] += __shfl_xor(ss[h], o); }
#pragma unroll
        for (int h = 0; h < GDNH; ++h) { const float rr = 1.0f / sqrtf(ss[h] * (1.0f / HD) + RMS_EPS);
            *(unsigned*)(MIX + (size_t)m * DM + FOXW + SCW + h * HD + 2 * lane) = pk2(v[h][0] * rr * gg[0] * silu_acc(bflo(zw[h])), v[h][1] * rr * gg[1] * silu_acc(bfhi(zw[h]))); }
    }
}

constexpr int ATT_PER_X = 3 * (SEQ / attn::QB);
constexpr int ATT_SLOT_OFF = 69632;
static_assert(attn::LDS_BYTES <= ATT_SLOT_OFF, "attention LDS map");
typedef attn::BlockRef<attn::bf16, attn::bf16> FoxRef;
__device__ __forceinline__ int fox_jlo(ArgsP A, int l, int bh, int P0) {
    (void)l;
    const float* FG = (const float*)(A->ws + WS_FG) + (size_t)bh * SEQ; const float* TN = (const float*)(A->ws + WS_TN);
    constexpr int NT_ = BATCH * FOXH * (SEQ / 64);
    const int lane = my_lane(), jd = P0 / attn::KVBLK, tb = bh * (SEQ / 64);
    float qn2 = 0.f, lb = 3.0e38f;
#pragma unroll
    for (int i = 0; i < 4; ++i) { qn2 = fmaxf(qn2, TN[tb + jd + i]); lb = fminf(lb, TN[2 * NT_ + tb + jd + i] + FG[64 * (jd + i)]); }
    const float qnb = sqrtf(qn2) * 1.001f;
    const bool s0 = qnb * sqrtf(TN[NT_ + tb + lane]) + FG[64 * lane + 63] - lb < -600.0f, s1 = qnb * sqrtf(TN[NT_ + tb + lane + 64]) + FG[64 * (lane + 64) + 63] - lb < -600.0f;
    const unsigned long long n0 = ~__ballot(s0), n1 = ~__ballot(s1);
    const int n = n0 ? __builtin_ctzll(n0) : 64 + (n1 ? __builtin_ctzll(n1) : 64);
    return __builtin_amdgcn_readfirstlane(n < jd ? n : jd);
}
__device__ __forceinline__ FoxRef fox_ref(ArgsP A, int id, int l) {
    const int qx = id / ATT_PER_X, i = id % ATT_PER_X, bh = 3 * qx + (i >> 5), qb = 31 - (i & 31);
    const int b = bh / FOXH, h = bh % FOXH; const size_t row0 = (size_t)b * SEQ;
    const attn::bf16* HM = (const attn::bf16*)(A->ws + WS_PROJ);
    FoxRef r;
    r.Q = HM + hm_off(HM_FQ, bh) + (size_t)qb * attn::QB * HD;
    r.K = HM + hm_off(HM_FK, bh); r.V = HM + hm_off(HM_FV, bh);
    r.F = (const float*)(A->ws + WS_FG) + (size_t)bh * SEQ;
    r.O = (attn::bf16*)(A->ws + WS_MIX) + (row0 + (size_t)qb * attn::QB) * DM + h * HD; r.P0 = qb * attn::QB; r.JLO = fox_jlo(A, l, bh, r.P0);
    return r;
}
__device__ __forceinline__ int att_claim(gu32* ctrs, volatile LAS int* st) {
    int qx = st[0], tried = st[1], r = -1;
    while (tried < 8) { const unsigned i = __hip_atomic_fetch_add(ctrs + qx * 64, 1u, __ATOMIC_RELAXED, __HIP_MEMORY_SCOPE_AGENT); if (i < (unsigned)ATT_PER_X) { r = qx * ATT_PER_X + (int)i; break; } qx = (qx + 1) & 7; ++tried; }
    st[0] = qx; st[1] = tried;
    return r;
}
__device__ __forceinline__ void p3_attention(ArgsP ap0, char* lds, int l, int rep = 0) {
    const ArgsP A = fresh(ap0);
    gu32* ctrs = (gu32*)(A->ws + WS_CTL) + CW_Q + (rep * 2 + l) * 8 * 64;
    volatile LAS int* slot = (volatile LAS int*)((LAS unsigned char*)lds + ATT_SLOT_OFF);
    if (ftid() == 0) { slot[4] = (int)(xb_xcc_id() & 7u); slot[5] = 0; slot[0] = att_claim(ctrs, slot + 4); slot[1] = att_claim(ctrs, slot + 4); }
    __syncthreads();
    int cur = __builtin_amdgcn_readfirstlane(slot[0]), nxt = __builtin_amdgcn_readfirstlane(slot[1]);
    if (cur < 0) return;
    FoxRef curR = fox_ref(A, cur, l);
    attn::Seam<attn::bf16> S;
    attn::causal_swa_prime<attn::bf16, attn::bf16>(curR, SEQ, lds, S);
    for (int k = 0;; ++k) {
        if (nxt >= 0 && ftid() == 0) slot[2 + (k & 1)] = att_claim(ctrs, slot + 4);
        const bool last = nxt < 0;
        const FoxRef nxtR = last ? curR : fox_ref(A, nxt, l);
        attn::causal_swa_block<attn::bf16, attn::bf16>(curR, nxtR, SEQ, SEQ, lds, S, &A->in[I_FOXON], l * HD);
        if (last) break;
        cur = nxt; curR = nxtR; nxt = __builtin_amdgcn_readfirstlane(slot[2 + (k & 1)]);
    }
}

constexpr int N_PHASES = 1 + 9 * DEPTH;

#ifndef PH_EN
#define PH_EN 0x3ff
#endif
#define IN(k) (lo <= (k) && (k) < hi)
#define EN(j) ((PH_EN >> (j)) & 1)
#ifndef REP_MASK
#define REP_MASK 0
#endif
#ifndef EXTRA_BARS
#define EXTRA_BARS 0
#endif
#define REPS(j) (((REP_MASK >> (j)) & 1) ? 2 : 1)
#define SEAM(k) do { if (IN(k) && IN((k) + 1)) { XcdBarrier b_; b_.bar = (unsigned*)(fresh(ap0)->ws + WS_CTL) + CW_BAR; b_.x = xb_xcc_id(); b_.st = (volatile LAS unsigned*)((LAS unsigned char*)lds + MISC_OFF) + 8; xcd_barrier(b_); } } while (0)
#define WSP(T, off) ((T*)(A->ws + (off)))


template <int l>
__device__ __forceinline__ void layer_phases(ArgsP ap0, LAS unsigned char* ldsl, unsigned char* lds, int lo, int hi) {

        const int pb = 1 + 9 * l;
        if (EN(1) && IN(pb + 0)) {
            const Ptrs P = fresh_ptrs(ap0); const ArgsP A = P.ap;
            pg8::Gemm g{WSP(bf16, WS_XN), WSP(bf16, WS_W + WO_IN), M, NP, DM}; pg8::StaticOrder S; S.init(M, NP, P.G, P.bid);
            pg8::EpiProj E{WSP(bf16, WS_PROJ), WSP(bf16, WS_SCB), WSP(float, WS_SB)};
            for (int rep_ = 0; rep_ < REPS(1); ++rep_) pg8::gemm_phase<pg8::EpiProj, pg8::StaticOrder, true, true>(ldsl, g, S, E);
            convert_weights(ap0, ldsl, l, I_IN + I_OUT + I_GU, I_LAYER, (M / 256) * (NP / 256) % P.G);
            SEAM(pb + 0);
        }
        if (EN(2) && IN(pb + 1)) {
            for (int rep_ = 0; rep_ < REPS(11); ++rep_) p2_prep(ap0, ldsl, l);
            for (int rep_ = 0; rep_ < REPS(2); ++rep_) gdn_prep(ap0, ldsl, l);
            SEAM(pb + 1);
            for (int xb_ = 0; xb_ < EXTRA_BARS; ++xb_) SEAM(pb + 1);
            }
        if (EN(3) && IN(pb + 2)) {
            for (int rep_ = 0; rep_ < REPS(10); ++rep_) if ((int)blockIdx.x < 2 * BATCH * GDNH) gdn_scan(ap0, ldsl);
            for (int rep_ = 0; rep_ < REPS(3); ++rep_) p3_attention(ap0, (char*)lds, l, rep_);
            SEAM(pb + 2);
        }
        if (EN(4) && IN(pb + 3)) { for (int rep_ = 0; rep_ < REPS(4); ++rep_) p4_finalize(ap0, l); SEAM(pb + 3); }
        if (EN(5) && IN(pb + 4)) {
            const Ptrs P = fresh_ptrs(ap0); const ArgsP A = P.ap;
            pg8::Gemm g{WSP(bf16, WS_MIX), WSP(bf16, WS_W + WO_OUT), M, DM, DM}; pg8::StaticOrder S; S.init(M, DM, P.G, P.bid);
            pg8::EpiY E{WSP(bf16, WS_Y), WSP(float, WS_SS)};
            for (int rep_ = 0; rep_ < REPS(5); ++rep_) pg8::gemm_phase<pg8::EpiY, pg8::StaticOrder, true, true>(ldsl, g, S, E);
            SEAM(pb + 4);
        }
        if (EN(6) && IN(pb + 5)) {
            const Ptrs P = fresh_ptrs(ap0); const ArgsP A = P.ap;
            const float* xin = l == 0 ? A->in[I_X] : (const float*)A->out;
            const float* gpost = A->in[I_MIXPOST] + l * DM; const float* gpre = A->in[I_FFNPRE] + l * DM;
            const bf16* Y = WSP(bf16, WS_Y); const float* SS = WSP(float, WS_SS); float* H = WSP(float, WS_H); bf16* XN = WSP(bf16, WS_XN);
            for (int rep_ = 0; rep_ < REPS(6); ++rep_)
            for (int m = P.gw; m < M; m += P.NGW)
                resid_norm_row(xin + (size_t)m * DM, Y + (size_t)m * DM, SS + (size_t)m * 64, gpost, H + (size_t)m * DM, gpre, XN + (size_t)m * DM, P.lane);
            SEAM(pb + 5);
        }
        if (EN(7) && IN(pb + 6)) {
            const Ptrs P = fresh_ptrs(ap0); const ArgsP A = P.ap;
            pg8::Gemm g{WSP(bf16, WS_XN), WSP(bf16, WS_W + WO_GU), M, NGU, DM}; pg8::StaticOrder S; S.init(M, NGU, P.G, P.bid);
            pg8::EpiSwiGLU E{WSP(bf16, WS_PROJ)};
            for (int rep_ = 0; rep_ < REPS(7); ++rep_) pg8::gemm_phase<pg8::EpiSwiGLU, pg8::StaticOrder, true, true>(ldsl, g, S, E);
            if (l + 1 < DEPTH) convert_weights(ap0, ldsl, l + 1, 0, I_IN + I_OUT, (M / 256) * (NGU / 256) % P.G);
            SEAM(pb + 6);
        }
        if (EN(8) && IN(pb + 7)) {
            const Ptrs P = fresh_ptrs(ap0); const ArgsP A = P.ap;
            pg8::Gemm g{WSP(bf16, WS_PROJ), WSP(bf16, WS_W + WO_DN), M, DM, FFN};
            pg8::EpiY E{WSP(bf16, WS_Y), WSP(float, WS_SS)};
            if (P.G == 256) { pg8::PanelOrder S{P.bid, M / (16 * 256)};
                for (int rep_ = 0; rep_ < REPS(8); ++rep_) pg8::gemm_phase<pg8::EpiY, pg8::PanelOrder, true, true>(ldsl, g, S, E); }
            else { pg8::StaticOrder S; S.init(M, DM, P.G, P.bid);
                for (int rep_ = 0; rep_ < REPS(8); ++rep_) pg8::gemm_phase<pg8::EpiY, pg8::StaticOrder, true, true>(ldsl, g, S, E); }
            SEAM(pb + 7);
        }
        if (EN(9) && IN(pb + 8)) {
            const Ptrs P = fresh_ptrs(ap0); const ArgsP A = P.ap;
            const float* gnext = l + 1 < DEPTH ? A->in[I_MIXPRE] + (l + 1) * DM : nullptr; const float* gpost = A->in[I_FFNPOST] + l * DM;
            const bf16* Y = WSP(bf16, WS_Y); const float* SS = WSP(float, WS_SS); const float* H = WSP(float, WS_H); bf16* XN = WSP(bf16, WS_XN); float* outp = A->out;
            for (int rep_ = 0; rep_ < REPS(9); ++rep_) {
            for (int m = P.gw; m < M; m += P.NGW)
                resid_norm_row(H + (size_t)m * DM, Y + (size_t)m * DM, SS + (size_t)m * 64, gpost, outp + (size_t)m * DM, gnext, XN + (size_t)m * DM, P.lane);
            if (l + 1 < DEPTH) convert_weights(ap0, ldsl, l + 1, I_IN + I_OUT, I_IN + I_OUT + I_GU);
            }
            SEAM(pb + 8);
        }
    }

__global__ void __launch_bounds__(NWAVES * 64, 2) hybrid_fwd(Args args) {
    extern __shared__ __attribute__((aligned(16))) unsigned char lds[];
    LAS unsigned char* ldsl = (LAS unsigned char*)lds;
    volatile LAS unsigned* MISC = (volatile LAS unsigned*)(ldsl + MISC_OFF);
    const ArgsP ap0 = (ArgsP)__builtin_amdgcn_kernarg_segment_ptr();
    for (int u = threadIdx.x; u < (LDS_BYTES - LDSCTL_OFF) / 4; u += NWAVES * 64) ((LAS unsigned*)(ldsl + LDSCTL_OFF))[u] = 0u;
    __syncthreads();
    if ((threadIdx.x & 63) == 0) *(volatile LAS int*)(ldsl + TIDTAB_OFF + 4 * hw_slot()) = (int)(threadIdx.x >> 6);
    __syncthreads();
    const int lo = args.ph_lo, hi = args.ph_hi;
    if (hi - lo > 1) (void)xcd_barrier_post((unsigned*)(args.ws + WS_CTL) + CW_BAR, MISC + 8);
    if (EN(0) && IN(0)) { for (int rep_ = 0; rep_ < REPS(0); ++rep_) p0_prologue(ap0, ldsl); SEAM(0); }
    layer_phases<0>(ap0, ldsl, lds, lo, hi);
    layer_phases<1>(ap0, ldsl, lds, lo, hi);
}

#undef IN
#undef SEAM
extern "C" void kernel_launch(void* const* d_in, const int* in_sizes, int n_in, void* d_out, int out_size, void* d_ws, size_t ws_size, hipStream_t stream) {
    static int grid = 0;
    if (grid == 0) {
        if (n_in != 17 || in_sizes[0] != M * DM || out_size != M * DM || ws_size < WS_END) {
            fprintf(stderr, "kernel_launch: shape/workspace mismatch: n_in %d in0 %d out %d ws %zu (need %zu)\n", n_in, n_in > 0 ? in_sizes[0] : -1, out_size, ws_size, (size_t)WS_END); grid = -1; return; }
        int dev = 0, cus = 0, per_cu = 0;
        if (hipGetDevice(&dev) != hipSuccess || hipDeviceGetAttribute(&cus, hipDeviceAttributeMultiprocessorCount, dev) != hipSuccess) { fprintf(stderr, "kernel_launch: device query failed\n"); grid = -1; return; }
        if (hipFuncSetAttribute((const void*)hybrid_fwd, hipFuncAttributeMaxDynamicSharedMemorySize, LDS_BYTES) != hipSuccess) { fprintf(stderr, "kernel_launch: hipFuncSetAttribute failed\n"); grid = -1; return; }
        if (hipOccupancyMaxActiveBlocksPerMultiprocessor(&per_cu, (const void*)hybrid_fwd, NWAVES * 64, LDS_BYTES) != hipSuccess || per_cu < 1)
            fprintf(stderr, "kernel_launch: note: occupancy query reports %d workgroups per CU\n", per_cu);
        (void)hipGetLastError();
        grid = cus;
    }
    if (grid < 0) return;
    if (hipMemsetAsync((char*)d_ws + WS_CTL, 0, CTL_ZERO_BYTES, stream) != hipSuccess) { fprintf(stderr, "kernel_launch: memset failed\n"); return; }
    Args a{};
    for (int i = 0; i < 17; ++i) a.in[i] = (const float*)d_in[i];
    a.out = (float*)d_out; a.ws = (unsigned char*)d_ws;
#if MK_N_LAUNCHES == 1
    a.ph_lo = 0; a.ph_hi = N_PHASES;
    hipLaunchKernelGGL(hybrid_fwd, dim3(grid), dim3(NWAVES * 64), LDS_BYTES, stream, a);
#else
    for (int p = 0; p < N_PHASES; ++p) { a.ph_lo = p; a.ph_hi = p + 1; hipLaunchKernelGGL(hybrid_fwd, dim3(grid), dim3(NWAVES * 64), LDS_BYTES, stream, a); }
#endif
    const hipError_t le = hipPeekAtLastError();
    if (le != hipSuccess) fprintf(stderr, "kernel_launch: launch failed: %s\n", hipGetErrorName(le));
}
```

```cpp
#include <hip/hip_runtime.h>
#include <hip/hip_bf16.h>
#include <cstdio>
#include <cstdint>
#include <cmath>

#ifndef MK_N_LAUNCHES
#define MK_N_LAUNCHES 1
#endif

constexpr int BATCH = 2, SEQ = 8192, DM = 4096, M = BATCH * SEQ, DEPTH = 2;
constexpr int HD = 128, FOXH = 12, FOXW = FOXH * HD, SCW = 1024, GDNH = 12, GDNW = GDNH * HD;
constexpr int PROJ_SRC = 13860;
constexpr int NP = 14080;
constexpr int FFN = 11008, NGU = 2 * FFN;
constexpr float RMS_EPS = 1e-6f;
constexpr int PC_FQ = 0, PC_FK = 1536, PC_FV = 3072, PC_SB = 4608, PC_SC = 5632, PC_SH = 6656, PC_GQ = 7680, PC_GK = 9216, PC_GV = 10752, PC_GZ = 12288, PC_SMALL = 13824;
constexpr int SBW = 64, SB_FF = 0, SB_GA = 12, SB_GB = 24;
constexpr int SRC_FF = 4608, SRC_SB = 4620, SRC_GQ = 7692, SRC_GA = 12300, SRC_GB = 12312, SRC_GZ = 12324;

constexpr size_t MiB = 1u << 20;
constexpr size_t WS_CTL = 0, CTL_ZERO_BYTES = 1 * MiB;
constexpr size_t WS_W = 16 * MiB;
constexpr size_t WO_IN = 0, WO_OUT = 110 * MiB, WO_GU = 142 * MiB, WO_DN = 314 * MiB;
constexpr size_t WS_XN = 416 * MiB;
constexpr size_t WS_MIX = 544 * MiB;
constexpr size_t WS_Y = 672 * MiB;
constexpr size_t WS_H = 800 * MiB;
constexpr size_t WS_PROJ = 1056 * MiB;
constexpr size_t WS_SCB = WS_PROJ + 336 * MiB;
constexpr int HM_FQ = 0, HM_FK = 1, HM_FV = 2, HM_GQ = 3, HM_GZ = 6, SCBW = 3 * SCW;
__host__ __device__ constexpr size_t hm_off(int part, int bh) { return ((size_t)(part * (BATCH * FOXH) + bh) * SEQ) * HD; }
constexpr size_t WS_SB = 1496 * MiB;
constexpr size_t WS_SS = 1500 * MiB;
constexpr size_t WS_FG = 1504 * MiB;
constexpr size_t WS_TN = WS_FG + 1 * MiB;
constexpr size_t WS_END = 1506 * MiB;
constexpr int CW_TMO = 0, CW_BAR = 4096, CW_Q = 16384;

constexpr int NWAVES = 8;
constexpr int RING_BYTES = 131072, LDSCTL_OFF = RING_BYTES, MISC_OFF = LDSCTL_OFF + 320, LDS_BYTES = 147456;


extern __shared__ __attribute__((aligned(16))) unsigned char g_lds[];
constexpr int TIDTAB_OFF = LDSCTL_OFF + 512;
__device__ __forceinline__ unsigned hw_slot() { return (unsigned)__builtin_amdgcn_s_getreg((5 << 11) | 4) & 63u; }
__device__ __forceinline__ int my_lane() { int l; asm volatile("v_mbcnt_lo_u32_b32 %0, -1, 0\n\tv_mbcnt_hi_u32_b32 %0, -1, %0" : "=v"(l)); return l; }
__device__ __forceinline__ int my_wave() { return __builtin_amdgcn_readfirstlane(*(volatile __attribute__((address_space(3))) int*)((__attribute__((address_space(3))) unsigned char*)g_lds + TIDTAB_OFF + 4 * hw_slot())); }
__device__ __forceinline__ int my_tid() { return my_wave() * 64 + my_lane(); }

#define GAS __attribute__((address_space(1)))
#define LAS __attribute__((address_space(3)))
typedef unsigned short bf16;
typedef unsigned v4u __attribute__((ext_vector_type(4)));
typedef float f32x4 __attribute__((ext_vector_type(4)));
typedef short bf16x8 __attribute__((ext_vector_type(8)));
typedef GAS unsigned gu32;
typedef GAS unsigned long long gu64;
#define RLX_AGENT __ATOMIC_RELAXED, __HIP_MEMORY_SCOPE_AGENT
#define LDS_WAIT() asm volatile("s_waitcnt lgkmcnt(0)" ::: "memory")
#define VM_WAIT() asm volatile("s_waitcnt vmcnt(0)" ::: "memory")
__device__ __forceinline__ unsigned long long rt() { return __builtin_amdgcn_s_memrealtime(); }
__device__ __forceinline__ unsigned f2bf(float f) { unsigned u = __builtin_bit_cast(unsigned, f); return (u + 0x7fffu + ((u >> 16) & 1u)) >> 16; }
__device__ __forceinline__ unsigned pk2(float lo, float hi) { return f2bf(lo) | (f2bf(hi) << 16); }

#define XB_TMO      128
#define XB_XCNT(j)  (256  + 64 * (j))
#define XB_XSUB(j)  (1280 + 64 * (j))
#define XB_XGEN(j)  (2304 + 64 * (j))
#define XB_TOP      3328
#define XB_TOPGEN   3392
#define XCD_BAR_WORDS 3456
#define XB_SPIN_CAP (1u << 18)

__device__ __forceinline__ unsigned xb_ld(unsigned* p)              { return __hip_atomic_load(p, __ATOMIC_RELAXED, __HIP_MEMORY_SCOPE_AGENT); }
__device__ __forceinline__ unsigned xb_add(unsigned* p, unsigned v) { return __hip_atomic_fetch_add(p, v, __ATOMIC_RELAXED, __HIP_MEMORY_SCOPE_AGENT); }
__device__ __forceinline__ unsigned xb_xcc_id() { return (unsigned)__builtin_amdgcn_s_getreg((3 << 11) | 20) & 0xFu; }
#define XB_SPIN(cond, bar) do { unsigned _sp = 0; while (cond) { __builtin_amdgcn_s_sleep(1); \
    if ((++_sp & 255u) == 0u) { if (xb_ld(&(bar)[XB_TMO])) break; if (_sp > XB_SPIN_CAP) { atomicAdd(&(bar)[XB_TMO], 1u); break; } } } } while (0)

struct XcdBarrier {
    unsigned* bar; unsigned x;
    volatile LAS unsigned* st;
};

__device__ __forceinline__ XcdBarrier xcd_barrier_post(unsigned* bar, volatile LAS unsigned* st) {
    XcdBarrier b; b.bar = bar; b.x = xb_xcc_id(); b.st = st;
    if (my_tid() == 0) (void)xb_add(&bar[XB_XCNT(b.x)], 1u);
    return b;
}
__device__ __forceinline__ void xcd_barrier_complete(unsigned* bar, unsigned x, unsigned& nloc, unsigned& nx) {
    const unsigned G = gridDim.x * gridDim.y * gridDim.z;
    unsigned sum, cnt, mine, sp = 0u;
    for (;;) {
        sum = 0u; cnt = 0u; mine = 0u;
#pragma unroll
        for (unsigned j = 0; j < 16; ++j) { const unsigned c = xb_ld(&bar[XB_XCNT(j)]); sum += c; cnt += (c > 0u) ? 1u : 0u; mine = (j == x) ? c : mine; }
        if (sum == G) break;
        __builtin_amdgcn_s_sleep(1);
        if ((++sp & 255u) == 0u) { if (xb_ld(&bar[XB_TMO])) break; if (sp > XB_SPIN_CAP) { atomicAdd(&bar[XB_TMO], 1u); break; } }
    }
    nloc = mine > 0u ? mine : 1u; nx = cnt > 0u ? cnt : 1u;
}

__device__ __forceinline__ void xcd_barrier(const XcdBarrier& b) {
    asm volatile("s_waitcnt vmcnt(0)" ::: "memory");
    __syncthreads();
    if (my_tid() == 0) {
        unsigned* bar = b.bar;
        __builtin_amdgcn_s_waitcnt(0);
        unsigned nloc = b.st[0], nx = b.st[1];
        if (nloc == 0u) { xcd_barrier_complete(bar, b.x, nloc, nx); b.st[0] = nloc; b.st[1] = nx; }
        const unsigned old = xb_add(&bar[XB_XSUB(b.x)], 1u);
        const unsigned gen = old / nloc;
        if (old + 1u == (gen + 1u) * nloc) {
            __builtin_amdgcn_fence(__ATOMIC_RELEASE, "agent");
            asm volatile("s_waitcnt vmcnt(0)" ::: "memory");
            const unsigned og = xb_add(&bar[XB_TOP], 1u);
            const unsigned tg = og / nx;
            if (og + 1u == (tg + 1u) * nx) xb_add(&bar[XB_TOPGEN], 1u);
            else XB_SPIN(xb_ld(&bar[XB_TOPGEN]) == tg, bar);
            __builtin_amdgcn_fence(__ATOMIC_ACQUIRE, "agent");
            xb_add(&bar[XB_XGEN(b.x)], 1u);
            asm volatile("s_waitcnt vmcnt(0)" ::: "memory");
        } else {
            XB_SPIN(xb_ld(&bar[XB_XGEN(b.x)]) == gen, bar);
            __builtin_amdgcn_fence(__ATOMIC_ACQUIRE, "agent");
            asm volatile("s_waitcnt vmcnt(0)" ::: "memory");
        }
    }
    __syncthreads();
}

namespace pg8 {
#define PG8_LAS __attribute__((address_space(3)))
typedef unsigned short bf16_t;
typedef short bf16x8 __attribute__((ext_vector_type(8)));
typedef float f32x4 __attribute__((ext_vector_type(4)));
typedef unsigned u32x4 __attribute__((ext_vector_type(4)));
constexpr int BM = 256, BK = 64, HALF = 128, HTB = HALF * BK * 2  , STAGE_BYTES = 8 * HTB, NXCD = 8, WGM = 8;

__host__ __device__ __forceinline__ int lds_byte(int r, int c) { const int st = (r >> 4) * 2 + (c >> 5), rr = r & 15, cc = c & 31, ob = rr * 64 + cc * 2; return st * 1024 + (ob ^ (((ob >> 9) & 1) << 5)); }
__host__ __device__ __forceinline__ void stage_rc(int b, int& R, int& C) { const int st = b / 1024, sb = b % 1024, swz = sb ^ (((sb >> 9) & 1) << 5); R = (st >> 1) * 16 + swz / 64; C = (st & 1) * 32 + (swz % 64) / 2; }
__host__ __device__ __forceinline__ int perm32(int rho) { const int n = rho >> 4, i = rho & 15; return 8 * (i >> 2) + 4 * n + (i & 3); }

struct Unit { int pm, pn; };
struct Gemm { const bf16_t* A; const bf16_t* Bt; int M, N, K; };

struct StaticOrder {
    int nM, nN, nwg, G, c;
    __host__ __device__ void init(int M, int N, int G_, int c_) { nM = M / BM; nN = N / BM; nwg = nM * nN; G = G_; c = c_; }
    __host__ __device__ bool next(int i, Unit& u) const {
        const long L = (long)i * G + c; if (L >= nwg) return false;
        int wgid = (int)L; { const int q = nwg / NXCD, r = nwg % NXCD, xcd = wgid % NXCD, off = wgid / NXCD; wgid = (xcd < r ? xcd * (q + 1) : r * (q + 1) + (xcd - r) * q) + off; }
        const int nig = WGM * nN, gid = wgid / nig, fm = gid * WGM, gsz = (nM - fm) < WGM ? (nM - fm) : WGM;
        u.pm = fm + ((wgid % nig) % gsz); u.pn = (wgid % nig) / gsz; return true;
    }
    __device__ __forceinline__ void a_ready(const Unit&) const {}
    __device__ __forceinline__ void done(const Unit&) const {}
};


typedef float f32x2e __attribute__((ext_vector_type(2))); typedef __bf16 bf16x2e __attribute__((ext_vector_type(2)));
__device__ __forceinline__ unsigned cvt_pk_bf16(float lo, float hi) { const f32x2e v = {lo, hi}; const bf16x2e b = __builtin_convertvector(v, bf16x2e); return __builtin_bit_cast(unsigned, b); }
__device__ __forceinline__ u32x4 pack8_bf16(const f32x4 v0, const f32x4 v1) { u32x4 w; w.x = cvt_pk_bf16(v0[0], v0[1]); w.y = cvt_pk_bf16(v0[2], v0[3]); w.z = cvt_pk_bf16(v1[0], v1[1]); w.w = cvt_pk_bf16(v1[2], v1[3]); return w; }

struct EpiProj {
    static constexpr bool PERM = true, AFTER_DRAIN = false;
    bf16_t* HM; bf16_t* SCB; float* SBp;
    __device__ __forceinline__ void operator()(const f32x4 (&acc)[2][2][4][2], const Unit& u, int wr, int wc, int fr, int fq) const {
        const int row0 = u.pm * BM + wr * 64 + fr;
        if (u.pn * BM == PC_SMALL) {
            if (wc < 2) {
#pragma unroll
                for (int ai = 0; ai < 2; ++ai)
#pragma unroll
                    for (int m = 0; m < 4; ++m) { float* rp = SBp + (size_t)(row0 + ai * HALF + m * 16) * SBW + wc * 32 + 8 * fq;
                        *(f32x4*)rp = acc[ai][0][m][0]; *(f32x4*)(rp + 4) = acc[ai][0][m][1]; }
            }
            return;
        }
        const int b = (u.pm * BM) / SEQ, s0 = row0 - b * SEQ;
#pragma unroll
        for (int bj = 0; bj < 2; ++bj) { const int colbase = u.pn * BM + bj * HALF;
            bf16_t* dst; size_t pitch;
            if (colbase >= PC_SB && colbase < PC_GQ) { dst = SCB + (size_t)row0 * SCBW + (colbase - PC_SB) + wc * 32 + 8 * fq; pitch = SCBW; }
            else { const int hc = colbase < PC_SB ? colbase : colbase - (PC_GQ - PC_SB), part = hc / 1536, head = (hc % 1536) / HD;
                   dst = HM + hm_off(part, b * FOXH + head) + (size_t)s0 * HD + wc * 32 + 8 * fq; pitch = HD; }
#pragma unroll
            for (int ai = 0; ai < 2; ++ai)
#pragma unroll
                for (int m = 0; m < 4; ++m) *(u32x4*)(dst + (size_t)(ai * HALF + m * 16) * pitch) = pack8_bf16(acc[ai][bj][m][0], acc[ai][bj][m][1]); }
    }
};
struct EpiY {
    static constexpr bool PERM = true, AFTER_DRAIN = false;
    bf16_t* Y; float* SS;
    __device__ __forceinline__ void operator()(const f32x4 (&acc)[2][2][4][2], const Unit& u, int wr, int wc, int fr, int fq) const {
        const int row0 = u.pm * BM + wr * 64 + fr, col0 = u.pn * BM + wc * 32 + 8 * fq;
#pragma unroll
        for (int ai = 0; ai < 2; ++ai)
#pragma unroll
            for (int m = 0; m < 4; ++m) { const int row = row0 + ai * HALF + m * 16; bf16_t* rowp = Y + (size_t)row * DM + col0; float s = 0.f;
#pragma unroll
                for (int bj = 0; bj < 2; ++bj) { const f32x4 a = acc[ai][bj][m][0], b = acc[ai][bj][m][1];
                    s += (a[0] * a[0] + a[1] * a[1]) + (a[2] * a[2] + a[3] * a[3]) + (b[0] * b[0] + b[1] * b[1]) + (b[2] * b[2] + b[3] * b[3]);
                    *(u32x4*)(rowp + bj * HALF) = pack8_bf16(a, b); }
                s += __shfl_xor(s, 16); s += __shfl_xor(s, 32);
                if (fq == 0) SS[(size_t)row * 64 + u.pn * 4 + wc] = s; }
    }
};
__device__ __forceinline__ float silu_f(float x) { return x * __builtin_amdgcn_rcpf(1.0f + __builtin_amdgcn_exp2f(-1.4426950408889634f * x)); }
struct EpiSwiGLU {
    static constexpr bool PERM = true, AFTER_DRAIN = false;
    bf16_t* Hd;
    __device__ __forceinline__ void operator()(const f32x4 (&acc)[2][2][4][2], const Unit& u, int wr, int wc, int fr, int fq) const {
        const int row0 = u.pm * BM + wr * 64 + fr, col0 = u.pn * HALF + wc * 32 + 8 * fq;
#pragma unroll
        for (int ai = 0; ai < 2; ++ai)
#pragma unroll
            for (int m = 0; m < 4; ++m) { const f32x4 g0 = acc[ai][0][m][0], g1 = acc[ai][0][m][1], u0 = acc[ai][1][m][0], u1 = acc[ai][1][m][1]; f32x4 h0, h1;
#pragma unroll
                for (int e = 0; e < 4; ++e) { h0[e] = silu_f(g0[e]) * u0[e]; h1[e] = silu_f(g1[e]) * u1[e]; }
                *(u32x4*)(Hd + (size_t)(row0 + ai * HALF + m * 16) * FFN + col0) = pack8_bf16(h0, h1); }
    }
};

struct PanelOrder {
    int c, nround;
    __device__ __forceinline__ bool next(int i, Unit& u) const { if (i >= nround) return false; const int x = c & 7, k = c >> 3; u.pm = 16 * i + 2 * x + (k >> 4); u.pn = k & 15; return true; }
    __device__ __forceinline__ void a_ready(const Unit&) const {}
    __device__ __forceinline__ void done(const Unit&) const {}
};
template <class Epi, class Sched, bool ALIGN_EPI = false, bool SP2 = false>
__device__ __forceinline__ void gemm_phase(PG8_LAS unsigned char* lds, const Gemm g, const Sched& S, const Epi& E) {
    int tid_ = my_tid(); asm volatile("" : "+v"(tid_));
    const int tid = tid_, wid = __builtin_amdgcn_readfirstlane(tid >> 6), lane = tid & 63, wr = wid >> 2, wc = wid & 3, fr = lane & 15, fq = lane >> 4;
    const int K = g.K, nt = K / BK;
    unsigned voffA[2], voffB[2];
#pragma unroll
    for (int i = 0; i < 2; ++i) { int R, C; stage_rc(tid * 16 + i * 8192, R, C); const int Rb = Epi::PERM ? ((R & ~31) + perm32(R & 31)) : R;
        voffA[i] = (unsigned)(R * K + C) * 2u; voffB[i] = (unsigned)(Rb * K + C) * 2u; }
    const size_t kstep = (size_t)(BK * 2);
    const size_t hstep = (size_t)HALF * K * 2;
    const size_t tstep = 2 * hstep;
    const unsigned ldsw = (unsigned)wid * 1024u;
    const int aoff = lds_byte(wr * 64 + fr, fq * 8), boff = lds_byte(wc * 32 + fr, fq * 8);
#define PG8_SA(b, h) (((b) * 2 + (h)) * HTB)
#define PG8_SB(b, h) ((4 + (b) * 2 + (h)) * HTB)
#define PG8_STAGE(bufoff, gbase, voff) do { _Pragma("unroll") for (int _i = 0; _i < 2; ++_i) \
        __builtin_amdgcn_global_load_lds((const unsigned*)((const char*)(gbase) + (voff)[_i]), (PG8_LAS unsigned*)(lds + (bufoff) + ldsw + _i * 8192), 16, 0, 0); } while (0)
#define PG8_LDA(dst, b, h) do { _Pragma("unroll") for (int m = 0; m < 4; ++m) _Pragma("unroll") for (int k = 0; k < 2; ++k) dst[m][k] = *(const PG8_LAS bf16x8*)(lds + PG8_SA(b, h) + aoff + m * 2048 + k * 1024); } while (0)
#define PG8_LDB(dst, b, h) do { _Pragma("unroll") for (int n = 0; n < 2; ++n) _Pragma("unroll") for (int k = 0; k < 2; ++k) dst[n][k] = *(const PG8_LAS bf16x8*)(lds + PG8_SB(b, h) + boff + n * 2048 + k * 1024); } while (0)
#define PG8_MMA(ai, bj, At, Bt) do { __builtin_amdgcn_s_setprio(1); _Pragma("unroll") for (int m = 0; m < 4; ++m) _Pragma("unroll") for (int n = 0; n < 2; ++n) _Pragma("unroll") for (int k = 0; k < 2; ++k) \
        acc[ai][bj][m][n] = __builtin_amdgcn_mfma_f32_16x16x32_bf16(Bt[n][k], At[m][k], acc[ai][bj][m][n], 0, 0, 0); __builtin_amdgcn_s_setprio(0); } while (0)
#define PG8_WAIT_V(n) asm volatile("s_waitcnt vmcnt(" #n ")" ::: "memory")
#define PG8_WAIT_L(n) asm volatile("s_waitcnt lgkmcnt(" #n ")" ::: "memory")
#define PG8_BAR __builtin_amdgcn_s_barrier()
#define PG8_SCHED __builtin_amdgcn_sched_barrier(0)
    Unit cur, nxt; int ui = 0;
    if (!S.next(0, cur)) return;
    f32x4 acc[2][2][4][2];
#pragma unroll
    for (int a = 0; a < 2; ++a)
#pragma unroll
        for (int b = 0; b < 2; ++b)
#pragma unroll
            for (int m = 0; m < 4; ++m)
#pragma unroll
                for (int n = 0; n < 2; ++n) acc[a][b][m][n] = (f32x4){0.f, 0.f, 0.f, 0.f};
    bf16x8 At[4][2], B0[2][2], B1[2][2];
    const char* cA = (const char*)g.A + (size_t)cur.pm * tstep; const char* cB = (const char*)g.Bt + (size_t)cur.pn * tstep;
    S.a_ready(cur);
    if constexpr (SP2) {
        PG8_STAGE(PG8_SB(0, 0), cB, voffB); PG8_STAGE(PG8_SB(0, 1), cB + hstep, voffB); PG8_STAGE(PG8_SA(0, 0), cA, voffA); PG8_STAGE(PG8_SA(0, 1), cA + hstep, voffA);
        if (wr == 1) PG8_BAR;
        PG8_WAIT_V(2); PG8_BAR;
        PG8_STAGE(PG8_SB(1, 0), cB + kstep, voffB); PG8_STAGE(PG8_SA(1, 0), cA + kstep, voffA); PG8_STAGE(PG8_SB(1, 1), cB + hstep + kstep, voffB);
        PG8_WAIT_V(6); PG8_BAR;
    } else {
        PG8_STAGE(PG8_SB(0, 0), cB, voffB); PG8_STAGE(PG8_SA(0, 0), cA, voffA); PG8_STAGE(PG8_SB(0, 1), cB + hstep, voffB); PG8_STAGE(PG8_SA(0, 1), cA + hstep, voffA);
        if (wr == 1) PG8_BAR;
        PG8_WAIT_V(4); PG8_BAR;
        PG8_STAGE(PG8_SB(1, 0), cB + kstep, voffB); PG8_STAGE(PG8_SA(1, 0), cA + kstep, voffA); PG8_STAGE(PG8_SB(1, 1), cB + hstep + kstep, voffB);
        PG8_WAIT_V(6); PG8_BAR;
    }
    for (;;) {
        const bool has_next = S.next(ui + 1, nxt);
        const char* nA = has_next ? (const char*)g.A + (size_t)nxt.pm * tstep : cA; const char* nB = has_next ? (const char*)g.Bt + (size_t)nxt.pn * tstep : cB;
        for (int t = 0; t < nt; t += 2) {
            const bool last = (t == nt - 2);
            const char* a1 = cA + (size_t)(t + 1) * kstep;
            const char* a2 = last ? nA : cA + (size_t)(t + 2) * kstep; const char* b2 = last ? nB : cB + (size_t)(t + 2) * kstep;
            const char* a3 = a2 + kstep; const char* b3 = b2 + kstep;
            if (last && has_next) S.a_ready(nxt);
            if constexpr (SP2) {
            PG8_LDB(B0, 0, 0); PG8_LDB(B1, 0, 1); PG8_SCHED; PG8_LDA(At, 0, 0); PG8_STAGE(PG8_SA(1, 1), a1 + hstep, voffA);
            PG8_WAIT_V(8); PG8_WAIT_L(0); PG8_BAR; PG8_MMA(0, 0, At, B0); PG8_MMA(0, 1, At, B1); PG8_BAR; PG8_SCHED;
            PG8_LDA(At, 0, 1); PG8_STAGE(PG8_SB(0, 0), b2, voffB); PG8_STAGE(PG8_SB(0, 1), b2 + hstep, voffB); PG8_STAGE(PG8_SA(0, 0), a2, voffA);
            PG8_WAIT_V(8); PG8_WAIT_L(0); PG8_BAR; PG8_MMA(1, 0, At, B0); PG8_MMA(1, 1, At, B1); PG8_BAR; PG8_SCHED;
            PG8_LDB(B0, 1, 0); PG8_LDB(B1, 1, 1); PG8_SCHED; PG8_LDA(At, 1, 0); PG8_STAGE(PG8_SA(0, 1), a2 + hstep, voffA);
            PG8_WAIT_V(8); PG8_WAIT_L(0); PG8_BAR; PG8_MMA(0, 0, At, B0); PG8_MMA(0, 1, At, B1); PG8_BAR; PG8_SCHED;
            PG8_LDA(At, 1, 1); PG8_STAGE(PG8_SB(1, 0), b3, voffB); PG8_STAGE(PG8_SB(1, 1), b3 + hstep, voffB); PG8_STAGE(PG8_SA(1, 0), a3, voffA);
            PG8_WAIT_V(8); PG8_WAIT_L(0); PG8_BAR; PG8_MMA(1, 0, At, B0); PG8_MMA(1, 1, At, B1); PG8_BAR; PG8_SCHED;
            } else {
            PG8_LDB(B0, 0, 0); PG8_SCHED; PG8_LDA(At, 0, 0); PG8_STAGE(PG8_SA(1, 1), a1 + hstep, voffA);
            PG8_WAIT_L(8); PG8_BAR; PG8_WAIT_L(0); PG8_MMA(0, 0, At, B0); PG8_BAR; PG8_SCHED;
            PG8_LDB(B1, 0, 1); PG8_STAGE(PG8_SB(0, 0), b2, voffB);
            PG8_BAR; PG8_WAIT_L(0); PG8_MMA(0, 1, At, B1); PG8_BAR;
            PG8_LDA(At, 0, 1); PG8_STAGE(PG8_SA(0, 0), a2, voffA);
            PG8_BAR; PG8_WAIT_L(0); PG8_MMA(1, 0, At, B0); PG8_BAR; PG8_SCHED;
            PG8_STAGE(PG8_SB(0, 1), b2 + hstep, voffB);
            PG8_WAIT_V(6); PG8_BAR; PG8_MMA(1, 1, At, B1); PG8_BAR;
            PG8_LDB(B0, 1, 0); PG8_SCHED; PG8_LDA(At, 1, 0); PG8_STAGE(PG8_SA(0, 1), a2 + hstep, voffA);
            PG8_WAIT_L(8); PG8_BAR; PG8_WAIT_L(0); PG8_MMA(0, 0, At, B0); PG8_BAR; PG8_SCHED;
            PG8_LDB(B1, 1, 1); PG8_STAGE(PG8_SB(1, 0), b3, voffB);
            PG8_BAR; PG8_WAIT_L(0); PG8_MMA(0, 1, At, B1); PG8_BAR;
            PG8_LDA(At, 1, 1); PG8_STAGE(PG8_SA(1, 0), a3, voffA);
            PG8_BAR; PG8_WAIT_L(0); PG8_MMA(1, 0, At, B0); PG8_BAR; PG8_SCHED;
            PG8_STAGE(PG8_SB(1, 1), b3 + hstep, voffB);
            PG8_WAIT_V(6); PG8_BAR; PG8_MMA(1, 1, At, B1); PG8_BAR;
            }
        }
        if constexpr (ALIGN_EPI) { if (wr == 0) PG8_BAR; }
        if constexpr (!Epi::AFTER_DRAIN) { E(acc, cur, wr, wc, fr, fq); S.done(cur); }
        if (!has_next) break;
#pragma unroll
        for (int a = 0; a < 2; ++a)
#pragma unroll
            for (int b = 0; b < 2; ++b)
#pragma unroll
                for (int m = 0; m < 4; ++m)
#pragma unroll
                    for (int n = 0; n < 2; ++n) acc[a][b][m][n] = (f32x4){0.f, 0.f, 0.f, 0.f};
        cur = nxt; cA = nA; cB = nB; ++ui;
        if constexpr (ALIGN_EPI) { if (wr == 1) PG8_BAR; }
    }
    PG8_WAIT_V(0);
    if constexpr (!ALIGN_EPI) { if (wr == 0) PG8_BAR; }
    PG8_BAR;
    if constexpr (Epi::AFTER_DRAIN) { E.fused(acc, cur, wr, wc, fr, fq, lds, wid, lane); S.done(cur); }
#undef PG8_SA
#undef PG8_SB
#undef PG8_STAGE
#undef PG8_LDA
#undef PG8_LDB
#undef PG8_MMA
#undef PG8_WAIT_V
#undef PG8_WAIT_L
#undef PG8_BAR
#undef PG8_SCHED
}
}

namespace attn {
constexpr int KVP = HD, OP = DM;
constexpr float SCALE = 0.08838834764831845f;
constexpr int D = 128;
constexpr int NW = 8, QBLK = 32, KVBLK = 64, QB = NW * QBLK;
constexpr int SHM_V = KVBLK * D * 2, SHM_K = KVBLK * D * 2;
constexpr int FB_OFF = 2 * SHM_V + 2 * SHM_K + NW * 64 * 4;
constexpr int LDS_BYTES = FB_OFF + 2 * 64 * 4;
constexpr bool WSKIP = false;
constexpr float THR = 16.f;

using bf16 = __hip_bfloat16;
typedef short bf16x8 __attribute__((ext_vector_type(8)));
typedef short s16x4 __attribute__((ext_vector_type(4)));
typedef float f32x16 __attribute__((ext_vector_type(16)));
typedef float f32x4 __attribute__((ext_vector_type(4)));
typedef unsigned u32x4 __attribute__((ext_vector_type(4)));
template <class A, class Bt> struct same_t { static constexpr bool v = false; };
template <class A> struct same_t<A, A> { static constexpr bool v = true; };

#define KSWZ(row, colB) ((row) * 256 + ((colB) ^ (((row) & 7) << 4)))
#define SBAR() __builtin_amdgcn_sched_barrier(0)
__device__ __forceinline__ int v_st(int k, int c) { const int kk = (k & ~0xC) | ((k & 4) << 1) | ((k & 8) >> 1); return ((kk >> 3) * 4 + (c >> 5)) * 512 + ((kk & 7) * 32 + (c & 31)) * 2; }
__device__ __forceinline__ int v_rd_base(int lane) { return ((lane & 3) << 3) | (((lane >> 2) & 3) << 6) | (((lane >> 4) & 1) << 5) | (((lane >> 5) & 1) << 8); }
constexpr int v_rd_off(int d0, int ks, int half) { return d0 * 512 + ks * 4096 + half * 2048; }
__device__ __forceinline__ int crow(int r, int hi) { return (r & 3) + 8 * (r >> 2) + 4 * hi; }
__device__ __forceinline__ unsigned cvtpk(float lo, float hi) {
    unsigned r; asm volatile("v_cvt_pk_bf16_f32 %0, %1, %2" : "=v"(r) : "v"(lo), "v"(hi)); return r;
}
__device__ __forceinline__ bf16x8 pack8(f32x4 a, f32x4 b) {
    u32x4 w = {cvtpk(a[0], a[1]), cvtpk(a[2], a[3]), cvtpk(b[0], b[1]), cvtpk(b[2], b[3])};
    return *reinterpret_cast<bf16x8*>(&w);
}
template <class T> __device__ __forceinline__ bf16x8 load8(const T* p) {
    if constexpr (same_t<T, float>::v) { return pack8(*(const f32x4*)p, *(const f32x4*)(p + 4)); }
    else { return *reinterpret_cast<const bf16x8*>(p); }
}
__device__ __forceinline__ void mask_tile(f32x16& p0, f32x16& p1, int dq, unsigned W) {
    const float NEG = -__builtin_inff();
#pragma unroll
    for (int r = 0; r < 16; ++r) {
        const int c = (r & 3) + 8 * (r >> 2);
        if ((unsigned)(dq - c) >= W) p0[r] = NEG;
        if ((unsigned)(dq - c - 32) >= W) p1[r] = NEG;
    }
}
__device__ __forceinline__ void partialSM(f32x16& p0, f32x16& p1, float& m_reg, float& mn, float& alpha) {
    float pmax = p0[0]; for (int r = 1; r < 16; ++r) pmax = fmaxf(pmax, p0[r]); for (int r = 0; r < 16; ++r) pmax = fmaxf(pmax, p1[r]);
    { auto rr = __builtin_amdgcn_permlane32_swap(__float_as_uint(pmax), __float_as_uint(pmax), false, false);
      pmax = fmaxf(__uint_as_float(rr[0]), __uint_as_float(rr[1])); }
    constexpr float C2 = 1.4426950408889634f * SCALE;
    if (__builtin_expect(__all((pmax - m_reg) * SCALE <= THR), 1)) { mn = m_reg; alpha = 1.f; }
    else { mn = fmaxf(m_reg, pmax); alpha = __builtin_amdgcn_exp2f((m_reg - mn) * C2); m_reg = mn; }
    const float mnL = -mn * C2;
    for (int r = 0; r < 16; ++r) p0[r] = fmaf(p0[r], C2, mnL); for (int r = 0; r < 16; ++r) p1[r] = fmaf(p1[r], C2, mnL);
    for (int r = 0; r < 16; ++r) p0[r] = __builtin_amdgcn_exp2f(p0[r]);
}
__device__ __forceinline__ void finishSM(f32x16& p0, f32x16& p1, float alpha, float& l_reg, bf16x8& pa0, bf16x8& pa1, bf16x8& pa2, bf16x8& pa3) {
    for (int r = 0; r < 16; ++r) p1[r] = __builtin_amdgcn_exp2f(p1[r]);
    float ps = 0; for (int r = 0; r < 16; ++r) ps += p0[r]; for (int r = 0; r < 16; ++r) ps += p1[r];
    { auto rr = __builtin_amdgcn_permlane32_swap(__float_as_uint(ps), __float_as_uint(ps), false, false);
      ps = __uint_as_float(rr[0]) + __uint_as_float(rr[1]); }
    l_reg = l_reg * alpha + ps;
#define PK4(P, B_, OUT) do { unsigned a0 = cvtpk(P[B_+0], P[B_+1]), a1 = cvtpk(P[B_+2], P[B_+3]);                          \
        unsigned b0 = cvtpk(P[B_+4], P[B_+5]), b1 = cvtpk(P[B_+6], P[B_+7]);                                             \
        auto r0 = __builtin_amdgcn_permlane32_swap(a0, b0, false, false); auto r1 = __builtin_amdgcn_permlane32_swap(a1, b1, false, false); \
        u32x4 w = {r0[0], r1[0], r0[1], r1[1]}; OUT = *reinterpret_cast<bf16x8*>(&w); } while (0)
    PK4(p0, 0, pa0); PK4(p0, 8, pa1); PK4(p1, 0, pa2); PK4(p1, 8, pa3);
#undef PK4
}
template <int KB, bool SK>
__device__ __forceinline__ void qkt(f32x16& p0, f32x16& p1, const char* K_lds, int r32, int hi, const bf16x8* qr, bool act) {
    if (SK && !act) { const float NEG = -__builtin_inff();
#pragma unroll
        for (int r = 0; r < 16; ++r) { p0[r] = NEG; p1[r] = NEG; } return; }
    { const char* fb = K_lds + 2 * SHM_K + NW * 64 * 4 + KB * 256 + hi * 16;
#pragma unroll
      for (int g = 0; g < 4; ++g) { const f32x4 a = *reinterpret_cast<const f32x4*>(fb + g * 32), b = *reinterpret_cast<const f32x4*>(fb + 128 + g * 32);
          p0[4 * g] = a[0]; p0[4 * g + 1] = a[1]; p0[4 * g + 2] = a[2]; p0[4 * g + 3] = a[3]; p1[4 * g] = b[0]; p1[4 * g + 1] = b[1]; p1[4 * g + 2] = b[2]; p1[4 * g + 3] = b[3]; } }
    const char* kb[4];
#pragma unroll
    for (int dd = 0; dd < 4; ++dd) kb[dd] = K_lds + KB * SHM_K + KSWZ(r32, (dd * 16 + hi * 8) * 2);
#pragma unroll
    for (int d0 = 0; d0 < 8; ++d0) { const char* a = kb[d0 & 3] + (d0 >> 2) * 128;
        bf16x8 b0 = *reinterpret_cast<const bf16x8*>(a);
        bf16x8 b1 = *reinterpret_cast<const bf16x8*>(a + 32 * 256);
        p0 = __builtin_amdgcn_mfma_f32_32x32x16_bf16(b0, qr[d0], p0, 0, 0, 0);
        p1 = __builtin_amdgcn_mfma_f32_32x32x16_bf16(b1, qr[d0], p1, 0, 0, 0); }
}
template <int VB, bool SK>
__device__ __forceinline__ void pv_tile(f32x16* o, int vb0, bf16x8 pa0, bf16x8 pa1, bf16x8 pa2, bf16x8 pa3, bool act) {
    if (SK && !act) return;
#define TRRD(dst, off) asm volatile("ds_read_b64_tr_b16 %0, %1 offset:%2" : "=&v"(dst) : "v"(vb0), "i"(off) : "memory")
#define PV_D0(d0) do { s16x4 l0, l1, l2, l3, h0, h1, h2, h3; constexpr int b_ = VB * SHM_V + v_rd_off(d0, 0, 0);     \
        TRRD(l0, b_); TRRD(h0, b_ + 2048); TRRD(l1, b_ + 4096); TRRD(h1, b_ + 6144); TRRD(l2, b_ + 8192); TRRD(h2, b_ + 10240); TRRD(l3, b_ + 12288); TRRD(h3, b_ + 14336); \
        asm volatile("s_waitcnt lgkmcnt(0)" ::: "memory"); SBAR();                 \
        o[d0] = __builtin_amdgcn_mfma_f32_32x32x16_bf16(pa0, (bf16x8){l0[0], l0[1], l0[2], l0[3], h0[0], h0[1], h0[2], h0[3]}, o[d0], 0, 0, 0);   \
        o[d0] = __builtin_amdgcn_mfma_f32_32x32x16_bf16(pa1, (bf16x8){l1[0], l1[1], l1[2], l1[3], h1[0], h1[1], h1[2], h1[3]}, o[d0], 0, 0, 0);   \
        o[d0] = __builtin_amdgcn_mfma_f32_32x32x16_bf16(pa2, (bf16x8){l2[0], l2[1], l2[2], l2[3], h2[0], h2[1], h2[2], h2[3]}, o[d0], 0, 0, 0);   \
        o[d0] = __builtin_amdgcn_mfma_f32_32x32x16_bf16(pa3, (bf16x8){l3[0], l3[1], l3[2], l3[3], h3[0], h3[1], h3[2], h3[3]}, o[d0], 0, 0, 0); } while (0)
    PV_D0(0); PV_D0(1); PV_D0(2); PV_D0(3);
#undef PV_D0
#undef TRRD
}

template <class TIn, class TOut> struct BlockRef { const TIn* Q; const TIn* K; const TIn* V; const float* F; TOut* O; int P0; int JLO; };
template <class TIn> struct Seam {
    bf16x8 qr[8];
    bf16x8 st_v0, st_v1, st_k0, st_k1; float st_f; f32x4 sf0, sf1, sf2, sf3;
    f32x4 tq[16];
};
__device__ __forceinline__ int swa_jlo(int P0, int W) { const int lowk = P0 - W + 1; return lowk > 0 ? lowk / KVBLK : 0; }
#define ROW(p, k0, rr) ((p) + (size_t)((k0) + (rr)) * KVP + sc)
#define VMW() asm volatile("s_waitcnt vmcnt(0)" ::: "memory")
#define VMWN(n) asm volatile("s_waitcnt vmcnt(%0)" :: "i"(n) : "memory")
#define SLOAD_H(Kp, Vp, Fp, k0) do { S.st_v0 = load8<TIn>(ROW(Vp, k0, sr)); S.st_v1 = load8<TIn>(ROW(Vp, k0, 32 + sr));              \
                         S.st_k0 = load8<TIn>(ROW(Kp, k0, sr)); S.st_k1 = load8<TIn>(ROW(Kp, k0, 32 + sr)); if (tid < 64) S.st_f = (Fp)[(k0) + tid]; } while (0)
#define SWRITE_HK(bf) do { *(bf16x8*)(K_lds + (bf) * SHM_K + kws) = S.st_k0; *(bf16x8*)(K_lds + (bf) * SHM_K + kws + 32 * 256) = S.st_k1; if (tid < 64) *(float*)(K_lds + 2 * SHM_K + NW * 64 * 4 + (bf) * 256 + tid * 4) = S.st_f; } while (0)
#define SWRITE_HV(bf) do { *(bf16x8*)(V_lds + (bf) * SHM_V + vst0) = S.st_v0; *(bf16x8*)(V_lds + (bf) * SHM_V + vst1) = S.st_v1; } while (0)
#define SWRITE_H(bf) do { SWRITE_HV(bf); SWRITE_HK(bf); } while (0)
#define SLOAD_F(p, k0) do { S.sf0 = *(const f32x4*)ROW(p, k0, sr); S.sf1 = *(const f32x4*)(ROW(p, k0, sr) + 4);                \
                            S.sf2 = *(const f32x4*)ROW(p, k0, 32 + sr); S.sf3 = *(const f32x4*)(ROW(p, k0, 32 + sr) + 4); } while (0)
#define SWRITE_KF(bf) do { *(bf16x8*)(K_lds + (bf) * SHM_K + kws) = pack8(S.sf0, S.sf1); *(bf16x8*)(K_lds + (bf) * SHM_K + kws + 32 * 256) = pack8(S.sf2, S.sf3); } while (0)
#define SWRITE_VF(bf) do { *(bf16x8*)(V_lds + (bf) * SHM_V + vst0) = pack8(S.sf0, S.sf1); *(bf16x8*)(V_lds + (bf) * SHM_V + vst1) = pack8(S.sf2, S.sf3); } while (0)
template <class TIn, class TOut>
__device__ __forceinline__ void causal_swa_prime(const BlockRef<TIn, TOut>& cur, int W, char* lds, Seam<TIn>& S) {
    constexpr bool F32 = same_t<TIn, float>::v;
    int tid_ = my_tid(); asm volatile("" : "+v"(tid_));
    const int tid = tid_, wid = __builtin_amdgcn_readfirstlane(tid >> 6), lane = tid & 63, r32 = lane & 31, hi = lane >> 5;
    const int sr = tid >> 4, sc = (tid & 15) * 8, kws = KSWZ(sr, sc * 2); char* K_lds = lds + 2 * SHM_V;
    const int kb0 = cur.JLO * KVBLK;
    for (int d0 = 0; d0 < 8; ++d0) S.qr[d0] = load8<TIn>(cur.Q + (size_t)(wid * QBLK + r32) * KVP + d0 * 16 + hi * 8);
    if constexpr (F32) { SLOAD_F((const float*)cur.K, kb0); VMW(); SWRITE_KF(0); SBAR(); SLOAD_F((const float*)cur.V, kb0); }
    else { SLOAD_H(cur.K, cur.V, cur.F, kb0); VMW(); SWRITE_HK(0); }
    __syncthreads();
}
template <class TIn, class TOut>
__device__ __forceinline__ void causal_swa_block(const BlockRef<TIn, TOut>& cur, const BlockRef<TIn, TOut>& nxt, int skv, int W, char* lds, Seam<TIn>& S, const float* const __attribute__((address_space(4)))* gslot, int goff) {
    constexpr bool F32 = same_t<TIn, float>::v;
    int tid_ = my_tid(); asm volatile("" : "+v"(tid_));
    const int tid = tid_, wid = __builtin_amdgcn_readfirstlane(tid >> 6), lane = tid & 63, r32 = lane & 31, hi = lane >> 5;
    const int j_lo = cur.JLO;
    int j_hi = (cur.P0 + QB - 1) / KVBLK + 1; if (j_hi > skv / KVBLK) j_hi = skv / KVBLK;
    const int NT = j_hi - j_lo;
    const int kbn = nxt.JLO * KVBLK;
    const int qlo = cur.P0 + wid * QBLK, qm = qlo + r32 - 4 * hi;
    char* V_lds = lds; char* K_lds = lds + 2 * SHM_V;
    float* ws = (float*)(lds + 2 * SHM_V + 2 * SHM_K) + wid * 64; float* li_l = ws, * al_l = ws + 32;
    float m_reg = -1e30f, l_reg = 0; f32x16 o[4] = {};
    const int sr = tid >> 4, sc = (tid & 15) * 8, vst0 = v_st(sr, sc), vst1 = v_st(32 + sr, sc), kws = KSWZ(sr, sc * 2);
    const int vb0 = (int)(uintptr_t)V_lds + v_rd_base(lane);
    const TIn* Kh = cur.K; const TIn* Vh = cur.V; const float* Fh = cur.F;
#define RESC(a) do { if (__any((a) < 1.f)) { if (hi == 0) al_l[r32] = (a); asm volatile("s_waitcnt lgkmcnt(0)" ::: "memory");              \
                     for (int d_ = 0; d_ < 4; ++d_) for (int r = 0; r < 16; ++r) o[d_][r] *= al_l[crow(r, hi)]; } } while (0)
#define KBASE(t) ((j_lo + (t)) * KVBLK)
#define ACT(t) (KBASE(t) <= qlo + QBLK - 1 && KBASE(t) + KVBLK - 1 >= qlo - W + 1)
#define MASKT(P0_, P1_, t) do { const int kb_ = KBASE(t); if ((!SK || ACT(t)) && (kb_ + KVBLK - 1 > qlo || kb_ <= qlo + QBLK - 1 - W)) mask_tile(P0_, P1_, qm - kb_, (unsigned)W); } while (0)
    constexpr int NQL = F32 ? 16 : 8;
    constexpr bool SK = WSKIP && !F32;
#define SEAM_K0() do { VMWN(NQL); if constexpr (F32) { SWRITE_KF(0); SBAR(); SLOAD_F((const float*)nxt.V, kbn); } else { SWRITE_HK(0); } SBAR(); } while (0)
    f32x16 pA0, pA1, pB0, pB1; float mnA, mnB, alA, alB; bf16x8 pa0, pa1, pa2, pa3;
    if constexpr (F32) { VMW(); SWRITE_VF(0); SBAR(); } else { SWRITE_HV(0); SBAR(); }
    if (NT > 1) { if constexpr (F32) SLOAD_F((const float*)Kh, KBASE(1)); else SLOAD_H(Kh, Vh, Fh, KBASE(1)); }
    SBAR(); qkt<0, SK>(pA0, pA1, K_lds, r32, hi, S.qr, ACT(0));
    if constexpr (F32) { if (NT > 1) { VMW(); SWRITE_KF(1); SBAR(); SLOAD_F((const float*)Vh, KBASE(1)); } }
    MASKT(pA0, pA1, 0); partialSM(pA0, pA1, m_reg, mnA, alA);
    if (NT > 1) { VMW(); if constexpr (F32) { SWRITE_VF(1); SBAR(); if (NT > 2) SLOAD_F((const float*)Kh, KBASE(2)); } else SWRITE_H(1); }
    __syncthreads();
#define HALF_STEP(PX0, PX1, mnX, alX, PY0, PY1, alY, t, KB, VB, SB) do {                                                      \
        SBAR(); qkt<KB, SK>(PX0, PX1, K_lds, r32, hi, S.qr, ACT(t));                                             \
        finishSM(PY0, PY1, alY, l_reg, pa0, pa1, pa2, pa3); SBAR();                                                           \
        if ((t) + 1 < NT) { if constexpr (F32) { VMW(); SWRITE_KF(SB); SBAR(); SLOAD_F((const float*)Vh, KBASE((t) + 1)); }  \
                            else { SLOAD_H(Kh, Vh, Fh, KBASE((t) + 1)); } SBAR(); }                                               \
        pv_tile<VB, SK>(o, vb0, pa0, pa1, pa2, pa3, ACT((t) - 1)); MASKT(PX0, PX1, (t)); partialSM(PX0, PX1, m_reg, mnX, alX);                                        \
        __syncthreads();                                                                                                      \
        if ((t) + 1 < NT) { VMW(); if constexpr (F32) { SWRITE_VF(SB); SBAR(); if ((t) + 2 < NT) SLOAD_F((const float*)Kh, KBASE((t) + 2)); } \
                            else { SWRITE_H(SB); } }                                                                          \
        RESC(alX); __syncthreads(); } while (0)
    for (int t = 1; t + 1 < NT; t += 2) {
        HALF_STEP(pB0, pB1, mnB, alB, pA0, pA1, alA, t, 1, 0, 0);
        HALF_STEP(pA0, pA1, mnA, alA, pB0, pB1, alB, t + 1, 0, 1, 1);
    }
    const bool even = (NT & 1) == 0;
    if (even) { SBAR(); qkt<1, SK>(pB0, pB1, K_lds, r32, hi, S.qr, ACT(NT - 1)); SBAR(); }
#define QROW(e) (nxt.Q + (size_t)(wid * QBLK + r32) * KVP + ((e) >> 1) * 16 + hi * 8 + ((e) & 1) * 4)
    if constexpr (F32) { SLOAD_F((const float*)nxt.K, kbn); SBAR();
#pragma unroll
        for (int e = 0; e < 8; ++e) S.tq[e] = *(const f32x4*)QROW(e); }
    else { SLOAD_H(nxt.K, nxt.V, nxt.F, kbn); SBAR();
#pragma unroll
        for (int d0 = 0; d0 < 8; ++d0) S.qr[d0] = load8<TIn>(nxt.Q + (size_t)(wid * QBLK + r32) * KVP + d0 * 16 + hi * 8); }
    SBAR();
    finishSM(pA0, pA1, alA, l_reg, pa0, pa1, pa2, pa3); SBAR();
    if constexpr (F32) {
#pragma unroll
        for (int e = 8; e < 16; ++e) S.tq[e] = *(const f32x4*)QROW(e); SBAR(); }
#undef QROW
    pv_tile<0, SK>(o, vb0, pa0, pa1, pa2, pa3, ACT(even ? NT - 2 : NT - 1));
    if (even) { MASKT(pB0, pB1, NT - 1); partialSM(pB0, pB1, m_reg, mnB, alB); __syncthreads(); RESC(alB);
        finishSM(pB0, pB1, alB, l_reg, pa0, pa1, pa2, pa3); SBAR(); pv_tile<1, SK>(o, vb0, pa0, pa1, pa2, pa3, ACT(NT - 1)); }
    SBAR(); SEAM_K0();
    if (hi == 0) li_l[r32] = l_reg; asm volatile("s_waitcnt lgkmcnt(0)" ::: "memory");
    float rli[16];
#pragma unroll
    for (int r = 0; r < 16; ++r) rli[r] = __builtin_amdgcn_rcpf(li_l[crow(r, hi)]);
    TOut* Ow = cur.O + (size_t)(wid * QBLK) * OP;
    float gn[4];
    { const float* G = *gslot + goff;
#pragma unroll
    for (int d0 = 0; d0 < 4; ++d0) gn[d0] = G[d0 * 32 + r32]; }
#pragma unroll
    for (int r = 0; r < 16; ++r) { const int orow = crow(r, hi);
        float y[4]; float ss = 0.f;
#pragma unroll
        for (int d0 = 0; d0 < 4; ++d0) { y[d0] = o[d0][r] * rli[r]; ss += y[d0] * y[d0]; }
        ss += __shfl_xor(ss, 1); ss += __shfl_xor(ss, 2); ss += __shfl_xor(ss, 4); ss += __shfl_xor(ss, 8); ss += __shfl_xor(ss, 16);
        const float rs = __builtin_amdgcn_rsqf(ss * (1.0f / 128.0f) + 1e-6f);
#pragma unroll
        for (int d0 = 0; d0 < 4; ++d0) { const float v = y[d0] * rs * gn[d0];
            if constexpr (same_t<TOut, float>::v) { Ow[(size_t)orow * OP + d0 * 32 + r32] = v; }
            else { const float vn = __shfl_xor(v, 1);
                   if ((r32 & 1) == 0) *(unsigned*)(Ow + (size_t)orow * OP + d0 * 32 + r32) = cvtpk(v, vn); } }
        SBAR(); }
    if constexpr (F32) {
#pragma unroll
        for (int d0 = 0; d0 < 8; ++d0) S.qr[d0] = pack8(S.tq[2 * d0], S.tq[2 * d0 + 1]); }
    __syncthreads();
#undef RESC
#undef KBASE
#undef ACT
#undef MASKT
#undef SEAM_K0
#undef HALF_STEP
}
#undef ROW
#undef VMW
#undef VMWN
#undef SLOAD_H
#undef SWRITE_HK
#undef SWRITE_HV
#undef SWRITE_H
#undef SLOAD_F
#undef SWRITE_KF
#undef SWRITE_VF


}

__device__ __forceinline__ float bflo(unsigned w) { return __uint_as_float(w << 16); }
__device__ __forceinline__ float bfhi(unsigned w) { return __uint_as_float(w & 0xffff0000u); }
__device__ __forceinline__ float wave_sum(float v) {
#pragma unroll
    for (int o = 1; o < 64; o <<= 1) v += __shfl_xor(v, o);
    return v;
}
__device__ __forceinline__ float sigmoid_f(float x) { return 1.0f / (1.0f + __expf(-x)); }
__device__ __forceinline__ float silu_acc(float x) { return x / (1.0f + __expf(-x)); }
__device__ __forceinline__ float softplus_f(float x) { return fmaxf(x, 0.f) + log1pf(__expf(-fabsf(x))); }
__device__ __forceinline__ float logsigmoid_f(float x) { return fminf(x, 0.f) - log1pf(__expf(-fabsf(x))); }

struct Args { const float* in[17]; float* out; unsigned char* ws; int ph_lo, ph_hi; };
typedef const __attribute__((address_space(4))) Args* ArgsP;
enum { I_X = 0, I_MIXPRE, I_WIN, I_FOXFB, I_FOXON, I_SCW, I_GDNCW, I_GDNALOG, I_GDNDTB, I_GDNON, I_WOUT, I_MIXPOST, I_FFNPRE, I_WGATE, I_WUP, I_WDOWN, I_FFNPOST };
struct Ptrs {
    ArgsP ap;
    int tid, lane, wave, gw, NGW, G, bid;
};
__device__ __forceinline__ Ptrs fresh_ptrs(ArgsP ap0);
__device__ __forceinline__ int ftid() { int t = my_tid(); asm volatile("" : "+v"(t)); return t; }
__device__ __forceinline__ int fbid() { int b = blockIdx.x; asm volatile("" : "+s"(b)); return b; }
__device__ __forceinline__ ArgsP fresh(ArgsP a) { asm volatile("" : "+s"(a)); return a; }
__device__ __forceinline__ Ptrs fresh_ptrs(ArgsP ap0) { Ptrs P; P.ap = fresh(ap0); P.tid = ftid(); P.lane = P.tid & 63; P.wave = __builtin_amdgcn_readfirstlane(P.tid >> 6); P.bid = fbid();
    P.G = gridDim.x; P.gw = P.bid * NWAVES + P.wave; P.NGW = P.G * NWAVES; return P; }

__device__ __forceinline__ int win_src4(int d) {
    if (d < PC_SB) return d;
    if (d < PC_GQ) return d - PC_SB + SRC_SB;
    if (d < PC_GZ) return d - PC_GQ + SRC_GQ;
    if (d < PC_SMALL) return d - PC_GZ + SRC_GZ;
    const int e = d - PC_SMALL;
    if (e < 12) return SRC_FF + e;
    if (e < 24) return SRC_GA + e - 12;
    if (e < 36) return SRC_GB + e - 24;
    return -1;
}
__device__ __forceinline__ void tr_item(const float* __restrict__ W, int Ns, int scol, int k0, bf16* WT, int K, int dn0, LAS float* scr, int lane) {
    const int sub = lane >> 3, g = lane & 7;
    f32x4 v[8];
#pragma unroll
    for (int i = 0; i < 8; ++i) { const int kk = 8 * i + sub; v[i] = (f32x4){0.f, 0.f, 0.f, 0.f}; if (scol >= 0) v[i] = *(const f32x4*)(W + (size_t)(k0 + kk) * Ns + scol); }
#pragma unroll
    for (int i = 0; i < 8; ++i) { const int kk = 8 * i + sub; LAS float* s = scr + kk * 33 + 4 * g; s[0] = v[i][0]; s[1] = v[i][1]; s[2] = v[i][2]; s[3] = v[i][3]; }
    LDS_WAIT(); asm volatile("" ::: "memory");
    const int c = lane & 7;
#pragma unroll
    for (int j = 0; j < 4; ++j) { const int n = (lane >> 3) + 8 * j; const LAS float* s = scr + (8 * c) * 33 + n;
        v4u o; o.x = pk2(s[0 * 33], s[1 * 33]); o.y = pk2(s[2 * 33], s[3 * 33]); o.z = pk2(s[4 * 33], s[5 * 33]); o.w = pk2(s[6 * 33], s[7 * 33]);
        *(v4u*)(WT + (size_t)(dn0 + n) * K + k0 + 8 * c) = o; }
    LDS_WAIT(); asm volatile("" ::: "memory");
}
constexpr int I_IN = 64 * (NP / 32), I_OUT = 64 * (DM / 32), I_GU = 64 * (NGU / 32), I_DN = (FFN / 64) * (DM / 32), I_LAYER = I_IN + I_OUT + I_GU + I_DN;
#ifndef CV_TAIL_DN
#define CV_TAIL_DN 12000
#endif
#ifndef CV_TAIL_IN
#define CV_TAIL_IN 25000
#endif
constexpr int I_3 = I_IN + I_OUT + I_GU;

typedef unsigned u32x2t __attribute__((ext_vector_type(2)));
__device__ __forceinline__ float sq4(const f32x4 v) { return (v[0] * v[0] + v[1] * v[1]) + (v[2] * v[2] + v[3] * v[3]); }
__device__ __forceinline__ void rms_row_to_bf16(const float* xrow, const float* gain, bf16* orow, int lane) {
    f32x4 a[16]; float ss = 0.f;
#pragma unroll
    for (int j = 0; j < 16; ++j) { a[j] = *(const f32x4*)(xrow + 256 * j + 4 * lane); ss += sq4(a[j]); }
    const float r = 1.0f / sqrtf(wave_sum(ss) * (1.0f / DM) + RMS_EPS);
#pragma unroll
    for (int j = 0; j < 16; ++j) { const f32x4 g = *(const f32x4*)(gain + 256 * j + 4 * lane);
        u32x2t o; o.x = pk2(a[j][0] * r * g[0], a[j][1] * r * g[1]); o.y = pk2(a[j][2] * r * g[2], a[j][3] * r * g[3]);
        *(u32x2t*)(orow + 256 * j + 4 * lane) = o; }
}
__device__ __forceinline__ void resid_norm_row(const float* base_row, const bf16* yrow, const float* ssrow, const float* gpost, float* out_row, const float* gnext, bf16* xn_row, int lane) {
    const float ry = 1.0f / sqrtf(wave_sum(ssrow[lane]) * (1.0f / DM) + RMS_EPS);
    f32x4 a[16]; float ss = 0.f;
#pragma unroll
    for (int j = 0; j < 16; ++j) { const int c = 256 * j + 4 * lane; const u32x2t yw = *(const u32x2t*)(yrow + c);
        const f32x4 x0 = *(const f32x4*)(base_row + c), g0 = *(const f32x4*)(gpost + c);
        a[j][0] = x0[0] + bflo(yw.x) * ry * g0[0]; a[j][1] = x0[1] + bfhi(yw.x) * ry * g0[1]; a[j][2] = x0[2] + bflo(yw.y) * ry * g0[2]; a[j][3] = x0[3] + bfhi(yw.y) * ry * g0[3];
        *(f32x4*)(out_row + c) = a[j]; ss += sq4(a[j]); }
    if (gnext) {
        const float r = 1.0f / sqrtf(wave_sum(ss) * (1.0f / DM) + RMS_EPS);
#pragma unroll
        for (int j = 0; j < 16; ++j) { const f32x4 g = *(const f32x4*)(gnext + 256 * j + 4 * lane);
            u32x2t o; o.x = pk2(a[j][0] * r * g[0], a[j][1] * r * g[1]); o.y = pk2(a[j][2] * r * g[2], a[j][3] * r * g[3]);
            *(u32x2t*)(xn_row + 256 * j + 4 * lane) = o; }
    }
}

__device__ __forceinline__ void convert_weights(ArgsP ap0, LAS unsigned char* lds, int l, int lo = 0, int hi = I_LAYER, int wg_lo = 0) {
    const Ptrs P = fresh_ptrs(ap0); const ArgsP A = P.ap;
    if (P.bid < wg_lo) return;
    LAS float* scr = (LAS float*)(lds + P.wave * 16384);
    const int g = P.lane & 7;
    bf16* wl = (bf16*)(A->ws + WS_W);
    for (int it = lo + (P.bid - wg_lo) * NWAVES + P.wave; it < hi; it += (P.G - wg_lo) * NWAVES) {
        int r = it;
        if (r < I_IN) { const int kb = r / (NP / 32), nb = r % (NP / 32);
            tr_item(A->in[I_WIN] + (size_t)l * DM * PROJ_SRC, PROJ_SRC, win_src4(32 * nb + 4 * g), 64 * kb, (bf16*)((unsigned char*)wl + WO_IN), DM, 32 * nb, scr, P.lane); continue; }
        r -= I_IN;
        if (r < I_OUT) { const int kb = r / (DM / 32), nb = r % (DM / 32);
            tr_item(A->in[I_WOUT] + (size_t)l * DM * DM, DM, 32 * nb + 4 * g, 64 * kb, (bf16*)((unsigned char*)wl + WO_OUT), DM, 32 * nb, scr, P.lane); continue; }
        r -= I_OUT;
        if (r < I_GU) { const int kb = r / (NGU / 32), nb = r % (NGU / 32), dn0 = 32 * nb, j = dn0 >> 8, w = dn0 & 255;
            const float* src = (w < 128 ? A->in[I_WGATE] : A->in[I_WUP]) + (size_t)l * DM * FFN;
            tr_item(src, FFN, 128 * j + (w & 127) + 4 * g, 64 * kb, (bf16*)((unsigned char*)wl + WO_GU), DM, dn0, scr, P.lane); continue; }
        r -= I_GU;
        { const int kb = r / (DM / 32), nb = r % (DM / 32);
            tr_item(A->in[I_WDOWN] + (size_t)l * FFN * DM, DM, 32 * nb + 4 * g, 64 * kb, (bf16*)((unsigned char*)wl + WO_DN), FFN, 32 * nb, scr, P.lane); }
    }
}
__device__ __forceinline__ void p0_prologue(ArgsP ap0, LAS unsigned char* lds) {
    convert_weights(ap0, lds, 0, 0, I_3);
    convert_weights(ap0, lds, 0, I_3 + CV_TAIL_DN, I_LAYER);
    const Ptrs P = fresh_ptrs(ap0); const ArgsP A = P.ap;
    bf16* XN = (bf16*)(A->ws + WS_XN);
    for (int m = P.gw; m < M; m += P.NGW) rms_row_to_bf16(A->in[I_X] + (size_t)m * DM, A->in[I_MIXPRE], XN + (size_t)m * DM, P.lane);
}

__device__ __forceinline__ void p2_prep(ArgsP ap0, LAS unsigned char* lds, int l) {
    const Ptrs P = fresh_ptrs(ap0); const ArgsP A = P.ap;
    const bf16* SCB = (const bf16*)(A->ws + WS_SCB); const float* SB = (const float*)(A->ws + WS_SB);
    bf16* MIX = (bf16*)(A->ws + WS_MIX); float* FG = (float*)(A->ws + WS_FG);
    const int lane = P.lane;
    if (P.bid < BATCH * FOXH) {
        const int bh = P.bid, b = bh / FOXH, h = bh % FOXH; const float fb = A->in[I_FOXFB][l * FOXH + h];
        const float* sb = SB + ((size_t)(b * SEQ) + 16 * P.tid) * SBW + SB_FF + h;
        float ls[16]; float loc = 0.f;
#pragma unroll
        for (int i = 0; i < 16; ++i) ls[i] = sb[(size_t)i * SBW];
#pragma unroll
        for (int i = 0; i < 16; ++i) { ls[i] = logsigmoid_f(ls[i] + fb); loc += ls[i]; }
        float incl = loc;
#pragma unroll
        for (int o = 1; o < 64; o <<= 1) { const float n = __shfl_up(incl, o); if (lane >= o) incl += n; }
        LAS float* wt = (LAS float*)lds;
        if (lane == 63) wt[P.wave] = incl;
        __syncthreads();
        float run = incl - loc;
        for (int w = 0; w < P.wave; ++w) run += wt[w];
        f32x4 o4[4];
#pragma unroll
        for (int i = 0; i < 16; ++i) { run += ls[i]; o4[i >> 2][i & 3] = -run * 11.313708498984761f; }
        float* fo = FG + (size_t)bh * SEQ + 16 * P.tid;
#pragma unroll
        for (int i = 0; i < 4; ++i) *(f32x4*)(fo + 4 * i) = o4[i];
        __syncthreads();
    }
    { const bf16* HMq = (const bf16*)(A->ws + WS_PROJ); float* TN = (float*)(A->ws + WS_TN);
      constexpr int NT_ = BATCH * FOXH * (SEQ / 64);
      for (int it = P.gw; it < NT_; it += P.NGW) {
        const int bh = it / (SEQ / 64), c = it % (SEQ / 64);
        const v4u* qrow = (const v4u*)(HMq + hm_off(HM_FQ, bh) + (size_t)(c * 64 + lane) * HD); const v4u* krow = (const v4u*)(HMq + hm_off(HM_FK, bh) + (size_t)(c * 64 + lane) * HD);
        v4u qv[16], kv[16];
#pragma unroll
        for (int j = 0; j < 16; ++j) { qv[j] = qrow[j]; kv[j] = krow[j]; }
        float sq = 0.f, sk = 0.f, d = 0.f;
#pragma unroll
        for (int j = 0; j < 16; ++j) {
#pragma unroll
            for (int e4 = 0; e4 < 4; ++e4) { const unsigned a = e4 == 0 ? qv[j].x : e4 == 1 ? qv[j].y : e4 == 2 ? qv[j].z : qv[j].w, b = e4 == 0 ? kv[j].x : e4 == 1 ? kv[j].y : e4 == 2 ? kv[j].z : kv[j].w;
                const float a0 = bflo(a), a1 = bfhi(a), b0 = bflo(b), b1 = bfhi(b); sq += a0 * a0 + a1 * a1; sk += b0 * b0 + b1 * b1; d += a0 * b0 + a1 * b1; } }
#pragma unroll
        for (int o = 1; o < 64; o <<= 1) { sq = fmaxf(sq, __shfl_xor(sq, o)); sk = fmaxf(sk, __shfl_xor(sk, o)); d = fminf(d, __shfl_xor(d, o)); }
        if (lane == 0) { TN[it] = sq; TN[NT_ + it] = sk; TN[2 * NT_ + it] = d; }
      } }
    { const float* cw = A->in[I_SCW] + (size_t)l * 3 * SCW;
      for (int idx = P.bid * 512 + P.tid; idx < M * (SCW / 8); idx += P.G * 512) {
        const int m = idx >> 7, c = (idx & 127) * 8, tp = m & (SEQ - 1);
        const bf16* row = SCB + (size_t)m * SCBW;
        const v4u bw = *(const v4u*)(row + c);
        float acc[8];
#pragma unroll
        for (int e = 0; e < 8; ++e) acc[e] = 0.f;
#pragma unroll
        for (int j = 0; j < 3; ++j) { const int dt = 2 - j;
            if (tp - dt >= 0) { const bf16* rj = row - (size_t)dt * SCBW; const v4u cwv = *(const v4u*)(rj + SCW + c), hw = *(const v4u*)(rj + 2 * SCW + c);
                const f32x4 w0 = *(const f32x4*)(cw + j * SCW + c), w1 = *(const f32x4*)(cw + j * SCW + c + 4);
                acc[0] += w0[0] * bflo(cwv.x) * bflo(hw.x); acc[1] += w0[1] * bfhi(cwv.x) * bfhi(hw.x); acc[2] += w0[2] * bflo(cwv.y) * bflo(hw.y); acc[3] += w0[3] * bfhi(cwv.y) * bfhi(hw.y);
                acc[4] += w1[0] * bflo(cwv.z) * bflo(hw.z); acc[5] += w1[1] * bfhi(cwv.z) * bfhi(hw.z); acc[6] += w1[2] * bflo(cwv.w) * bflo(hw.w); acc[7] += w1[3] * bfhi(cwv.w) * bfhi(hw.w); } }
        v4u o; o.x = pk2(acc[0] * bflo(bw.x), acc[1] * bfhi(bw.x)); o.y = pk2(acc[2] * bflo(bw.y), acc[3] * bfhi(bw.y)); o.z = pk2(acc[4] * bflo(bw.z), acc[5] * bfhi(bw.z)); o.w = pk2(acc[6] * bflo(bw.w), acc[7] * bfhi(bw.w));
        *(v4u*)(MIX + (size_t)m * DM + FOXW + c) = o; } }
}


#ifndef GP_REP_S1
#define GP_REP_S1 1
#endif
#ifndef GP_REP_S4
#define GP_REP_S4 1
#endif
constexpr int GD_OPS_BYTES = 57344;
constexpr int GD_F_WN = 0, GD_F_QD = 16, GD_F_AT = 32, GD_F_KT = 40;
constexpr int GD_NCH = SEQ / 64;
constexpr int GD_NCHH = BATCH * GDNH * GD_NCH;
constexpr size_t WS_GOPS = WS_Y, WS_GU = WS_Y + 168 * MiB, WS_GL = WS_Y + 264 * MiB, WS_GO2 = WS_Y + 266 * MiB;
constexpr int GP_QS = 0, GP_KS = 17408, GP_VS = 34816, GP_LT = 68608, GP_AT = 86016, GP_WM = 103424, GP_SM = 120832;
typedef float f32x2v __attribute__((ext_vector_type(2)));
typedef unsigned u32x2v __attribute__((ext_vector_type(2)));
typedef __bf16 bf16x2c_t __attribute__((ext_vector_type(2)));
__device__ __forceinline__ unsigned cvtpk_bf16(float lo, float hi) { const f32x2v v = {lo, hi}; const bf16x2c_t b = __builtin_convertvector(v, bf16x2c_t); return __builtin_bit_cast(unsigned, b); }


template <int N> __device__ __forceinline__ void fma_bcast(float& x, float l, float nxi) {
    asm volatile("v_fmac_f32_dpp %0, %1, %2 row_newbcast:%3 row_mask:0xf bank_mask:0xf" : "+v"(x) : "v"(l), "v"(nxi), "n"(N));
}
template <int I, int R> struct TriRow {
    static __device__ __forceinline__ void run(float (&x)[64], const float (&L)[4], float nxi) { fma_bcast<(R & 15)>(x[R], L[R >> 4], nxi); TriRow<I, R + 1>::run(x, L, nxi); }
};
template <int I> struct TriRow<I, 64> { static __device__ __forceinline__ void run(float (&)[64], const float (&)[4], float) {} };
template <int I> struct TriSolve {
    static __device__ __forceinline__ void run(float (&x)[64], const LAS float* ltb, float (&Lc)[4]) {
        float Ln[4] = {0.f, 0.f, 0.f, 0.f};
        if (I + 1 < 63) {
#pragma unroll
            for (int q = (I + 2) >> 4; q < 4; ++q) Ln[q] = ltb[(I + 1) * 68 + 16 * q]; }
        const float nxi = -x[I];
        asm volatile("s_nop 1" ::: "memory");
        TriRow<I, I + 1>::run(x, Lc, nxi);
#pragma unroll
        for (int q = 0; q < 4; ++q) Lc[q] = Ln[q];
        TriSolve<I + 1>::run(x, ltb, Lc);
    }
};
template <> struct TriSolve<63> { static __device__ __forceinline__ void run(float (&)[64], const LAS float*, float (&)[4]) {} };


template <int NT>
__device__ __forceinline__ void gp_s1(LAS unsigned char* lds, const bf16* HMG, const float* cw, int ch, int ltid) {
    const int bh = ch / GD_NCH, n = ch % GD_NCH, h = bh % GDNH;
    constexpr int NI = 3072 / NT, PER = NI / 3, ROWS = NT / 16, NB = (NT == 256 ? 4 : 3);
    const int c = (ltid & 15) * 8;
#pragma unroll
    for (int i0 = 0; i0 < NI; i0 += NB) {
        v4u xw[NB][4];
#pragma unroll
        for (int ib = 0; ib < NB; ++ib) { const int i = i0 + ib, part = i / PER, t = (i % PER) * ROWS + (ltid >> 4), tp = n * 64 + t;
            const bf16* src = HMG + hm_off(part, bh) + (size_t)(n * 64 + t) * HD + c;
#pragma unroll
            for (int j = 0; j < 4; ++j) { xw[ib][j] = (v4u){0u, 0u, 0u, 0u}; if (tp - (3 - j) >= 0) xw[ib][j] = *(const v4u*)(src - (size_t)(3 - j) * HD); } }
#pragma unroll
        for (int ib = 0; ib < NB; ++ib) { const int i = i0 + ib, part = i / PER, t = (i % PER) * ROWS + (ltid >> 4);
            const float* wp = cw + part * GDNW + h * HD + c;
            float acc[8];
#pragma unroll
            for (int e = 0; e < 8; ++e) acc[e] = 0.f;
#pragma unroll
            for (int j = 0; j < 4; ++j) { const v4u xv = xw[ib][j]; const f32x4 w0 = *(const f32x4*)(wp + j * (3 * GDNW)), w1 = *(const f32x4*)(wp + j * (3 * GDNW) + 4);
                acc[0] += w0[0] * bflo(xv.x); acc[1] += w0[1] * bfhi(xv.x); acc[2] += w0[2] * bflo(xv.y); acc[3] += w0[3] * bfhi(xv.y);
                acc[4] += w1[0] * bflo(xv.z); acc[5] += w1[1] * bfhi(xv.z); acc[6] += w1[2] * bflo(xv.w); acc[7] += w1[3] * bfhi(xv.w); }
            float ss = 0.f;
#pragma unroll
            for (int e = 0; e < 8; ++e) { acc[e] = acc[e] * __builtin_amdgcn_rcpf(1.0f + __builtin_amdgcn_exp2f(-1.4426950408889634f * acc[e])); ss += acc[e] * acc[e]; }
            if (part < 2) {
                ss += __shfl_xor(ss, 1); ss += __shfl_xor(ss, 2); ss += __shfl_xor(ss, 4); ss += __shfl_xor(ss, 8);
                const float r = (1.0f / sqrtf(ss + RMS_EPS)) * (part == 0 ? 0.08838834764831845f : 1.0f);
                v4u o; o.x = cvtpk_bf16(acc[0] * r, acc[1] * r); o.y = cvtpk_bf16(acc[2] * r, acc[3] * r); o.z = cvtpk_bf16(acc[4] * r, acc[5] * r); o.w = cvtpk_bf16(acc[6] * r, acc[7] * r);
                *(LAS v4u*)(lds + (part == 0 ? GP_QS : GP_KS) + (t * 136 + c) * 2) = o;
            } else {
                LAS float* vp = (LAS float*)(lds + GP_VS) + t * 132 + c;
                *(LAS f32x4*)vp = (f32x4){acc[0], acc[1], acc[2], acc[3]}; *(LAS f32x4*)(vp + 4) = (f32x4){acc[4], acc[5], acc[6], acc[7]};
            }
        }
    }
}
__device__ __forceinline__ void gp_s2(ArgsP A, LAS float* SMf, const float* SB, float* GL, int l, int ch, int lane) {
    const int bh = ch / GD_NCH, n = ch % GD_NCH, b = bh / GDNH, h = bh % GDNH;
    const size_t m = (size_t)b * SEQ + (size_t)n * 64 + lane;
    const float xb = SB[m * SBW + SB_GB + h], xa = SB[m * SBW + SB_GA + h] + A->in[I_GDNDTB][l * GDNH + h];
    const float bt = __builtin_amdgcn_rcpf(1.0f + __builtin_amdgcn_exp2f(-1.4426950408889634f * xb));
    const float sp = fmaxf(xa, 0.f) + 0.6931471805599453f * __builtin_amdgcn_logf(1.0f + __builtin_amdgcn_exp2f(-1.4426950408889634f * fabsf(xa)));
    const float gg = -__builtin_amdgcn_exp2f(1.4426950408889634f * A->in[I_GDNALOG][l * GDNH + h]) * sp;
    float gc = gg;
#pragma unroll
    for (int o = 1; o < 64; o <<= 1) { const float nb = __shfl_up(gc, o); if (lane >= o) gc += nb; }
    const float gtot = __shfl(gc, 63);
    SMf[lane] = bt; SMf[64 + lane] = gc; SMf[128 + lane] = __builtin_amdgcn_exp2f(1.4426950408889634f * gc); SMf[192 + lane] = __builtin_amdgcn_exp2f(1.4426950408889634f * (gtot - gc));
    if (lane == 63) GL[ch] = __builtin_amdgcn_exp2f(1.4426950408889634f * gtot);
}

__device__ __forceinline__ void gdn_prep(ArgsP ap0, LAS unsigned char* lds, int l) {
    const Ptrs P = fresh_ptrs(ap0); const ArgsP A = P.ap;
    const int tid = P.tid, lane = P.lane, wave = P.wave;
    const bf16* HMG = (const bf16*)(A->ws + WS_PROJ) + hm_off(HM_GQ, 0); const float* SB = (const float*)(A->ws + WS_SB);
    unsigned char* GOPS = A->ws + WS_GOPS; float* GU = (float*)(A->ws + WS_GU); float* GL = (float*)(A->ws + WS_GL);
    const float* cw = A->in[I_GDNCW] + (size_t)l * 4 * (3 * GDNW);
    LAS float* SMf = (LAS float*)(lds + GP_SM);
    LAS unsigned* hb = (LAS unsigned*)(lds + GP_SM + 1024); unsigned hb_epoch = 0u;
    if (tid == 0) *hb = 0u;
    if (P.bid < GD_NCHH) { gp_s1<512>(lds, HMG, cw, P.bid, tid); if (wave == 0) gp_s2(A, SMf, SB, GL, l, P.bid, lane); }
    for (int ch = P.bid; ch < GD_NCHH; ch += P.G) {
        const int bh = ch / GD_NCH, n = ch % GD_NCH, b = bh / GDNH, h = bh % GDNH;
        const size_t row0 = (size_t)b * SEQ + (size_t)n * 64;
        (void)b; (void)h; (void)row0; (void)n;
        __syncthreads();
        {
            const int mat = wave >> 2, mt = wave & 3, q4 = lane >> 4, m16 = lane & 15;
            f32x4 acc[4];
#pragma unroll
            for (int nt = 0; nt < 4; ++nt) acc[nt] = (f32x4){0.f, 0.f, 0.f, 0.f};
            const LAS unsigned char* abase = lds + (mat == 0 ? GP_KS : GP_QS) + ((16 * mt + m16) * 136 + 8 * q4) * 2;
            const LAS unsigned char* bbase = lds + GP_KS + (m16 * 136 + 8 * q4) * 2;
#pragma unroll
            for (int ks = 0; ks < 4; ++ks) { const bf16x8 a = *(const LAS bf16x8*)(abase + ks * 64);
#pragma unroll
                for (int nt = 0; nt < 4; ++nt) { const bf16x8 bb = *(const LAS bf16x8*)(bbase + nt * (16 * 136 * 2) + ks * 64); acc[nt] = __builtin_amdgcn_mfma_f32_16x16x32_bf16(a, bb, acc[nt], 0, 0, 0); } }
            const int c0 = 16 * mt + 4 * q4;
            const f32x4 gcc = *(const LAS f32x4*)(SMf + 64 + c0), btc = *(const LAS f32x4*)(SMf + c0);
#pragma unroll
            for (int nt = 0; nt < 4; ++nt) { const int s = 16 * nt + m16; const float gs = SMf[64 + s];
                if (mat == 0) { f32x4 o;
#pragma unroll
                    for (int r = 0; r < 4; ++r) o[r] = (s < c0 + r) ? btc[r] * acc[nt][r] * __builtin_amdgcn_exp2f(1.4426950408889634f * (gcc[r] - gs)) : 0.f;
                    *(LAS f32x4*)((LAS float*)(lds + GP_LT) + s * 68 + c0) = o;
                } else {
#pragma unroll
                    for (int r = 0; r < 4; ++r) ((LAS float*)(lds + GP_AT))[(c0 + r) * 68 + s] = (s <= c0 + r) ? acc[nt][r] * __builtin_amdgcn_exp2f(1.4426950408889634f * (gcc[r] - gs)) : 0.f;
                } }
        }
        __syncthreads();
        float x[64];
        if (tid < 256) {
            const int j = tid & 127, isw = tid >> 7;
            int vz = 0; asm volatile("" : "+v"(vz));
            const LAS float* SMv = SMf + vz;
#pragma unroll
            for (int r4 = 0; r4 < 16; ++r4) { const f32x4 bt = *(const LAS f32x4*)(SMv + 4 * r4), eg = *(const LAS f32x4*)(SMv + 128 + 4 * r4);
#pragma unroll
                for (int e = 0; e < 4; ++e) { const int r = 4 * r4 + e;
                    x[r] = isw ? __uint_as_float((unsigned)(*(const LAS unsigned short*)(lds + GP_KS + (r * 136 + j) * 2)) << 16) * (bt[e] * eg[e]) : ((const LAS float*)(lds + GP_VS))[r * 132 + j] * bt[e]; } }
        }
        __syncthreads();
        if (tid < 256) {
            const int j = tid & 127, isw = tid >> 7;
            { const LAS float* ltb = (const LAS float*)(lds + GP_LT) + (lane & 15);
              float Lc[4];
#pragma unroll
              for (int q = 0; q < 4; ++q) Lc[q] = ltb[16 * q];
              TriSolve<0>::run(x, ltb, Lc); }
            if (!isw) { float* up = GU + (size_t)ch * 8192 + (size_t)((j >> 4) * 4) * 256 + (j & 15) * 4;
#pragma unroll
                for (int mt = 0; mt < 4; ++mt)
#pragma unroll
                    for (int q4 = 0; q4 < 4; ++q4) *(f32x4*)(up + mt * 256 + q4 * 64) = (f32x4){x[16 * mt + 4 * q4], x[16 * mt + 4 * q4 + 1], x[16 * mt + 4 * q4 + 2], x[16 * mt + 4 * q4 + 3]};
            } else {
#pragma unroll
                for (int r = 0; r < 64; ++r) *(LAS unsigned short*)(lds + GP_WM + (r * 136 + j) * 2) = (unsigned short)f2bf(-x[r]);
            }
        } else {
            const int wv = wave - 4, q4 = lane >> 4, m16 = lane & 15;
            unsigned char* dst = GOPS + (size_t)ch * GD_OPS_BYTES + lane * 16;
            for (int f = wv; f < 40; f += 4) {
                v4u o;
                if (f < 16) { const int mt = f >> 2, ks = f & 3, row = 16 * mt + m16; const float eg = SMf[128 + row];
                    const LAS unsigned char* p = lds + GP_QS + (row * 136 + 32 * ks + 4 * q4) * 2;
                    const u32x2v a = *(const LAS u32x2v*)p, bq = *(const LAS u32x2v*)(p + 32);
                    o.x = cvtpk_bf16(bflo(a.x) * eg, bfhi(a.x) * eg); o.y = cvtpk_bf16(bflo(a.y) * eg, bfhi(a.y) * eg); o.z = cvtpk_bf16(bflo(bq.x) * eg, bfhi(bq.x) * eg); o.w = cvtpk_bf16(bflo(bq.y) * eg, bfhi(bq.y) * eg);
                    *(v4u*)(dst + (GD_F_QD + f) * 1024) = o;
                } else if (f < 24) { const int ff = f - 16, mt = ff >> 1, ks = ff & 1, row = 16 * mt + m16;
                    const LAS float* p = (const LAS float*)(lds + GP_AT) + row * 68 + 32 * ks + 4 * q4;
                    const f32x4 a = *(const LAS f32x4*)p, bq = *(const LAS f32x4*)(p + 16);
                    o.x = cvtpk_bf16(a[0], a[1]); o.y = cvtpk_bf16(a[2], a[3]); o.z = cvtpk_bf16(bq[0], bq[1]); o.w = cvtpk_bf16(bq[2], bq[3]);
                    *(v4u*)(dst + (GD_F_AT + ff) * 1024) = o;
                } else { const int ff = f - 24, mt = ff >> 1, ks = ff & 1, dk = 16 * mt + m16;
                    const int cA = 32 * ks + 4 * q4; const f32x4 ekA = *(const LAS f32x4*)(SMf + 192 + cA), ekB = *(const LAS f32x4*)(SMf + 192 + cA + 16);
                    float kv[8];
#pragma unroll
                    for (int e = 0; e < 4; ++e) { kv[e] = __uint_as_float((unsigned)(*(const LAS unsigned short*)(lds + GP_KS + ((cA + e) * 136 + dk) * 2)) << 16) * ekA[e];
                                                  kv[4 + e] = __uint_as_float((unsigned)(*(const LAS unsigned short*)(lds + GP_KS + ((cA + 16 + e) * 136 + dk) * 2)) << 16) * ekB[e]; }
                    o.x = cvtpk_bf16(kv[0], kv[1]); o.y = cvtpk_bf16(kv[2], kv[3]); o.z = cvtpk_bf16(kv[4], kv[5]); o.w = cvtpk_bf16(kv[6], kv[7]);
                    *(v4u*)(dst + (GD_F_KT + ff) * 1024) = o;
                }
            }
            if (ch + P.G < GD_NCHH) {
                asm volatile("s_waitcnt lgkmcnt(0)" ::: "memory");
                ++hb_epoch;
                if (lane == 0) (void)__hip_atomic_fetch_add(hb, 1u, __ATOMIC_RELAXED, __HIP_MEMORY_SCOPE_WORKGROUP);
                while (__hip_atomic_load(hb, __ATOMIC_RELAXED, __HIP_MEMORY_SCOPE_WORKGROUP) < 4u * hb_epoch) __builtin_amdgcn_s_sleep(1);
                asm volatile("" ::: "memory");
                gp_s1<256>(lds, HMG, cw, ch + P.G, tid - 256); if (wave == 4) gp_s2(A, SMf, SB, GL, l, ch + P.G, lane); }
        }
        __syncthreads();
        { const int q4 = lane >> 4, m16 = lane & 15;
#pragma unroll
          for (int k2 = 0; k2 < 2; ++k2) { const int f = wave * 2 + k2, mt = f >> 2, ks = f & 3, row = 16 * mt + m16;
            const LAS unsigned char* p = lds + GP_WM + (row * 136 + 32 * ks + 4 * q4) * 2;
            const u32x2v a = *(const LAS u32x2v*)p, bq = *(const LAS u32x2v*)(p + 32);
            v4u o; o.x = a.x; o.y = a.y; o.z = bq.x; o.w = bq.y;
            *(v4u*)(GOPS + (size_t)ch * GD_OPS_BYTES + (GD_F_WN + f) * 1024 + lane * 16) = o; } }
    }
    __syncthreads();
}

__device__ __forceinline__ void gdn_scan(ArgsP ap0, LAS unsigned char* lds) {
    const Ptrs P = fresh_ptrs(ap0); const ArgsP A = P.ap;
    const int lane = P.lane, wave = P.wave, bh = P.bid >> 1, b = bh / GDNH, h = bh % GDNH, q4 = lane >> 4, n16 = lane & 15;
    const int cs = (P.bid & 1) * 4 + (wave & 3);
    const bool comp = wave < 4;
    const unsigned char* ops = A->ws + WS_GOPS + (size_t)bh * GD_NCH * GD_OPS_BYTES;
    const float* Up = (const float*)(A->ws + WS_GU) + (size_t)bh * GD_NCH * 8192 + (size_t)(cs * 4) * 256 + lane * 4;
    const float* GLp = (const float*)(A->ws + WS_GL) + (size_t)bh * GD_NCH;
    float* GO = (float*)(A->ws + WS_GO2) + ((size_t)b * SEQ) * GDNW + h * HD + 16 * cs + n16;
    f32x4 S[8];
#pragma unroll
    for (int i = 0; i < 8; ++i) S[i] = (f32x4){0.f, 0.f, 0.f, 0.f};
    f32x4 Un[4]; float gln = 0.f;
#pragma unroll
    for (int i = 0; i < 4; ++i) Un[i] = (f32x4){0.f, 0.f, 0.f, 0.f};
#define GD_DMA(nn, buf) do { _Pragma("unroll") for (int i_ = 0; i_ < 7; ++i_) __builtin_amdgcn_global_load_lds((const unsigned*)(ops + (size_t)(nn) * GD_OPS_BYTES + (i_ * 8 + wave) * 1024 + lane * 16), \
        (LAS unsigned*)(lds + (buf) * GD_OPS_BYTES + (i_ * 8 + wave) * 1024), 16, 0, 0); } while (0)
#define GD_ULOAD(nn) do { if (comp) { _Pragma("unroll") for (int mt_ = 0; mt_ < 4; ++mt_) Un[mt_] = *(const f32x4*)(Up + (size_t)(nn) * 8192 + mt_ * 256); gln = GLp[nn]; } } while (0)
    GD_DMA(0, 0); GD_ULOAD(0);
    for (int n = 0; n < GD_NCH; ++n) {
        asm volatile("s_waitcnt vmcnt(0)" ::: "memory");
        __syncthreads();
        f32x4 Uc[4]; const float gl = gln;
#pragma unroll
        for (int mt = 0; mt < 4; ++mt) Uc[mt] = Un[mt];
        if (n + 1 < GD_NCH) { GD_DMA(n + 1, (n + 1) & 1); GD_ULOAD(n + 1); }
        if (comp) {
        const LAS unsigned char* fr = lds + (n & 1) * GD_OPS_BYTES + lane * 16;
#define GD_FRAG(f) (*(const LAS bf16x8*)(fr + (f) * 1024))
        bf16x8 Sb[4];
#pragma unroll
        for (int ks = 0; ks < 4; ++ks) { v4u w; w.x = cvtpk_bf16(S[2 * ks][0], S[2 * ks][1]); w.y = cvtpk_bf16(S[2 * ks][2], S[2 * ks][3]); w.z = cvtpk_bf16(S[2 * ks + 1][0], S[2 * ks + 1][1]); w.w = cvtpk_bf16(S[2 * ks + 1][2], S[2 * ks + 1][3]);
            Sb[ks] = __builtin_bit_cast(bf16x8, w); }
        f32x4 vn[4];
#pragma unroll
        for (int mt = 0; mt < 4; ++mt) { vn[mt] = Uc[mt];
#pragma unroll
            for (int ks = 0; ks < 4; ++ks) vn[mt] = __builtin_amdgcn_mfma_f32_16x16x32_bf16(GD_FRAG(GD_F_WN + mt * 4 + ks), Sb[ks], vn[mt], 0, 0, 0); }
        bf16x8 Vb[2];
#pragma unroll
        for (int ks = 0; ks < 2; ++ks) { v4u w; w.x = cvtpk_bf16(vn[2 * ks][0], vn[2 * ks][1]); w.y = cvtpk_bf16(vn[2 * ks][2], vn[2 * ks][3]); w.z = cvtpk_bf16(vn[2 * ks + 1][0], vn[2 * ks + 1][1]); w.w = cvtpk_bf16(vn[2 * ks + 1][2], vn[2 * ks + 1][3]);
            Vb[ks] = __builtin_bit_cast(bf16x8, w); }
        float* orow = GO + (size_t)(n * 64 + 4 * q4) * GDNW;
#pragma unroll
        for (int mt = 0; mt < 4; ++mt) { f32x4 o = (f32x4){0.f, 0.f, 0.f, 0.f};
#pragma unroll
            for (int ks = 0; ks < 4; ++ks) o = __builtin_amdgcn_mfma_f32_16x16x32_bf16(GD_FRAG(GD_F_QD + mt * 4 + ks), Sb[ks], o, 0, 0, 0);
#pragma unroll
            for (int ks = 0; ks < 2; ++ks) o = __builtin_amdgcn_mfma_f32_16x16x32_bf16(GD_FRAG(GD_F_AT + mt * 2 + ks), Vb[ks], o, 0, 0, 0);
#pragma unroll
            for (int r = 0; r < 4; ++r) orow[(size_t)(16 * mt + r) * GDNW] = o[r]; }
#pragma unroll
        for (int mt = 0; mt < 8; ++mt) { S[mt] = S[mt] * gl;
#pragma unroll
            for (int ks = 0; ks < 2; ++ks) S[mt] = __builtin_amdgcn_mfma_f32_16x16x32_bf16(GD_FRAG(GD_F_KT + mt * 2 + ks), Vb[ks], S[mt], 0, 0, 0); }
        }
    }
#undef GD_FRAG
#undef GD_DMA
#undef GD_ULOAD
    asm volatile("s_waitcnt vmcnt(0)" ::: "memory");
    __syncthreads();
}
__device__ __forceinline__ void p4_finalize(ArgsP ap0, int l) {
    const Ptrs P = fresh_ptrs(ap0); const ArgsP A = P.ap;
    const float* GO = (const float*)(A->ws + WS_GO2); const bf16* HMZ = (const bf16*)(A->ws + WS_PROJ) + hm_off(HM_GZ, 0);
    bf16* MIX = (bf16*)(A->ws + WS_MIX); const int lane = P.lane;
    typedef float f32x2 __attribute__((ext_vector_type(2)));
    const f32x2 gg = *(const f32x2*)(A->in[I_GDNON] + l * HD + 2 * lane);
    for (int m = P.gw; m < M; m += P.NGW) {
        const int b = m / SEQ, s = m % SEQ;
        f32x2 v[GDNH]; unsigned zw[GDNH];
#pragma unroll
        for (int h = 0; h < GDNH; ++h) { v[h] = *(const f32x2*)(GO + (size_t)m * GDNW + h * HD + 2 * lane); zw[h] = *(const unsigned*)(HMZ + ((size_t)(b * GDNH + h) * SEQ + s) * HD + 2 * lane); }
        float ss[GDNH];
#pragma unroll
        for (int h = 0; h < GDNH; ++h) ss[h] = v[h][0] * v[h][0] + v[h][1] * v[h][1];
#pragma unroll
        for (int o = 1; o < 64; o <<= 1) {
#pragma unroll
            for (int h = 0; h < GDNH; ++h) ss[h] += __shfl_xor(ss[h], o); }
#pragma unroll
        for (int h = 0; h < GDNH; ++h) { const float rr = 1.0f / sqrtf(ss[h] * (1.0f / HD) + RMS_EPS);
            *(unsigned*)(MIX + (size_t)m * DM + FOXW + SCW + h * HD + 2 * lane) = pk2(v[h][0] * rr * gg[0] * silu_acc(bflo(zw[h])), v[h][1] * rr * gg[1] * silu_acc(bfhi(zw[h]))); }
    }
}

constexpr int ATT_PER_X = 3 * (SEQ / attn::QB);
constexpr int ATT_SLOT_OFF = 69632;
static_assert(attn::LDS_BYTES <= ATT_SLOT_OFF, "attention LDS map");
typedef attn::BlockRef<attn::bf16, attn::bf16> FoxRef;
__device__ __forceinline__ int fox_jlo(ArgsP A, int l, int bh, int P0) {
    (void)l;
    const float* FG = (const float*)(A->ws + WS_FG) + (size_t)bh * SEQ; const float* TN = (const float*)(A->ws + WS_TN);
    constexpr int NT_ = BATCH * FOXH * (SEQ / 64);
    const int lane = my_lane(), jd = P0 / attn::KVBLK, tb = bh * (SEQ / 64);
    float qn2 = 0.f, lb = 3.0e38f;
#pragma unroll
    for (int i = 0; i < 4; ++i) { qn2 = fmaxf(qn2, TN[tb + jd + i]); lb = fminf(lb, TN[2 * NT_ + tb + jd + i] + FG[64 * (jd + i)]); }
    const float qnb = sqrtf(qn2) * 1.001f;
    const bool s0 = qnb * sqrtf(TN[NT_ + tb + lane]) + FG[64 * lane + 63] - lb < -600.0f, s1 = qnb * sqrtf(TN[NT_ + tb + lane + 64]) + FG[64 * (lane + 64) + 63] - lb < -600.0f;
    const unsigned long long n0 = ~__ballot(s0), n1 = ~__ballot(s1);
    const int n = n0 ? __builtin_ctzll(n0) : 64 + (n1 ? __builtin_ctzll(n1) : 64);
    return __builtin_amdgcn_readfirstlane(n < jd ? n : jd);
}
__device__ __forceinline__ void fox_head_table(ArgsP A, volatile LAS int* hmap, int lane) {
    const float* FG = (const float*)(A->ws + WS_FG);
    const float v = lane < BATCH * FOXH ? FG[(size_t)lane * SEQ + (SEQ - 1)] : 3.0e38f;
    int rank = 0;
    for (int j = 0; j < BATCH * FOXH; ++j) { const float vj = __shfl(v, j); rank += (vj < v || (vj == v && j < lane)) ? 1 : 0; }
    if (lane < BATCH * FOXH) { const int slot = rank >> 3, qx = slot == 1 ? 15 - rank : (rank & 7); hmap[qx * 3 + slot] = lane; }
}
__device__ __forceinline__ FoxRef fox_ref(ArgsP A, int id, int l, volatile LAS int* hmap) {
    const int qx = id / ATT_PER_X, i = id % ATT_PER_X, bh = __builtin_amdgcn_readfirstlane(hmap[qx * 3 + (i >> 5)]), qb = 31 - (i & 31);
    const int b = bh / FOXH, h = bh % FOXH; const size_t row0 = (size_t)b * SEQ;
    const attn::bf16* HM = (const attn::bf16*)(A->ws + WS_PROJ);
    FoxRef r;
    r.Q = HM + hm_off(HM_FQ, bh) + (size_t)qb * attn::QB * HD;
    r.K = HM + hm_off(HM_FK, bh); r.V = HM + hm_off(HM_FV, bh);
    r.F = (const float*)(A->ws + WS_FG) + (size_t)bh * SEQ;
    r.O = (attn::bf16*)(A->ws + WS_MIX) + (row0 + (size_t)qb * attn::QB) * DM + h * HD; r.P0 = qb * attn::QB; r.JLO = fox_jlo(A, l, bh, r.P0);
    return r;
}
__device__ __forceinline__ int att_claim(gu32* ctrs, volatile LAS int* st) {
    int qx = st[0], tried = st[1], r = -1;
    while (tried < 8) { const unsigned i = __hip_atomic_fetch_add(ctrs + qx * 64, 1u, __ATOMIC_RELAXED, __HIP_MEMORY_SCOPE_AGENT); if (i < (unsigned)ATT_PER_X) { r = qx * ATT_PER_X + (int)i; break; } qx = (qx + 1) & 7; ++tried; }
    st[0] = qx; st[1] = tried;
    return r;
}
__device__ __forceinline__ void p3_attention(ArgsP ap0, char* lds, int l, int rep = 0) {
    const ArgsP A = fresh(ap0);
    gu32* ctrs = (gu32*)(A->ws + WS_CTL) + CW_Q + (rep * 2 + l) * 8 * 64;
    volatile LAS int* slot = (volatile LAS int*)((LAS unsigned char*)lds + ATT_SLOT_OFF);
    volatile LAS int* hmap = slot + 8;
    { const int t_ = ftid(); if (t_ < 64) fox_head_table(A, hmap, t_); if (t_ == 0) { slot[4] = (int)(xb_xcc_id() & 7u); slot[5] = 0; slot[0] = att_claim(ctrs, slot + 4); slot[1] = att_claim(ctrs, slot + 4); } }
    __syncthreads();
    int cur = __builtin_amdgcn_readfirstlane(slot[0]), nxt = __builtin_amdgcn_readfirstlane(slot[1]);
    if (cur < 0) return;
    FoxRef curR = fox_ref(A, cur, l, hmap);
    attn::Seam<attn::bf16> S;
    attn::causal_swa_prime<attn::bf16, attn::bf16>(curR, SEQ, lds, S);
    for (int k = 0;; ++k) {
        if (nxt >= 0 && ftid() == 0) slot[2 + (k & 1)] = att_claim(ctrs, slot + 4);
        const bool last = nxt < 0;
        const FoxRef nxtR = last ? curR : fox_ref(A, nxt, l, hmap);
        attn::causal_swa_block<attn::bf16, attn::bf16>(curR, nxtR, SEQ, SEQ, lds, S, &A->in[I_FOXON], l * HD);
        if (last) break;
        cur = nxt; curR = nxtR; nxt = __builtin_amdgcn_readfirstlane(slot[2 + (k & 1)]);
    }
}

constexpr int N_PHASES = 1 + 9 * DEPTH;

#ifndef PH_EN
#define PH_EN 0x3ff
#endif
#define IN(k) (lo <= (k) && (k) < hi)
#define EN(j) ((PH_EN >> (j)) & 1)
#ifndef REP_MASK
#define REP_MASK 0
#endif
#ifndef EXTRA_BARS
#define EXTRA_BARS 0
#endif
#define REPS(j) (((REP_MASK >> (j)) & 1) ? 2 : 1)
#define SEAM(k) do { if (IN(k) && IN((k) + 1)) { XcdBarrier b_; b_.bar = (unsigned*)(fresh(ap0)->ws + WS_CTL) + CW_BAR; b_.x = xb_xcc_id(); b_.st = (volatile LAS unsigned*)((LAS unsigned char*)lds + MISC_OFF) + 8; xcd_barrier(b_); } } while (0)
#define WSP(T, off) ((T*)(A->ws + (off)))


template <int l>
__device__ __forceinline__ void layer_phases(ArgsP ap0, LAS unsigned char* ldsl, unsigned char* lds, int lo, int hi) {

        const int pb = 1 + 9 * l;
        if (EN(1) && IN(pb + 0)) {
            const Ptrs P = fresh_ptrs(ap0); const ArgsP A = P.ap;
            pg8::Gemm g{WSP(bf16, WS_XN), WSP(bf16, WS_W + WO_IN), M, NP, DM}; pg8::StaticOrder S; S.init(M, NP, P.G, P.bid);
            pg8::EpiProj E{WSP(bf16, WS_PROJ), WSP(bf16, WS_SCB), WSP(float, WS_SB)};
            for (int rep_ = 0; rep_ < REPS(1); ++rep_) pg8::gemm_phase<pg8::EpiProj, pg8::StaticOrder, true, true>(ldsl, g, S, E);
            convert_weights(ap0, ldsl, l, I_3, I_3 + CV_TAIL_DN, (M / 256) * (NP / 256) % P.G);
            SEAM(pb + 0);
        }
        if (EN(2) && IN(pb + 1)) {
            for (int rep_ = 0; rep_ < REPS(11); ++rep_) p2_prep(ap0, ldsl, l);
            for (int rep_ = 0; rep_ < REPS(2); ++rep_) gdn_prep(ap0, ldsl, l);
            SEAM(pb + 1);
            for (int xb_ = 0; xb_ < EXTRA_BARS; ++xb_) SEAM(pb + 1);
            }
        if (EN(3) && IN(pb + 2)) {
            for (int rep_ = 0; rep_ < REPS(10); ++rep_) if ((int)blockIdx.x < 2 * BATCH * GDNH) gdn_scan(ap0, ldsl);
            for (int rep_ = 0; rep_ < REPS(3); ++rep_) p3_attention(ap0, (char*)lds, l, rep_);
            SEAM(pb + 2);
        }
        if (EN(4) && IN(pb + 3)) { for (int rep_ = 0; rep_ < REPS(4); ++rep_) p4_finalize(ap0, l); SEAM(pb + 3); }
        if (EN(5) && IN(pb + 4)) {
            const Ptrs P = fresh_ptrs(ap0); const ArgsP A = P.ap;
            pg8::Gemm g{WSP(bf16, WS_MIX), WSP(bf16, WS_W + WO_OUT), M, DM, DM}; pg8::StaticOrder S; S.init(M, DM, P.G, P.bid);
            pg8::EpiY E{WSP(bf16, WS_Y), WSP(float, WS_SS)};
            for (int rep_ = 0; rep_ < REPS(5); ++rep_) pg8::gemm_phase<pg8::EpiY, pg8::StaticOrder, true, true>(ldsl, g, S, E);
            SEAM(pb + 4);
        }
        if (EN(6) && IN(pb + 5)) {
            const Ptrs P = fresh_ptrs(ap0); const ArgsP A = P.ap;
            const float* xin = l == 0 ? A->in[I_X] : (const float*)A->out;
            const float* gpost = A->in[I_MIXPOST] + l * DM; const float* gpre = A->in[I_FFNPRE] + l * DM;
            const bf16* Y = WSP(bf16, WS_Y); const float* SS = WSP(float, WS_SS); float* H = WSP(float, WS_H); bf16* XN = WSP(bf16, WS_XN);
            for (int rep_ = 0; rep_ < REPS(6); ++rep_)
            for (int m = P.gw; m < M; m += P.NGW)
                resid_norm_row(xin + (size_t)m * DM, Y + (size_t)m * DM, SS + (size_t)m * 64, gpost, H + (size_t)m * DM, gpre, XN + (size_t)m * DM, P.lane);
            SEAM(pb + 5);
        }
        if (EN(7) && IN(pb + 6)) {
            const Ptrs P = fresh_ptrs(ap0); const ArgsP A = P.ap;
            pg8::Gemm g{WSP(bf16, WS_XN), WSP(bf16, WS_W + WO_GU), M, NGU, DM}; pg8::StaticOrder S; S.init(M, NGU, P.G, P.bid);
            pg8::EpiSwiGLU E{WSP(bf16, WS_PROJ)};
            for (int rep_ = 0; rep_ < REPS(7); ++rep_) pg8::gemm_phase<pg8::EpiSwiGLU, pg8::StaticOrder, true, true>(ldsl, g, S, E);
            if (l + 1 < DEPTH) convert_weights(ap0, ldsl, l + 1, 0, CV_TAIL_IN, (M / 256) * (NGU / 256) % P.G);
            SEAM(pb + 6);
        }
        if (EN(8) && IN(pb + 7)) {
            const Ptrs P = fresh_ptrs(ap0); const ArgsP A = P.ap;
            pg8::Gemm g{WSP(bf16, WS_PROJ), WSP(bf16, WS_W + WO_DN), M, DM, FFN};
            pg8::EpiY E{WSP(bf16, WS_Y), WSP(float, WS_SS)};
            if (P.G == 256) { pg8::PanelOrder S{P.bid, M / (16 * 256)};
                for (int rep_ = 0; rep_ < REPS(8); ++rep_) pg8::gemm_phase<pg8::EpiY, pg8::PanelOrder, true, true>(ldsl, g, S, E); }
            else { pg8::StaticOrder S; S.init(M, DM, P.G, P.bid);
                for (int rep_ = 0; rep_ < REPS(8); ++rep_) pg8::gemm_phase<pg8::EpiY, pg8::StaticOrder, true, true>(ldsl, g, S, E); }
            SEAM(pb + 7);
        }
        if (EN(9) && IN(pb + 8)) {
            const Ptrs P = fresh_ptrs(ap0); const ArgsP A = P.ap;
            const float* gnext = l + 1 < DEPTH ? A->in[I_MIXPRE] + (l + 1) * DM : nullptr; const float* gpost = A->in[I_FFNPOST] + l * DM;
            const bf16* Y = WSP(bf16, WS_Y); const float* SS = WSP(float, WS_SS); const float* H = WSP(float, WS_H); bf16* XN = WSP(bf16, WS_XN); float* outp = A->out;
            for (int rep_ = 0; rep_ < REPS(9); ++rep_) {
            for (int m = P.gw; m < M; m += P.NGW)
                resid_norm_row(H + (size_t)m * DM, Y + (size_t)m * DM, SS + (size_t)m * 64, gpost, outp + (size_t)m * DM, gnext, XN + (size_t)m * DM, P.lane);
            if (l + 1 < DEPTH) { convert_weights(ap0, ldsl, l + 1, CV_TAIL_IN, I_3); convert_weights(ap0, ldsl, l + 1, I_3 + CV_TAIL_DN, I_LAYER); }
            }
            SEAM(pb + 8);
        }
    }

__global__ void __launch_bounds__(NWAVES * 64, 2) hybrid_fwd(Args args) {
    extern __shared__ __attribute__((aligned(16))) unsigned char lds[];
    LAS unsigned char* ldsl = (LAS unsigned char*)lds;
    volatile LAS unsigned* MISC = (volatile LAS unsigned*)(ldsl + MISC_OFF);
    const ArgsP ap0 = (ArgsP)__builtin_amdgcn_kernarg_segment_ptr();
    for (int u = threadIdx.x; u < (LDS_BYTES - LDSCTL_OFF) / 4; u += NWAVES * 64) ((LAS unsigned*)(ldsl + LDSCTL_OFF))[u] = 0u;
    __syncthreads();
    if ((threadIdx.x & 63) == 0) *(volatile LAS int*)(ldsl + TIDTAB_OFF + 4 * hw_slot()) = (int)(threadIdx.x >> 6);
    __syncthreads();
    const int lo = args.ph_lo, hi = args.ph_hi;
    if (hi - lo > 1) (void)xcd_barrier_post((unsigned*)(args.ws + WS_CTL) + CW_BAR, MISC + 8);
    if (EN(0) && IN(0)) { for (int rep_ = 0; rep_ < REPS(0); ++rep_) p0_prologue(ap0, ldsl); SEAM(0); }
    layer_phases<0>(ap0, ldsl, lds, lo, hi);
    layer_phases<1>(ap0, ldsl, lds, lo, hi);
}

#undef IN
#undef SEAM
extern "C" void kernel_launch(void* const* d_in, const int* in_sizes, int n_in, void* d_out, int out_size, void* d_ws, size_t ws_size, hipStream_t stream) {
    static int grid = 0;
    if (grid == 0) {
        if (n_in != 17 || in_sizes[0] != M * DM || out_size != M * DM || ws_size < WS_END) {
            fprintf(stderr, "kernel_launch: shape/workspace mismatch: n_in %d in0 %d out %d ws %zu (need %zu)\n", n_in, n_in > 0 ? in_sizes[0] : -1, out_size, ws_size, (size_t)WS_END); grid = -1; return; }
        int dev = 0, cus = 0, per_cu = 0;
        if (hipGetDevice(&dev) != hipSuccess || hipDeviceGetAttribute(&cus, hipDeviceAttributeMultiprocessorCount, dev) != hipSuccess) { fprintf(stderr, "kernel_launch: device query failed\n"); grid = -1; return; }
        if (hipFuncSetAttribute((const void*)hybrid_fwd, hipFuncAttributeMaxDynamicSharedMemorySize, LDS_BYTES) != hipSuccess) { fprintf(stderr, "kernel_launch: hipFuncSetAttribute failed\n"); grid = -1; return; }
        if (hipOccupancyMaxActiveBlocksPerMultiprocessor(&per_cu, (const void*)hybrid_fwd, NWAVES * 64, LDS_BYTES) != hipSuccess || per_cu < 1)
            fprintf(stderr, "kernel_launch: note: occupancy query reports %d workgroups per CU\n", per_cu);
        (void)hipGetLastError();
        grid = cus;
    }
    if (grid < 0) return;
    if (hipMemsetAsync((char*)d_ws + WS_CTL, 0, CTL_ZERO_BYTES, stream) != hipSuccess) { fprintf(stderr, "kernel_launch: memset failed\n"); return; }
    Args a{};
    for (int i = 0; i < 17; ++i) a.in[i] = (const float*)d_in[i];
    a.out = (float*)d_out; a.ws = (unsigned char*)d_ws;
#if MK_N_LAUNCHES == 1
    a.ph_lo = 0; a.ph_hi = N_PHASES;
    hipLaunchKernelGGL(hybrid_fwd, dim3(grid), dim3(NWAVES * 64), LDS_BYTES, stream, a);
#else
    for (int p = 0; p < N_PHASES; ++p) { a.ph_lo = p; a.ph_hi = p + 1; hipLaunchKernelGGL(hybrid_fwd, dim3(grid), dim3(NWAVES * 64), LDS_BYTES, stream, a); }
#endif
    const hipError_t le = hipPeekAtLastError();
    if (le != hipSuccess) fprintf(stderr, "kernel_launch: launch failed: %s\n", hipGetErrorName(le));
}
```

```cpp
#include <hip/hip_runtime.h>
#include <hip/hip_bf16.h>
#include <cstdio>
#include <cstdint>
#include <cmath>

#ifndef MK_N_LAUNCHES
#define MK_N_LAUNCHES 1
#endif

constexpr int BATCH = 2, SEQ = 8192, DM = 4096, M = BATCH * SEQ, DEPTH = 2;
constexpr int HD = 128, FOXH = 12, FOXW = FOXH * HD, SCW = 1024, GDNH = 12, GDNW = GDNH * HD;
constexpr int PROJ_SRC = 13860;
constexpr int NP = 14080;
constexpr int FFN = 11008, NGU = 2 * FFN;
constexpr float RMS_EPS = 1e-6f;
constexpr int PC_FQ = 0, PC_FK = 1536, PC_FV = 3072, PC_SB = 4608, PC_SC = 5632, PC_SH = 6656, PC_GQ = 7680, PC_GK = 9216, PC_GV = 10752, PC_GZ = 12288, PC_SMALL = 13824;
constexpr int SBW = 64, SB_FF = 0, SB_GA = 12, SB_GB = 24;
constexpr int SRC_FF = 4608, SRC_SB = 4620, SRC_GQ = 7692, SRC_GA = 12300, SRC_GB = 12312, SRC_GZ = 12324;

constexpr size_t MiB = 1u << 20;
constexpr size_t WS_CTL = 0, CTL_ZERO_BYTES = 1 * MiB;
constexpr size_t WS_W = 16 * MiB;
constexpr size_t WO_IN = 0, WO_OUT = 110 * MiB, WO_GU = 142 * MiB, WO_DN = 314 * MiB;
constexpr size_t WS_XN = 416 * MiB;
constexpr size_t WS_MIX = 544 * MiB;
constexpr size_t WS_Y = 672 * MiB;
constexpr size_t WS_H = 800 * MiB;
constexpr size_t WS_PROJ = 1056 * MiB;
constexpr size_t WS_SCB = WS_PROJ + 336 * MiB;
constexpr int HM_FQ = 0, HM_FK = 1, HM_FV = 2, HM_GQ = 3, HM_GZ = 6, SCBW = 3 * SCW;
__host__ __device__ constexpr size_t hm_off(int part, int bh) { return ((size_t)(part * (BATCH * FOXH) + bh) * SEQ) * HD; }
constexpr size_t WS_SB = 1496 * MiB;
constexpr size_t WS_SS = 1500 * MiB;
constexpr size_t WS_FG = 1504 * MiB;
constexpr size_t WS_TN = WS_FG + 1 * MiB;
constexpr size_t WS_END = 1506 * MiB;
constexpr int CW_TMO = 0, CW_BAR = 4096, CW_Q = 16384;

constexpr int NWAVES = 8;
constexpr int RING_BYTES = 131072, LDSCTL_OFF = RING_BYTES, MISC_OFF = LDSCTL_OFF + 320, LDS_BYTES = 147456;


extern __shared__ __attribute__((aligned(16))) unsigned char g_lds[];
constexpr int TIDTAB_OFF = LDSCTL_OFF + 512;
__device__ __forceinline__ unsigned hw_slot() { return (unsigned)__builtin_amdgcn_s_getreg((5 << 11) | 4) & 63u; }
__device__ __forceinline__ int my_lane() { int l; asm volatile("v_mbcnt_lo_u32_b32 %0, -1, 0\n\tv_mbcnt_hi_u32_b32 %0, -1, %0" : "=v"(l)); return l; }
__device__ __forceinline__ int my_wave() { return __builtin_amdgcn_readfirstlane(*(volatile __attribute__((address_space(3))) int*)((__attribute__((address_space(3))) unsigned char*)g_lds + TIDTAB_OFF + 4 * hw_slot())); }
__device__ __forceinline__ int my_tid() { return my_wave() * 64 + my_lane(); }

#define GAS __attribute__((address_space(1)))
#define LAS __attribute__((address_space(3)))
typedef unsigned short bf16;
typedef unsigned v4u __attribute__((ext_vector_type(4)));
typedef float f32x4 __attribute__((ext_vector_type(4)));
typedef short bf16x8 __attribute__((ext_vector_type(8)));
typedef GAS unsigned gu32;
typedef GAS unsigned long long gu64;
#define RLX_AGENT __ATOMIC_RELAXED, __HIP_MEMORY_SCOPE_AGENT
#define LDS_WAIT() asm volatile("s_waitcnt lgkmcnt(0)" ::: "memory")
#define VM_WAIT() asm volatile("s_waitcnt vmcnt(0)" ::: "memory")
__device__ __forceinline__ unsigned long long rt() { return __builtin_amdgcn_s_memrealtime(); }
__device__ __forceinline__ unsigned f2bf(float f) { unsigned u = __builtin_bit_cast(unsigned, f); return (u + 0x7fffu + ((u >> 16) & 1u)) >> 16; }
__device__ __forceinline__ unsigned pk2(float lo, float hi) { return f2bf(lo) | (f2bf(hi) << 16); }

#define XB_TMO      128
#define XB_XCNT(j)  (256  + 64 * (j))
#define XB_XSUB(j)  (1280 + 64 * (j))
#define XB_XGEN(j)  (2304 + 64 * (j))
#define XB_TOP      3328
#define XB_TOPGEN   3392
#define XCD_BAR_WORDS 3456
#define XB_SPIN_CAP (1u << 18)

__device__ __forceinline__ unsigned xb_ld(unsigned* p)              { return __hip_atomic_load(p, __ATOMIC_RELAXED, __HIP_MEMORY_SCOPE_AGENT); }
__device__ __forceinline__ unsigned xb_add(unsigned* p, unsigned v) { return __hip_atomic_fetch_add(p, v, __ATOMIC_RELAXED, __HIP_MEMORY_SCOPE_AGENT); }
__device__ __forceinline__ unsigned xb_xcc_id() { return (unsigned)__builtin_amdgcn_s_getreg((3 << 11) | 20) & 0xFu; }
#define XB_SPIN(cond, bar) do { unsigned _sp = 0; while (cond) { __builtin_amdgcn_s_sleep(1); \
    if ((++_sp & 255u) == 0u) { if (xb_ld(&(bar)[XB_TMO])) break; if (_sp > XB_SPIN_CAP) { atomicAdd(&(bar)[XB_TMO], 1u); break; } } } } while (0)

struct XcdBarrier {
    unsigned* bar; unsigned x;
    volatile LAS unsigned* st;
};

__device__ __forceinline__ XcdBarrier xcd_barrier_post(unsigned* bar, volatile LAS unsigned* st) {
    XcdBarrier b; b.bar = bar; b.x = xb_xcc_id(); b.st = st;
    if (my_tid() == 0) (void)xb_add(&bar[XB_XCNT(b.x)], 1u);
    return b;
}
__device__ __forceinline__ void xcd_barrier_complete(unsigned* bar, unsigned x, unsigned& nloc, unsigned& nx) {
    const unsigned G = gridDim.x * gridDim.y * gridDim.z;
    unsigned sum, cnt, mine, sp = 0u;
    for (;;) {
        sum = 0u; cnt = 0u; mine = 0u;
#pragma unroll
        for (unsigned j = 0; j < 16; ++j) { const unsigned c = xb_ld(&bar[XB_XCNT(j)]); sum += c; cnt += (c > 0u) ? 1u : 0u; mine = (j == x) ? c : mine; }
        if (sum == G) break;
        __builtin_amdgcn_s_sleep(1);
        if ((++sp & 255u) == 0u) { if (xb_ld(&bar[XB_TMO])) break; if (sp > XB_SPIN_CAP) { atomicAdd(&bar[XB_TMO], 1u); break; } }
    }
    nloc = mine > 0u ? mine : 1u; nx = cnt > 0u ? cnt : 1u;
}

__device__ __forceinline__ void xcd_barrier(const XcdBarrier& b) {
    asm volatile("s_waitcnt vmcnt(0)" ::: "memory");
    __syncthreads();
    if (my_tid() == 0) {
        unsigned* bar = b.bar;
        __builtin_amdgcn_s_waitcnt(0);
        unsigned nloc = b.st[0], nx = b.st[1];
        if (nloc == 0u) { xcd_barrier_complete(bar, b.x, nloc, nx); b.st[0] = nloc; b.st[1] = nx; }
        const unsigned old = xb_add(&bar[XB_XSUB(b.x)], 1u);
        const unsigned gen = old / nloc;
        if (old + 1u == (gen + 1u) * nloc) {
            __builtin_amdgcn_fence(__ATOMIC_RELEASE, "agent");
            asm volatile("s_waitcnt vmcnt(0)" ::: "memory");
            const unsigned og = xb_add(&bar[XB_TOP], 1u);
            const unsigned tg = og / nx;
            if (og + 1u == (tg + 1u) * nx) xb_add(&bar[XB_TOPGEN], 1u);
            else XB_SPIN(xb_ld(&bar[XB_TOPGEN]) == tg, bar);
            __builtin_amdgcn_fence(__ATOMIC_ACQUIRE, "agent");
            xb_add(&bar[XB_XGEN(b.x)], 1u);
            asm volatile("s_waitcnt vmcnt(0)" ::: "memory");
        } else {
            XB_SPIN(xb_ld(&bar[XB_XGEN(b.x)]) == gen, bar);
            __builtin_amdgcn_fence(__ATOMIC_ACQUIRE, "agent");
            asm volatile("s_waitcnt vmcnt(0)" ::: "memory");
        }
    }
    __syncthreads();
}

namespace pg8 {
#define PG8_LAS __attribute__((address_space(3)))
typedef unsigned short bf16_t;
typedef short bf16x8 __attribute__((ext_vector_type(8)));
typedef float f32x4 __attribute__((ext_vector_type(4)));
typedef unsigned u32x4 __attribute__((ext_vector_type(4)));
constexpr int BM = 256, BK = 64, HALF = 128, HTB = HALF * BK * 2  , STAGE_BYTES = 8 * HTB, NXCD = 8, WGM = 8;

__host__ __device__ __forceinline__ int lds_byte(int r, int c) { const int st = (r >> 4) * 2 + (c >> 5), rr = r & 15, cc = c & 31, ob = rr * 64 + cc * 2; return st * 1024 + (ob ^ (((ob >> 9) & 1) << 5)); }
__host__ __device__ __forceinline__ void stage_rc(int b, int& R, int& C) { const int st = b / 1024, sb = b % 1024, swz = sb ^ (((sb >> 9) & 1) << 5); R = (st >> 1) * 16 + swz / 64; C = (st & 1) * 32 + (swz % 64) / 2; }
__host__ __device__ __forceinline__ int perm32(int rho) { const int n = rho >> 4, i = rho & 15; return 8 * (i >> 2) + 4 * n + (i & 3); }

struct Unit { int pm, pn; };
struct Gemm { const bf16_t* A; const bf16_t* Bt; int M, N, K; };

struct StaticOrder {
    int nM, nN, nwg, G, c;
    __host__ __device__ void init(int M, int N, int G_, int c_) { nM = M / BM; nN = N / BM; nwg = nM * nN; G = G_; c = c_; }
    __host__ __device__ bool next(int i, Unit& u) const {
        const long L = (long)i * G + c; if (L >= nwg) return false;
        int wgid = (int)L; { const int q = nwg / NXCD, r = nwg % NXCD, xcd = wgid % NXCD, off = wgid / NXCD; wgid = (xcd < r ? xcd * (q + 1) : r * (q + 1) + (xcd - r) * q) + off; }
        const int nig = WGM * nN, gid = wgid / nig, fm = gid * WGM, gsz = (nM - fm) < WGM ? (nM - fm) : WGM;
        u.pm = fm + ((wgid % nig) % gsz); u.pn = (wgid % nig) / gsz; return true;
    }
    __device__ __forceinline__ void a_ready(const Unit&) const {}
    __device__ __forceinline__ void done(const Unit&) const {}
};


typedef float f32x2e __attribute__((ext_vector_type(2))); typedef __bf16 bf16x2e __attribute__((ext_vector_type(2)));
__device__ __forceinline__ unsigned cvt_pk_bf16(float lo, float hi) { const f32x2e v = {lo, hi}; const bf16x2e b = __builtin_convertvector(v, bf16x2e); return __builtin_bit_cast(unsigned, b); }
__device__ __forceinline__ u32x4 pack8_bf16(const f32x4 v0, const f32x4 v1) { u32x4 w; w.x = cvt_pk_bf16(v0[0], v0[1]); w.y = cvt_pk_bf16(v0[2], v0[3]); w.z = cvt_pk_bf16(v1[0], v1[1]); w.w = cvt_pk_bf16(v1[2], v1[3]); return w; }

struct EpiProj {
    static constexpr bool PERM = true, AFTER_DRAIN = false;
    bf16_t* HM; bf16_t* SCB; float* SBp;
    __device__ __forceinline__ void operator()(const f32x4 (&acc)[2][2][4][2], const Unit& u, int wr, int wc, int fr, int fq) const {
        const int row0 = u.pm * BM + wr * 64 + fr;
        if (u.pn * BM == PC_SMALL) {
            if (wc < 2) {
#pragma unroll
                for (int ai = 0; ai < 2; ++ai)
#pragma unroll
                    for (int m = 0; m < 4; ++m) { float* rp = SBp + (size_t)(row0 + ai * HALF + m * 16) * SBW + wc * 32 + 8 * fq;
                        *(f32x4*)rp = acc[ai][0][m][0]; *(f32x4*)(rp + 4) = acc[ai][0][m][1]; }
            }
            return;
        }
        const int b = (u.pm * BM) / SEQ, s0 = row0 - b * SEQ;
#pragma unroll
        for (int bj = 0; bj < 2; ++bj) { const int colbase = u.pn * BM + bj * HALF;
            bf16_t* dst; size_t pitch;
            if (colbase >= PC_SB && colbase < PC_GQ) { dst = SCB + (size_t)row0 * SCBW + (colbase - PC_SB) + wc * 32 + 8 * fq; pitch = SCBW; }
            else { const int hc = colbase < PC_SB ? colbase : colbase - (PC_GQ - PC_SB), part = hc / 1536, head = (hc % 1536) / HD;
                   dst = HM + hm_off(part, b * FOXH + head) + (size_t)s0 * HD + wc * 32 + 8 * fq; pitch = HD; }
#pragma unroll
            for (int ai = 0; ai < 2; ++ai)
#pragma unroll
                for (int m = 0; m < 4; ++m) *(u32x4*)(dst + (size_t)(ai * HALF + m * 16) * pitch) = pack8_bf16(acc[ai][bj][m][0], acc[ai][bj][m][1]); }
    }
};
struct EpiY {
    static constexpr bool PERM = true, AFTER_DRAIN = false;
    bf16_t* Y; float* SS;
    __device__ __forceinline__ void operator()(const f32x4 (&acc)[2][2][4][2], const Unit& u, int wr, int wc, int fr, int fq) const {
        const int row0 = u.pm * BM + wr * 64 + fr, col0 = u.pn * BM + wc * 32 + 8 * fq;
#pragma unroll
        for (int ai = 0; ai < 2; ++ai)
#pragma unroll
            for (int m = 0; m < 4; ++m) { const int row = row0 + ai * HALF + m * 16; bf16_t* rowp = Y + (size_t)row * DM + col0; float s = 0.f;
#pragma unroll
                for (int bj = 0; bj < 2; ++bj) { const f32x4 a = acc[ai][bj][m][0], b = acc[ai][bj][m][1];
                    s += (a[0] * a[0] + a[1] * a[1]) + (a[2] * a[2] + a[3] * a[3]) + (b[0] * b[0] + b[1] * b[1]) + (b[2] * b[2] + b[3] * b[3]);
                    *(u32x4*)(rowp + bj * HALF) = pack8_bf16(a, b); }
                s += __shfl_xor(s, 16); s += __shfl_xor(s, 32);
                if (fq == 0) SS[(size_t)row * 64 + u.pn * 4 + wc] = s; }
    }
};
__device__ __forceinline__ float silu_f(float x) { return x * __builtin_amdgcn_rcpf(1.0f + __builtin_amdgcn_exp2f(-1.4426950408889634f * x)); }
struct EpiSwiGLU {
    static constexpr bool PERM = true, AFTER_DRAIN = false;
    bf16_t* Hd;
    __device__ __forceinline__ void operator()(const f32x4 (&acc)[2][2][4][2], const Unit& u, int wr, int wc, int fr, int fq) const {
        const int row0 = u.pm * BM + wr * 64 + fr, col0 = u.pn * HALF + wc * 32 + 8 * fq;
#pragma unroll
        for (int ai = 0; ai < 2; ++ai)
#pragma unroll
            for (int m = 0; m < 4; ++m) { const f32x4 g0 = acc[ai][0][m][0], g1 = acc[ai][0][m][1], u0 = acc[ai][1][m][0], u1 = acc[ai][1][m][1]; f32x4 h0, h1;
#pragma unroll
                for (int e = 0; e < 4; ++e) { h0[e] = silu_f(g0[e]) * u0[e]; h1[e] = silu_f(g1[e]) * u1[e]; }
                *(u32x4*)(Hd + (size_t)(row0 + ai * HALF + m * 16) * FFN + col0) = pack8_bf16(h0, h1); }
    }
};

struct PanelOrder {
    int c, nround;
    __device__ __forceinline__ bool next(int i, Unit& u) const { if (i >= nround) return false; const int x = c & 7, k = c >> 3; u.pm = 16 * i + 2 * x + (k >> 4); u.pn = k & 15; return true; }
    __device__ __forceinline__ void a_ready(const Unit&) const {}
    __device__ __forceinline__ void done(const Unit&) const {}
};
template <class Epi, class Sched, bool ALIGN_EPI = false, bool SP2 = false>
__device__ __forceinline__ void gemm_phase(PG8_LAS unsigned char* lds, const Gemm g, const Sched& S, const Epi& E) {
    int tid_ = my_tid(); asm volatile("" : "+v"(tid_));
    const int tid = tid_, wid = __builtin_amdgcn_readfirstlane(tid >> 6), lane = tid & 63, wr = wid >> 2, wc = wid & 3, fr = lane & 15, fq = lane >> 4;
    const int K = g.K, nt = K / BK;
    unsigned voffA[2], voffB[2];
#pragma unroll
    for (int i = 0; i < 2; ++i) { int R, C; stage_rc(tid * 16 + i * 8192, R, C); const int Rb = Epi::PERM ? ((R & ~31) + perm32(R & 31)) : R;
        voffA[i] = (unsigned)(R * K + C) * 2u; voffB[i] = (unsigned)(Rb * K + C) * 2u; }
    const size_t kstep = (size_t)(BK * 2);
    const size_t hstep = (size_t)HALF * K * 2;
    const size_t tstep = 2 * hstep;
    const unsigned ldsw = (unsigned)wid * 1024u;
    const int aoff = lds_byte(wr * 64 + fr, fq * 8), boff = lds_byte(wc * 32 + fr, fq * 8);
#define PG8_SA(b, h) (((b) * 2 + (h)) * HTB)
#define PG8_SB(b, h) ((4 + (b) * 2 + (h)) * HTB)
#define PG8_STAGE(bufoff, gbase, voff) do { _Pragma("unroll") for (int _i = 0; _i < 2; ++_i) \
        __builtin_amdgcn_global_load_lds((const unsigned*)((const char*)(gbase) + (voff)[_i]), (PG8_LAS unsigned*)(lds + (bufoff) + ldsw + _i * 8192), 16, 0, 0); } while (0)
#define PG8_LDA(dst, b, h) do { _Pragma("unroll") for (int m = 0; m < 4; ++m) _Pragma("unroll") for (int k = 0; k < 2; ++k) dst[m][k] = *(const PG8_LAS bf16x8*)(lds + PG8_SA(b, h) + aoff + m * 2048 + k * 1024); } while (0)
#define PG8_LDB(dst, b, h) do { _Pragma("unroll") for (int n = 0; n < 2; ++n) _Pragma("unroll") for (int k = 0; k < 2; ++k) dst[n][k] = *(const PG8_LAS bf16x8*)(lds + PG8_SB(b, h) + boff + n * 2048 + k * 1024); } while (0)
#define PG8_MMA(ai, bj, At, Bt) do { __builtin_amdgcn_s_setprio(1); _Pragma("unroll") for (int m = 0; m < 4; ++m) _Pragma("unroll") for (int n = 0; n < 2; ++n) _Pragma("unroll") for (int k = 0; k < 2; ++k) \
        acc[ai][bj][m][n] = __builtin_amdgcn_mfma_f32_16x16x32_bf16(Bt[n][k], At[m][k], acc[ai][bj][m][n], 0, 0, 0); __builtin_amdgcn_s_setprio(0); } while (0)
#define PG8_WAIT_V(n) asm volatile("s_waitcnt vmcnt(" #n ")" ::: "memory")
#define PG8_WAIT_L(n) asm volatile("s_waitcnt lgkmcnt(" #n ")" ::: "memory")
#define PG8_BAR __builtin_amdgcn_s_barrier()
#define PG8_SCHED __builtin_amdgcn_sched_barrier(0)
    Unit cur, nxt; int ui = 0;
    if (!S.next(0, cur)) return;
    f32x4 acc[2][2][4][2];
#pragma unroll
    for (int a = 0; a < 2; ++a)
#pragma unroll
        for (int b = 0; b < 2; ++b)
#pragma unroll
            for (int m = 0; m < 4; ++m)
#pragma unroll
                for (int n = 0; n < 2; ++n) acc[a][b][m][n] = (f32x4){0.f, 0.f, 0.f, 0.f};
    bf16x8 At[4][2], B0[2][2], B1[2][2];
    const char* cA = (const char*)g.A + (size_t)cur.pm * tstep; const char* cB = (const char*)g.Bt + (size_t)cur.pn * tstep;
    S.a_ready(cur);
    if constexpr (SP2) {
        PG8_STAGE(PG8_SB(0, 0), cB, voffB); PG8_STAGE(PG8_SB(0, 1), cB + hstep, voffB); PG8_STAGE(PG8_SA(0, 0), cA, voffA); PG8_STAGE(PG8_SA(0, 1), cA + hstep, voffA);
        if (wr == 1) PG8_BAR;
        PG8_WAIT_V(2); PG8_BAR;
        PG8_STAGE(PG8_SB(1, 0), cB + kstep, voffB); PG8_STAGE(PG8_SA(1, 0), cA + kstep, voffA); PG8_STAGE(PG8_SB(1, 1), cB + hstep + kstep, voffB);
        PG8_WAIT_V(6); PG8_BAR;
    } else {
        PG8_STAGE(PG8_SB(0, 0), cB, voffB); PG8_STAGE(PG8_SA(0, 0), cA, voffA); PG8_STAGE(PG8_SB(0, 1), cB + hstep, voffB); PG8_STAGE(PG8_SA(0, 1), cA + hstep, voffA);
        if (wr == 1) PG8_BAR;
        PG8_WAIT_V(4); PG8_BAR;
        PG8_STAGE(PG8_SB(1, 0), cB + kstep, voffB); PG8_STAGE(PG8_SA(1, 0), cA + kstep, voffA); PG8_STAGE(PG8_SB(1, 1), cB + hstep + kstep, voffB);
        PG8_WAIT_V(6); PG8_BAR;
    }
    for (;;) {
        const bool has_next = S.next(ui + 1, nxt);
        const char* nA = has_next ? (const char*)g.A + (size_t)nxt.pm * tstep : cA; const char* nB = has_next ? (const char*)g.Bt + (size_t)nxt.pn * tstep : cB;
        for (int t = 0; t < nt; t += 2) {
            const bool last = (t == nt - 2);
            const char* a1 = cA + (size_t)(t + 1) * kstep;
            const char* a2 = last ? nA : cA + (size_t)(t + 2) * kstep; const char* b2 = last ? nB : cB + (size_t)(t + 2) * kstep;
            const char* a3 = a2 + kstep; const char* b3 = b2 + kstep;
            if (last && has_next) S.a_ready(nxt);
            if constexpr (SP2) {
            PG8_LDB(B0, 0, 0); PG8_LDB(B1, 0, 1); PG8_SCHED; PG8_LDA(At, 0, 0); PG8_STAGE(PG8_SA(1, 1), a1 + hstep, voffA);
            PG8_WAIT_V(8); PG8_WAIT_L(0); PG8_BAR; PG8_MMA(0, 0, At, B0); PG8_MMA(0, 1, At, B1); PG8_BAR; PG8_SCHED;
            PG8_LDA(At, 0, 1); PG8_STAGE(PG8_SB(0, 0), b2, voffB); PG8_STAGE(PG8_SB(0, 1), b2 + hstep, voffB); PG8_STAGE(PG8_SA(0, 0), a2, voffA);
            PG8_WAIT_V(8); PG8_WAIT_L(0); PG8_BAR; PG8_MMA(1, 0, At, B0); PG8_MMA(1, 1, At, B1); PG8_BAR; PG8_SCHED;
            PG8_LDB(B0, 1, 0); PG8_LDB(B1, 1, 1); PG8_SCHED; PG8_LDA(At, 1, 0); PG8_STAGE(PG8_SA(0, 1), a2 + hstep, voffA);
            PG8_WAIT_V(8); PG8_WAIT_L(0); PG8_BAR; PG8_MMA(0, 0, At, B0); PG8_MMA(0, 1, At, B1); PG8_BAR; PG8_SCHED;
            PG8_LDA(At, 1, 1); PG8_STAGE(PG8_SB(1, 0), b3, voffB); PG8_STAGE(PG8_SB(1, 1), b3 + hstep, voffB); PG8_STAGE(PG8_SA(1, 0), a3, voffA);
            PG8_WAIT_V(8); PG8_WAIT_L(0); PG8_BAR; PG8_MMA(1, 0, At, B0); PG8_MMA(1, 1, At, B1); PG8_BAR; PG8_SCHED;
            } else {
            PG8_LDB(B0, 0, 0); PG8_SCHED; PG8_LDA(At, 0, 0); PG8_STAGE(PG8_SA(1, 1), a1 + hstep, voffA);
            PG8_WAIT_L(8); PG8_BAR; PG8_WAIT_L(0); PG8_MMA(0, 0, At, B0); PG8_BAR; PG8_SCHED;
            PG8_LDB(B1, 0, 1); PG8_STAGE(PG8_SB(0, 0), b2, voffB);
            PG8_BAR; PG8_WAIT_L(0); PG8_MMA(0, 1, At, B1); PG8_BAR;
            PG8_LDA(At, 0, 1); PG8_STAGE(PG8_SA(0, 0), a2, voffA);
            PG8_BAR; PG8_WAIT_L(0); PG8_MMA(1, 0, At, B0); PG8_BAR; PG8_SCHED;
            PG8_STAGE(PG8_SB(0, 1), b2 + hstep, voffB);
            PG8_WAIT_V(6); PG8_BAR; PG8_MMA(1, 1, At, B1); PG8_BAR;
            PG8_LDB(B0, 1, 0); PG8_SCHED; PG8_LDA(At, 1, 0); PG8_STAGE(PG8_SA(0, 1), a2 + hstep, voffA);
            PG8_WAIT_L(8); PG8_BAR; PG8_WAIT_L(0); PG8_MMA(0, 0, At, B0); PG8_BAR; PG8_SCHED;
            PG8_LDB(B1, 1, 1); PG8_STAGE(PG8_SB(1, 0), b3, voffB);
            PG8_BAR; PG8_WAIT_L(0); PG8_MMA(0, 1, At, B1); PG8_BAR;
            PG8_LDA(At, 1, 1); PG8_STAGE(PG8_SA(1, 0), a3, voffA);
            PG8_BAR; PG8_WAIT_L(0); PG8_MMA(1, 0, At, B0); PG8_BAR; PG8_SCHED;
            PG8_STAGE(PG8_SB(1, 1), b3 + hstep, voffB);
            PG8_WAIT_V(6); PG8_BAR; PG8_MMA(1, 1, At, B1); PG8_BAR;
            }
        }
        if constexpr (ALIGN_EPI) { if (wr == 0) PG8_BAR; }
        if constexpr (!Epi::AFTER_DRAIN) { E(acc, cur, wr, wc, fr, fq); S.done(cur); }
        if (!has_next) break;
#pragma unroll
        for (int a = 0; a < 2; ++a)
#pragma unroll
            for (int b = 0; b < 2; ++b)
#pragma unroll
                for (int m = 0; m < 4; ++m)
#pragma unroll
                    for (int n = 0; n < 2; ++n) acc[a][b][m][n] = (f32x4){0.f, 0.f, 0.f, 0.f};
        cur = nxt; cA = nA; cB = nB; ++ui;
        if constexpr (ALIGN_EPI) { if (wr == 1) PG8_BAR; }
    }
    PG8_WAIT_V(0);
    if constexpr (!ALIGN_EPI) { if (wr == 0) PG8_BAR; }
    PG8_BAR;
    if constexpr (Epi::AFTER_DRAIN) { E.fused(acc, cur, wr, wc, fr, fq, lds, wid, lane); S.done(cur); }
#undef PG8_SA
#undef PG8_SB
#undef PG8_STAGE
#undef PG8_LDA
#undef PG8_LDB
#undef PG8_MMA
#undef PG8_WAIT_V
#undef PG8_WAIT_L
#undef PG8_BAR
#undef PG8_SCHED
}
}

namespace attn {
constexpr int KVP = HD, OP = DM;
constexpr float SCALE = 0.08838834764831845f;
constexpr int D = 128;
constexpr int NW = 8, QBLK = 32, KVBLK = 64, QB = NW * QBLK;
constexpr int SHM_V = KVBLK * D * 2, SHM_K = KVBLK * D * 2;
constexpr int FB_OFF = 2 * SHM_V + 2 * SHM_K + NW * 64 * 4;
constexpr int LDS_BYTES = FB_OFF + 2 * 64 * 4;
constexpr bool WSKIP = false;
constexpr float THR = 16.f;

using bf16 = __hip_bfloat16;
typedef short bf16x8 __attribute__((ext_vector_type(8)));
typedef short s16x4 __attribute__((ext_vector_type(4)));
typedef float f32x16 __attribute__((ext_vector_type(16)));
typedef float f32x4 __attribute__((ext_vector_type(4)));
typedef unsigned u32x4 __attribute__((ext_vector_type(4)));
template <class A, class Bt> struct same_t { static constexpr bool v = false; };
template <class A> struct same_t<A, A> { static constexpr bool v = true; };

#define KSWZ(row, colB) ((row) * 256 + ((colB) ^ (((row) & 7) << 4)))
#define SBAR() __builtin_amdgcn_sched_barrier(0)
__device__ __forceinline__ int v_st(int k, int c) { const int kk = (k & ~0xC) | ((k & 4) << 1) | ((k & 8) >> 1); return ((kk >> 3) * 4 + (c >> 5)) * 512 + ((kk & 7) * 32 + (c & 31)) * 2; }
__device__ __forceinline__ int v_rd_base(int lane) { return ((lane & 3) << 3) | (((lane >> 2) & 3) << 6) | (((lane >> 4) & 1) << 5) | (((lane >> 5) & 1) << 8); }
constexpr int v_rd_off(int d0, int ks, int half) { return d0 * 512 + ks * 4096 + half * 2048; }
__device__ __forceinline__ int crow(int r, int hi) { return (r & 3) + 8 * (r >> 2) + 4 * hi; }
__device__ __forceinline__ unsigned cvtpk(float lo, float hi) {
    unsigned r; asm volatile("v_cvt_pk_bf16_f32 %0, %1, %2" : "=v"(r) : "v"(lo), "v"(hi)); return r;
}
__device__ __forceinline__ bf16x8 pack8(f32x4 a, f32x4 b) {
    u32x4 w = {cvtpk(a[0], a[1]), cvtpk(a[2], a[3]), cvtpk(b[0], b[1]), cvtpk(b[2], b[3])};
    return *reinterpret_cast<bf16x8*>(&w);
}
template <class T> __device__ __forceinline__ bf16x8 load8(const T* p) {
    if constexpr (same_t<T, float>::v) { return pack8(*(const f32x4*)p, *(const f32x4*)(p + 4)); }
    else { return *reinterpret_cast<const bf16x8*>(p); }
}
__device__ __forceinline__ void mask_tile(f32x16& p0, f32x16& p1, int dq, unsigned W) {
    const float NEG = -__builtin_inff();
#pragma unroll
    for (int r = 0; r < 16; ++r) {
        const int c = (r & 3) + 8 * (r >> 2);
        if ((unsigned)(dq - c) >= W) p0[r] = NEG;
        if ((unsigned)(dq - c - 32) >= W) p1[r] = NEG;
    }
}
__device__ __forceinline__ void partialSM(f32x16& p0, f32x16& p1, float& m_reg, float& mn, float& alpha) {
    float pmax = p0[0]; for (int r = 1; r < 16; ++r) pmax = fmaxf(pmax, p0[r]); for (int r = 0; r < 16; ++r) pmax = fmaxf(pmax, p1[r]);
    { auto rr = __builtin_amdgcn_permlane32_swap(__float_as_uint(pmax), __float_as_uint(pmax), false, false);
      pmax = fmaxf(__uint_as_float(rr[0]), __uint_as_float(rr[1])); }
    constexpr float C2 = 1.4426950408889634f * SCALE;
    if (__builtin_expect(__all((pmax - m_reg) * SCALE <= THR), 1)) { mn = m_reg; alpha = 1.f; }
    else { mn = fmaxf(m_reg, pmax); alpha = __builtin_amdgcn_exp2f((m_reg - mn) * C2); m_reg = mn; }
    const float mnL = -mn * C2;
    for (int r = 0; r < 16; ++r) p0[r] = fmaf(p0[r], C2, mnL); for (int r = 0; r < 16; ++r) p1[r] = fmaf(p1[r], C2, mnL);
    for (int r = 0; r < 16; ++r) p0[r] = __builtin_amdgcn_exp2f(p0[r]);
}
__device__ __forceinline__ void finishSM(f32x16& p0, f32x16& p1, float alpha, float& l_reg, bf16x8& pa0, bf16x8& pa1, bf16x8& pa2, bf16x8& pa3) {
    for (int r = 0; r < 16; ++r) p1[r] = __builtin_amdgcn_exp2f(p1[r]);
    float ps = 0; for (int r = 0; r < 16; ++r) ps += p0[r]; for (int r = 0; r < 16; ++r) ps += p1[r];
    { auto rr = __builtin_amdgcn_permlane32_swap(__float_as_uint(ps), __float_as_uint(ps), false, false);
      ps = __uint_as_float(rr[0]) + __uint_as_float(rr[1]); }
    l_reg = l_reg * alpha + ps;
#define PK4(P, B_, OUT) do { unsigned a0 = cvtpk(P[B_+0], P[B_+1]), a1 = cvtpk(P[B_+2], P[B_+3]);                          \
        unsigned b0 = cvtpk(P[B_+4], P[B_+5]), b1 = cvtpk(P[B_+6], P[B_+7]);                                             \
        auto r0 = __builtin_amdgcn_permlane32_swap(a0, b0, false, false); auto r1 = __builtin_amdgcn_permlane32_swap(a1, b1, false, false); \
        u32x4 w = {r0[0], r1[0], r0[1], r1[1]}; OUT = *reinterpret_cast<bf16x8*>(&w); } while (0)
    PK4(p0, 0, pa0); PK4(p0, 8, pa1); PK4(p1, 0, pa2); PK4(p1, 8, pa3);
#undef PK4
}
template <int KB, bool SK>
__device__ __forceinline__ void qkt(f32x16& p0, f32x16& p1, const char* K_lds, int r32, int hi, const bf16x8* qr, bool act) {
    if (SK && !act) { const float NEG = -__builtin_inff();
#pragma unroll
        for (int r = 0; r < 16; ++r) { p0[r] = NEG; p1[r] = NEG; } return; }
    { const char* fb = K_lds + 2 * SHM_K + NW * 64 * 4 + KB * 256 + hi * 16;
#pragma unroll
      for (int g = 0; g < 4; ++g) { const f32x4 a = *reinterpret_cast<const f32x4*>(fb + g * 32), b = *reinterpret_cast<const f32x4*>(fb + 128 + g * 32);
          p0[4 * g] = a[0]; p0[4 * g + 1] = a[1]; p0[4 * g + 2] = a[2]; p0[4 * g + 3] = a[3]; p1[4 * g] = b[0]; p1[4 * g + 1] = b[1]; p1[4 * g + 2] = b[2]; p1[4 * g + 3] = b[3]; } }
    const char* kb[4];
#pragma unroll
    for (int dd = 0; dd < 4; ++dd) kb[dd] = K_lds + KB * SHM_K + KSWZ(r32, (dd * 16 + hi * 8) * 2);
#pragma unroll
    for (int d0 = 0; d0 < 8; ++d0) { const char* a = kb[d0 & 3] + (d0 >> 2) * 128;
        bf16x8 b0 = *reinterpret_cast<const bf16x8*>(a);
        bf16x8 b1 = *reinterpret_cast<const bf16x8*>(a + 32 * 256);
        p0 = __builtin_amdgcn_mfma_f32_32x32x16_bf16(b0, qr[d0], p0, 0, 0, 0);
        p1 = __builtin_amdgcn_mfma_f32_32x32x16_bf16(b1, qr[d0], p1, 0, 0, 0); }
}
template <int VB, bool SK>
__device__ __forceinline__ void pv_tile(f32x16* o, int vb0, bf16x8 pa0, bf16x8 pa1, bf16x8 pa2, bf16x8 pa3, bool act) {
    if (SK && !act) return;
#define TRRD(dst, off) asm volatile("ds_read_b64_tr_b16 %0, %1 offset:%2" : "=&v"(dst) : "v"(vb0), "i"(off) : "memory")
#define PV_D0(d0) do { s16x4 l0, l1, l2, l3, h0, h1, h2, h3; constexpr int b_ = VB * SHM_V + v_rd_off(d0, 0, 0);     \
        TRRD(l0, b_); TRRD(h0, b_ + 2048); TRRD(l1, b_ + 4096); TRRD(h1, b_ + 6144); TRRD(l2, b_ + 8192); TRRD(h2, b_ + 10240); TRRD(l3, b_ + 12288); TRRD(h3, b_ + 14336); \
        asm volatile("s_waitcnt lgkmcnt(0)" ::: "memory"); SBAR();                 \
        o[d0] = __builtin_amdgcn_mfma_f32_32x32x16_bf16(pa0, (bf16x8){l0[0], l0[1], l0[2], l0[3], h0[0], h0[1], h0[2], h0[3]}, o[d0], 0, 0, 0);   \
        o[d0] = __builtin_amdgcn_mfma_f32_32x32x16_bf16(pa1, (bf16x8){l1[0], l1[1], l1[2], l1[3], h1[0], h1[1], h1[2], h1[3]}, o[d0], 0, 0, 0);   \
        o[d0] = __builtin_amdgcn_mfma_f32_32x32x16_bf16(pa2, (bf16x8){l2[0], l2[1], l2[2], l2[3], h2[0], h2[1], h2[2], h2[3]}, o[d0], 0, 0, 0);   \
        o[d0] = __builtin_amdgcn_mfma_f32_32x32x16_bf16(pa3, (bf16x8){l3[0], l3[1], l3[2], l3[3], h3[0], h3[1], h3[2], h3[3]}, o[d0], 0, 0, 0); } while (0)
    PV_D0(0); PV_D0(1); PV_D0(2); PV_D0(3);
#undef PV_D0
#undef TRRD
}

template <class TIn, class TOut> struct BlockRef { const TIn* Q; const TIn* K; const TIn* V; const float* F; TOut* O; int P0; int JLO; };
template <class TIn> struct Seam {
    bf16x8 qr[8];
    bf16x8 st_v0, st_v1, st_k0, st_k1; float st_f; f32x4 sf0, sf1, sf2, sf3;
    f32x4 tq[16];
};
__device__ __forceinline__ int swa_jlo(int P0, int W) { const int lowk = P0 - W + 1; return lowk > 0 ? lowk / KVBLK : 0; }
#define ROW(p, k0, rr) ((p) + (size_t)((k0) + (rr)) * KVP + sc)
#define VMW() asm volatile("s_waitcnt vmcnt(0)" ::: "memory")
#define VMWN(n) asm volatile("s_waitcnt vmcnt(%0)" :: "i"(n) : "memory")
#define SLOAD_H(Kp, Vp, Fp, k0) do { S.st_v0 = load8<TIn>(ROW(Vp, k0, sr)); S.st_v1 = load8<TIn>(ROW(Vp, k0, 32 + sr));              \
                         S.st_k0 = load8<TIn>(ROW(Kp, k0, sr)); S.st_k1 = load8<TIn>(ROW(Kp, k0, 32 + sr)); if (tid < 64) S.st_f = (Fp)[(k0) + tid]; } while (0)
#define SWRITE_HK(bf) do { *(bf16x8*)(K_lds + (bf) * SHM_K + kws) = S.st_k0; *(bf16x8*)(K_lds + (bf) * SHM_K + kws + 32 * 256) = S.st_k1; if (tid < 64) *(float*)(K_lds + 2 * SHM_K + NW * 64 * 4 + (bf) * 256 + tid * 4) = S.st_f; } while (0)
#define SWRITE_HV(bf) do { *(bf16x8*)(V_lds + (bf) * SHM_V + vst0) = S.st_v0; *(bf16x8*)(V_lds + (bf) * SHM_V + vst1) = S.st_v1; } while (0)
#define SWRITE_H(bf) do { SWRITE_HV(bf); SWRITE_HK(bf); } while (0)
#define SLOAD_F(p, k0) do { S.sf0 = *(const f32x4*)ROW(p, k0, sr); S.sf1 = *(const f32x4*)(ROW(p, k0, sr) + 4);                \
                            S.sf2 = *(const f32x4*)ROW(p, k0, 32 + sr); S.sf3 = *(const f32x4*)(ROW(p, k0, 32 + sr) + 4); } while (0)
#define SWRITE_KF(bf) do { *(bf16x8*)(K_lds + (bf) * SHM_K + kws) = pack8(S.sf0, S.sf1); *(bf16x8*)(K_lds + (bf) * SHM_K + kws + 32 * 256) = pack8(S.sf2, S.sf3); } while (0)
#define SWRITE_VF(bf) do { *(bf16x8*)(V_lds + (bf) * SHM_V + vst0) = pack8(S.sf0, S.sf1); *(bf16x8*)(V_lds + (bf) * SHM_V + vst1) = pack8(S.sf2, S.sf3); } while (0)
template <class TIn, class TOut>
__device__ __forceinline__ void causal_swa_prime(const BlockRef<TIn, TOut>& cur, int W, char* lds, Seam<TIn>& S) {
    constexpr bool F32 = same_t<TIn, float>::v;
    int tid_ = my_tid(); asm volatile("" : "+v"(tid_));
    const int tid = tid_, wid = __builtin_amdgcn_readfirstlane(tid >> 6), lane = tid & 63, r32 = lane & 31, hi = lane >> 5;
    const int sr = tid >> 4, sc = (tid & 15) * 8, kws = KSWZ(sr, sc * 2); char* K_lds = lds + 2 * SHM_V;
    const int kb0 = cur.JLO * KVBLK;
    for (int d0 = 0; d0 < 8; ++d0) S.qr[d0] = load8<TIn>(cur.Q + (size_t)(wid * QBLK + r32) * KVP + d0 * 16 + hi * 8);
    if constexpr (F32) { SLOAD_F((const float*)cur.K, kb0); VMW(); SWRITE_KF(0); SBAR(); SLOAD_F((const float*)cur.V, kb0); }
    else { SLOAD_H(cur.K, cur.V, cur.F, kb0); VMW(); SWRITE_HK(0); }
    __syncthreads();
}
template <class TIn, class TOut>
__device__ __forceinline__ void causal_swa_block(const BlockRef<TIn, TOut>& cur, const BlockRef<TIn, TOut>& nxt, int skv, int W, char* lds, Seam<TIn>& S, const float* const __attribute__((address_space(4)))* gslot, int goff) {
    constexpr bool F32 = same_t<TIn, float>::v;
    int tid_ = my_tid(); asm volatile("" : "+v"(tid_));
    const int tid = tid_, wid = __builtin_amdgcn_readfirstlane(tid >> 6), lane = tid & 63, r32 = lane & 31, hi = lane >> 5;
    const int j_lo = cur.JLO;
    int j_hi = (cur.P0 + QB - 1) / KVBLK + 1; if (j_hi > skv / KVBLK) j_hi = skv / KVBLK;
    const int NT = j_hi - j_lo;
    const int kbn = nxt.JLO * KVBLK;
    const int qlo = cur.P0 + wid * QBLK, qm = qlo + r32 - 4 * hi;
    char* V_lds = lds; char* K_lds = lds + 2 * SHM_V;
    float* ws = (float*)(lds + 2 * SHM_V + 2 * SHM_K) + wid * 64; float* li_l = ws, * al_l = ws + 32;
    float m_reg = -1e30f, l_reg = 0; f32x16 o[4] = {};
    const int sr = tid >> 4, sc = (tid & 15) * 8, vst0 = v_st(sr, sc), vst1 = v_st(32 + sr, sc), kws = KSWZ(sr, sc * 2);
    const int vb0 = (int)(uintptr_t)V_lds + v_rd_base(lane);
    const TIn* Kh = cur.K; const TIn* Vh = cur.V; const float* Fh = cur.F;
#define RESC(a) do { if (__any((a) < 1.f)) { if (hi == 0) al_l[r32] = (a); asm volatile("s_waitcnt lgkmcnt(0)" ::: "memory");              \
                     for (int d_ = 0; d_ < 4; ++d_) for (int r = 0; r < 16; ++r) o[d_][r] *= al_l[crow(r, hi)]; } } while (0)
#define KBASE(t) ((j_lo + (t)) * KVBLK)
#define ACT(t) (KBASE(t) <= qlo + QBLK - 1 && KBASE(t) + KVBLK - 1 >= qlo - W + 1)
#define MASKT(P0_, P1_, t) do { const int kb_ = KBASE(t); if ((!SK || ACT(t)) && (kb_ + KVBLK - 1 > qlo || kb_ <= qlo + QBLK - 1 - W)) mask_tile(P0_, P1_, qm - kb_, (unsigned)W); } while (0)
    constexpr int NQL = F32 ? 16 : 8;
    constexpr bool SK = WSKIP && !F32;
#define SEAM_K0() do { VMWN(NQL); if constexpr (F32) { SWRITE_KF(0); SBAR(); SLOAD_F((const float*)nxt.V, kbn); } else { SWRITE_HK(0); } SBAR(); } while (0)
    f32x16 pA0, pA1, pB0, pB1; float mnA, mnB, alA, alB; bf16x8 pa0, pa1, pa2, pa3;
    if constexpr (F32) { VMW(); SWRITE_VF(0); SBAR(); } else { SWRITE_HV(0); SBAR(); }
    if (NT > 1) { if constexpr (F32) SLOAD_F((const float*)Kh, KBASE(1)); else SLOAD_H(Kh, Vh, Fh, KBASE(1)); }
    SBAR(); qkt<0, SK>(pA0, pA1, K_lds, r32, hi, S.qr, ACT(0));
    if constexpr (F32) { if (NT > 1) { VMW(); SWRITE_KF(1); SBAR(); SLOAD_F((const float*)Vh, KBASE(1)); } }
    MASKT(pA0, pA1, 0); partialSM(pA0, pA1, m_reg, mnA, alA);
    if (NT > 1) { VMW(); if constexpr (F32) { SWRITE_VF(1); SBAR(); if (NT > 2) SLOAD_F((const float*)Kh, KBASE(2)); } else SWRITE_H(1); }
    __syncthreads();
#define HALF_STEP(PX0, PX1, mnX, alX, PY0, PY1, alY, t, KB, VB, SB) do {                                                      \
        SBAR(); qkt<KB, SK>(PX0, PX1, K_lds, r32, hi, S.qr, ACT(t));                                             \
        finishSM(PY0, PY1, alY, l_reg, pa0, pa1, pa2, pa3); SBAR();                                                           \
        if ((t) + 1 < NT) { if constexpr (F32) { VMW(); SWRITE_KF(SB); SBAR(); SLOAD_F((const float*)Vh, KBASE((t) + 1)); }  \
                            else { SLOAD_H(Kh, Vh, Fh, KBASE((t) + 1)); } SBAR(); }                                               \
        pv_tile<VB, SK>(o, vb0, pa0, pa1, pa2, pa3, ACT((t) - 1)); MASKT(PX0, PX1, (t)); partialSM(PX0, PX1, m_reg, mnX, alX);                                        \
        __syncthreads();                                                                                                      \
        if ((t) + 1 < NT) { VMW(); if constexpr (F32) { SWRITE_VF(SB); SBAR(); if ((t) + 2 < NT) SLOAD_F((const float*)Kh, KBASE((t) + 2)); } \
                            else { SWRITE_H(SB); } }                                                                          \
        RESC(alX); __syncthreads(); } while (0)
    for (int t = 1; t + 1 < NT; t += 2) {
        HALF_STEP(pB0, pB1, mnB, alB, pA0, pA1, alA, t, 1, 0, 0);
        HALF_STEP(pA0, pA1, mnA, alA, pB0, pB1, alB, t + 1, 0, 1, 1);
    }
    const bool even = (NT & 1) == 0;
    if (even) { SBAR(); qkt<1, SK>(pB0, pB1, K_lds, r32, hi, S.qr, ACT(NT - 1)); SBAR(); }
#define QROW(e) (nxt.Q + (size_t)(wid * QBLK + r32) * KVP + ((e) >> 1) * 16 + hi * 8 + ((e) & 1) * 4)
    if constexpr (F32) { SLOAD_F((const float*)nxt.K, kbn); SBAR();
#pragma unroll
        for (int e = 0; e < 8; ++e) S.tq[e] = *(const f32x4*)QROW(e); }
    else { SLOAD_H(nxt.K, nxt.V, nxt.F, kbn); SBAR();
#pragma unroll
        for (int d0 = 0; d0 < 8; ++d0) S.qr[d0] = load8<TIn>(nxt.Q + (size_t)(wid * QBLK + r32) * KVP + d0 * 16 + hi * 8); }
    SBAR();
    finishSM(pA0, pA1, alA, l_reg, pa0, pa1, pa2, pa3); SBAR();
    if constexpr (F32) {
#pragma unroll
        for (int e = 8; e < 16; ++e) S.tq[e] = *(const f32x4*)QROW(e); SBAR(); }
#undef QROW
    pv_tile<0, SK>(o, vb0, pa0, pa1, pa2, pa3, ACT(even ? NT - 2 : NT - 1));
    if (even) { MASKT(pB0, pB1, NT - 1); partialSM(pB0, pB1, m_reg, mnB, alB); __syncthreads(); RESC(alB);
        finishSM(pB0, pB1, alB, l_reg, pa0, pa1, pa2, pa3); SBAR(); pv_tile<1, SK>(o, vb0, pa0, pa1, pa2, pa3, ACT(NT - 1)); }
    SBAR(); SEAM_K0();
    if (hi == 0) li_l[r32] = l_reg; asm volatile("s_waitcnt lgkmcnt(0)" ::: "memory");
    float rli[16];
#pragma unroll
    for (int r = 0; r < 16; ++r) rli[r] = __builtin_amdgcn_rcpf(li_l[crow(r, hi)]);
    TOut* Ow = cur.O + (size_t)(wid * QBLK) * OP;
    float gn[4];
    { const float* G = *gslot + goff;
#pragma unroll
    for (int d0 = 0; d0 < 4; ++d0) gn[d0] = G[d0 * 32 + r32]; }
#pragma unroll
    for (int r = 0; r < 16; ++r) { const int orow = crow(r, hi);
        float y[4]; float ss = 0.f;
#pragma unroll
        for (int d0 = 0; d0 < 4; ++d0) { y[d0] = o[d0][r] * rli[r]; ss += y[d0] * y[d0]; }
        ss += __shfl_xor(ss, 1); ss += __shfl_xor(ss, 2); ss += __shfl_xor(ss, 4); ss += __shfl_xor(ss, 8); ss += __shfl_xor(ss, 16);
        const float rs = __builtin_amdgcn_rsqf(ss * (1.0f / 128.0f) + 1e-6f);
#pragma unroll
        for (int d0 = 0; d0 < 4; ++d0) { const float v = y[d0] * rs * gn[d0];
            if constexpr (same_t<TOut, float>::v) { Ow[(size_t)orow * OP + d0 * 32 + r32] = v; }
            else { const float vn = __shfl_xor(v, 1);
                   if ((r32 & 1) == 0) *(unsigned*)(Ow + (size_t)orow * OP + d0 * 32 + r32) = cvtpk(v, vn); } }
        SBAR(); }
    if constexpr (F32) {
#pragma unroll
        for (int d0 = 0; d0 < 8; ++d0) S.qr[d0] = pack8(S.tq[2 * d0], S.tq[2 * d0 + 1]); }
    __syncthreads();
#undef RESC
#undef KBASE
#undef ACT
#undef MASKT
#undef SEAM_K0
#undef HALF_STEP
}
#undef ROW
#undef VMW
#undef VMWN
#undef SLOAD_H
#undef SWRITE_HK
#undef SWRITE_HV
#undef SWRITE_H
#undef SLOAD_F
#undef SWRITE_KF
#undef SWRITE_VF


}

__device__ __forceinline__ float bflo(unsigned w) { return __uint_as_float(w << 16); }
__device__ __forceinline__ float bfhi(unsigned w) { return __uint_as_float(w & 0xffff0000u); }
__device__ __forceinline__ float wave_sum(float v) {
#pragma unroll
    for (int o = 1; o < 64; o <<= 1) v += __shfl_xor(v, o);
    return v;
}
__device__ __forceinline__ float sigmoid_f(float x) { return 1.0f / (1.0f + __expf(-x)); }
__device__ __forceinline__ float silu_acc(float x) { return x / (1.0f + __expf(-x)); }
__device__ __forceinline__ float softplus_f(float x) { return fmaxf(x, 0.f) + log1pf(__expf(-fabsf(x))); }
__device__ __forceinline__ float logsigmoid_f(float x) { return fminf(x, 0.f) - log1pf(__expf(-fabsf(x))); }

struct Args { const float* in[17]; float* out; unsigned char* ws; int ph_lo, ph_hi; };
typedef const __attribute__((address_space(4))) Args* ArgsP;
enum { I_X = 0, I_MIXPRE, I_WIN, I_FOXFB, I_FOXON, I_SCW, I_GDNCW, I_GDNALOG, I_GDNDTB, I_GDNON, I_WOUT, I_MIXPOST, I_FFNPRE, I_WGATE, I_WUP, I_WDOWN, I_FFNPOST };
struct Ptrs {
    ArgsP ap;
    int tid, lane, wave, gw, NGW, G, bid;
};
__device__ __forceinline__ Ptrs fresh_ptrs(ArgsP ap0);
__device__ __forceinline__ int ftid() { int t = my_tid(); asm volatile("" : "+v"(t)); return t; }
__device__ __forceinline__ int fbid() { int b = blockIdx.x; asm volatile("" : "+s"(b)); return b; }
__device__ __forceinline__ ArgsP fresh(ArgsP a) { asm volatile("" : "+s"(a)); return a; }
__device__ __forceinline__ Ptrs fresh_ptrs(ArgsP ap0) { Ptrs P; P.ap = fresh(ap0); P.tid = ftid(); P.lane = P.tid & 63; P.wave = __builtin_amdgcn_readfirstlane(P.tid >> 6); P.bid = fbid();
    P.G = gridDim.x; P.gw = P.bid * NWAVES + P.wave; P.NGW = P.G * NWAVES; return P; }

__device__ __forceinline__ int win_src4(int d) {
    if (d < PC_SB) return d;
    if (d < PC_GQ) return d - PC_SB + SRC_SB;
    if (d < PC_GZ) return d - PC_GQ + SRC_GQ;
    if (d < PC_SMALL) return d - PC_GZ + SRC_GZ;
    const int e = d - PC_SMALL;
    if (e < 12) return SRC_FF + e;
    if (e < 24) return SRC_GA + e - 12;
    if (e < 36) return SRC_GB + e - 24;
    return -1;
}
struct TrItem { const float* W; int Ns, scol, k0; bf16* WT; int K, dn0; };
__device__ __forceinline__ void tr_load(const TrItem& t, f32x4 (&v)[8], int lane) {
    const int sub = lane >> 3;
#pragma unroll
    for (int i = 0; i < 8; ++i) { const int kk = 8 * i + sub; v[i] = (f32x4){0.f, 0.f, 0.f, 0.f}; if (t.scol >= 0) v[i] = *(const f32x4*)(t.W + (size_t)(t.k0 + kk) * t.Ns + t.scol); }
}
__device__ __forceinline__ void tr_store(const TrItem& t, const f32x4 (&v)[8], LAS float* scr, int lane) {
    const int sub = lane >> 3, g = lane & 7;
#pragma unroll
    for (int i = 0; i < 8; ++i) { const int kk = 8 * i + sub; LAS float* s = scr + kk * 33 + 4 * g; s[0] = v[i][0]; s[1] = v[i][1]; s[2] = v[i][2]; s[3] = v[i][3]; }
    LDS_WAIT(); asm volatile("" ::: "memory");
    const int c = lane & 7;
#pragma unroll
    for (int j = 0; j < 4; ++j) { const int n = (lane >> 3) + 8 * j; const LAS float* s = scr + (8 * c) * 33 + n;
        v4u o; o.x = pk2(s[0 * 33], s[1 * 33]); o.y = pk2(s[2 * 33], s[3 * 33]); o.z = pk2(s[4 * 33], s[5 * 33]); o.w = pk2(s[6 * 33], s[7 * 33]);
        *(v4u*)(t.WT + (size_t)(t.dn0 + n) * t.K + t.k0 + 8 * c) = o; }
    LDS_WAIT(); asm volatile("" ::: "memory");
}
constexpr int I_IN = 64 * (NP / 32), I_OUT = 64 * (DM / 32), I_GU = 64 * (NGU / 32), I_DN = (FFN / 64) * (DM / 32), I_LAYER = I_IN + I_OUT + I_GU + I_DN;
#ifndef CV_TAIL_DN
#define CV_TAIL_DN 12000
#endif
#ifndef CV_TAIL_IN
#define CV_TAIL_IN 25000
#endif
constexpr int I_3 = I_IN + I_OUT + I_GU;

typedef unsigned u32x2t __attribute__((ext_vector_type(2)));
__device__ __forceinline__ float sq4(const f32x4 v) { return (v[0] * v[0] + v[1] * v[1]) + (v[2] * v[2] + v[3] * v[3]); }
__device__ __forceinline__ void rms_row_to_bf16(const float* xrow, const float* gain, bf16* orow, int lane) {
    f32x4 a[16]; float ss = 0.f;
#pragma unroll
    for (int j = 0; j < 16; ++j) { a[j] = *(const f32x4*)(xrow + 256 * j + 4 * lane); ss += sq4(a[j]); }
    const float r = 1.0f / sqrtf(wave_sum(ss) * (1.0f / DM) + RMS_EPS);
#pragma unroll
    for (int j = 0; j < 16; ++j) { const f32x4 g = *(const f32x4*)(gain + 256 * j + 4 * lane);
        u32x2t o; o.x = pk2(a[j][0] * r * g[0], a[j][1] * r * g[1]); o.y = pk2(a[j][2] * r * g[2], a[j][3] * r * g[3]);
        *(u32x2t*)(orow + 256 * j + 4 * lane) = o; }
}
__device__ __forceinline__ void resid_norm_row(const float* base_row, const bf16* yrow, const float* ssrow, const float* gpost, float* out_row, const float* gnext, bf16* xn_row, int lane) {
    const float ry = 1.0f / sqrtf(wave_sum(ssrow[lane]) * (1.0f / DM) + RMS_EPS);
    f32x4 a[16]; float ss = 0.f;
#pragma unroll
    for (int j = 0; j < 16; ++j) { const int c = 256 * j + 4 * lane; const u32x2t yw = *(const u32x2t*)(yrow + c);
        const f32x4 x0 = *(const f32x4*)(base_row + c), g0 = *(const f32x4*)(gpost + c);
        a[j][0] = x0[0] + bflo(yw.x) * ry * g0[0]; a[j][1] = x0[1] + bfhi(yw.x) * ry * g0[1]; a[j][2] = x0[2] + bflo(yw.y) * ry * g0[2]; a[j][3] = x0[3] + bfhi(yw.y) * ry * g0[3];
        *(f32x4*)(out_row + c) = a[j]; ss += sq4(a[j]); }
    if (gnext) {
        const float r = 1.0f / sqrtf(wave_sum(ss) * (1.0f / DM) + RMS_EPS);
#pragma unroll
        for (int j = 0; j < 16; ++j) { const f32x4 g = *(const f32x4*)(gnext + 256 * j + 4 * lane);
            u32x2t o; o.x = pk2(a[j][0] * r * g[0], a[j][1] * r * g[1]); o.y = pk2(a[j][2] * r * g[2], a[j][3] * r * g[3]);
            *(u32x2t*)(xn_row + 256 * j + 4 * lane) = o; }
    }
}

__device__ __forceinline__ TrItem cv_item(ArgsP A, int l, int it, int g) {
    bf16* wl = (bf16*)(A->ws + WS_W);
    int r = it; TrItem t;
    if (r < I_IN) { const int kb = r / (NP / 32), nb = r % (NP / 32);
        t.W = A->in[I_WIN] + (size_t)l * DM * PROJ_SRC; t.Ns = PROJ_SRC; t.scol = win_src4(32 * nb + 4 * g); t.k0 = 64 * kb; t.WT = (bf16*)((unsigned char*)wl + WO_IN); t.K = DM; t.dn0 = 32 * nb; return t; }
    r -= I_IN;
    if (r < I_OUT) { const int kb = r / (DM / 32), nb = r % (DM / 32);
        t.W = A->in[I_WOUT] + (size_t)l * DM * DM; t.Ns = DM; t.scol = 32 * nb + 4 * g; t.k0 = 64 * kb; t.WT = (bf16*)((unsigned char*)wl + WO_OUT); t.K = DM; t.dn0 = 32 * nb; return t; }
    r -= I_OUT;
    if (r < I_GU) { const int kb = r / (NGU / 32), nb = r % (NGU / 32), dn0 = 32 * nb, j = dn0 >> 8, w = dn0 & 255;
        t.W = (w < 128 ? A->in[I_WGATE] : A->in[I_WUP]) + (size_t)l * DM * FFN; t.Ns = FFN; t.scol = 128 * j + (w & 127) + 4 * g; t.k0 = 64 * kb; t.WT = (bf16*)((unsigned char*)wl + WO_GU); t.K = DM; t.dn0 = dn0; return t; }
    r -= I_GU;
    { const int kb = r / (DM / 32), nb = r % (DM / 32);
        t.W = A->in[I_WDOWN] + (size_t)l * FFN * DM; t.Ns = DM; t.scol = 32 * nb + 4 * g; t.k0 = 64 * kb; t.WT = (bf16*)((unsigned char*)wl + WO_DN); t.K = FFN; t.dn0 = 32 * nb; return t; }
}
__device__ __forceinline__ void convert_weights(ArgsP ap0, LAS unsigned char* lds, int l, int lo = 0, int hi = I_LAYER, int wg_lo = 0) {
    const Ptrs P = fresh_ptrs(ap0); const ArgsP A = P.ap;
    if (P.bid < wg_lo) return;
    LAS float* scr = (LAS float*)(lds + P.wave * 16384);
    const int g = P.lane & 7, stride = (P.G - wg_lo) * NWAVES;
    int it = lo + (P.bid - wg_lo) * NWAVES + P.wave;
    if (it >= hi) return;
    f32x4 va[8], vb[8];
    tr_load(cv_item(A, l, it, g), va, P.lane);
    for (;;) {
        { const int nit = it + stride; const bool hasn = nit < hi; if (hasn) tr_load(cv_item(A, l, nit, g), vb, P.lane);
          tr_store(cv_item(A, l, it, g), va, scr, P.lane); if (!hasn) break; it = nit; }
        { const int nit = it + stride; const bool hasn = nit < hi; if (hasn) tr_load(cv_item(A, l, nit, g), va, P.lane);
          tr_store(cv_item(A, l, it, g), vb, scr, P.lane); if (!hasn) break; it = nit; }
    }
}
__device__ __forceinline__ void p0_prologue(ArgsP ap0, LAS unsigned char* lds) {
    convert_weights(ap0, lds, 0, 0, I_3);
    convert_weights(ap0, lds, 0, I_3 + CV_TAIL_DN, I_LAYER);
    const Ptrs P = fresh_ptrs(ap0); const ArgsP A = P.ap;
    bf16* XN = (bf16*)(A->ws + WS_XN);
    for (int m = P.gw; m < M; m += P.NGW) rms_row_to_bf16(A->in[I_X] + (size_t)m * DM, A->in[I_MIXPRE], XN + (size_t)m * DM, P.lane);
}

__device__ __forceinline__ void p2_prep(ArgsP ap0, LAS unsigned char* lds, int l) {
    const Ptrs P = fresh_ptrs(ap0); const ArgsP A = P.ap;
    const bf16* SCB = (const bf16*)(A->ws + WS_SCB); const float* SB = (const float*)(A->ws + WS_SB);
    bf16* MIX = (bf16*)(A->ws + WS_MIX); float* FG = (float*)(A->ws + WS_FG);
    const int lane = P.lane;
    if (P.bid < BATCH * FOXH) {
        const int bh = P.bid, b = bh / FOXH, h = bh % FOXH; const float fb = A->in[I_FOXFB][l * FOXH + h];
        const float* sb = SB + ((size_t)(b * SEQ) + 16 * P.tid) * SBW + SB_FF + h;
        float ls[16]; float loc = 0.f;
#pragma unroll
        for (int i = 0; i < 16; ++i) ls[i] = sb[(size_t)i * SBW];
#pragma unroll
        for (int i = 0; i < 16; ++i) { ls[i] = logsigmoid_f(ls[i] + fb); loc += ls[i]; }
        float incl = loc;
#pragma unroll
        for (int o = 1; o < 64; o <<= 1) { const float n = __shfl_up(incl, o); if (lane >= o) incl += n; }
        LAS float* wt = (LAS float*)lds;
        if (lane == 63) wt[P.wave] = incl;
        __syncthreads();
        float run = incl - loc;
        for (int w = 0; w < P.wave; ++w) run += wt[w];
        f32x4 o4[4];
#pragma unroll
        for (int i = 0; i < 16; ++i) { run += ls[i]; o4[i >> 2][i & 3] = -run * 11.313708498984761f; }
        float* fo = FG + (size_t)bh * SEQ + 16 * P.tid;
#pragma unroll
        for (int i = 0; i < 4; ++i) *(f32x4*)(fo + 4 * i) = o4[i];
        __syncthreads();
    }
    { const bf16* HMq = (const bf16*)(A->ws + WS_PROJ); float* TN = (float*)(A->ws + WS_TN);
      constexpr int NT_ = BATCH * FOXH * (SEQ / 64);
      for (int it = P.gw; it < NT_; it += P.NGW) {
        const int bh = it / (SEQ / 64), c = it % (SEQ / 64);
        const v4u* qrow = (const v4u*)(HMq + hm_off(HM_FQ, bh) + (size_t)(c * 64 + lane) * HD); const v4u* krow = (const v4u*)(HMq + hm_off(HM_FK, bh) + (size_t)(c * 64 + lane) * HD);
        v4u qv[16], kv[16];
#pragma unroll
        for (int j = 0; j < 16; ++j) { qv[j] = qrow[j]; kv[j] = krow[j]; }
        float sq = 0.f, sk = 0.f, d = 0.f;
#pragma unroll
        for (int j = 0; j < 16; ++j) {
#pragma unroll
            for (int e4 = 0; e4 < 4; ++e4) { const unsigned a = e4 == 0 ? qv[j].x : e4 == 1 ? qv[j].y : e4 == 2 ? qv[j].z : qv[j].w, b = e4 == 0 ? kv[j].x : e4 == 1 ? kv[j].y : e4 == 2 ? kv[j].z : kv[j].w;
                const float a0 = bflo(a), a1 = bfhi(a), b0 = bflo(b), b1 = bfhi(b); sq += a0 * a0 + a1 * a1; sk += b0 * b0 + b1 * b1; d += a0 * b0 + a1 * b1; } }
#pragma unroll
        for (int o = 1; o < 64; o <<= 1) { sq = fmaxf(sq, __shfl_xor(sq, o)); sk = fmaxf(sk, __shfl_xor(sk, o)); d = fminf(d, __shfl_xor(d, o)); }
        if (lane == 0) { TN[it] = sq; TN[NT_ + it] = sk; TN[2 * NT_ + it] = d; }
      } }
    { const float* cw = A->in[I_SCW] + (size_t)l * 3 * SCW;
      for (int idx = P.bid * 512 + P.tid; idx < M * (SCW / 8); idx += P.G * 512) {
        const int m = idx >> 7, c = (idx & 127) * 8, tp = m & (SEQ - 1);
        const bf16* row = SCB + (size_t)m * SCBW;
        const v4u bw = *(const v4u*)(row + c);
        float acc[8];
#pragma unroll
        for (int e = 0; e < 8; ++e) acc[e] = 0.f;
#pragma unroll
        for (int j = 0; j < 3; ++j) { const int dt = 2 - j;
            if (tp - dt >= 0) { const bf16* rj = row - (size_t)dt * SCBW; const v4u cwv = *(const v4u*)(rj + SCW + c), hw = *(const v4u*)(rj + 2 * SCW + c);
                const f32x4 w0 = *(const f32x4*)(cw + j * SCW + c), w1 = *(const f32x4*)(cw + j * SCW + c + 4);
                acc[0] += w0[0] * bflo(cwv.x) * bflo(hw.x); acc[1] += w0[1] * bfhi(cwv.x) * bfhi(hw.x); acc[2] += w0[2] * bflo(cwv.y) * bflo(hw.y); acc[3] += w0[3] * bfhi(cwv.y) * bfhi(hw.y);
                acc[4] += w1[0] * bflo(cwv.z) * bflo(hw.z); acc[5] += w1[1] * bfhi(cwv.z) * bfhi(hw.z); acc[6] += w1[2] * bflo(cwv.w) * bflo(hw.w); acc[7] += w1[3] * bfhi(cwv.w) * bfhi(hw.w); } }
        v4u o; o.x = pk2(acc[0] * bflo(bw.x), acc[1] * bfhi(bw.x)); o.y = pk2(acc[2] * bflo(bw.y), acc[3] * bfhi(bw.y)); o.z = pk2(acc[4] * bflo(bw.z), acc[5] * bfhi(bw.z)); o.w = pk2(acc[6] * bflo(bw.w), acc[7] * bfhi(bw.w));
        *(v4u*)(MIX + (size_t)m * DM + FOXW + c) = o; } }
}


#ifndef GP_REP_S1
#define GP_REP_S1 1
#endif
#ifndef GP_REP_S4
#define GP_REP_S4 1
#endif
constexpr int GD_OPS_BYTES = 57344;
constexpr int GD_F_WN = 0, GD_F_QD = 16, GD_F_AT = 32, GD_F_KT = 40;
constexpr int GD_NCH = SEQ / 64;
constexpr int GD_NCHH = BATCH * GDNH * GD_NCH;
constexpr size_t WS_GOPS = WS_Y, WS_GU = WS_Y + 168 * MiB, WS_GL = WS_Y + 264 * MiB, WS_GO2 = WS_Y + 266 * MiB;
constexpr int GP_QS = 0, GP_KS = 17408, GP_VS = 34816, GP_LT = 68608, GP_AT = 86016, GP_WM = 103424, GP_SM = 120832;
typedef float f32x2v __attribute__((ext_vector_type(2)));
typedef unsigned u32x2v __attribute__((ext_vector_type(2)));
typedef __bf16 bf16x2c_t __attribute__((ext_vector_type(2)));
__device__ __forceinline__ unsigned cvtpk_bf16(float lo, float hi) { const f32x2v v = {lo, hi}; const bf16x2c_t b = __builtin_convertvector(v, bf16x2c_t); return __builtin_bit_cast(unsigned, b); }


template <int N> __device__ __forceinline__ void fma_bcast(float& x, float l, float nxi) {
    asm volatile("v_fmac_f32_dpp %0, %1, %2 row_newbcast:%3 row_mask:0xf bank_mask:0xf" : "+v"(x) : "v"(l), "v"(nxi), "n"(N));
}
template <int I, int R> struct TriRow {
    static __device__ __forceinline__ void run(float (&x)[64], const float (&L)[4], float nxi) { fma_bcast<(R & 15)>(x[R], L[R >> 4], nxi); TriRow<I, R + 1>::run(x, L, nxi); }
};
template <int I> struct TriRow<I, 64> { static __device__ __forceinline__ void run(float (&)[64], const float (&)[4], float) {} };
template <int I> struct TriSolve {
    static __device__ __forceinline__ void run(float (&x)[64], const LAS float* ltb, float (&Lc)[4]) {
        float Ln[4] = {0.f, 0.f, 0.f, 0.f};
        if (I + 1 < 63) {
#pragma unroll
            for (int q = (I + 2) >> 4; q < 4; ++q) Ln[q] = ltb[(I + 1) * 68 + 16 * q]; }
        const float nxi = -x[I];
        asm volatile("s_nop 1" ::: "memory");
        TriRow<I, I + 1>::run(x, Lc, nxi);
#pragma unroll
        for (int q = 0; q < 4; ++q) Lc[q] = Ln[q];
        TriSolve<I + 1>::run(x, ltb, Lc);
    }
};
template <> struct TriSolve<63> { static __device__ __forceinline__ void run(float (&)[64], const LAS float*, float (&)[4]) {} };


template <int NT>
__device__ __forceinline__ void gp_s1(LAS unsigned char* lds, const bf16* HMG, const float* cw, int ch, int ltid) {
    const int bh = ch / GD_NCH, n = ch % GD_NCH, h = bh % GDNH;
    constexpr int NI = 3072 / NT, PER = NI / 3, ROWS = NT / 16, NB = (NT == 256 ? 4 : 3);
    const int c = (ltid & 15) * 8;
#pragma unroll
    for (int i0 = 0; i0 < NI; i0 += NB) {
        v4u xw[NB][4];
#pragma unroll
        for (int ib = 0; ib < NB; ++ib) { const int i = i0 + ib, part = i / PER, t = (i % PER) * ROWS + (ltid >> 4), tp = n * 64 + t;
            const bf16* src = HMG + hm_off(part, bh) + (size_t)(n * 64 + t) * HD + c;
#pragma unroll
            for (int j = 0; j < 4; ++j) { xw[ib][j] = (v4u){0u, 0u, 0u, 0u}; if (tp - (3 - j) >= 0) xw[ib][j] = *(const v4u*)(src - (size_t)(3 - j) * HD); } }
#pragma unroll
        for (int ib = 0; ib < NB; ++ib) { const int i = i0 + ib, part = i / PER, t = (i % PER) * ROWS + (ltid >> 4);
            const float* wp = cw + part * GDNW + h * HD + c;
            float acc[8];
#pragma unroll
            for (int e = 0; e < 8; ++e) acc[e] = 0.f;
#pragma unroll
            for (int j = 0; j < 4; ++j) { const v4u xv = xw[ib][j]; const f32x4 w0 = *(const f32x4*)(wp + j * (3 * GDNW)), w1 = *(const f32x4*)(wp + j * (3 * GDNW) + 4);
                acc[0] += w0[0] * bflo(xv.x); acc[1] += w0[1] * bfhi(xv.x); acc[2] += w0[2] * bflo(xv.y); acc[3] += w0[3] * bfhi(xv.y);
                acc[4] += w1[0] * bflo(xv.z); acc[5] += w1[1] * bfhi(xv.z); acc[6] += w1[2] * bflo(xv.w); acc[7] += w1[3] * bfhi(xv.w); }
            float ss = 0.f;
#pragma unroll
            for (int e = 0; e < 8; ++e) { acc[e] = acc[e] * __builtin_amdgcn_rcpf(1.0f + __builtin_amdgcn_exp2f(-1.4426950408889634f * acc[e])); ss += acc[e] * acc[e]; }
            if (part < 2) {
                ss += __shfl_xor(ss, 1); ss += __shfl_xor(ss, 2); ss += __shfl_xor(ss, 4); ss += __shfl_xor(ss, 8);
                const float r = (1.0f / sqrtf(ss + RMS_EPS)) * (part == 0 ? 0.08838834764831845f : 1.0f);
                v4u o; o.x = cvtpk_bf16(acc[0] * r, acc[1] * r); o.y = cvtpk_bf16(acc[2] * r, acc[3] * r); o.z = cvtpk_bf16(acc[4] * r, acc[5] * r); o.w = cvtpk_bf16(acc[6] * r, acc[7] * r);
                *(LAS v4u*)(lds + (part == 0 ? GP_QS : GP_KS) + (t * 136 + c) * 2) = o;
            } else {
                LAS float* vp = (LAS float*)(lds + GP_VS) + t * 132 + c;
                *(LAS f32x4*)vp = (f32x4){acc[0], acc[1], acc[2], acc[3]}; *(LAS f32x4*)(vp + 4) = (f32x4){acc[4], acc[5], acc[6], acc[7]};
            }
        }
    }
}
__device__ __forceinline__ void gp_s2(ArgsP A, LAS float* SMf, const float* SB, float* GL, int l, int ch, int lane) {
    const int bh = ch / GD_NCH, n = ch % GD_NCH, b = bh / GDNH, h = bh % GDNH;
    const size_t m = (size_t)b * SEQ + (size_t)n * 64 + lane;
    const float xb = SB[m * SBW + SB_GB + h], xa = SB[m * SBW + SB_GA + h] + A->in[I_GDNDTB][l * GDNH + h];
    const float bt = __builtin_amdgcn_rcpf(1.0f + __builtin_amdgcn_exp2f(-1.4426950408889634f * xb));
    const float sp = fmaxf(xa, 0.f) + 0.6931471805599453f * __builtin_amdgcn_logf(1.0f + __builtin_amdgcn_exp2f(-1.4426950408889634f * fabsf(xa)));
    const float gg = -__builtin_amdgcn_exp2f(1.4426950408889634f * A->in[I_GDNALOG][l * GDNH + h]) * sp;
    float gc = gg;
#pragma unroll
    for (int o = 1; o < 64; o <<= 1) { const float nb = __shfl_up(gc, o); if (lane >= o) gc += nb; }
    const float gtot = __shfl(gc, 63);
    SMf[lane] = bt; SMf[64 + lane] = gc; SMf[128 + lane] = __builtin_amdgcn_exp2f(1.4426950408889634f * gc); SMf[192 + lane] = __builtin_amdgcn_exp2f(1.4426950408889634f * (gtot - gc));
    if (lane == 63) GL[ch] = __builtin_amdgcn_exp2f(1.4426950408889634f * gtot);
}

__device__ __forceinline__ void gdn_prep(ArgsP ap0, LAS unsigned char* lds, int l) {
    const Ptrs P = fresh_ptrs(ap0); const ArgsP A = P.ap;
    const int tid = P.tid, lane = P.lane, wave = P.wave;
    const bf16* HMG = (const bf16*)(A->ws + WS_PROJ) + hm_off(HM_GQ, 0); const float* SB = (const float*)(A->ws + WS_SB);
    unsigned char* GOPS = A->ws + WS_GOPS; float* GU = (float*)(A->ws + WS_GU); float* GL = (float*)(A->ws + WS_GL);
    const float* cw = A->in[I_GDNCW] + (size_t)l * 4 * (3 * GDNW);
    LAS float* SMf = (LAS float*)(lds + GP_SM);
    LAS unsigned* hb = (LAS unsigned*)(lds + GP_SM + 1024); unsigned hb_epoch = 0u;
    if (tid == 0) *hb = 0u;
    if (P.bid < GD_NCHH) { gp_s1<512>(lds, HMG, cw, P.bid, tid); if (wave == 0) gp_s2(A, SMf, SB, GL, l, P.bid, lane); }
    for (int ch = P.bid; ch < GD_NCHH; ch += P.G) {
        const int bh = ch / GD_NCH, n = ch % GD_NCH, b = bh / GDNH, h = bh % GDNH;
        const size_t row0 = (size_t)b * SEQ + (size_t)n * 64;
        (void)b; (void)h; (void)row0; (void)n;
        __syncthreads();
        {
            const int mat = wave >> 2, mt = wave & 3, q4 = lane >> 4, m16 = lane & 15;
            f32x4 acc[4];
#pragma unroll
            for (int nt = 0; nt < 4; ++nt) acc[nt] = (f32x4){0.f, 0.f, 0.f, 0.f};
            const LAS unsigned char* abase = lds + (mat == 0 ? GP_KS : GP_QS) + ((16 * mt + m16) * 136 + 8 * q4) * 2;
            const LAS unsigned char* bbase = lds + GP_KS + (m16 * 136 + 8 * q4) * 2;
#pragma unroll
            for (int ks = 0; ks < 4; ++ks) { const bf16x8 a = *(const LAS bf16x8*)(abase + ks * 64);
#pragma unroll
                for (int nt = 0; nt < 4; ++nt) { const bf16x8 bb = *(const LAS bf16x8*)(bbase + nt * (16 * 136 * 2) + ks * 64); acc[nt] = __builtin_amdgcn_mfma_f32_16x16x32_bf16(a, bb, acc[nt], 0, 0, 0); } }
            const int c0 = 16 * mt + 4 * q4;
            const f32x4 gcc = *(const LAS f32x4*)(SMf + 64 + c0), btc = *(const LAS f32x4*)(SMf + c0);
#pragma unroll
            for (int nt = 0; nt < 4; ++nt) { const int s = 16 * nt + m16; const float gs = SMf[64 + s];
                if (mat == 0) { f32x4 o;
#pragma unroll
                    for (int r = 0; r < 4; ++r) o[r] = (s < c0 + r) ? btc[r] * acc[nt][r] * __builtin_amdgcn_exp2f(1.4426950408889634f * (gcc[r] - gs)) : 0.f;
                    *(LAS f32x4*)((LAS float*)(lds + GP_LT) + s * 68 + c0) = o;
                } else {
#pragma unroll
                    for (int r = 0; r < 4; ++r) ((LAS float*)(lds + GP_AT))[(c0 + r) * 68 + s] = (s <= c0 + r) ? acc[nt][r] * __builtin_amdgcn_exp2f(1.4426950408889634f * (gcc[r] - gs)) : 0.f;
                } }
        }
        __syncthreads();
        float x[64];
        if (tid < 256) {
            const int j = tid & 127, isw = tid >> 7;
            int vz = 0; asm volatile("" : "+v"(vz));
            const LAS float* SMv = SMf + vz;
#pragma unroll
            for (int r4 = 0; r4 < 16; ++r4) { const f32x4 bt = *(const LAS f32x4*)(SMv + 4 * r4), eg = *(const LAS f32x4*)(SMv + 128 + 4 * r4);
#pragma unroll
                for (int e = 0; e < 4; ++e) { const int r = 4 * r4 + e;
                    x[r] = isw ? __uint_as_float((unsigned)(*(const LAS unsigned short*)(lds + GP_KS + (r * 136 + j) * 2)) << 16) * (bt[e] * eg[e]) : ((const LAS float*)(lds + GP_VS))[r * 132 + j] * bt[e]; } }
        }
        __syncthreads();
        if (tid < 256) {
            const int j = tid & 127, isw = tid >> 7;
            { const LAS float* ltb = (const LAS float*)(lds + GP_LT) + (lane & 15);
              float Lc[4];
#pragma unroll
              for (int q = 0; q < 4; ++q) Lc[q] = ltb[16 * q];
              TriSolve<0>::run(x, ltb, Lc); }
            if (!isw) { float* up = GU + (size_t)ch * 8192 + (size_t)((j >> 4) * 4) * 256 + (j & 15) * 4;
#pragma unroll
                for (int mt = 0; mt < 4; ++mt)
#pragma unroll
                    for (int q4 = 0; q4 < 4; ++q4) *(f32x4*)(up + mt * 256 + q4 * 64) = (f32x4){x[16 * mt + 4 * q4], x[16 * mt + 4 * q4 + 1], x[16 * mt + 4 * q4 + 2], x[16 * mt + 4 * q4 + 3]};
            } else {
#pragma unroll
                for (int r = 0; r < 64; ++r) *(LAS unsigned short*)(lds + GP_WM + (r * 136 + j) * 2) = (unsigned short)f2bf(-x[r]);
            }
        } else {
            const int wv = wave - 4, q4 = lane >> 4, m16 = lane & 15;
            unsigned char* dst = GOPS + (size_t)ch * GD_OPS_BYTES + lane * 16;
            for (int f = wv; f < 40; f += 4) {
                v4u o;
                if (f < 16) { const int mt = f >> 2, ks = f & 3, row = 16 * mt + m16; const float eg = SMf[128 + row];
                    const LAS unsigned char* p = lds + GP_QS + (row * 136 + 32 * ks + 4 * q4) * 2;
                    const u32x2v a = *(const LAS u32x2v*)p, bq = *(const LAS u32x2v*)(p + 32);
                    o.x = cvtpk_bf16(bflo(a.x) * eg, bfhi(a.x) * eg); o.y = cvtpk_bf16(bflo(a.y) * eg, bfhi(a.y) * eg); o.z = cvtpk_bf16(bflo(bq.x) * eg, bfhi(bq.x) * eg); o.w = cvtpk_bf16(bflo(bq.y) * eg, bfhi(bq.y) * eg);
                    *(v4u*)(dst + (GD_F_QD + f) * 1024) = o;
                } else if (f < 24) { const int ff = f - 16, mt = ff >> 1, ks = ff & 1, row = 16 * mt + m16;
                    const LAS float* p = (const LAS float*)(lds + GP_AT) + row * 68 + 32 * ks + 4 * q4;
                    const f32x4 a = *(const LAS f32x4*)p, bq = *(const LAS f32x4*)(p + 16);
                    o.x = cvtpk_bf16(a[0], a[1]); o.y = cvtpk_bf16(a[2], a[3]); o.z = cvtpk_bf16(bq[0], bq[1]); o.w = cvtpk_bf16(bq[2], bq[3]);
                    *(v4u*)(dst + (GD_F_AT + ff) * 1024) = o;
                } else { const int ff = f - 24, mt = ff >> 1, ks = ff & 1, dk = 16 * mt + m16;
                    const int cA = 32 * ks + 4 * q4; const f32x4 ekA = *(const LAS f32x4*)(SMf + 192 + cA), ekB = *(const LAS f32x4*)(SMf + 192 + cA + 16);
                    float kv[8];
#pragma unroll
                    for (int e = 0; e < 4; ++e) { kv[e] = __uint_as_float((unsigned)(*(const LAS unsigned short*)(lds + GP_KS + ((cA + e) * 136 + dk) * 2)) << 16) * ekA[e];
                                                  kv[4 + e] = __uint_as_float((unsigned)(*(const LAS unsigned short*)(lds + GP_KS + ((cA + 16 + e) * 136 + dk) * 2)) << 16) * ekB[e]; }
                    o.x = cvtpk_bf16(kv[0], kv[1]); o.y = cvtpk_bf16(kv[2], kv[3]); o.z = cvtpk_bf16(kv[4], kv[5]); o.w = cvtpk_bf16(kv[6], kv[7]);
                    *(v4u*)(dst + (GD_F_KT + ff) * 1024) = o;
                }
            }
            if (ch + P.G < GD_NCHH) {
                asm volatile("s_waitcnt lgkmcnt(0)" ::: "memory");
                ++hb_epoch;
                if (lane == 0) (void)__hip_atomic_fetch_add(hb, 1u, __ATOMIC_RELAXED, __HIP_MEMORY_SCOPE_WORKGROUP);
                while (__hip_atomic_load(hb, __ATOMIC_RELAXED, __HIP_MEMORY_SCOPE_WORKGROUP) < 4u * hb_epoch) __builtin_amdgcn_s_sleep(1);
                asm volatile("" ::: "memory");
                gp_s1<256>(lds, HMG, cw, ch + P.G, tid - 256); if (wave == 4) gp_s2(A, SMf, SB, GL, l, ch + P.G, lane); }
        }
        __syncthreads();
        { const int q4 = lane >> 4, m16 = lane & 15;
#pragma unroll
          for (int k2 = 0; k2 < 2; ++k2) { const int f = wave * 2 + k2, mt = f >> 2, ks = f & 3, row = 16 * mt + m16;
            const LAS unsigned char* p = lds + GP_WM + (row * 136 + 32 * ks + 4 * q4) * 2;
            const u32x2v a = *(const LAS u32x2v*)p, bq = *(const LAS u32x2v*)(p + 32);
            v4u o; o.x = a.x; o.y = a.y; o.z = bq.x; o.w = bq.y;
            *(v4u*)(GOPS + (size_t)ch * GD_OPS_BYTES + (GD_F_WN + f) * 1024 + lane * 16) = o; } }
    }
    __syncthreads();
}

__device__ __forceinline__ void gdn_scan(ArgsP ap0, LAS unsigned char* lds) {
    const Ptrs P = fresh_ptrs(ap0); const ArgsP A = P.ap;
    const int lane = P.lane, wave = P.wave, bh = P.bid >> 1, b = bh / GDNH, h = bh % GDNH, q4 = lane >> 4, n16 = lane & 15;
    const int cs = (P.bid & 1) * 4 + (wave & 3);
    const bool comp = wave < 4;
    const unsigned char* ops = A->ws + WS_GOPS + (size_t)bh * GD_NCH * GD_OPS_BYTES;
    const float* Up = (const float*)(A->ws + WS_GU) + (size_t)bh * GD_NCH * 8192 + (size_t)(cs * 4) * 256 + lane * 4;
    const float* GLp = (const float*)(A->ws + WS_GL) + (size_t)bh * GD_NCH;
    float* GO = (float*)(A->ws + WS_GO2) + ((size_t)b * SEQ) * GDNW + h * HD + 16 * cs + n16;
    f32x4 S[8];
#pragma unroll
    for (int i = 0; i < 8; ++i) S[i] = (f32x4){0.f, 0.f, 0.f, 0.f};
    f32x4 Un[4]; float gln = 0.f;
#pragma unroll
    for (int i = 0; i < 4; ++i) Un[i] = (f32x4){0.f, 0.f, 0.f, 0.f};
#define GD_DMA(nn, buf) do { _Pragma("unroll") for (int i_ = 0; i_ < 7; ++i_) __builtin_amdgcn_global_load_lds((const unsigned*)(ops + (size_t)(nn) * GD_OPS_BYTES + (i_ * 8 + wave) * 1024 + lane * 16), \
        (LAS unsigned*)(lds + (buf) * GD_OPS_BYTES + (i_ * 8 + wave) * 1024), 16, 0, 0); } while (0)
#define GD_ULOAD(nn) do { if (comp) { _Pragma("unroll") for (int mt_ = 0; mt_ < 4; ++mt_) Un[mt_] = *(const f32x4*)(Up + (size_t)(nn) * 8192 + mt_ * 256); gln = GLp[nn]; } } while (0)
    GD_DMA(0, 0); GD_ULOAD(0);
    for (int n = 0; n < GD_NCH; ++n) {
        asm volatile("s_waitcnt vmcnt(0)" ::: "memory");
        __syncthreads();
        f32x4 Uc[4]; const float gl = gln;
#pragma unroll
        for (int mt = 0; mt < 4; ++mt) Uc[mt] = Un[mt];
        if (n + 1 < GD_NCH) { GD_DMA(n + 1, (n + 1) & 1); GD_ULOAD(n + 1); }
        if (comp) {
        const LAS unsigned char* fr = lds + (n & 1) * GD_OPS_BYTES + lane * 16;
#define GD_FRAG(f) (*(const LAS bf16x8*)(fr + (f) * 1024))
        bf16x8 Sb[4];
#pragma unroll
        for (int ks = 0; ks < 4; ++ks) { v4u w; w.x = cvtpk_bf16(S[2 * ks][0], S[2 * ks][1]); w.y = cvtpk_bf16(S[2 * ks][2], S[2 * ks][3]); w.z = cvtpk_bf16(S[2 * ks + 1][0], S[2 * ks + 1][1]); w.w = cvtpk_bf16(S[2 * ks + 1][2], S[2 * ks + 1][3]);
            Sb[ks] = __builtin_bit_cast(bf16x8, w); }
        f32x4 vn[4];
#pragma unroll
        for (int mt = 0; mt < 4; ++mt) { vn[mt] = Uc[mt];
#pragma unroll
            for (int ks = 0; ks < 4; ++ks) vn[mt] = __builtin_amdgcn_mfma_f32_16x16x32_bf16(GD_FRAG(GD_F_WN + mt * 4 + ks), Sb[ks], vn[mt], 0, 0, 0); }
        bf16x8 Vb[2];
#pragma unroll
        for (int ks = 0; ks < 2; ++ks) { v4u w; w.x = cvtpk_bf16(vn[2 * ks][0], vn[2 * ks][1]); w.y = cvtpk_bf16(vn[2 * ks][2], vn[2 * ks][3]); w.z = cvtpk_bf16(vn[2 * ks + 1][0], vn[2 * ks + 1][1]); w.w = cvtpk_bf16(vn[2 * ks + 1][2], vn[2 * ks + 1][3]);
            Vb[ks] = __builtin_bit_cast(bf16x8, w); }
        float* orow = GO + (size_t)(n * 64 + 4 * q4) * GDNW;
#pragma unroll
        for (int mt = 0; mt < 4; ++mt) { f32x4 o = (f32x4){0.f, 0.f, 0.f, 0.f};
#pragma unroll
            for (int ks = 0; ks < 4; ++ks) o = __builtin_amdgcn_mfma_f32_16x16x32_bf16(GD_FRAG(GD_F_QD + mt * 4 + ks), Sb[ks], o, 0, 0, 0);
#pragma unroll
            for (int ks = 0; ks < 2; ++ks) o = __builtin_amdgcn_mfma_f32_16x16x32_bf16(GD_FRAG(GD_F_AT + mt * 2 + ks), Vb[ks], o, 0, 0, 0);
#pragma unroll
            for (int r = 0; r < 4; ++r) orow[(size_t)(16 * mt + r) * GDNW] = o[r]; }
#pragma unroll
        for (int mt = 0; mt < 8; ++mt) { S[mt] = S[mt] * gl;
#pragma unroll
            for (int ks = 0; ks < 2; ++ks) S[mt] = __builtin_amdgcn_mfma_f32_16x16x32_bf16(GD_FRAG(GD_F_KT + mt * 2 + ks), Vb[ks], S[mt], 0, 0, 0); }
        }
    }
#undef GD_FRAG
#undef GD_DMA
#undef GD_ULOAD
    asm volatile("s_waitcnt vmcnt(0)" ::: "memory");
    __syncthreads();
}
__device__ __forceinline__ void p4_finalize(ArgsP ap0, int l) {
    const Ptrs P = fresh_ptrs(ap0); const ArgsP A = P.ap;
    const float* GO = (const float*)(A->ws + WS_GO2); const bf16* HMZ = (const bf16*)(A->ws + WS_PROJ) + hm_off(HM_GZ, 0);
    bf16* MIX = (bf16*)(A->ws + WS_MIX); const int lane = P.lane;
    typedef float f32x2 __attribute__((ext_vector_type(2)));
    const f32x2 gg = *(const f32x2*)(A->in[I_GDNON] + l * HD + 2 * lane);
    for (int m = P.gw; m < M; m += P.NGW) {
        const int b = m / SEQ, s = m % SEQ;
        f32x2 v[GDNH]; unsigned zw[GDNH];
#pragma unroll
        for (int h = 0; h < GDNH; ++h) { v[h] = *(const f32x2*)(GO + (size_t)m * GDNW + h * HD + 2 * lane); zw[h] = *(const unsigned*)(HMZ + ((size_t)(b * GDNH + h) * SEQ + s) * HD + 2 * lane); }
        float ss[GDNH];
#pragma unroll
        for (int h = 0; h < GDNH; ++h) ss[h] = v[h][0] * v[h][0] + v[h][1] * v[h][1];
#pragma unroll
        for (int o = 1; o < 64; o <<= 1) {
#pragma unroll
            for (int h = 0; h < GDNH; ++h) ss[h] += __shfl_xor(ss[h], o); }
#pragma unroll
        for (int h = 0; h < GDNH; ++h) { const float rr = 1.0f / sqrtf(ss[h] * (1.0f / HD) + RMS_EPS);
            *(unsigned*)(MIX + (size_t)m * DM + FOXW + SCW + h * HD + 2 * lane) = pk2(v[h][0] * rr * gg[0] * silu_acc(bflo(zw[h])), v[h][1] * rr * gg[1] * silu_acc(bfhi(zw[h]))); }
    }
}

constexpr int ATT_PER_X = 3 * (SEQ / attn::QB);
constexpr int ATT_SLOT_OFF = 69632;
static_assert(attn::LDS_BYTES <= ATT_SLOT_OFF, "attention LDS map");
typedef attn::BlockRef<attn::bf16, attn::bf16> FoxRef;
__device__ __forceinline__ int fox_jlo(ArgsP A, int l, int bh, int P0) {
    (void)l;
    const float* FG = (const float*)(A->ws + WS_FG) + (size_t)bh * SEQ; const float* TN = (const float*)(A->ws + WS_TN);
    constexpr int NT_ = BATCH * FOXH * (SEQ / 64);
    const int lane = my_lane(), jd = P0 / attn::KVBLK, tb = bh * (SEQ / 64);
    float qn2 = 0.f, lb = 3.0e38f;
#pragma unroll
    for (int i = 0; i < 4; ++i) { qn2 = fmaxf(qn2, TN[tb + jd + i]); lb = fminf(lb, TN[2 * NT_ + tb + jd + i] + FG[64 * (jd + i)]); }
    const float qnb = sqrtf(qn2) * 1.001f;
    const bool s0 = qnb * sqrtf(TN[NT_ + tb + lane]) + FG[64 * lane + 63] - lb < -600.0f, s1 = qnb * sqrtf(TN[NT_ + tb + lane + 64]) + FG[64 * (lane + 64) + 63] - lb < -600.0f;
    const unsigned long long n0 = ~__ballot(s0), n1 = ~__ballot(s1);
    const int n = n0 ? __builtin_ctzll(n0) : 64 + (n1 ? __builtin_ctzll(n1) : 64);
    return __builtin_amdgcn_readfirstlane(n < jd ? n : jd);
}
__device__ __forceinline__ void fox_head_table(ArgsP A, volatile LAS int* hmap, int lane) {
    const float* FG = (const float*)(A->ws + WS_FG);
    const float v = lane < BATCH * FOXH ? FG[(size_t)lane * SEQ + (SEQ - 1)] : 3.0e38f;
    int rank = 0;
    for (int j = 0; j < BATCH * FOXH; ++j) { const float vj = __shfl(v, j); rank += (vj < v || (vj == v && j < lane)) ? 1 : 0; }
    if (lane < BATCH * FOXH) { const int slot = rank >> 3, qx = slot == 1 ? 15 - rank : (rank & 7); hmap[qx * 3 + slot] = lane; }
}
__device__ __forceinline__ FoxRef fox_ref(ArgsP A, int id, int l, volatile LAS int* hmap) {
    const int qx = id / ATT_PER_X, i = id % ATT_PER_X, bh = __builtin_amdgcn_readfirstlane(hmap[qx * 3 + (i >> 5)]), qb = 31 - (i & 31);
    const int b = bh / FOXH, h = bh % FOXH; const size_t row0 = (size_t)b * SEQ;
    const attn::bf16* HM = (const attn::bf16*)(A->ws + WS_PROJ);
    FoxRef r;
    r.Q = HM + hm_off(HM_FQ, bh) + (size_t)qb * attn::QB * HD;
    r.K = HM + hm_off(HM_FK, bh); r.V = HM + hm_off(HM_FV, bh);
    r.F = (const float*)(A->ws + WS_FG) + (size_t)bh * SEQ;
    r.O = (attn::bf16*)(A->ws + WS_MIX) + (row0 + (size_t)qb * attn::QB) * DM + h * HD; r.P0 = qb * attn::QB; r.JLO = fox_jlo(A, l, bh, r.P0);
    return r;
}
__device__ __forceinline__ int att_claim(gu32* ctrs, volatile LAS int* st) {
    int qx = st[0], tried = st[1], r = -1;
    while (tried < 8) { const unsigned i = __hip_atomic_fetch_add(ctrs + qx * 64, 1u, __ATOMIC_RELAXED, __HIP_MEMORY_SCOPE_AGENT); if (i < (unsigned)ATT_PER_X) { r = qx * ATT_PER_X + (int)i; break; } qx = (qx + 1) & 7; ++tried; }
    st[0] = qx; st[1] = tried;
    return r;
}
__device__ __forceinline__ void p3_attention(ArgsP ap0, char* lds, int l, int rep = 0) {
    const ArgsP A = fresh(ap0);
    gu32* ctrs = (gu32*)(A->ws + WS_CTL) + CW_Q + (rep * 2 + l) * 8 * 64;
    volatile LAS int* slot = (volatile LAS int*)((LAS unsigned char*)lds + ATT_SLOT_OFF);
    volatile LAS int* hmap = slot + 8;
    { const int t_ = ftid(); if (t_ < 64) fox_head_table(A, hmap, t_); if (t_ == 0) { slot[4] = (int)(xb_xcc_id() & 7u); slot[5] = 0; slot[0] = att_claim(ctrs, slot + 4); slot[1] = att_claim(ctrs, slot + 4); } }
    __syncthreads();
    int cur = __builtin_amdgcn_readfirstlane(slot[0]), nxt = __builtin_amdgcn_readfirstlane(slot[1]);
    if (cur < 0) return;
    FoxRef curR = fox_ref(A, cur, l, hmap);
    attn::Seam<attn::bf16> S;
    attn::causal_swa_prime<attn::bf16, attn::bf16>(curR, SEQ, lds, S);
    for (int k = 0;; ++k) {
        if (nxt >= 0 && ftid() == 0) slot[2 + (k & 1)] = att_claim(ctrs, slot + 4);
        const bool last = nxt < 0;
        const FoxRef nxtR = last ? curR : fox_ref(A, nxt, l, hmap);
        attn::causal_swa_block<attn::bf16, attn::bf16>(curR, nxtR, SEQ, SEQ, lds, S, &A->in[I_FOXON], l * HD);
        if (last) break;
        cur = nxt; curR = nxtR; nxt = __builtin_amdgcn_readfirstlane(slot[2 + (k & 1)]);
    }
}

constexpr int N_PHASES = 1 + 9 * DEPTH;

#ifndef PH_EN
#define PH_EN 0x3ff
#endif
#define IN(k) (lo <= (k) && (k) < hi)
#define EN(j) ((PH_EN >> (j)) & 1)
#ifndef REP_MASK
#define REP_MASK 0
#endif
#ifndef EXTRA_BARS
#define EXTRA_BARS 0
#endif
#define REPS(j) (((REP_MASK >> (j)) & 1) ? 2 : 1)
#define SEAM(k) do { if (IN(k) && IN((k) + 1)) { XcdBarrier b_; b_.bar = (unsigned*)(fresh(ap0)->ws + WS_CTL) + CW_BAR; b_.x = xb_xcc_id(); b_.st = (volatile LAS unsigned*)((LAS unsigned char*)lds + MISC_OFF) + 8; xcd_barrier(b_); } } while (0)
#define WSP(T, off) ((T*)(A->ws + (off)))


template <int l>
__device__ __forceinline__ void layer_phases(ArgsP ap0, LAS unsigned char* ldsl, unsigned char* lds, int lo, int hi) {

        const int pb = 1 + 9 * l;
        if (EN(1) && IN(pb + 0)) {
            const Ptrs P = fresh_ptrs(ap0); const ArgsP A = P.ap;
            pg8::Gemm g{WSP(bf16, WS_XN), WSP(bf16, WS_W + WO_IN), M, NP, DM}; pg8::StaticOrder S; S.init(M, NP, P.G, P.bid);
            pg8::EpiProj E{WSP(bf16, WS_PROJ), WSP(bf16, WS_SCB), WSP(float, WS_SB)};
            for (int rep_ = 0; rep_ < REPS(1); ++rep_) pg8::gemm_phase<pg8::EpiProj, pg8::StaticOrder, true, true>(ldsl, g, S, E);
            convert_weights(ap0, ldsl, l, I_3, I_3 + CV_TAIL_DN, (M / 256) * (NP / 256) % P.G);
            SEAM(pb + 0);
        }
        if (EN(2) && IN(pb + 1)) {
            for (int rep_ = 0; rep_ < REPS(11); ++rep_) p2_prep(ap0, ldsl, l);
            for (int rep_ = 0; rep_ < REPS(2); ++rep_) gdn_prep(ap0, ldsl, l);
            SEAM(pb + 1);
            for (int xb_ = 0; xb_ < EXTRA_BARS; ++xb_) SEAM(pb + 1);
            }
        if (EN(3) && IN(pb + 2)) {
            for (int rep_ = 0; rep_ < REPS(10); ++rep_) if ((int)blockIdx.x < 2 * BATCH * GDNH) gdn_scan(ap0, ldsl);
            for (int rep_ = 0; rep_ < REPS(3); ++rep_) p3_attention(ap0, (char*)lds, l, rep_);
            SEAM(pb + 2);
        }
        if (EN(4) && IN(pb + 3)) { for (int rep_ = 0; rep_ < REPS(4); ++rep_) p4_finalize(ap0, l); SEAM(pb + 3); }
        if (EN(5) && IN(pb + 4)) {
            const Ptrs P = fresh_ptrs(ap0); const ArgsP A = P.ap;
            pg8::Gemm g{WSP(bf16, WS_MIX), WSP(bf16, WS_W + WO_OUT), M, DM, DM}; pg8::StaticOrder S; S.init(M, DM, P.G, P.bid);
            pg8::EpiY E{WSP(bf16, WS_Y), WSP(float, WS_SS)};
            for (int rep_ = 0; rep_ < REPS(5); ++rep_) pg8::gemm_phase<pg8::EpiY, pg8::StaticOrder, true, true>(ldsl, g, S, E);
            SEAM(pb + 4);
        }
        if (EN(6) && IN(pb + 5)) {
            const Ptrs P = fresh_ptrs(ap0); const ArgsP A = P.ap;
            const float* xin = l == 0 ? A->in[I_X] : (const float*)A->out;
            const float* gpost = A->in[I_MIXPOST] + l * DM; const float* gpre = A->in[I_FFNPRE] + l * DM;
            const bf16* Y = WSP(bf16, WS_Y); const float* SS = WSP(float, WS_SS); float* H = WSP(float, WS_H); bf16* XN = WSP(bf16, WS_XN);
            for (int rep_ = 0; rep_ < REPS(6); ++rep_)
            for (int m = P.gw; m < M; m += P.NGW)
                resid_norm_row(xin + (size_t)m * DM, Y + (size_t)m * DM, SS + (size_t)m * 64, gpost, H + (size_t)m * DM, gpre, XN + (size_t)m * DM, P.lane);
            SEAM(pb + 5);
        }
        if (EN(7) && IN(pb + 6)) {
            const Ptrs P = fresh_ptrs(ap0); const ArgsP A = P.ap;
            pg8::Gemm g{WSP(bf16, WS_XN), WSP(bf16, WS_W + WO_GU), M, NGU, DM}; pg8::StaticOrder S; S.init(M, NGU, P.G, P.bid);
            pg8::EpiSwiGLU E{WSP(bf16, WS_PROJ)};
            for (int rep_ = 0; rep_ < REPS(7); ++rep_) pg8::gemm_phase<pg8::EpiSwiGLU, pg8::StaticOrder, true, true>(ldsl, g, S, E);
            if (l + 1 < DEPTH) convert_weights(ap0, ldsl, l + 1, 0, CV_TAIL_IN, (M / 256) * (NGU / 256) % P.G);
            SEAM(pb + 6);
        }
        if (EN(8) && IN(pb + 7)) {
            const Ptrs P = fresh_ptrs(ap0); const ArgsP A = P.ap;
            pg8::Gemm g{WSP(bf16, WS_PROJ), WSP(bf16, WS_W + WO_DN), M, DM, FFN};
            pg8::EpiY E{WSP(bf16, WS_Y), WSP(float, WS_SS)};
            if (P.G == 256) { pg8::PanelOrder S{P.bid, M / (16 * 256)};
                for (int rep_ = 0; rep_ < REPS(8); ++rep_) pg8::gemm_phase<pg8::EpiY, pg8::PanelOrder, true, true>(ldsl, g, S, E); }
            else { pg8::StaticOrder S; S.init(M, DM, P.G, P.bid);
                for (int rep_ = 0; rep_ < REPS(8); ++rep_) pg8::gemm_phase<pg8::EpiY, pg8::StaticOrder, true, true>(ldsl, g, S, E); }
            SEAM(pb + 7);
        }
        if (EN(9) && IN(pb + 8)) {
            const Ptrs P = fresh_ptrs(ap0); const ArgsP A = P.ap;
            const float* gnext = l + 1 < DEPTH ? A->in[I_MIXPRE] + (l + 1) * DM : nullptr; const float* gpost = A->in[I_FFNPOST] + l * DM;
            const bf16* Y = WSP(bf16, WS_Y); const float* SS = WSP(float, WS_SS); const float* H = WSP(float, WS_H); bf16* XN = WSP(bf16, WS_XN); float* outp = A->out;
            for (int rep_ = 0; rep_ < REPS(9); ++rep_) {
            for (int m = P.gw; m < M; m += P.NGW)
                resid_norm_row(H + (size_t)m * DM, Y + (size_t)m * DM, SS + (size_t)m * 64, gpost, outp + (size_t)m * DM, gnext, XN + (size_t)m * DM, P.lane);
            if (l + 1 < DEPTH) { convert_weights(ap0, ldsl, l + 1, CV_TAIL_IN, I_3); convert_weights(ap0, ldsl, l + 1, I_3 + CV_TAIL_DN, I_LAYER); }
            }
            SEAM(pb + 8);
        }
    }

__global__ void __launch_bounds__(NWAVES * 64, 2) hybrid_fwd(Args args) {
    extern __shared__ __attribute__((aligned(16))) unsigned char lds[];
    LAS unsigned char* ldsl = (LAS unsigned char*)lds;
    volatile LAS unsigned* MISC = (volatile LAS unsigned*)(ldsl + MISC_OFF);
    const ArgsP ap0 = (ArgsP)__builtin_amdgcn_kernarg_segment_ptr();
    for (int u = threadIdx.x; u < (LDS_BYTES - LDSCTL_OFF) / 4; u += NWAVES * 64) ((LAS unsigned*)(ldsl + LDSCTL_OFF))[u] = 0u;
    __syncthreads();
    if ((threadIdx.x & 63) == 0) *(volatile LAS int*)(ldsl + TIDTAB_OFF + 4 * hw_slot()) = (int)(threadIdx.x >> 6);
    __syncthreads();
    const int lo = args.ph_lo, hi = args.ph_hi;
    if (hi - lo > 1) (void)xcd_barrier_post((unsigned*)(args.ws + WS_CTL) + CW_BAR, MISC + 8);
    if (EN(0) && IN(0)) { for (int rep_ = 0; rep_ < REPS(0); ++rep_) p0_prologue(ap0, ldsl); SEAM(0); }
    layer_phases<0>(ap0, ldsl, lds, lo, hi);
    layer_phases<1>(ap0, ldsl, lds, lo, hi);
}

#undef IN
#undef SEAM
extern "C" void kernel_launch(void* const* d_in, const int* in_sizes, int n_in, void* d_out, int out_size, void* d_ws, size_t ws_size, hipStream_t stream) {
    static int grid = 0;
    if (grid == 0) {
        if (n_in != 17 || in_sizes[0] != M * DM || out_size != M * DM || ws_size < WS_END) {
            fprintf(stderr, "kernel_launch: shape/workspace mismatch: n_in %d in0 %d out %d ws %zu (need %zu)\n", n_in, n_in > 0 ? in_sizes[0] : -1, out_size, ws_size, (size_t)WS_END); grid = -1; return; }
        int dev = 0, cus = 0, per_cu = 0;
        if (hipGetDevice(&dev) != hipSuccess || hipDeviceGetAttribute(&cus, hipDeviceAttributeMultiprocessorCount, dev) != hipSuccess) { fprintf(stderr, "kernel_launch: device query failed\n"); grid = -1; return; }
        if (hipFuncSetAttribute((const void*)hybrid_fwd, hipFuncAttributeMaxDynamicSharedMemorySize, LDS_BYTES) != hipSuccess) { fprintf(stderr, "kernel_launch: hipFuncSetAttribute failed\n"); grid = -1; return; }
        if (hipOccupancyMaxActiveBlocksPerMultiprocessor(&per_cu, (const void*)hybrid_fwd, NWAVES * 64, LDS_BYTES) != hipSuccess || per_cu < 1)
            fprintf(stderr, "kernel_launch: note: occupancy query reports %d workgroups per CU\n", per_cu);
        (void)hipGetLastError();
        grid = cus;
    }
    if (grid < 0) return;
    if (hipMemsetAsync((char*)d_ws + WS_CTL, 0, CTL_ZERO_BYTES, stream) != hipSuccess) { fprintf(stderr, "kernel_launch: memset failed\n"); return; }
    Args a{};
    for (int i = 0; i < 17; ++i) a.in[i] = (const float*)d_in[i];
    a.out = (float*)d_out; a.ws = (unsigned char*)d_ws;
#if MK_N_LAUNCHES == 1
    a.ph_lo = 0; a.ph_hi = N_PHASES;
    hipLaunchKernelGGL(hybrid_fwd, dim3(grid), dim3(NWAVES * 64), LDS_BYTES, stream, a);
#else
    for (int p = 0; p < N_PHASES; ++p) { a.ph_lo = p; a.ph_hi = p + 1; hipLaunchKernelGGL(hybrid_fwd, dim3(grid), dim3(NWAVES * 64), LDS_BYTES, stream, a); }
#endif
    const hipError_t le = hipPeekAtLastError();
    if (le != hipSuccess) fprintf(stderr, "kernel_launch: launch failed: %s\n", hipGetErrorName(le));
}
```

```cpp
#include <hip/hip_runtime.h>
#include <hip/hip_bf16.h>
#include <cstdio>
#include <cstdint>
#include <cmath>

#ifndef MK_N_LAUNCHES
#define MK_N_LAUNCHES 1
#endif

constexpr int BATCH = 2, SEQ = 8192, DM = 4096, M = BATCH * SEQ, DEPTH = 2;
constexpr int HD = 128, FOXH = 12, FOXW = FOXH * HD, SCW = 1024, GDNH = 12, GDNW = GDNH * HD;
constexpr int PROJ_SRC = 13860;
constexpr int NP = 14080;
constexpr int FFN = 11008, NGU = 2 * FFN;
constexpr float RMS_EPS = 1e-6f;
constexpr int PC_FQ = 0, PC_FK = 1536, PC_FV = 3072, PC_SB = 4608, PC_SC = 5632, PC_SH = 6656, PC_GQ = 7680, PC_GK = 9216, PC_GV = 10752, PC_GZ = 12288, PC_SMALL = 13824;
constexpr int SBW = 64, SB_FF = 0, SB_GA = 12, SB_GB = 24;
constexpr int SRC_FF = 4608, SRC_SB = 4620, SRC_GQ = 7692, SRC_GA = 12300, SRC_GB = 12312, SRC_GZ = 12324;

constexpr size_t MiB = 1u << 20;
constexpr size_t WS_CTL = 0, CTL_ZERO_BYTES = 1 * MiB;
constexpr size_t WS_W = 16 * MiB;
constexpr size_t WO_IN = 0, WO_OUT = 110 * MiB, WO_GU = 142 * MiB, WO_DN = 314 * MiB;
constexpr size_t WS_XN = 416 * MiB;
constexpr size_t WS_MIX = 544 * MiB;
constexpr size_t WS_Y = 672 * MiB;
constexpr size_t WS_H = 800 * MiB;
constexpr size_t WS_PROJ = 1056 * MiB;
constexpr size_t WS_SCB = WS_PROJ + 336 * MiB;
constexpr int HM_FQ = 0, HM_FK = 1, HM_FV = 2, HM_GQ = 3, HM_GZ = 6, SCBW = 3 * SCW;
__host__ __device__ constexpr size_t hm_off(int part, int bh) { return ((size_t)(part * (BATCH * FOXH) + bh) * SEQ) * HD; }
constexpr size_t WS_SB = 1496 * MiB;
constexpr size_t WS_SS = 1500 * MiB;
constexpr size_t WS_FG = 1504 * MiB;
constexpr size_t WS_TN = WS_FG + 1 * MiB;
constexpr size_t WS_END = 1506 * MiB;
constexpr int CW_TMO = 0, CW_BAR = 4096, CW_Q = 16384;

constexpr int NWAVES = 8;
constexpr int RING_BYTES = 131072, LDSCTL_OFF = RING_BYTES, MISC_OFF = LDSCTL_OFF + 320, LDS_BYTES = 147456;


extern __shared__ __attribute__((aligned(16))) unsigned char g_lds[];
constexpr int TIDTAB_OFF = LDSCTL_OFF + 512;
__device__ __forceinline__ unsigned hw_slot() { return (unsigned)__builtin_amdgcn_s_getreg((5 << 11) | 4) & 63u; }
__device__ __forceinline__ int my_lane() { int l; asm volatile("v_mbcnt_lo_u32_b32 %0, -1, 0\n\tv_mbcnt_hi_u32_b32 %0, -1, %0" : "=v"(l)); return l; }
__device__ __forceinline__ int my_wave() { return __builtin_amdgcn_readfirstlane(*(volatile __attribute__((address_space(3))) int*)((__attribute__((address_space(3))) unsigned char*)g_lds + TIDTAB_OFF + 4 * hw_slot())); }
__device__ __forceinline__ int my_tid() { return my_wave() * 64 + my_lane(); }

#define GAS __attribute__((address_space(1)))
#define LAS __attribute__((address_space(3)))
typedef unsigned short bf16;
typedef unsigned v4u __attribute__((ext_vector_type(4)));
typedef float f32x4 __attribute__((ext_vector_type(4)));
typedef short bf16x8 __attribute__((ext_vector_type(8)));
typedef GAS unsigned gu32;
typedef GAS unsigned long long gu64;
#define RLX_AGENT __ATOMIC_RELAXED, __HIP_MEMORY_SCOPE_AGENT
#define LDS_WAIT() asm volatile("s_waitcnt lgkmcnt(0)" ::: "memory")
#define VM_WAIT() asm volatile("s_waitcnt vmcnt(0)" ::: "memory")
__device__ __forceinline__ unsigned long long rt() { return __builtin_amdgcn_s_memrealtime(); }
__device__ __forceinline__ unsigned f2bf(float f) { unsigned u = __builtin_bit_cast(unsigned, f); return (u + 0x7fffu + ((u >> 16) & 1u)) >> 16; }
__device__ __forceinline__ unsigned pk2(float lo, float hi) { return f2bf(lo) | (f2bf(hi) << 16); }

#define XB_TMO      128
#define XB_XCNT(j)  (256  + 64 * (j))
#define XB_XSUB(j)  (1280 + 64 * (j))
#define XB_XGEN(j)  (2304 + 64 * (j))
#define XB_TOP      3328
#define XB_TOPGEN   3392
#define XCD_BAR_WORDS 3456
#define XB_SPIN_CAP (1u << 18)

__device__ __forceinline__ unsigned xb_ld(unsigned* p)              { return __hip_atomic_load(p, __ATOMIC_RELAXED, __HIP_MEMORY_SCOPE_AGENT); }
__device__ __forceinline__ unsigned xb_add(unsigned* p, unsigned v) { return __hip_atomic_fetch_add(p, v, __ATOMIC_RELAXED, __HIP_MEMORY_SCOPE_AGENT); }
__device__ __forceinline__ unsigned xb_xcc_id() { return (unsigned)__builtin_amdgcn_s_getreg((3 << 11) | 20) & 0xFu; }
#define XB_SPIN(cond, bar) do { unsigned _sp = 0; while (cond) { __builtin_amdgcn_s_sleep(1); \
    if ((++_sp & 255u) == 0u) { if (xb_ld(&(bar)[XB_TMO])) break; if (_sp > XB_SPIN_CAP) { atomicAdd(&(bar)[XB_TMO], 1u); break; } } } } while (0)

struct XcdBarrier {
    unsigned* bar; unsigned x;
    volatile LAS unsigned* st;
};

__device__ __forceinline__ XcdBarrier xcd_barrier_post(unsigned* bar, volatile LAS unsigned* st) {
    XcdBarrier b; b.bar = bar; b.x = xb_xcc_id(); b.st = st;
    if (my_tid() == 0) (void)xb_add(&bar[XB_XCNT(b.x)], 1u);
    return b;
}
__device__ __forceinline__ void xcd_barrier_complete(unsigned* bar, unsigned x, unsigned& nloc, unsigned& nx) {
    const unsigned G = gridDim.x * gridDim.y * gridDim.z;
    unsigned sum, cnt, mine, sp = 0u;
    for (;;) {
        sum = 0u; cnt = 0u; mine = 0u;
#pragma unroll
        for (unsigned j = 0; j < 16; ++j) { const unsigned c = xb_ld(&bar[XB_XCNT(j)]); sum += c; cnt += (c > 0u) ? 1u : 0u; mine = (j == x) ? c : mine; }
        if (sum == G) break;
        __builtin_amdgcn_s_sleep(1);
        if ((++sp & 255u) == 0u) { if (xb_ld(&bar[XB_TMO])) break; if (sp > XB_SPIN_CAP) { atomicAdd(&bar[XB_TMO], 1u); break; } }
    }
    nloc = mine > 0u ? mine : 1u; nx = cnt > 0u ? cnt : 1u;
}

__device__ __forceinline__ void xcd_barrier(const XcdBarrier& b) {
    asm volatile("s_waitcnt vmcnt(0)" ::: "memory");
    __syncthreads();
    if (my_tid() == 0) {
        unsigned* bar = b.bar;
        __builtin_amdgcn_s_waitcnt(0);
        unsigned nloc = b.st[0], nx = b.st[1];
        if (nloc == 0u) { xcd_barrier_complete(bar, b.x, nloc, nx); b.st[0] = nloc; b.st[1] = nx; }
        const unsigned old = xb_add(&bar[XB_XSUB(b.x)], 1u);
        const unsigned gen = old / nloc;
        if (old + 1u == (gen + 1u) * nloc) {
            __builtin_amdgcn_fence(__ATOMIC_RELEASE, "agent");
            asm volatile("s_waitcnt vmcnt(0)" ::: "memory");
            const unsigned og = xb_add(&bar[XB_TOP], 1u);
            const unsigned tg = og / nx;
            if (og + 1u == (tg + 1u) * nx) xb_add(&bar[XB_TOPGEN], 1u);
            else XB_SPIN(xb_ld(&bar[XB_TOPGEN]) == tg, bar);
            __builtin_amdgcn_fence(__ATOMIC_ACQUIRE, "agent");
            xb_add(&bar[XB_XGEN(b.x)], 1u);
            asm volatile("s_waitcnt vmcnt(0)" ::: "memory");
        } else {
            XB_SPIN(xb_ld(&bar[XB_XGEN(b.x)]) == gen, bar);
            __builtin_amdgcn_fence(__ATOMIC_ACQUIRE, "agent");
            asm volatile("s_waitcnt vmcnt(0)" ::: "memory");
        }
    }
    __syncthreads();
}

namespace pg8 {
#define PG8_LAS __attribute__((address_space(3)))
typedef unsigned short bf16_t;
typedef short bf16x8 __attribute__((ext_vector_type(8)));
typedef float f32x4 __attribute__((ext_vector_type(4)));
typedef unsigned u32x4 __attribute__((ext_vector_type(4)));
constexpr int BM = 256, BK = 64, HALF = 128, HTB = HALF * BK * 2  , STAGE_BYTES = 8 * HTB, NXCD = 8, WGM = 8;

__host__ __device__ __forceinline__ int lds_byte(int r, int c) { const int st = (r >> 4) * 2 + (c >> 5), rr = r & 15, cc = c & 31, ob = rr * 64 + cc * 2; return st * 1024 + (ob ^ (((ob >> 9) & 1) << 5)); }
__host__ __device__ __forceinline__ void stage_rc(int b, int& R, int& C) { const int st = b / 1024, sb = b % 1024, swz = sb ^ (((sb >> 9) & 1) << 5); R = (st >> 1) * 16 + swz / 64; C = (st & 1) * 32 + (swz % 64) / 2; }
__host__ __device__ __forceinline__ int perm32(int rho) { const int n = rho >> 4, i = rho & 15; return 8 * (i >> 2) + 4 * n + (i & 3); }

struct Unit { int pm, pn; };
struct Gemm { const bf16_t* A; const bf16_t* Bt; int M, N, K; };

struct StaticOrder {
    int nM, nN, nwg, G, c;
    __host__ __device__ void init(int M, int N, int G_, int c_) { nM = M / BM; nN = N / BM; nwg = nM * nN; G = G_; c = c_; }
    __host__ __device__ bool next(int i, Unit& u) const {
        const long L = (long)i * G + c; if (L >= nwg) return false;
        int wgid = (int)L; { const int q = nwg / NXCD, r = nwg % NXCD, xcd = wgid % NXCD, off = wgid / NXCD; wgid = (xcd < r ? xcd * (q + 1) : r * (q + 1) + (xcd - r) * q) + off; }
        const int nig = WGM * nN, gid = wgid / nig, fm = gid * WGM, gsz = (nM - fm) < WGM ? (nM - fm) : WGM;
        u.pm = fm + ((wgid % nig) % gsz); u.pn = (wgid % nig) / gsz; return true;
    }
    __device__ __forceinline__ void a_ready(const Unit&) const {}
    __device__ __forceinline__ void done(const Unit&) const {}
};


typedef float f32x2e __attribute__((ext_vector_type(2))); typedef __bf16 bf16x2e __attribute__((ext_vector_type(2)));
__device__ __forceinline__ unsigned cvt_pk_bf16(float lo, float hi) { const f32x2e v = {lo, hi}; const bf16x2e b = __builtin_convertvector(v, bf16x2e); return __builtin_bit_cast(unsigned, b); }
__device__ __forceinline__ u32x4 pack8_bf16(const f32x4 v0, const f32x4 v1) { u32x4 w; w.x = cvt_pk_bf16(v0[0], v0[1]); w.y = cvt_pk_bf16(v0[2], v0[3]); w.z = cvt_pk_bf16(v1[0], v1[1]); w.w = cvt_pk_bf16(v1[2], v1[3]); return w; }

struct EpiProj {
    static constexpr bool PERM = true, AFTER_DRAIN = false;
    bf16_t* HM; bf16_t* SCB; float* SBp;
    __device__ __forceinline__ void operator()(const f32x4 (&acc)[2][2][4][2], const Unit& u, int wr, int wc, int fr, int fq) const {
        const int row0 = u.pm * BM + wr * 64 + fr;
        if (u.pn * BM == PC_SMALL) {
            if (wc < 2) {
#pragma unroll
                for (int ai = 0; ai < 2; ++ai)
#pragma unroll
                    for (int m = 0; m < 4; ++m) { float* rp = SBp + (size_t)(row0 + ai * HALF + m * 16) * SBW + wc * 32 + 8 * fq;
                        *(f32x4*)rp = acc[ai][0][m][0]; *(f32x4*)(rp + 4) = acc[ai][0][m][1]; }
            }
            return;
        }
        const int b = (u.pm * BM) / SEQ, s0 = row0 - b * SEQ;
#pragma unroll
        for (int bj = 0; bj < 2; ++bj) { const int colbase = u.pn * BM + bj * HALF;
            bf16_t* dst; size_t pitch;
            if (colbase >= PC_SB && colbase < PC_GQ) { dst = SCB + (size_t)row0 * SCBW + (colbase - PC_SB) + wc * 32 + 8 * fq; pitch = SCBW; }
            else { const int hc = colbase < PC_SB ? colbase : colbase - (PC_GQ - PC_SB), part = hc / 1536, head = (hc % 1536) / HD;
                   dst = HM + hm_off(part, b * FOXH + head) + (size_t)s0 * HD + wc * 32 + 8 * fq; pitch = HD; }
#pragma unroll
            for (int ai = 0; ai < 2; ++ai)
#pragma unroll
                for (int m = 0; m < 4; ++m) *(u32x4*)(dst + (size_t)(ai * HALF + m * 16) * pitch) = pack8_bf16(acc[ai][bj][m][0], acc[ai][bj][m][1]); }
    }
};
struct EpiY {
    static constexpr bool PERM = true, AFTER_DRAIN = false;
    bf16_t* Y; float* SS;
    __device__ __forceinline__ void operator()(const f32x4 (&acc)[2][2][4][2], const Unit& u, int wr, int wc, int fr, int fq) const {
        const int row0 = u.pm * BM + wr * 64 + fr, col0 = u.pn * BM + wc * 32 + 8 * fq;
#pragma unroll
        for (int ai = 0; ai < 2; ++ai)
#pragma unroll
            for (int m = 0; m < 4; ++m) { const int row = row0 + ai * HALF + m * 16; bf16_t* rowp = Y + (size_t)row * DM + col0; float s = 0.f;
#pragma unroll
                for (int bj = 0; bj < 2; ++bj) { const f32x4 a = acc[ai][bj][m][0], b = acc[ai][bj][m][1];
                    s += (a[0] * a[0] + a[1] * a[1]) + (a[2] * a[2] + a[3] * a[3]) + (b[0] * b[0] + b[1] * b[1]) + (b[2] * b[2] + b[3] * b[3]);
                    *(u32x4*)(rowp + bj * HALF) = pack8_bf16(a, b); }
                s += __shfl_xor(s, 16); s += __shfl_xor(s, 32);
                if (fq == 0) SS[(size_t)row * 64 + u.pn * 4 + wc] = s; }
    }
};
__device__ __forceinline__ float silu_f(float x) { return x * __builtin_amdgcn_rcpf(1.0f + __builtin_amdgcn_exp2f(-1.4426950408889634f * x)); }
struct EpiSwiGLU {
    static constexpr bool PERM = true, AFTER_DRAIN = false;
    bf16_t* Hd;
    __device__ __forceinline__ void operator()(const f32x4 (&acc)[2][2][4][2], const Unit& u, int wr, int wc, int fr, int fq) const {
        const int row0 = u.pm * BM + wr * 64 + fr, col0 = u.pn * HALF + wc * 32 + 8 * fq;
#pragma unroll
        for (int ai = 0; ai < 2; ++ai)
#pragma unroll
            for (int m = 0; m < 4; ++m) { const f32x4 g0 = acc[ai][0][m][0], g1 = acc[ai][0][m][1], u0 = acc[ai][1][m][0], u1 = acc[ai][1][m][1]; f32x4 h0, h1;
#pragma unroll
                for (int e = 0; e < 4; ++e) { h0[e] = silu_f(g0[e]) * u0[e]; h1[e] = silu_f(g1[e]) * u1[e]; }
                *(u32x4*)(Hd + (size_t)(row0 + ai * HALF + m * 16) * FFN + col0) = pack8_bf16(h0, h1); }
    }
};

struct PanelOrder {
    int c, nround;
    __device__ __forceinline__ bool next(int i, Unit& u) const { if (i >= nround) return false; const int x = c & 7, k = c >> 3; u.pm = 16 * i + 2 * x + (k >> 4); u.pn = k & 15; return true; }
    __device__ __forceinline__ void a_ready(const Unit&) const {}
    __device__ __forceinline__ void done(const Unit&) const {}
};
template <class Epi, class Sched, bool ALIGN_EPI = false, bool SP2 = false>
__device__ __forceinline__ void gemm_phase(PG8_LAS unsigned char* lds, const Gemm g, const Sched& S, const Epi& E) {
    int tid_ = my_tid(); asm volatile("" : "+v"(tid_));
    const int tid = tid_, wid = __builtin_amdgcn_readfirstlane(tid >> 6), lane = tid & 63, wr = wid >> 2, wc = wid & 3, fr = lane & 15, fq = lane >> 4;
    const int K = g.K, nt = K / BK;
    unsigned voffA[2], voffB[2];
#pragma unroll
    for (int i = 0; i < 2; ++i) { int R, C; stage_rc(tid * 16 + i * 8192, R, C); const int Rb = Epi::PERM ? ((R & ~31) + perm32(R & 31)) : R;
        voffA[i] = (unsigned)(R * K + C) * 2u; voffB[i] = (unsigned)(Rb * K + C) * 2u; }
    const size_t kstep = (size_t)(BK * 2);
    const size_t hstep = (size_t)HALF * K * 2;
    const size_t tstep = 2 * hstep;
    const unsigned ldsw = (unsigned)wid * 1024u;
    const int aoff = lds_byte(wr * 64 + fr, fq * 8), boff = lds_byte(wc * 32 + fr, fq * 8);
#define PG8_SA(b, h) (((b) * 2 + (h)) * HTB)
#define PG8_SB(b, h) ((4 + (b) * 2 + (h)) * HTB)
#define PG8_STAGE(bufoff, gbase, voff) do { _Pragma("unroll") for (int _i = 0; _i < 2; ++_i) \
        __builtin_amdgcn_global_load_lds((const unsigned*)((const char*)(gbase) + (voff)[_i]), (PG8_LAS unsigned*)(lds + (bufoff) + ldsw + _i * 8192), 16, 0, 0); } while (0)
#define PG8_LDA(dst, b, h) do { _Pragma("unroll") for (int m = 0; m < 4; ++m) _Pragma("unroll") for (int k = 0; k < 2; ++k) dst[m][k] = *(const PG8_LAS bf16x8*)(lds + PG8_SA(b, h) + aoff + m * 2048 + k * 1024); } while (0)
#define PG8_LDB(dst, b, h) do { _Pragma("unroll") for (int n = 0; n < 2; ++n) _Pragma("unroll") for (int k = 0; k < 2; ++k) dst[n][k] = *(const PG8_LAS bf16x8*)(lds + PG8_SB(b, h) + boff + n * 2048 + k * 1024); } while (0)
#define PG8_MMA(ai, bj, At, Bt) do { __builtin_amdgcn_s_setprio(1); _Pragma("unroll") for (int m = 0; m < 4; ++m) _Pragma("unroll") for (int n = 0; n < 2; ++n) _Pragma("unroll") for (int k = 0; k < 2; ++k) \
        acc[ai][bj][m][n] = __builtin_amdgcn_mfma_f32_16x16x32_bf16(Bt[n][k], At[m][k], acc[ai][bj][m][n], 0, 0, 0); __builtin_amdgcn_s_setprio(0); } while (0)
#define PG8_WAIT_V(n) asm volatile("s_waitcnt vmcnt(" #n ")" ::: "memory")
#define PG8_WAIT_L(n) asm volatile("s_waitcnt lgkmcnt(" #n ")" ::: "memory")
#define PG8_BAR __builtin_amdgcn_s_barrier()
#define PG8_SCHED __builtin_amdgcn_sched_barrier(0)
    Unit cur, nxt; int ui = 0;
    if (!S.next(0, cur)) return;
    f32x4 acc[2][2][4][2];
#pragma unroll
    for (int a = 0; a < 2; ++a)
#pragma unroll
        for (int b = 0; b < 2; ++b)
#pragma unroll
            for (int m = 0; m < 4; ++m)
#pragma unroll
                for (int n = 0; n < 2; ++n) acc[a][b][m][n] = (f32x4){0.f, 0.f, 0.f, 0.f};
    bf16x8 At[4][2], B0[2][2], B1[2][2];
    const char* cA = (const char*)g.A + (size_t)cur.pm * tstep; const char* cB = (const char*)g.Bt + (size_t)cur.pn * tstep;
    S.a_ready(cur);
    if constexpr (SP2) {
        PG8_STAGE(PG8_SB(0, 0), cB, voffB); PG8_STAGE(PG8_SB(0, 1), cB + hstep, voffB); PG8_STAGE(PG8_SA(0, 0), cA, voffA); PG8_STAGE(PG8_SA(0, 1), cA + hstep, voffA);
        if (wr == 1) PG8_BAR;
        PG8_WAIT_V(2); PG8_BAR;
        PG8_STAGE(PG8_SB(1, 0), cB + kstep, voffB); PG8_STAGE(PG8_SA(1, 0), cA + kstep, voffA); PG8_STAGE(PG8_SB(1, 1), cB + hstep + kstep, voffB);
        PG8_WAIT_V(6); PG8_BAR;
    } else {
        PG8_STAGE(PG8_SB(0, 0), cB, voffB); PG8_STAGE(PG8_SA(0, 0), cA, voffA); PG8_STAGE(PG8_SB(0, 1), cB + hstep, voffB); PG8_STAGE(PG8_SA(0, 1), cA + hstep, voffA);
        if (wr == 1) PG8_BAR;
        PG8_WAIT_V(4); PG8_BAR;
        PG8_STAGE(PG8_SB(1, 0), cB + kstep, voffB); PG8_STAGE(PG8_SA(1, 0), cA + kstep, voffA); PG8_STAGE(PG8_SB(1, 1), cB + hstep + kstep, voffB);
        PG8_WAIT_V(6); PG8_BAR;
    }
    for (;;) {
        const bool has_next = S.next(ui + 1, nxt);
        const char* nA = has_next ? (const char*)g.A + (size_t)nxt.pm * tstep : cA; const char* nB = has_next ? (const char*)g.Bt + (size_t)nxt.pn * tstep : cB;
        for (int t = 0; t < nt; t += 2) {
            const bool last = (t == nt - 2);
            const char* a1 = cA + (size_t)(t + 1) * kstep;
            const char* a2 = last ? nA : cA + (size_t)(t + 2) * kstep; const char* b2 = last ? nB : cB + (size_t)(t + 2) * kstep;
            const char* a3 = a2 + kstep; const char* b3 = b2 + kstep;
            if (last && has_next) S.a_ready(nxt);
            if constexpr (SP2) {
            PG8_LDB(B0, 0, 0); PG8_LDB(B1, 0, 1); PG8_SCHED; PG8_LDA(At, 0, 0); PG8_STAGE(PG8_SA(1, 1), a1 + hstep, voffA);
            PG8_WAIT_V(8); PG8_WAIT_L(0); PG8_BAR; PG8_MMA(0, 0, At, B0); PG8_MMA(0, 1, At, B1); PG8_BAR; PG8_SCHED;
            PG8_LDA(At, 0, 1); PG8_STAGE(PG8_SB(0, 0), b2, voffB); PG8_STAGE(PG8_SB(0, 1), b2 + hstep, voffB); PG8_STAGE(PG8_SA(0, 0), a2, voffA);
            PG8_WAIT_V(8); PG8_WAIT_L(0); PG8_BAR; PG8_MMA(1, 0, At, B0); PG8_MMA(1, 1, At, B1); PG8_BAR; PG8_SCHED;
            PG8_LDB(B0, 1, 0); PG8_LDB(B1, 1, 1); PG8_SCHED; PG8_LDA(At, 1, 0); PG8_STAGE(PG8_SA(0, 1), a2 + hstep, voffA);
            PG8_WAIT_V(8); PG8_WAIT_L(0); PG8_BAR; PG8_MMA(0, 0, At, B0); PG8_MMA(0, 1, At, B1); PG8_BAR; PG8_SCHED;
            PG8_LDA(At, 1, 1); PG8_STAGE(PG8_SB(1, 0), b3, voffB); PG8_STAGE(PG8_SB(1, 1), b3 + hstep, voffB); PG8_STAGE(PG8_SA(1, 0), a3, voffA);
            PG8_WAIT_V(8); PG8_WAIT_L(0); PG8_BAR; PG8_MMA(1, 0, At, B0); PG8_MMA(1, 1, At, B1); PG8_BAR; PG8_SCHED;
            } else {
            PG8_LDB(B0, 0, 0); PG8_SCHED; PG8_LDA(At, 0, 0); PG8_STAGE(PG8_SA(1, 1), a1 + hstep, voffA);
            PG8_WAIT_L(8); PG8_BAR; PG8_WAIT_L(0); PG8_MMA(0, 0, At, B0); PG8_BAR; PG8_SCHED;
            PG8_LDB(B1, 0, 1); PG8_STAGE(PG8_SB(0, 0), b2, voffB);
            PG8_BAR; PG8_WAIT_L(0); PG8_MMA(0, 1, At, B1); PG8_BAR;
            PG8_LDA(At, 0, 1); PG8_STAGE(PG8_SA(0, 0), a2, voffA);
            PG8_BAR; PG8_WAIT_L(0); PG8_MMA(1, 0, At, B0); PG8_BAR; PG8_SCHED;
            PG8_STAGE(PG8_SB(0, 1), b2 + hstep, voffB);
            PG8_WAIT_V(6); PG8_BAR; PG8_MMA(1, 1, At, B1); PG8_BAR;
            PG8_LDB(B0, 1, 0); PG8_SCHED; PG8_LDA(At, 1, 0); PG8_STAGE(PG8_SA(0, 1), a2 + hstep, voffA);
            PG8_WAIT_L(8); PG8_BAR; PG8_WAIT_L(0); PG8_MMA(0, 0, At, B0); PG8_BAR; PG8_SCHED;
            PG8_LDB(B1, 1, 1); PG8_STAGE(PG8_SB(1, 0), b3, voffB);
            PG8_BAR; PG8_WAIT_L(0); PG8_MMA(0, 1, At, B1); PG8_BAR;
            PG8_LDA(At, 1, 1); PG8_STAGE(PG8_SA(1, 0), a3, voffA);
            PG8_BAR; PG8_WAIT_L(0); PG8_MMA(1, 0, At, B0); PG8_BAR; PG8_SCHED;
            PG8_STAGE(PG8_SB(1, 1), b3 + hstep, voffB);
            PG8_WAIT_V(6); PG8_BAR; PG8_MMA(1, 1, At, B1); PG8_BAR;
            }
        }
        if constexpr (ALIGN_EPI) { if (wr == 0) PG8_BAR; }
        if constexpr (!Epi::AFTER_DRAIN) { E(acc, cur, wr, wc, fr, fq); S.done(cur); }
        if (!has_next) break;
#pragma unroll
        for (int a = 0; a < 2; ++a)
#pragma unroll
            for (int b = 0; b < 2; ++b)
#pragma unroll
                for (int m = 0; m < 4; ++m)
#pragma unroll
                    for (int n = 0; n < 2; ++n) acc[a][b][m][n] = (f32x4){0.f, 0.f, 0.f, 0.f};
        cur = nxt; cA = nA; cB = nB; ++ui;
        if constexpr (ALIGN_EPI) { if (wr == 1) PG8_BAR; }
    }
    PG8_WAIT_V(0);
    if constexpr (!ALIGN_EPI) { if (wr == 0) PG8_BAR; }
    PG8_BAR;
    if constexpr (Epi::AFTER_DRAIN) { E.fused(acc, cur, wr, wc, fr, fq, lds, wid, lane); S.done(cur); }
#undef PG8_SA
#undef PG8_SB
#undef PG8_STAGE
#undef PG8_LDA
#undef PG8_LDB
#undef PG8_MMA
#undef PG8_WAIT_V
#undef PG8_WAIT_L
#undef PG8_BAR
#undef PG8_SCHED
}
}

namespace attn {
constexpr int KVP = HD, OP = DM;
constexpr float SCALE = 0.08838834764831845f;
constexpr int D = 128;
constexpr int NW = 8, QBLK = 32, KVBLK = 64, QB = NW * QBLK;
constexpr int SHM_V = KVBLK * D * 2, SHM_K = KVBLK * D * 2;
constexpr int FB_OFF = 2 * SHM_V + 2 * SHM_K + NW * 64 * 4;
constexpr int LDS_BYTES = FB_OFF + 2 * 64 * 4;
constexpr bool WSKIP = false;
constexpr float THR = 16.f;

using bf16 = __hip_bfloat16;
typedef short bf16x8 __attribute__((ext_vector_type(8)));
typedef short s16x4 __attribute__((ext_vector_type(4)));
typedef float f32x16 __attribute__((ext_vector_type(16)));
typedef float f32x4 __attribute__((ext_vector_type(4)));
typedef unsigned u32x4 __attribute__((ext_vector_type(4)));
template <class A, class Bt> struct same_t { static constexpr bool v = false; };
template <class A> struct same_t<A, A> { static constexpr bool v = true; };

#define KSWZ(row, colB) ((row) * 256 + ((colB) ^ (((row) & 7) << 4)))
#define SBAR() __builtin_amdgcn_sched_barrier(0)
__device__ __forceinline__ int v_st(int k, int c) { const int kk = (k & ~0xC) | ((k & 4) << 1) | ((k & 8) >> 1); return ((kk >> 3) * 4 + (c >> 5)) * 512 + ((kk & 7) * 32 + (c & 31)) * 2; }
__device__ __forceinline__ int v_rd_base(int lane) { return ((lane & 3) << 3) | (((lane >> 2) & 3) << 6) | (((lane >> 4) & 1) << 5) | (((lane >> 5) & 1) << 8); }
constexpr int v_rd_off(int d0, int ks, int half) { return d0 * 512 + ks * 4096 + half * 2048; }
__device__ __forceinline__ int crow(int r, int hi) { return (r & 3) + 8 * (r >> 2) + 4 * hi; }
__device__ __forceinline__ unsigned cvtpk(float lo, float hi) {
    unsigned r; asm volatile("v_cvt_pk_bf16_f32 %0, %1, %2" : "=v"(r) : "v"(lo), "v"(hi)); return r;
}
__device__ __forceinline__ bf16x8 pack8(f32x4 a, f32x4 b) {
    u32x4 w = {cvtpk(a[0], a[1]), cvtpk(a[2], a[3]), cvtpk(b[0], b[1]), cvtpk(b[2], b[3])};
    return *reinterpret_cast<bf16x8*>(&w);
}
template <class T> __device__ __forceinline__ bf16x8 load8(const T* p) {
    if constexpr (same_t<T, float>::v) { return pack8(*(const f32x4*)p, *(const f32x4*)(p + 4)); }
    else { return *reinterpret_cast<const bf16x8*>(p); }
}
__device__ __forceinline__ void mask_tile(f32x16& p0, f32x16& p1, int dq, unsigned W) {
    const float NEG = -__builtin_inff();
#pragma unroll
    for (int r = 0; r < 16; ++r) {
        const int c = (r & 3) + 8 * (r >> 2);
        if ((unsigned)(dq - c) >= W) p0[r] = NEG;
        if ((unsigned)(dq - c - 32) >= W) p1[r] = NEG;
    }
}
__device__ __forceinline__ void partialSM(f32x16& p0, f32x16& p1, float& m_reg, float& mn, float& alpha) {
    float pmax = p0[0]; for (int r = 1; r < 16; ++r) pmax = fmaxf(pmax, p0[r]); for (int r = 0; r < 16; ++r) pmax = fmaxf(pmax, p1[r]);
    { auto rr = __builtin_amdgcn_permlane32_swap(__float_as_uint(pmax), __float_as_uint(pmax), false, false);
      pmax = fmaxf(__uint_as_float(rr[0]), __uint_as_float(rr[1])); }
    constexpr float C2 = 1.4426950408889634f * SCALE;
    if (__builtin_expect(__all((pmax - m_reg) * SCALE <= THR), 1)) { mn = m_reg; alpha = 1.f; }
    else { mn = fmaxf(m_reg, pmax); alpha = __builtin_amdgcn_exp2f((m_reg - mn) * C2); m_reg = mn; }
    const float mnL = -mn * C2;
    for (int r = 0; r < 16; ++r) p0[r] = fmaf(p0[r], C2, mnL); for (int r = 0; r < 16; ++r) p1[r] = fmaf(p1[r], C2, mnL);
    for (int r = 0; r < 16; ++r) p0[r] = __builtin_amdgcn_exp2f(p0[r]);
}
__device__ __forceinline__ void finishSM(f32x16& p0, f32x16& p1, float alpha, float& l_reg, bf16x8& pa0, bf16x8& pa1, bf16x8& pa2, bf16x8& pa3) {
    for (int r = 0; r < 16; ++r) p1[r] = __builtin_amdgcn_exp2f(p1[r]);
    float ps = 0; for (int r = 0; r < 16; ++r) ps += p0[r]; for (int r = 0; r < 16; ++r) ps += p1[r];
    { auto rr = __builtin_amdgcn_permlane32_swap(__float_as_uint(ps), __float_as_uint(ps), false, false);
      ps = __uint_as_float(rr[0]) + __uint_as_float(rr[1]); }
    l_reg = l_reg * alpha + ps;
#define PK4(P, B_, OUT) do { unsigned a0 = cvtpk(P[B_+0], P[B_+1]), a1 = cvtpk(P[B_+2], P[B_+3]);                          \
        unsigned b0 = cvtpk(P[B_+4], P[B_+5]), b1 = cvtpk(P[B_+6], P[B_+7]);                                             \
        auto r0 = __builtin_amdgcn_permlane32_swap(a0, b0, false, false); auto r1 = __builtin_amdgcn_permlane32_swap(a1, b1, false, false); \
        u32x4 w = {r0[0], r1[0], r0[1], r1[1]}; OUT = *reinterpret_cast<bf16x8*>(&w); } while (0)
    PK4(p0, 0, pa0); PK4(p0, 8, pa1); PK4(p1, 0, pa2); PK4(p1, 8, pa3);
#undef PK4
}
template <int KB, bool SK>
__device__ __forceinline__ void qkt(f32x16& p0, f32x16& p1, const char* K_lds, int r32, int hi, const bf16x8* qr, bool act) {
    if (SK && !act) { const float NEG = -__builtin_inff();
#pragma unroll
        for (int r = 0; r < 16; ++r) { p0[r] = NEG; p1[r] = NEG; } return; }
    { const char* fb = K_lds + 2 * SHM_K + NW * 64 * 4 + KB * 256 + hi * 16;
#pragma unroll
      for (int g = 0; g < 4; ++g) { const f32x4 a = *reinterpret_cast<const f32x4*>(fb + g * 32), b = *reinterpret_cast<const f32x4*>(fb + 128 + g * 32);
          p0[4 * g] = a[0]; p0[4 * g + 1] = a[1]; p0[4 * g + 2] = a[2]; p0[4 * g + 3] = a[3]; p1[4 * g] = b[0]; p1[4 * g + 1] = b[1]; p1[4 * g + 2] = b[2]; p1[4 * g + 3] = b[3]; } }
    const char* kb[4];
#pragma unroll
    for (int dd = 0; dd < 4; ++dd) kb[dd] = K_lds + KB * SHM_K + KSWZ(r32, (dd * 16 + hi * 8) * 2);
#pragma unroll
    for (int d0 = 0; d0 < 8; ++d0) { const char* a = kb[d0 & 3] + (d0 >> 2) * 128;
        bf16x8 b0 = *reinterpret_cast<const bf16x8*>(a);
        bf16x8 b1 = *reinterpret_cast<const bf16x8*>(a + 32 * 256);
        p0 = __builtin_amdgcn_mfma_f32_32x32x16_bf16(b0, qr[d0], p0, 0, 0, 0);
        p1 = __builtin_amdgcn_mfma_f32_32x32x16_bf16(b1, qr[d0], p1, 0, 0, 0); }
}
template <int VB, bool SK>
__device__ __forceinline__ void pv_tile(f32x16* o, int vb0, bf16x8 pa0, bf16x8 pa1, bf16x8 pa2, bf16x8 pa3, bool act) {
    if (SK && !act) return;
#define TRRD(dst, off) asm volatile("ds_read_b64_tr_b16 %0, %1 offset:%2" : "=&v"(dst) : "v"(vb0), "i"(off) : "memory")
#define PV_D0(d0) do { s16x4 l0, l1, l2, l3, h0, h1, h2, h3; constexpr int b_ = VB * SHM_V + v_rd_off(d0, 0, 0);     \
        TRRD(l0, b_); TRRD(h0, b_ + 2048); TRRD(l1, b_ + 4096); TRRD(h1, b_ + 6144); TRRD(l2, b_ + 8192); TRRD(h2, b_ + 10240); TRRD(l3, b_ + 12288); TRRD(h3, b_ + 14336); \
        asm volatile("s_waitcnt lgkmcnt(0)" ::: "memory"); SBAR();                 \
        o[d0] = __builtin_amdgcn_mfma_f32_32x32x16_bf16(pa0, (bf16x8){l0[0], l0[1], l0[2], l0[3], h0[0], h0[1], h0[2], h0[3]}, o[d0], 0, 0, 0);   \
        o[d0] = __builtin_amdgcn_mfma_f32_32x32x16_bf16(pa1, (bf16x8){l1[0], l1[1], l1[2], l1[3], h1[0], h1[1], h1[2], h1[3]}, o[d0], 0, 0, 0);   \
        o[d0] = __builtin_amdgcn_mfma_f32_32x32x16_bf16(pa2, (bf16x8){l2[0], l2[1], l2[2], l2[3], h2[0], h2[1], h2[2], h2[3]}, o[d0], 0, 0, 0);   \
        o[d0] = __builtin_amdgcn_mfma_f32_32x32x16_bf16(pa3, (bf16x8){l3[0], l3[1], l3[2], l3[3], h3[0], h3[1], h3[2], h3[3]}, o[d0], 0, 0, 0); } while (0)
    PV_D0(0); PV_D0(1); PV_D0(2); PV_D0(3);
#undef PV_D0
#undef TRRD
}

template <class TIn, class TOut> struct BlockRef { const TIn* Q; const TIn* K; const TIn* V; const float* F; TOut* O; int P0; int JLO; };
template <class TIn> struct Seam {
    bf16x8 qr[8];
    bf16x8 st_v0, st_v1, st_k0, st_k1; float st_f; f32x4 sf0, sf1, sf2, sf3;
    f32x4 tq[16];
};
__device__ __forceinline__ int swa_jlo(int P0, int W) { const int lowk = P0 - W + 1; return lowk > 0 ? lowk / KVBLK : 0; }
#define ROW(p, k0, rr) ((p) + (size_t)((k0) + (rr)) * KVP + sc)
#define VMW() asm volatile("s_waitcnt vmcnt(0)" ::: "memory")
#define VMWN(n) asm volatile("s_waitcnt vmcnt(%0)" :: "i"(n) : "memory")
#define SLOAD_H(Kp, Vp, Fp, k0) do { S.st_v0 = load8<TIn>(ROW(Vp, k0, sr)); S.st_v1 = load8<TIn>(ROW(Vp, k0, 32 + sr));              \
                         S.st_k0 = load8<TIn>(ROW(Kp, k0, sr)); S.st_k1 = load8<TIn>(ROW(Kp, k0, 32 + sr)); if (tid < 64) S.st_f = (Fp)[(k0) + tid]; } while (0)
#define SWRITE_HK(bf) do { *(bf16x8*)(K_lds + (bf) * SHM_K + kws) = S.st_k0; *(bf16x8*)(K_lds + (bf) * SHM_K + kws + 32 * 256) = S.st_k1; if (tid < 64) *(float*)(K_lds + 2 * SHM_K + NW * 64 * 4 + (bf) * 256 + tid * 4) = S.st_f; } while (0)
#define SWRITE_HV(bf) do { *(bf16x8*)(V_lds + (bf) * SHM_V + vst0) = S.st_v0; *(bf16x8*)(V_lds + (bf) * SHM_V + vst1) = S.st_v1; } while (0)
#define SWRITE_H(bf) do { SWRITE_HV(bf); SWRITE_HK(bf); } while (0)
#define SLOAD_F(p, k0) do { S.sf0 = *(const f32x4*)ROW(p, k0, sr); S.sf1 = *(const f32x4*)(ROW(p, k0, sr) + 4);                \
                            S.sf2 = *(const f32x4*)ROW(p, k0, 32 + sr); S.sf3 = *(const f32x4*)(ROW(p, k0, 32 + sr) + 4); } while (0)
#define SWRITE_KF(bf) do { *(bf16x8*)(K_lds + (bf) * SHM_K + kws) = pack8(S.sf0, S.sf1); *(bf16x8*)(K_lds + (bf) * SHM_K + kws + 32 * 256) = pack8(S.sf2, S.sf3); } while (0)
#define SWRITE_VF(bf) do { *(bf16x8*)(V_lds + (bf) * SHM_V + vst0) = pack8(S.sf0, S.sf1); *(bf16x8*)(V_lds + (bf) * SHM_V + vst1) = pack8(S.sf2, S.sf3); } while (0)
template <class TIn, class TOut>
__device__ __forceinline__ void causal_swa_prime(const BlockRef<TIn, TOut>& cur, int W, char* lds, Seam<TIn>& S) {
    constexpr bool F32 = same_t<TIn, float>::v;
    int tid_ = my_tid(); asm volatile("" : "+v"(tid_));
    const int tid = tid_, wid = __builtin_amdgcn_readfirstlane(tid >> 6), lane = tid & 63, r32 = lane & 31, hi = lane >> 5;
    const int sr = tid >> 4, sc = (tid & 15) * 8, kws = KSWZ(sr, sc * 2); char* K_lds = lds + 2 * SHM_V;
    const int kb0 = cur.JLO * KVBLK;
    for (int d0 = 0; d0 < 8; ++d0) S.qr[d0] = load8<TIn>(cur.Q + (size_t)(wid * QBLK + r32) * KVP + d0 * 16 + hi * 8);
    if constexpr (F32) { SLOAD_F((const float*)cur.K, kb0); VMW(); SWRITE_KF(0); SBAR(); SLOAD_F((const float*)cur.V, kb0); }
    else { SLOAD_H(cur.K, cur.V, cur.F, kb0); VMW(); SWRITE_HK(0); }
    __syncthreads();
}
template <class TIn, class TOut>
__device__ __forceinline__ void causal_swa_block(const BlockRef<TIn, TOut>& cur, const BlockRef<TIn, TOut>& nxt, int skv, int W, char* lds, Seam<TIn>& S, const float* const __attribute__((address_space(4)))* gslot, int goff) {
    constexpr bool F32 = same_t<TIn, float>::v;
    int tid_ = my_tid(); asm volatile("" : "+v"(tid_));
    const int tid = tid_, wid = __builtin_amdgcn_readfirstlane(tid >> 6), lane = tid & 63, r32 = lane & 31, hi = lane >> 5;
    const int j_lo = cur.JLO;
    int j_hi = (cur.P0 + QB - 1) / KVBLK + 1; if (j_hi > skv / KVBLK) j_hi = skv / KVBLK;
    const int NT = j_hi - j_lo;
    const int kbn = nxt.JLO * KVBLK;
    const int qlo = cur.P0 + wid * QBLK, qm = qlo + r32 - 4 * hi;
    char* V_lds = lds; char* K_lds = lds + 2 * SHM_V;
    float* ws = (float*)(lds + 2 * SHM_V + 2 * SHM_K) + wid * 64; float* li_l = ws, * al_l = ws + 32;
    float m_reg = -1e30f, l_reg = 0; f32x16 o[4] = {};
    const int sr = tid >> 4, sc = (tid & 15) * 8, vst0 = v_st(sr, sc), vst1 = v_st(32 + sr, sc), kws = KSWZ(sr, sc * 2);
    const int vb0 = (int)(uintptr_t)V_lds + v_rd_base(lane);
    const TIn* Kh = cur.K; const TIn* Vh = cur.V; const float* Fh = cur.F;
#define RESC(a) do { if (__any((a) < 1.f)) { if (hi == 0) al_l[r32] = (a); asm volatile("s_waitcnt lgkmcnt(0)" ::: "memory");              \
                     for (int d_ = 0; d_ < 4; ++d_) for (int r = 0; r < 16; ++r) o[d_][r] *= al_l[crow(r, hi)]; } } while (0)
#define KBASE(t) ((j_lo + (t)) * KVBLK)
#define ACT(t) (KBASE(t) <= qlo + QBLK - 1 && KBASE(t) + KVBLK - 1 >= qlo - W + 1)
#define MASKT(P0_, P1_, t) do { const int kb_ = KBASE(t); if ((!SK || ACT(t)) && (kb_ + KVBLK - 1 > qlo || kb_ <= qlo + QBLK - 1 - W)) mask_tile(P0_, P1_, qm - kb_, (unsigned)W); } while (0)
    constexpr int NQL = F32 ? 16 : 8;
    constexpr bool SK = WSKIP && !F32;
#define SEAM_K0() do { VMWN(NQL); if constexpr (F32) { SWRITE_KF(0); SBAR(); SLOAD_F((const float*)nxt.V, kbn); } else { SWRITE_HK(0); } SBAR(); } while (0)
    f32x16 pA0, pA1, pB0, pB1; float mnA, mnB, alA, alB; bf16x8 pa0, pa1, pa2, pa3;
    if constexpr (F32) { VMW(); SWRITE_VF(0); SBAR(); } else { SWRITE_HV(0); SBAR(); }
    if (NT > 1) { if constexpr (F32) SLOAD_F((const float*)Kh, KBASE(1)); else SLOAD_H(Kh, Vh, Fh, KBASE(1)); }
    SBAR(); qkt<0, SK>(pA0, pA1, K_lds, r32, hi, S.qr, ACT(0));
    if constexpr (F32) { if (NT > 1) { VMW(); SWRITE_KF(1); SBAR(); SLOAD_F((const float*)Vh, KBASE(1)); } }
    MASKT(pA0, pA1, 0); partialSM(pA0, pA1, m_reg, mnA, alA);
    if (NT > 1) { VMW(); if constexpr (F32) { SWRITE_VF(1); SBAR(); if (NT > 2) SLOAD_F((const float*)Kh, KBASE(2)); } else SWRITE_H(1); }
    __syncthreads();
#define HALF_STEP(PX0, PX1, mnX, alX, PY0, PY1, alY, t, KB, VB, SB) do {                                                      \
        SBAR(); qkt<KB, SK>(PX0, PX1, K_lds, r32, hi, S.qr, ACT(t));                                             \
        finishSM(PY0, PY1, alY, l_reg, pa0, pa1, pa2, pa3); SBAR();                                                           \
        if ((t) + 1 < NT) { if constexpr (F32) { VMW(); SWRITE_KF(SB); SBAR(); SLOAD_F((const float*)Vh, KBASE((t) + 1)); }  \
                            else { SLOAD_H(Kh, Vh, Fh, KBASE((t) + 1)); } SBAR(); }                                               \
        pv_tile<VB, SK>(o, vb0, pa0, pa1, pa2, pa3, ACT((t) - 1)); MASKT(PX0, PX1, (t)); partialSM(PX0, PX1, m_reg, mnX, alX);                                        \
        __syncthreads();                                                                                                      \
        if ((t) + 1 < NT) { VMW(); if constexpr (F32) { SWRITE_VF(SB); SBAR(); if ((t) + 2 < NT) SLOAD_F((const float*)Kh, KBASE((t) + 2)); } \
                            else { SWRITE_H(SB); } }                                                                          \
        RESC(alX); __syncthreads(); } while (0)
    for (int t = 1; t + 1 < NT; t += 2) {
        HALF_STEP(pB0, pB1, mnB, alB, pA0, pA1, alA, t, 1, 0, 0);
        HALF_STEP(pA0, pA1, mnA, alA, pB0, pB1, alB, t + 1, 0, 1, 1);
    }
    const bool even = (NT & 1) == 0;
    if (even) { SBAR(); qkt<1, SK>(pB0, pB1, K_lds, r32, hi, S.qr, ACT(NT - 1)); SBAR(); }
#define QROW(e) (nxt.Q + (size_t)(wid * QBLK + r32) * KVP + ((e) >> 1) * 16 + hi * 8 + ((e) & 1) * 4)
    if constexpr (F32) { SLOAD_F((const float*)nxt.K, kbn); SBAR();
#pragma unroll
        for (int e = 0; e < 8; ++e) S.tq[e] = *(const f32x4*)QROW(e); }
    else { SLOAD_H(nxt.K, nxt.V, nxt.F, kbn); SBAR();
#pragma unroll
        for (int d0 = 0; d0 < 8; ++d0) S.qr[d0] = load8<TIn>(nxt.Q + (size_t)(wid * QBLK + r32) * KVP + d0 * 16 + hi * 8); }
    SBAR();
    finishSM(pA0, pA1, alA, l_reg, pa0, pa1, pa2, pa3); SBAR();
    if constexpr (F32) {
#pragma unroll
        for (int e = 8; e < 16; ++e) S.tq[e] = *(const f32x4*)QROW(e); SBAR(); }
#undef QROW
    pv_tile<0, SK>(o, vb0, pa0, pa1, pa2, pa3, ACT(even ? NT - 2 : NT - 1));
    if (even) { MASKT(pB0, pB1, NT - 1); partialSM(pB0, pB1, m_reg, mnB, alB); __syncthreads(); RESC(alB);
        finishSM(pB0, pB1, alB, l_reg, pa0, pa1, pa2, pa3); SBAR(); pv_tile<1, SK>(o, vb0, pa0, pa1, pa2, pa3, ACT(NT - 1)); }
    SBAR(); SEAM_K0();
    if (hi == 0) li_l[r32] = l_reg; asm volatile("s_waitcnt lgkmcnt(0)" ::: "memory");
    float rli[16];
#pragma unroll
    for (int r = 0; r < 16; ++r) rli[r] = __builtin_amdgcn_rcpf(li_l[crow(r, hi)]);
    TOut* Ow = cur.O + (size_t)(wid * QBLK) * OP;
    float gn[4];
    { const float* G = *gslot + goff;
#pragma unroll
    for (int d0 = 0; d0 < 4; ++d0) gn[d0] = G[d0 * 32 + r32]; }
#pragma unroll
    for (int r = 0; r < 16; ++r) { const int orow = crow(r, hi);
        float y[4]; float ss = 0.f;
#pragma unroll
        for (int d0 = 0; d0 < 4; ++d0) { y[d0] = o[d0][r] * rli[r]; ss += y[d0] * y[d0]; }
        ss += __shfl_xor(ss, 1); ss += __shfl_xor(ss, 2); ss += __shfl_xor(ss, 4); ss += __shfl_xor(ss, 8); ss += __shfl_xor(ss, 16);
        const float rs = __builtin_amdgcn_rsqf(ss * (1.0f / 128.0f) + 1e-6f);
#pragma unroll
        for (int d0 = 0; d0 < 4; ++d0) { const float v = y[d0] * rs * gn[d0];
            if constexpr (same_t<TOut, float>::v) { Ow[(size_t)orow * OP + d0 * 32 + r32] = v; }
            else { const float vn = __shfl_xor(v, 1);
                   if ((r32 & 1) == 0) *(unsigned*)(Ow + (size_t)orow * OP + d0 * 32 + r32) = cvtpk(v, vn); } }
        SBAR(); }
    if constexpr (F32) {
#pragma unroll
        for (int d0 = 0; d0 < 8; ++d0) S.qr[d0] = pack8(S.tq[2 * d0], S.tq[2 * d0 + 1]); }
    __syncthreads();
#undef RESC
#undef KBASE
#undef ACT
#undef MASKT
#undef SEAM_K0
#undef HALF_STEP
}
#undef ROW
#undef VMW
#undef VMWN
#undef SLOAD_H
#undef SWRITE_HK
#undef SWRITE_HV
#undef SWRITE_H
#undef SLOAD_F
#undef SWRITE_KF
#undef SWRITE_VF


}

__device__ __forceinline__ float bflo(unsigned w) { return __uint_as_float(w << 16); }
__device__ __forceinline__ float bfhi(unsigned w) { return __uint_as_float(w & 0xffff0000u); }
__device__ __forceinline__ float wave_sum(float v) {
#pragma unroll
    for (int o = 1; o < 64; o <<= 1) v += __shfl_xor(v, o);
    return v;
}
__device__ __forceinline__ float sigmoid_f(float x) { return 1.0f / (1.0f + __expf(-x)); }
__device__ __forceinline__ float silu_acc(float x) { return x / (1.0f + __expf(-x)); }
__device__ __forceinline__ float softplus_f(float x) { return fmaxf(x, 0.f) + log1pf(__expf(-fabsf(x))); }
__device__ __forceinline__ float logsigmoid_f(float x) { return fminf(x, 0.f) - log1pf(__expf(-fabsf(x))); }

struct Args { const float* in[17]; float* out; unsigned char* ws; int ph_lo, ph_hi; };
typedef const __attribute__((address_space(4))) Args* ArgsP;
enum { I_X = 0, I_MIXPRE, I_WIN, I_FOXFB, I_FOXON, I_SCW, I_GDNCW, I_GDNALOG, I_GDNDTB, I_GDNON, I_WOUT, I_MIXPOST, I_FFNPRE, I_WGATE, I_WUP, I_WDOWN, I_FFNPOST };
struct Ptrs {
    ArgsP ap;
    int tid, lane, wave, gw, NGW, G, bid;
};
__device__ __forceinline__ Ptrs fresh_ptrs(ArgsP ap0);
__device__ __forceinline__ int ftid() { int t = my_tid(); asm volatile("" : "+v"(t)); return t; }
__device__ __forceinline__ int fbid() { int b = blockIdx.x; asm volatile("" : "+s"(b)); return b; }
__device__ __forceinline__ ArgsP fresh(ArgsP a) { asm volatile("" : "+s"(a)); return a; }
__device__ __forceinline__ Ptrs fresh_ptrs(ArgsP ap0) { Ptrs P; P.ap = fresh(ap0); P.tid = ftid(); P.lane = P.tid & 63; P.wave = __builtin_amdgcn_readfirstlane(P.tid >> 6); P.bid = fbid();
    P.G = gridDim.x; P.gw = P.bid * NWAVES + P.wave; P.NGW = P.G * NWAVES; return P; }

__device__ __forceinline__ int win_src4(int d) {
    if (d < PC_SB) return d;
    if (d < PC_GQ) return d - PC_SB + SRC_SB;
    if (d < PC_GZ) return d - PC_GQ + SRC_GQ;
    if (d < PC_SMALL) return d - PC_GZ + SRC_GZ;
    const int e = d - PC_SMALL;
    if (e < 12) return SRC_FF + e;
    if (e < 24) return SRC_GA + e - 12;
    if (e < 36) return SRC_GB + e - 24;
    return -1;
}
struct TrItem { const float* W; int Ns, scol, k0; bf16* WT; int K, dn0; };
__device__ __forceinline__ void tr_load(const TrItem& t, f32x4 (&v)[8], int lane) {
    const int sub = lane >> 3;
#pragma unroll
    for (int i = 0; i < 8; ++i) { const int kk = 8 * i + sub; v[i] = (f32x4){0.f, 0.f, 0.f, 0.f}; if (t.scol >= 0) v[i] = *(const f32x4*)(t.W + (size_t)(t.k0 + kk) * t.Ns + t.scol); }
}
__device__ __forceinline__ void tr_store(const TrItem& t, const f32x4 (&v)[8], LAS float* scr, int lane) {
    const int sub = lane >> 3, g = lane & 7;
#pragma unroll
    for (int i = 0; i < 8; ++i) { const int kk = 8 * i + sub; LAS float* s = scr + kk * 33 + 4 * g; s[0] = v[i][0]; s[1] = v[i][1]; s[2] = v[i][2]; s[3] = v[i][3]; }
    LDS_WAIT(); asm volatile("" ::: "memory");
    const int c = lane & 7;
#pragma unroll
    for (int j = 0; j < 4; ++j) { const int n = (lane >> 3) + 8 * j; const LAS float* s = scr + (8 * c) * 33 + n;
        v4u o; o.x = pk2(s[0 * 33], s[1 * 33]); o.y = pk2(s[2 * 33], s[3 * 33]); o.z = pk2(s[4 * 33], s[5 * 33]); o.w = pk2(s[6 * 33], s[7 * 33]);
        *(v4u*)(t.WT + (size_t)(t.dn0 + n) * t.K + t.k0 + 8 * c) = o; }
    LDS_WAIT(); asm volatile("" ::: "memory");
}
constexpr int I_IN = 64 * (NP / 32), I_OUT = 64 * (DM / 32), I_GU = 64 * (NGU / 32), I_DN = (FFN / 64) * (DM / 32), I_LAYER = I_IN + I_OUT + I_GU + I_DN;
#ifndef CV_TAIL_DN
#define CV_TAIL_DN 12000
#endif
#ifndef CV_TAIL_IN
#define CV_TAIL_IN 25000
#endif
constexpr int I_3 = I_IN + I_OUT + I_GU;

typedef unsigned u32x2t __attribute__((ext_vector_type(2)));
__device__ __forceinline__ float sq4(const f32x4 v) { return (v[0] * v[0] + v[1] * v[1]) + (v[2] * v[2] + v[3] * v[3]); }
__device__ __forceinline__ void rms_row_to_bf16(const float* xrow, const float* gain, bf16* orow, int lane) {
    f32x4 a[16]; float ss = 0.f;
#pragma unroll
    for (int j = 0; j < 16; ++j) { a[j] = *(const f32x4*)(xrow + 256 * j + 4 * lane); ss += sq4(a[j]); }
    const float r = 1.0f / sqrtf(wave_sum(ss) * (1.0f / DM) + RMS_EPS);
#pragma unroll
    for (int j = 0; j < 16; ++j) { const f32x4 g = *(const f32x4*)(gain + 256 * j + 4 * lane);
        u32x2t o; o.x = pk2(a[j][0] * r * g[0], a[j][1] * r * g[1]); o.y = pk2(a[j][2] * r * g[2], a[j][3] * r * g[3]);
        *(u32x2t*)(orow + 256 * j + 4 * lane) = o; }
}
__device__ __forceinline__ void resid_norm_row(const float* base_row, const bf16* yrow, const float* ssrow, const float* gpost, float* out_row, const float* gnext, bf16* xn_row, int lane) {
    const float ry = 1.0f / sqrtf(wave_sum(ssrow[lane]) * (1.0f / DM) + RMS_EPS);
    f32x4 a[16]; float ss = 0.f;
#pragma unroll
    for (int j = 0; j < 16; ++j) { const int c = 256 * j + 4 * lane; const u32x2t yw = *(const u32x2t*)(yrow + c);
        const f32x4 x0 = *(const f32x4*)(base_row + c), g0 = *(const f32x4*)(gpost + c);
        a[j][0] = x0[0] + bflo(yw.x) * ry * g0[0]; a[j][1] = x0[1] + bfhi(yw.x) * ry * g0[1]; a[j][2] = x0[2] + bflo(yw.y) * ry * g0[2]; a[j][3] = x0[3] + bfhi(yw.y) * ry * g0[3];
        *(f32x4*)(out_row + c) = a[j]; ss += sq4(a[j]); }
    if (gnext) {
        const float r = 1.0f / sqrtf(wave_sum(ss) * (1.0f / DM) + RMS_EPS);
#pragma unroll
        for (int j = 0; j < 16; ++j) { const f32x4 g = *(const f32x4*)(gnext + 256 * j + 4 * lane);
            u32x2t o; o.x = pk2(a[j][0] * r * g[0], a[j][1] * r * g[1]); o.y = pk2(a[j][2] * r * g[2], a[j][3] * r * g[3]);
            *(u32x2t*)(xn_row + 256 * j + 4 * lane) = o; }
    }
}

__device__ __forceinline__ TrItem cv_item(ArgsP A, int l, int it, int g) {
    bf16* wl = (bf16*)(A->ws + WS_W);
    int r = it; TrItem t;
    if (r < I_IN) { const int kb = r / (NP / 32), nb = r % (NP / 32);
        t.W = A->in[I_WIN] + (size_t)l * DM * PROJ_SRC; t.Ns = PROJ_SRC; t.scol = win_src4(32 * nb + 4 * g); t.k0 = 64 * kb; t.WT = (bf16*)((unsigned char*)wl + WO_IN); t.K = DM; t.dn0 = 32 * nb; return t; }
    r -= I_IN;
    if (r < I_OUT) { const int kb = r / (DM / 32), nb = r % (DM / 32);
        t.W = A->in[I_WOUT] + (size_t)l * DM * DM; t.Ns = DM; t.scol = 32 * nb + 4 * g; t.k0 = 64 * kb; t.WT = (bf16*)((unsigned char*)wl + WO_OUT); t.K = DM; t.dn0 = 32 * nb; return t; }
    r -= I_OUT;
    if (r < I_GU) { const int kb = r / (NGU / 32), nb = r % (NGU / 32), dn0 = 32 * nb, j = dn0 >> 8, w = dn0 & 255;
        t.W = (w < 128 ? A->in[I_WGATE] : A->in[I_WUP]) + (size_t)l * DM * FFN; t.Ns = FFN; t.scol = 128 * j + (w & 127) + 4 * g; t.k0 = 64 * kb; t.WT = (bf16*)((unsigned char*)wl + WO_GU); t.K = DM; t.dn0 = dn0; return t; }
    r -= I_GU;
    { const int kb = r / (DM / 32), nb = r % (DM / 32);
        t.W = A->in[I_WDOWN] + (size_t)l * FFN * DM; t.Ns = DM; t.scol = 32 * nb + 4 * g; t.k0 = 64 * kb; t.WT = (bf16*)((unsigned char*)wl + WO_DN); t.K = FFN; t.dn0 = 32 * nb; return t; }
}
__device__ __forceinline__ void convert_weights(ArgsP ap0, LAS unsigned char* lds, int l, int lo = 0, int hi = I_LAYER, int wg_lo = 0) {
    const Ptrs P = fresh_ptrs(ap0); const ArgsP A = P.ap;
    if (P.bid < wg_lo) return;
    LAS float* scr = (LAS float*)(lds + P.wave * 16384);
    const int g = P.lane & 7, stride = (P.G - wg_lo) * NWAVES;
    int it = lo + (P.bid - wg_lo) * NWAVES + P.wave;
    if (it >= hi) return;
    f32x4 va[8], vb[8];
    tr_load(cv_item(A, l, it, g), va, P.lane);
    for (;;) {
        { const int nit = it + stride; const bool hasn = nit < hi; if (hasn) tr_load(cv_item(A, l, nit, g), vb, P.lane);
          tr_store(cv_item(A, l, it, g), va, scr, P.lane); if (!hasn) break; it = nit; }
        { const int nit = it + stride; const bool hasn = nit < hi; if (hasn) tr_load(cv_item(A, l, nit, g), va, P.lane);
          tr_store(cv_item(A, l, it, g), vb, scr, P.lane); if (!hasn) break; it = nit; }
    }
}
__device__ __forceinline__ void p0_prologue(ArgsP ap0, LAS unsigned char* lds) {
    convert_weights(ap0, lds, 0, 0, I_3);
    convert_weights(ap0, lds, 0, I_3 + CV_TAIL_DN, I_LAYER);
    const Ptrs P = fresh_ptrs(ap0); const ArgsP A = P.ap;
    bf16* XN = (bf16*)(A->ws + WS_XN);
    for (int m = P.gw; m < M; m += P.NGW) rms_row_to_bf16(A->in[I_X] + (size_t)m * DM, A->in[I_MIXPRE], XN + (size_t)m * DM, P.lane);
}

__device__ __forceinline__ void p2_prep(ArgsP ap0, LAS unsigned char* lds, int l) {
    const Ptrs P = fresh_ptrs(ap0); const ArgsP A = P.ap;
    const bf16* SCB = (const bf16*)(A->ws + WS_SCB); const float* SB = (const float*)(A->ws + WS_SB);
    bf16* MIX = (bf16*)(A->ws + WS_MIX); float* FG = (float*)(A->ws + WS_FG);
    const int lane = P.lane;
    if (P.bid < BATCH * FOXH) {
        const int bh = P.bid, b = bh / FOXH, h = bh % FOXH; const float fb = A->in[I_FOXFB][l * FOXH + h];
        const float* sb = SB + ((size_t)(b * SEQ) + 16 * P.tid) * SBW + SB_FF + h;
        float ls[16]; float loc = 0.f;
#pragma unroll
        for (int i = 0; i < 16; ++i) ls[i] = sb[(size_t)i * SBW];
#pragma unroll
        for (int i = 0; i < 16; ++i) { ls[i] = logsigmoid_f(ls[i] + fb); loc += ls[i]; }
        float incl = loc;
#pragma unroll
        for (int o = 1; o < 64; o <<= 1) { const float n = __shfl_up(incl, o); if (lane >= o) incl += n; }
        LAS float* wt = (LAS float*)lds;
        if (lane == 63) wt[P.wave] = incl;
        __syncthreads();
        float run = incl - loc;
        for (int w = 0; w < P.wave; ++w) run += wt[w];
        f32x4 o4[4];
#pragma unroll
        for (int i = 0; i < 16; ++i) { run += ls[i]; o4[i >> 2][i & 3] = -run * 11.313708498984761f; }
        float* fo = FG + (size_t)bh * SEQ + 16 * P.tid;
#pragma unroll
        for (int i = 0; i < 4; ++i) *(f32x4*)(fo + 4 * i) = o4[i];
        __syncthreads();
    }
    { const bf16* HMq = (const bf16*)(A->ws + WS_PROJ); float* TN = (float*)(A->ws + WS_TN);
      constexpr int NT_ = BATCH * FOXH * (SEQ / 64);
      for (int it = P.gw; it < NT_; it += P.NGW) {
        const int bh = it / (SEQ / 64), c = it % (SEQ / 64);
        const v4u* qrow = (const v4u*)(HMq + hm_off(HM_FQ, bh) + (size_t)(c * 64 + lane) * HD); const v4u* krow = (const v4u*)(HMq + hm_off(HM_FK, bh) + (size_t)(c * 64 + lane) * HD);
        v4u qv[16], kv[16];
#pragma unroll
        for (int j = 0; j < 16; ++j) { qv[j] = qrow[j]; kv[j] = krow[j]; }
        float sq = 0.f, sk = 0.f, d = 0.f;
#pragma unroll
        for (int j = 0; j < 16; ++j) {
#pragma unroll
            for (int e4 = 0; e4 < 4; ++e4) { const unsigned a = e4 == 0 ? qv[j].x : e4 == 1 ? qv[j].y : e4 == 2 ? qv[j].z : qv[j].w, b = e4 == 0 ? kv[j].x : e4 == 1 ? kv[j].y : e4 == 2 ? kv[j].z : kv[j].w;
                const float a0 = bflo(a), a1 = bfhi(a), b0 = bflo(b), b1 = bfhi(b); sq += a0 * a0 + a1 * a1; sk += b0 * b0 + b1 * b1; d += a0 * b0 + a1 * b1; } }
#pragma unroll
        for (int o = 1; o < 64; o <<= 1) { sq = fmaxf(sq, __shfl_xor(sq, o)); sk = fmaxf(sk, __shfl_xor(sk, o)); d = fminf(d, __shfl_xor(d, o)); }
        if (lane == 0) { TN[it] = sq; TN[NT_ + it] = sk; TN[2 * NT_ + it] = d; }
      } }
    { const float* cw = A->in[I_SCW] + (size_t)l * 3 * SCW;
      for (int idx = P.bid * 512 + P.tid; idx < M * (SCW / 8); idx += P.G * 512) {
        const int m = idx >> 7, c = (idx & 127) * 8, tp = m & (SEQ - 1);
        const bf16* row = SCB + (size_t)m * SCBW;
        const v4u bw = *(const v4u*)(row + c);
        float acc[8];
#pragma unroll
        for (int e = 0; e < 8; ++e) acc[e] = 0.f;
#pragma unroll
        for (int j = 0; j < 3; ++j) { const int dt = 2 - j;
            if (tp - dt >= 0) { const bf16* rj = row - (size_t)dt * SCBW; const v4u cwv = *(const v4u*)(rj + SCW + c), hw = *(const v4u*)(rj + 2 * SCW + c);
                const f32x4 w0 = *(const f32x4*)(cw + j * SCW + c), w1 = *(const f32x4*)(cw + j * SCW + c + 4);
                acc[0] += w0[0] * bflo(cwv.x) * bflo(hw.x); acc[1] += w0[1] * bfhi(cwv.x) * bfhi(hw.x); acc[2] += w0[2] * bflo(cwv.y) * bflo(hw.y); acc[3] += w0[3] * bfhi(cwv.y) * bfhi(hw.y);
                acc[4] += w1[0] * bflo(cwv.z) * bflo(hw.z); acc[5] += w1[1] * bfhi(cwv.z) * bfhi(hw.z); acc[6] += w1[2] * bflo(cwv.w) * bflo(hw.w); acc[7] += w1[3] * bfhi(cwv.w) * bfhi(hw.w); } }
        v4u o; o.x = pk2(acc[0] * bflo(bw.x), acc[1] * bfhi(bw.x)); o.y = pk2(acc[2] * bflo(bw.y), acc[3] * bfhi(bw.y)); o.z = pk2(acc[4] * bflo(bw.z), acc[5] * bfhi(bw.z)); o.w = pk2(acc[6] * bflo(bw.w), acc[7] * bfhi(bw.w));
        *(v4u*)(MIX + (size_t)m * DM + FOXW + c) = o; } }
}


#ifndef GP_REP_S1
#define GP_REP_S1 1
#endif
#ifndef GP_REP_S4
#define GP_REP_S4 1
#endif
constexpr int GD_OPS_BYTES = 57344;
constexpr int GD_F_WN = 0, GD_F_QD = 16, GD_F_AT = 32, GD_F_KT = 40;
constexpr int GD_NCH = SEQ / 64;
constexpr int GD_NCHH = BATCH * GDNH * GD_NCH;
constexpr size_t WS_GOPS = WS_Y, WS_GU = WS_Y + 168 * MiB, WS_GL = WS_Y + 264 * MiB, WS_GO2 = WS_Y + 266 * MiB;
constexpr int GP_QS = 0, GP_KS = 17408, GP_VS = 34816, GP_LT = 68608, GP_AT = 86016, GP_WM = 103424, GP_SM = 120832;
typedef float f32x2v __attribute__((ext_vector_type(2)));
typedef unsigned u32x2v __attribute__((ext_vector_type(2)));
typedef __bf16 bf16x2c_t __attribute__((ext_vector_type(2)));
__device__ __forceinline__ unsigned cvtpk_bf16(float lo, float hi) { const f32x2v v = {lo, hi}; const bf16x2c_t b = __builtin_convertvector(v, bf16x2c_t); return __builtin_bit_cast(unsigned, b); }


template <int N> __device__ __forceinline__ void fma_bcast(float& x, float l, float nxi) {
    asm volatile("v_fmac_f32_dpp %0, %1, %2 row_newbcast:%3 row_mask:0xf bank_mask:0xf" : "+v"(x) : "v"(l), "v"(nxi), "n"(N));
}
template <int I, int R> struct TriRow {
    static __device__ __forceinline__ void run(float (&x)[64], const float (&L)[4], float nxi) { fma_bcast<(R & 15)>(x[R], L[R >> 4], nxi); TriRow<I, R + 1>::run(x, L, nxi); }
};
template <int I> struct TriRow<I, 64> { static __device__ __forceinline__ void run(float (&)[64], const float (&)[4], float) {} };
template <int I> struct TriSolve {
    static __device__ __forceinline__ void run(float (&x)[64], const LAS float* ltb, float (&Lc)[4]) {
        float Ln[4] = {0.f, 0.f, 0.f, 0.f};
        if (I + 1 < 63) {
#pragma unroll
            for (int q = (I + 2) >> 4; q < 4; ++q) Ln[q] = ltb[(I + 1) * 68 + 16 * q]; }
        const float nxi = -x[I];
        asm volatile("s_nop 1" ::: "memory");
        TriRow<I, I + 1>::run(x, Lc, nxi);
#pragma unroll
        for (int q = 0; q < 4; ++q) Lc[q] = Ln[q];
        TriSolve<I + 1>::run(x, ltb, Lc);
    }
};
template <> struct TriSolve<63> { static __device__ __forceinline__ void run(float (&)[64], const LAS float*, float (&)[4]) {} };


template <int NT, int PA = 0, int PB = 3>
__device__ __forceinline__ void gp_s1(LAS unsigned char* lds, const bf16* HMG, const float* cw, int ch, int ltid) {
    const int bh = ch / GD_NCH, n = ch % GD_NCH, h = bh % GDNH;
    constexpr int NI = 3072 / NT, PER = NI / 3, ROWS = NT / 16, NB = (NT == 256 ? 4 : 3);
    const int c = (ltid & 15) * 8;
#pragma unroll
    for (int i0 = PA * PER; i0 < PB * PER; i0 += NB) {
        v4u xw[NB][4];
#pragma unroll
        for (int ib = 0; ib < NB; ++ib) { const int i = i0 + ib, part = i / PER, t = (i % PER) * ROWS + (ltid >> 4), tp = n * 64 + t;
            const bf16* src = HMG + hm_off(part, bh) + (size_t)(n * 64 + t) * HD + c;
#pragma unroll
            for (int j = 0; j < 4; ++j) { xw[ib][j] = (v4u){0u, 0u, 0u, 0u}; if (tp - (3 - j) >= 0) xw[ib][j] = *(const v4u*)(src - (size_t)(3 - j) * HD); } }
#pragma unroll
        for (int ib = 0; ib < NB; ++ib) { const int i = i0 + ib, part = i / PER, t = (i % PER) * ROWS + (ltid >> 4);
            const float* wp = cw + part * GDNW + h * HD + c;
            float acc[8];
#pragma unroll
            for (int e = 0; e < 8; ++e) acc[e] = 0.f;
#pragma unroll
            for (int j = 0; j < 4; ++j) { const v4u xv = xw[ib][j]; const f32x4 w0 = *(const f32x4*)(wp + j * (3 * GDNW)), w1 = *(const f32x4*)(wp + j * (3 * GDNW) + 4);
                acc[0] += w0[0] * bflo(xv.x); acc[1] += w0[1] * bfhi(xv.x); acc[2] += w0[2] * bflo(xv.y); acc[3] += w0[3] * bfhi(xv.y);
                acc[4] += w1[0] * bflo(xv.z); acc[5] += w1[1] * bfhi(xv.z); acc[6] += w1[2] * bflo(xv.w); acc[7] += w1[3] * bfhi(xv.w); }
            float ss = 0.f;
#pragma unroll
            for (int e = 0; e < 8; ++e) { acc[e] = acc[e] * __builtin_amdgcn_rcpf(1.0f + __builtin_amdgcn_exp2f(-1.4426950408889634f * acc[e])); ss += acc[e] * acc[e]; }
            if (part < 2) {
                ss += __shfl_xor(ss, 1); ss += __shfl_xor(ss, 2); ss += __shfl_xor(ss, 4); ss += __shfl_xor(ss, 8);
                const float r = (1.0f / sqrtf(ss + RMS_EPS)) * (part == 0 ? 0.08838834764831845f : 1.0f);
                v4u o; o.x = cvtpk_bf16(acc[0] * r, acc[1] * r); o.y = cvtpk_bf16(acc[2] * r, acc[3] * r); o.z = cvtpk_bf16(acc[4] * r, acc[5] * r); o.w = cvtpk_bf16(acc[6] * r, acc[7] * r);
                *(LAS v4u*)(lds + (part == 0 ? GP_QS : GP_KS) + (t * 136 + c) * 2) = o;
            } else {
                LAS float* vp = (LAS float*)(lds + GP_VS) + t * 132 + c;
                *(LAS f32x4*)vp = (f32x4){acc[0], acc[1], acc[2], acc[3]}; *(LAS f32x4*)(vp + 4) = (f32x4){acc[4], acc[5], acc[6], acc[7]};
            }
        }
    }
}
__device__ __forceinline__ void gp_s2(ArgsP A, LAS float* SMf, const float* SB, float* GL, int l, int ch, int lane) {
    const int bh = ch / GD_NCH, n = ch % GD_NCH, b = bh / GDNH, h = bh % GDNH;
    const size_t m = (size_t)b * SEQ + (size_t)n * 64 + lane;
    const float xb = SB[m * SBW + SB_GB + h], xa = SB[m * SBW + SB_GA + h] + A->in[I_GDNDTB][l * GDNH + h];
    const float bt = __builtin_amdgcn_rcpf(1.0f + __builtin_amdgcn_exp2f(-1.4426950408889634f * xb));
    const float sp = fmaxf(xa, 0.f) + 0.6931471805599453f * __builtin_amdgcn_logf(1.0f + __builtin_amdgcn_exp2f(-1.4426950408889634f * fabsf(xa)));
    const float gg = -__builtin_amdgcn_exp2f(1.4426950408889634f * A->in[I_GDNALOG][l * GDNH + h]) * sp;
    float gc = gg;
#pragma unroll
    for (int o = 1; o < 64; o <<= 1) { const float nb = __shfl_up(gc, o); if (lane >= o) gc += nb; }
    const float gtot = __shfl(gc, 63);
    SMf[lane] = bt; SMf[64 + lane] = gc; SMf[128 + lane] = __builtin_amdgcn_exp2f(1.4426950408889634f * gc); SMf[192 + lane] = __builtin_amdgcn_exp2f(1.4426950408889634f * (gtot - gc));
    if (lane == 63) GL[ch] = __builtin_amdgcn_exp2f(1.4426950408889634f * gtot);
}

__device__ __forceinline__ void gdn_prep(ArgsP ap0, LAS unsigned char* lds, int l) {
    const Ptrs P = fresh_ptrs(ap0); const ArgsP A = P.ap;
    const int tid = P.tid, lane = P.lane, wave = P.wave;
    const bf16* HMG = (const bf16*)(A->ws + WS_PROJ) + hm_off(HM_GQ, 0); const float* SB = (const float*)(A->ws + WS_SB);
    unsigned char* GOPS = A->ws + WS_GOPS; float* GU = (float*)(A->ws + WS_GU); float* GL = (float*)(A->ws + WS_GL);
    const float* cw = A->in[I_GDNCW] + (size_t)l * 4 * (3 * GDNW);
    LAS float* SMf = (LAS float*)(lds + GP_SM);
    LAS unsigned* hb = (LAS unsigned*)(lds + GP_SM + 1024); unsigned hb_epoch = 0u;
    if (tid == 0) *hb = 0u;
    if (P.bid < GD_NCHH) { gp_s1<512>(lds, HMG, cw, P.bid, tid); if (wave == 0) gp_s2(A, SMf, SB, GL, l, P.bid, lane); }
    for (int ch = P.bid; ch < GD_NCHH; ch += P.G) {
        const int bh = ch / GD_NCH, n = ch % GD_NCH, b = bh / GDNH, h = bh % GDNH;
        const size_t row0 = (size_t)b * SEQ + (size_t)n * 64;
        (void)b; (void)h; (void)row0; (void)n;
        __syncthreads();
        {
            const int mat = wave >> 2, mt = wave & 3, q4 = lane >> 4, m16 = lane & 15;
            f32x4 acc[4];
#pragma unroll
            for (int nt = 0; nt < 4; ++nt) acc[nt] = (f32x4){0.f, 0.f, 0.f, 0.f};
            const LAS unsigned char* abase = lds + (mat == 0 ? GP_KS : GP_QS) + ((16 * mt + m16) * 136 + 8 * q4) * 2;
            const LAS unsigned char* bbase = lds + GP_KS + (m16 * 136 + 8 * q4) * 2;
#pragma unroll
            for (int ks = 0; ks < 4; ++ks) { const bf16x8 a = *(const LAS bf16x8*)(abase + ks * 64);
#pragma unroll
                for (int nt = 0; nt < 4; ++nt) { const bf16x8 bb = *(const LAS bf16x8*)(bbase + nt * (16 * 136 * 2) + ks * 64); acc[nt] = __builtin_amdgcn_mfma_f32_16x16x32_bf16(a, bb, acc[nt], 0, 0, 0); } }
            const int c0 = 16 * mt + 4 * q4;
            const f32x4 gcc = *(const LAS f32x4*)(SMf + 64 + c0), btc = *(const LAS f32x4*)(SMf + c0);
#pragma unroll
            for (int nt = 0; nt < 4; ++nt) { const int s = 16 * nt + m16; const float gs = SMf[64 + s];
                if (mat == 0) { f32x4 o;
#pragma unroll
                    for (int r = 0; r < 4; ++r) o[r] = (s < c0 + r) ? btc[r] * acc[nt][r] * __builtin_amdgcn_exp2f(1.4426950408889634f * (gcc[r] - gs)) : 0.f;
                    *(LAS f32x4*)((LAS float*)(lds + GP_LT) + s * 68 + c0) = o;
                } else {
#pragma unroll
                    for (int r = 0; r < 4; ++r) ((LAS float*)(lds + GP_AT))[(c0 + r) * 68 + s] = (s <= c0 + r) ? acc[nt][r] * __builtin_amdgcn_exp2f(1.4426950408889634f * (gcc[r] - gs)) : 0.f;
                } }
        }
        __syncthreads();
        float x[64];
        if (tid < 256) {
            const int j = tid & 127, isw = tid >> 7;
            int vz = 0; asm volatile("" : "+v"(vz));
            const LAS float* SMv = SMf + vz;
#pragma unroll
            for (int r4 = 0; r4 < 16; ++r4) { const f32x4 bt = *(const LAS f32x4*)(SMv + 4 * r4), eg = *(const LAS f32x4*)(SMv + 128 + 4 * r4);
#pragma unroll
                for (int e = 0; e < 4; ++e) { const int r = 4 * r4 + e;
                    x[r] = isw ? __uint_as_float((unsigned)(*(const LAS unsigned short*)(lds + GP_KS + (r * 136 + j) * 2)) << 16) * (bt[e] * eg[e]) : ((const LAS float*)(lds + GP_VS))[r * 132 + j] * bt[e]; } }
        }
        __syncthreads();
        if (tid < 256) {
            const int j = tid & 127, isw = tid >> 7;
            { const LAS float* ltb = (const LAS float*)(lds + GP_LT) + (lane & 15);
              float Lc[4];
#pragma unroll
              for (int q = 0; q < 4; ++q) Lc[q] = ltb[16 * q];
              TriSolve<0>::run(x, ltb, Lc); }
            if (!isw) { float* up = GU + (size_t)ch * 8192 + (size_t)((j >> 4) * 4) * 256 + (j & 15) * 4;
#pragma unroll
                for (int mt = 0; mt < 4; ++mt)
#pragma unroll
                    for (int q4 = 0; q4 < 4; ++q4) *(f32x4*)(up + mt * 256 + q4 * 64) = (f32x4){x[16 * mt + 4 * q4], x[16 * mt + 4 * q4 + 1], x[16 * mt + 4 * q4 + 2], x[16 * mt + 4 * q4 + 3]};
            } else {
#pragma unroll
                for (int r = 0; r < 64; ++r) *(LAS unsigned short*)(lds + GP_WM + (r * 136 + j) * 2) = (unsigned short)f2bf(-x[r]);
            }
            if (ch + P.G < GD_NCHH) gp_s1<256, 2, 3>(lds, HMG, cw, ch + P.G, tid);
        } else {
            const int wv = wave - 4, q4 = lane >> 4, m16 = lane & 15;
            unsigned char* dst = GOPS + (size_t)ch * GD_OPS_BYTES + lane * 16;
            for (int f = wv; f < 40; f += 4) {
                v4u o;
                if (f < 16) { const int mt = f >> 2, ks = f & 3, row = 16 * mt + m16; const float eg = SMf[128 + row];
                    const LAS unsigned char* p = lds + GP_QS + (row * 136 + 32 * ks + 4 * q4) * 2;
                    const u32x2v a = *(const LAS u32x2v*)p, bq = *(const LAS u32x2v*)(p + 32);
                    o.x = cvtpk_bf16(bflo(a.x) * eg, bfhi(a.x) * eg); o.y = cvtpk_bf16(bflo(a.y) * eg, bfhi(a.y) * eg); o.z = cvtpk_bf16(bflo(bq.x) * eg, bfhi(bq.x) * eg); o.w = cvtpk_bf16(bflo(bq.y) * eg, bfhi(bq.y) * eg);
                    *(v4u*)(dst + (GD_F_QD + f) * 1024) = o;
                } else if (f < 24) { const int ff = f - 16, mt = ff >> 1, ks = ff & 1, row = 16 * mt + m16;
                    const LAS float* p = (const LAS float*)(lds + GP_AT) + row * 68 + 32 * ks + 4 * q4;
                    const f32x4 a = *(const LAS f32x4*)p, bq = *(const LAS f32x4*)(p + 16);
                    o.x = cvtpk_bf16(a[0], a[1]); o.y = cvtpk_bf16(a[2], a[3]); o.z = cvtpk_bf16(bq[0], bq[1]); o.w = cvtpk_bf16(bq[2], bq[3]);
                    *(v4u*)(dst + (GD_F_AT + ff) * 1024) = o;
                } else { const int ff = f - 24, mt = ff >> 1, ks = ff & 1, dk = 16 * mt + m16;
                    const int cA = 32 * ks + 4 * q4; const f32x4 ekA = *(const LAS f32x4*)(SMf + 192 + cA), ekB = *(const LAS f32x4*)(SMf + 192 + cA + 16);
                    float kv[8];
#pragma unroll
                    for (int e = 0; e < 4; ++e) { kv[e] = __uint_as_float((unsigned)(*(const LAS unsigned short*)(lds + GP_KS + ((cA + e) * 136 + dk) * 2)) << 16) * ekA[e];
                                                  kv[4 + e] = __uint_as_float((unsigned)(*(const LAS unsigned short*)(lds + GP_KS + ((cA + 16 + e) * 136 + dk) * 2)) << 16) * ekB[e]; }
                    o.x = cvtpk_bf16(kv[0], kv[1]); o.y = cvtpk_bf16(kv[2], kv[3]); o.z = cvtpk_bf16(kv[4], kv[5]); o.w = cvtpk_bf16(kv[6], kv[7]);
                    *(v4u*)(dst + (GD_F_KT + ff) * 1024) = o;
                }
            }
            if (ch + P.G < GD_NCHH) {
                asm volatile("s_waitcnt lgkmcnt(0)" ::: "memory");
                ++hb_epoch;
                if (lane == 0) (void)__hip_atomic_fetch_add(hb, 1u, __ATOMIC_RELAXED, __HIP_MEMORY_SCOPE_WORKGROUP);
                while (__hip_atomic_load(hb, __ATOMIC_RELAXED, __HIP_MEMORY_SCOPE_WORKGROUP) < 4u * hb_epoch) __builtin_amdgcn_s_sleep(1);
                asm volatile("" ::: "memory");
                gp_s1<256, 0, 2>(lds, HMG, cw, ch + P.G, tid - 256); if (wave == 4) gp_s2(A, SMf, SB, GL, l, ch + P.G, lane); }
        }
        __syncthreads();
        { const int q4 = lane >> 4, m16 = lane & 15;
#pragma unroll
          for (int k2 = 0; k2 < 2; ++k2) { const int f = wave * 2 + k2, mt = f >> 2, ks = f & 3, row = 16 * mt + m16;
            const LAS unsigned char* p = lds + GP_WM + (row * 136 + 32 * ks + 4 * q4) * 2;
            const u32x2v a = *(const LAS u32x2v*)p, bq = *(const LAS u32x2v*)(p + 32);
            v4u o; o.x = a.x; o.y = a.y; o.z = bq.x; o.w = bq.y;
            *(v4u*)(GOPS + (size_t)ch * GD_OPS_BYTES + (GD_F_WN + f) * 1024 + lane * 16) = o; } }
    }
    __syncthreads();
}

__device__ __forceinline__ void gdn_scan(ArgsP ap0, LAS unsigned char* lds) {
    const Ptrs P = fresh_ptrs(ap0); const ArgsP A = P.ap;
    const int lane = P.lane, wave = P.wave, bh = P.bid >> 1, b = bh / GDNH, h = bh % GDNH, q4 = lane >> 4, n16 = lane & 15;
    const int cs = (P.bid & 1) * 4 + (wave & 3);
    const bool comp = wave < 4;
    const unsigned char* ops = A->ws + WS_GOPS + (size_t)bh * GD_NCH * GD_OPS_BYTES;
    const float* Up = (const float*)(A->ws + WS_GU) + (size_t)bh * GD_NCH * 8192 + (size_t)(cs * 4) * 256 + lane * 4;
    const float* GLp = (const float*)(A->ws + WS_GL) + (size_t)bh * GD_NCH;
    float* GO = (float*)(A->ws + WS_GO2) + ((size_t)b * SEQ) * GDNW + h * HD + 16 * cs + n16;
    f32x4 S[8];
#pragma unroll
    for (int i = 0; i < 8; ++i) S[i] = (f32x4){0.f, 0.f, 0.f, 0.f};
    f32x4 Un[4]; float gln = 0.f;
#pragma unroll
    for (int i = 0; i < 4; ++i) Un[i] = (f32x4){0.f, 0.f, 0.f, 0.f};
#define GD_DMA(nn, buf) do { _Pragma("unroll") for (int i_ = 0; i_ < 7; ++i_) __builtin_amdgcn_global_load_lds((const unsigned*)(ops + (size_t)(nn) * GD_OPS_BYTES + (i_ * 8 + wave) * 1024 + lane * 16), \
        (LAS unsigned*)(lds + (buf) * GD_OPS_BYTES + (i_ * 8 + wave) * 1024), 16, 0, 0); } while (0)
#define GD_ULOAD(nn) do { if (comp) { _Pragma("unroll") for (int mt_ = 0; mt_ < 4; ++mt_) Un[mt_] = *(const f32x4*)(Up + (size_t)(nn) * 8192 + mt_ * 256); gln = GLp[nn]; } } while (0)
    GD_DMA(0, 0); GD_ULOAD(0);
    for (int n = 0; n < GD_NCH; ++n) {
        asm volatile("s_waitcnt vmcnt(0)" ::: "memory");
        __syncthreads();
        f32x4 Uc[4]; const float gl = gln;
#pragma unroll
        for (int mt = 0; mt < 4; ++mt) Uc[mt] = Un[mt];
        if (n + 1 < GD_NCH) { GD_DMA(n + 1, (n + 1) & 1); GD_ULOAD(n + 1); }
        if (comp) {
        const LAS unsigned char* fr = lds + (n & 1) * GD_OPS_BYTES + lane * 16;
#define GD_FRAG(f) (*(const LAS bf16x8*)(fr + (f) * 1024))
        bf16x8 Sb[4];
#pragma unroll
        for (int ks = 0; ks < 4; ++ks) { v4u w; w.x = cvtpk_bf16(S[2 * ks][0], S[2 * ks][1]); w.y = cvtpk_bf16(S[2 * ks][2], S[2 * ks][3]); w.z = cvtpk_bf16(S[2 * ks + 1][0], S[2 * ks + 1][1]); w.w = cvtpk_bf16(S[2 * ks + 1][2], S[2 * ks + 1][3]);
            Sb[ks] = __builtin_bit_cast(bf16x8, w); }
        f32x4 vn[4];
#pragma unroll
        for (int mt = 0; mt < 4; ++mt) { vn[mt] = Uc[mt];
#pragma unroll
            for (int ks = 0; ks < 4; ++ks) vn[mt] = __builtin_amdgcn_mfma_f32_16x16x32_bf16(GD_FRAG(GD_F_WN + mt * 4 + ks), Sb[ks], vn[mt], 0, 0, 0); }
        bf16x8 Vb[2];
#pragma unroll
        for (int ks = 0; ks < 2; ++ks) { v4u w; w.x = cvtpk_bf16(vn[2 * ks][0], vn[2 * ks][1]); w.y = cvtpk_bf16(vn[2 * ks][2], vn[2 * ks][3]); w.z = cvtpk_bf16(vn[2 * ks + 1][0], vn[2 * ks + 1][1]); w.w = cvtpk_bf16(vn[2 * ks + 1][2], vn[2 * ks + 1][3]);
            Vb[ks] = __builtin_bit_cast(bf16x8, w); }
        float* orow = GO + (size_t)(n * 64 + 4 * q4) * GDNW;
#pragma unroll
        for (int mt = 0; mt < 4; ++mt) { f32x4 o = (f32x4){0.f, 0.f, 0.f, 0.f};
#pragma unroll
            for (int ks = 0; ks < 4; ++ks) o = __builtin_amdgcn_mfma_f32_16x16x32_bf16(GD_FRAG(GD_F_QD + mt * 4 + ks), Sb[ks], o, 0, 0, 0);
#pragma unroll
            for (int ks = 0; ks < 2; ++ks) o = __builtin_amdgcn_mfma_f32_16x16x32_bf16(GD_FRAG(GD_F_AT + mt * 2 + ks), Vb[ks], o, 0, 0, 0);
#pragma unroll
            for (int r = 0; r < 4; ++r) orow[(size_t)(16 * mt + r) * GDNW] = o[r]; }
#pragma unroll
        for (int mt = 0; mt < 8; ++mt) { S[mt] = S[mt] * gl;
#pragma unroll
            for (int ks = 0; ks < 2; ++ks) S[mt] = __builtin_amdgcn_mfma_f32_16x16x32_bf16(GD_FRAG(GD_F_KT + mt * 2 + ks), Vb[ks], S[mt], 0, 0, 0); }
        }
    }
#undef GD_FRAG
#undef GD_DMA
#undef GD_ULOAD
    asm volatile("s_waitcnt vmcnt(0)" ::: "memory");
    __syncthreads();
}
__device__ __forceinline__ void p4_finalize(ArgsP ap0, int l) {
    const Ptrs P = fresh_ptrs(ap0); const ArgsP A = P.ap;
    const float* GO = (const float*)(A->ws + WS_GO2); const bf16* HMZ = (const bf16*)(A->ws + WS_PROJ) + hm_off(HM_GZ, 0);
    bf16* MIX = (bf16*)(A->ws + WS_MIX); const int lane = P.lane;
    typedef float f32x2 __attribute__((ext_vector_type(2)));
    const f32x2 gg = *(const f32x2*)(A->in[I_GDNON] + l * HD + 2 * lane);
    for (int m = P.gw; m < M; m += P.NGW) {
        const int b = m / SEQ, s = m % SEQ;
        f32x2 v[GDNH]; unsigned zw[GDNH];
#pragma unroll
        for (int h = 0; h < GDNH; ++h) { v[h] = *(const f32x2*)(GO + (size_t)m * GDNW + h * HD + 2 * lane); zw[h] = *(const unsigned*)(HMZ + ((size_t)(b * GDNH + h) * SEQ + s) * HD + 2 * lane); }
        float ss[GDNH];
#pragma unroll
        for (int h = 0; h < GDNH; ++h) ss[h] = v[h][0] * v[h][0] + v[h][1] * v[h][1];
#pragma unroll
        for (int o = 1; o < 64; o <<= 1) {
#pragma unroll
            for (int h = 0; h < GDNH; ++h) ss[h] += __shfl_xor(ss[h], o); }
#pragma unroll
        for (int h = 0; h < GDNH; ++h) { const float rr = 1.0f / sqrtf(ss[h] * (1.0f / HD) + RMS_EPS);
            *(unsigned*)(MIX + (size_t)m * DM + FOXW + SCW + h * HD + 2 * lane) = pk2(v[h][0] * rr * gg[0] * silu_acc(bflo(zw[h])), v[h][1] * rr * gg[1] * silu_acc(bfhi(zw[h]))); }
    }
}

constexpr int ATT_PER_X = 3 * (SEQ / attn::QB);
constexpr int ATT_SLOT_OFF = 69632;
static_assert(attn::LDS_BYTES <= ATT_SLOT_OFF, "attention LDS map");
typedef attn::BlockRef<attn::bf16, attn::bf16> FoxRef;
__device__ __forceinline__ int fox_jlo(ArgsP A, int l, int bh, int P0) {
    (void)l;
    const float* FG = (const float*)(A->ws + WS_FG) + (size_t)bh * SEQ; const float* TN = (const float*)(A->ws + WS_TN);
    constexpr int NT_ = BATCH * FOXH * (SEQ / 64);
    const int lane = my_lane(), jd = P0 / attn::KVBLK, tb = bh * (SEQ / 64);
    float qn2 = 0.f, lb = 3.0e38f;
#pragma unroll
    for (int i = 0; i < 4; ++i) { qn2 = fmaxf(qn2, TN[tb + jd + i]); lb = fminf(lb, TN[2 * NT_ + tb + jd + i] + FG[64 * (jd + i)]); }
    const float qnb = sqrtf(qn2) * 1.001f;
    const bool s0 = qnb * sqrtf(TN[NT_ + tb + lane]) + FG[64 * lane + 63] - lb < -600.0f, s1 = qnb * sqrtf(TN[NT_ + tb + lane + 64]) + FG[64 * (lane + 64) + 63] - lb < -600.0f;
    const unsigned long long n0 = ~__ballot(s0), n1 = ~__ballot(s1);
    const int n = n0 ? __builtin_ctzll(n0) : 64 + (n1 ? __builtin_ctzll(n1) : 64);
    return __builtin_amdgcn_readfirstlane(n < jd ? n : jd);
}
__device__ __forceinline__ void fox_head_table(ArgsP A, volatile LAS int* hmap, int lane) {
    const float* FG = (const float*)(A->ws + WS_FG);
    const float v = lane < BATCH * FOXH ? FG[(size_t)lane * SEQ + (SEQ - 1)] : 3.0e38f;
    int rank = 0;
    for (int j = 0; j < BATCH * FOXH; ++j) { const float vj = __shfl(v, j); rank += (vj < v || (vj == v && j < lane)) ? 1 : 0; }
    if (lane < BATCH * FOXH) { const int slot = rank >> 3, qx = slot == 1 ? 15 - rank : (rank & 7); hmap[qx * 3 + slot] = lane; }
}
__device__ __forceinline__ FoxRef fox_ref(ArgsP A, int id, int l, volatile LAS int* hmap) {
    const int qx = id / ATT_PER_X, i = id % ATT_PER_X, bh = __builtin_amdgcn_readfirstlane(hmap[qx * 3 + (i >> 5)]), qb = 31 - (i & 31);
    const int b = bh / FOXH, h = bh % FOXH; const size_t row0 = (size_t)b * SEQ;
    const attn::bf16* HM = (const attn::bf16*)(A->ws + WS_PROJ);
    FoxRef r;
    r.Q = HM + hm_off(HM_FQ, bh) + (size_t)qb * attn::QB * HD;
    r.K = HM + hm_off(HM_FK, bh); r.V = HM + hm_off(HM_FV, bh);
    r.F = (const float*)(A->ws + WS_FG) + (size_t)bh * SEQ;
    r.O = (attn::bf16*)(A->ws + WS_MIX) + (row0 + (size_t)qb * attn::QB) * DM + h * HD; r.P0 = qb * attn::QB; r.JLO = fox_jlo(A, l, bh, r.P0);
    return r;
}
__device__ __forceinline__ int att_claim(gu32* ctrs, volatile LAS int* st) {
    int qx = st[0], tried = st[1], r = -1;
    while (tried < 8) { const unsigned i = __hip_atomic_fetch_add(ctrs + qx * 64, 1u, __ATOMIC_RELAXED, __HIP_MEMORY_SCOPE_AGENT); if (i < (unsigned)ATT_PER_X) { r = qx * ATT_PER_X + (int)i; break; } qx = (qx + 1) & 7; ++tried; }
    st[0] = qx; st[1] = tried;
    return r;
}
__device__ __forceinline__ void p3_attention(ArgsP ap0, char* lds, int l, int rep = 0) {
    const ArgsP A = fresh(ap0);
    gu32* ctrs = (gu32*)(A->ws + WS_CTL) + CW_Q + (rep * 2 + l) * 8 * 64;
    volatile LAS int* slot = (volatile LAS int*)((LAS unsigned char*)lds + ATT_SLOT_OFF);
    volatile LAS int* hmap = slot + 8;
    { const int t_ = ftid(); if (t_ < 64) fox_head_table(A, hmap, t_); if (t_ == 0) { slot[4] = (int)(xb_xcc_id() & 7u); slot[5] = 0; slot[0] = att_claim(ctrs, slot + 4); slot[1] = att_claim(ctrs, slot + 4); } }
    __syncthreads();
    int cur = __builtin_amdgcn_readfirstlane(slot[0]), nxt = __builtin_amdgcn_readfirstlane(slot[1]);
    if (cur < 0) return;
    FoxRef curR = fox_ref(A, cur, l, hmap);
    attn::Seam<attn::bf16> S;
    attn::causal_swa_prime<attn::bf16, attn::bf16>(curR, SEQ, lds, S);
    for (int k = 0;; ++k) {
        if (nxt >= 0 && ftid() == 0) slot[2 + (k & 1)] = att_claim(ctrs, slot + 4);
        const bool last = nxt < 0;
        const FoxRef nxtR = last ? curR : fox_ref(A, nxt, l, hmap);
        attn::causal_swa_block<attn::bf16, attn::bf16>(curR, nxtR, SEQ, SEQ, lds, S, &A->in[I_FOXON], l * HD);
        if (last) break;
        cur = nxt; curR = nxtR; nxt = __builtin_amdgcn_readfirstlane(slot[2 + (k & 1)]);
    }
}

constexpr int N_PHASES = 1 + 9 * DEPTH;

#ifndef PH_EN
#define PH_EN 0x3ff
#endif
#define IN(k) (lo <= (k) && (k) < hi)
#define EN(j) ((PH_EN >> (j)) & 1)
#ifndef REP_MASK
#define REP_MASK 0
#endif
#ifndef EXTRA_BARS
#define EXTRA_BARS 0
#endif
#define REPS(j) (((REP_MASK >> (j)) & 1) ? 2 : 1)
#define SEAM(k) do { if (IN(k) && IN((k) + 1)) { XcdBarrier b_; b_.bar = (unsigned*)(fresh(ap0)->ws + WS_CTL) + CW_BAR; b_.x = xb_xcc_id(); b_.st = (volatile LAS unsigned*)((LAS unsigned char*)lds + MISC_OFF) + 8; xcd_barrier(b_); } } while (0)
#define WSP(T, off) ((T*)(A->ws + (off)))


template <int l>
__device__ __forceinline__ void layer_phases(ArgsP ap0, LAS unsigned char* ldsl, unsigned char* lds, int lo, int hi) {

        const int pb = 1 + 9 * l;
        if (EN(1) && IN(pb + 0)) {
            const Ptrs P = fresh_ptrs(ap0); const ArgsP A = P.ap;
            pg8::Gemm g{WSP(bf16, WS_XN), WSP(bf16, WS_W + WO_IN), M, NP, DM}; pg8::StaticOrder S; S.init(M, NP, P.G, P.bid);
            pg8::EpiProj E{WSP(bf16, WS_PROJ), WSP(bf16, WS_SCB), WSP(float, WS_SB)};
            for (int rep_ = 0; rep_ < REPS(1); ++rep_) pg8::gemm_phase<pg8::EpiProj, pg8::StaticOrder, true, true>(ldsl, g, S, E);
            convert_weights(ap0, ldsl, l, I_3, I_3 + CV_TAIL_DN, (M / 256) * (NP / 256) % P.G);
            SEAM(pb + 0);
        }
        if (EN(2) && IN(pb + 1)) {
            for (int rep_ = 0; rep_ < REPS(11); ++rep_) p2_prep(ap0, ldsl, l);
            for (int rep_ = 0; rep_ < REPS(2); ++rep_) gdn_prep(ap0, ldsl, l);
            SEAM(pb + 1);
            for (int xb_ = 0; xb_ < EXTRA_BARS; ++xb_) SEAM(pb + 1);
            }
        if (EN(3) && IN(pb + 2)) {
            for (int rep_ = 0; rep_ < REPS(10); ++rep_) if ((int)blockIdx.x < 2 * BATCH * GDNH) gdn_scan(ap0, ldsl);
            for (int rep_ = 0; rep_ < REPS(3); ++rep_) p3_attention(ap0, (char*)lds, l, rep_);
            SEAM(pb + 2);
        }
        if (EN(4) && IN(pb + 3)) { for (int rep_ = 0; rep_ < REPS(4); ++rep_) p4_finalize(ap0, l); SEAM(pb + 3); }
        if (EN(5) && IN(pb + 4)) {
            const Ptrs P = fresh_ptrs(ap0); const ArgsP A = P.ap;
            pg8::Gemm g{WSP(bf16, WS_MIX), WSP(bf16, WS_W + WO_OUT), M, DM, DM}; pg8::StaticOrder S; S.init(M, DM, P.G, P.bid);
            pg8::EpiY E{WSP(bf16, WS_Y), WSP(float, WS_SS)};
            for (int rep_ = 0; rep_ < REPS(5); ++rep_) pg8::gemm_phase<pg8::EpiY, pg8::StaticOrder, true, true>(ldsl, g, S, E);
            SEAM(pb + 4);
        }
        if (EN(6) && IN(pb + 5)) {
            const Ptrs P = fresh_ptrs(ap0); const ArgsP A = P.ap;
            const float* xin = l == 0 ? A->in[I_X] : (const float*)A->out;
            const float* gpost = A->in[I_MIXPOST] + l * DM; const float* gpre = A->in[I_FFNPRE] + l * DM;
            const bf16* Y = WSP(bf16, WS_Y); const float* SS = WSP(float, WS_SS); float* H = WSP(float, WS_H); bf16* XN = WSP(bf16, WS_XN);
            for (int rep_ = 0; rep_ < REPS(6); ++rep_)
            for (int m = P.gw; m < M; m += P.NGW)
                resid_norm_row(xin + (size_t)m * DM, Y + (size_t)m * DM, SS + (size_t)m * 64, gpost, H + (size_t)m * DM, gpre, XN + (size_t)m * DM, P.lane);
            SEAM(pb + 5);
        }
        if (EN(7) && IN(pb + 6)) {
            const Ptrs P = fresh_ptrs(ap0); const ArgsP A = P.ap;
            pg8::Gemm g{WSP(bf16, WS_XN), WSP(bf16, WS_W + WO_GU), M, NGU, DM}; pg8::StaticOrder S; S.init(M, NGU, P.G, P.bid);
            pg8::EpiSwiGLU E{WSP(bf16, WS_PROJ)};
            for (int rep_ = 0; rep_ < REPS(7); ++rep_) pg8::gemm_phase<pg8::EpiSwiGLU, pg8::StaticOrder, true, true>(ldsl, g, S, E);
            if (l + 1 < DEPTH) convert_weights(ap0, ldsl, l + 1, 0, CV_TAIL_IN, (M / 256) * (NGU / 256) % P.G);
            SEAM(pb + 6);
        }
        if (EN(8) && IN(pb + 7)) {
            const Ptrs P = fresh_ptrs(ap0); const ArgsP A = P.ap;
            pg8::Gemm g{WSP(bf16, WS_PROJ), WSP(bf16, WS_W + WO_DN), M, DM, FFN};
            pg8::EpiY E{WSP(bf16, WS_Y), WSP(float, WS_SS)};
            if (P.G == 256) { pg8::PanelOrder S{P.bid, M / (16 * 256)};
                for (int rep_ = 0; rep_ < REPS(8); ++rep_) pg8::gemm_phase<pg8::EpiY, pg8::PanelOrder, true, true>(ldsl, g, S, E); }
            else { pg8::StaticOrder S; S.init(M, DM, P.G, P.bid);
                for (int rep_ = 0; rep_ < REPS(8); ++rep_) pg8::gemm_phase<pg8::EpiY, pg8::StaticOrder, true, true>(ldsl, g, S, E); }
            SEAM(pb + 7);
        }
        if (EN(9) && IN(pb + 8)) {
            const Ptrs P = fresh_ptrs(ap0); const ArgsP A = P.ap;
            const float* gnext = l + 1 < DEPTH ? A->in[I_MIXPRE] + (l + 1) * DM : nullptr; const float* gpost = A->in[I_FFNPOST] + l * DM;
            const bf16* Y = WSP(bf16, WS_Y); const float* SS = WSP(float, WS_SS); const float* H = WSP(float, WS_H); bf16* XN = WSP(bf16, WS_XN); float* outp = A->out;
            for (int rep_ = 0; rep_ < REPS(9); ++rep_) {
            for (int m = P.gw; m < M; m += P.NGW)
                resid_norm_row(H + (size_t)m * DM, Y + (size_t)m * DM, SS + (size_t)m * 64, gpost, outp + (size_t)m * DM, gnext, XN + (size_t)m * DM, P.lane);
            if (l + 1 < DEPTH) { convert_weights(ap0, ldsl, l + 1, CV_TAIL_IN, I_3); convert_weights(ap0, ldsl, l + 1, I_3 + CV_TAIL_DN, I_LAYER); }
            }
            SEAM(pb + 8);
        }
    }

__global__ void __launch_bounds__(NWAVES * 64, 2) hybrid_fwd(Args args) {
    extern __shared__ __attribute__((aligned(16))) unsigned char lds[];
    LAS unsigned char* ldsl = (LAS unsigned char*)lds;
    volatile LAS unsigned* MISC = (volatile LAS unsigned*)(ldsl + MISC_OFF);
    const ArgsP ap0 = (ArgsP)__builtin_amdgcn_kernarg_segment_ptr();
    for (int u = threadIdx.x; u < (LDS_BYTES - LDSCTL_OFF) / 4; u += NWAVES * 64) ((LAS unsigned*)(ldsl + LDSCTL_OFF))[u] = 0u;
    __syncthreads();
    if ((threadIdx.x & 63) == 0) *(volatile LAS int*)(ldsl + TIDTAB_OFF + 4 * hw_slot()) = (int)(threadIdx.x >> 6);
    __syncthreads();
    const int lo = args.ph_lo, hi = args.ph_hi;
    if (hi - lo > 1) (void)xcd_barrier_post((unsigned*)(args.ws + WS_CTL) + CW_BAR, MISC + 8);
    if (EN(0) && IN(0)) { for (int rep_ = 0; rep_ < REPS(0); ++rep_) p0_prologue(ap0, ldsl); SEAM(0); }
    layer_phases<0>(ap0, ldsl, lds, lo, hi);
    layer_phases<1>(ap0, ldsl, lds, lo, hi);
}

#undef IN
#undef SEAM
extern "C" void kernel_launch(void* const* d_in, const int* in_sizes, int n_in, void* d_out, int out_size, void* d_ws, size_t ws_size, hipStream_t stream) {
    static int grid = 0;
    if (grid == 0) {
        if (n_in != 17 || in_sizes[0] != M * DM || out_size != M * DM || ws_size < WS_END) {
            fprintf(stderr, "kernel_launch: shape/workspace mismatch: n_in %d in0 %d out %d ws %zu (need %zu)\n", n_in, n_in > 0 ? in_sizes[0] : -1, out_size, ws_size, (size_t)WS_END); grid = -1; return; }
        int dev = 0, cus = 0, per_cu = 0;
        if (hipGetDevice(&dev) != hipSuccess || hipDeviceGetAttribute(&cus, hipDeviceAttributeMultiprocessorCount, dev) != hipSuccess) { fprintf(stderr, "kernel_launch: device query failed\n"); grid = -1; return; }
        if (hipFuncSetAttribute((const void*)hybrid_fwd, hipFuncAttributeMaxDynamicSharedMemorySize, LDS_BYTES) != hipSuccess) { fprintf(stderr, "kernel_launch: hipFuncSetAttribute failed\n"); grid = -1; return; }
        if (hipOccupancyMaxActiveBlocksPerMultiprocessor(&per_cu, (const void*)hybrid_fwd, NWAVES * 64, LDS_BYTES) != hipSuccess || per_cu < 1)
            fprintf(stderr, "kernel_launch: note: occupancy query reports %d workgroups per CU\n", per_cu);
        (void)hipGetLastError();
        grid = cus;
    }
    if (grid < 0) return;
    if (hipMemsetAsync((char*)d_ws + WS_CTL, 0, CTL_ZERO_BYTES, stream) != hipSuccess) { fprintf(stderr, "kernel_launch: memset failed\n"); return; }
    Args a{};
    for (int i = 0; i < 17; ++i) a.in[i] = (const float*)d_in[i];
    a.out = (float*)d_out; a.ws = (unsigned char*)d_ws;
#if MK_N_LAUNCHES == 1
    a.ph_lo = 0; a.ph_hi = N_PHASES;
    hipLaunchKernelGGL(hybrid_fwd, dim3(grid), dim3(NWAVES * 64), LDS_BYTES, stream, a);
#else
    for (int p = 0; p < N_PHASES; ++p) { a.ph_lo = p; a.ph_hi = p + 1; hipLaunchKernelGGL(hybrid_fwd, dim3(grid), dim3(NWAVES * 64), LDS_BYTES, stream, a); }
#endif
    const hipError_t le = hipPeekAtLastError();
    if (le != hipSuccess) fprintf(stderr, "kernel_launch: launch failed: %s\n", hipGetErrorName(le));
}
```

```cpp
#include <hip/hip_runtime.h>
#include <hip/hip_bf16.h>
#include <cstdio>
#include <cstdint>
#include <cmath>

#ifndef MK_N_LAUNCHES
#define MK_N_LAUNCHES 1
#endif

constexpr int BATCH = 2, SEQ = 8192, DM = 4096, M = BATCH * SEQ, DEPTH = 2;
constexpr int HD = 128, FOXH = 12, FOXW = FOXH * HD, SCW = 1024, GDNH = 12, GDNW = GDNH * HD;
constexpr int PROJ_SRC = 13860;
constexpr int NP = 14080;
constexpr int FFN = 11008, NGU = 2 * FFN;
constexpr float RMS_EPS = 1e-6f;
constexpr int PC_FQ = 0, PC_FK = 1536, PC_FV = 3072, PC_SB = 4608, PC_SC = 5632, PC_SH = 6656, PC_GQ = 7680, PC_GK = 9216, PC_GV = 10752, PC_GZ = 12288, PC_SMALL = 13824;
constexpr int SBW = 64, SB_FF = 0, SB_GA = 12, SB_GB = 24;
constexpr int SRC_FF = 4608, SRC_SB = 4620, SRC_GQ = 7692, SRC_GA = 12300, SRC_GB = 12312, SRC_GZ = 12324;

constexpr size_t MiB = 1u << 20;
constexpr size_t WS_CTL = 0, CTL_ZERO_BYTES = 1 * MiB;
constexpr size_t WS_W = 16 * MiB;
constexpr size_t WO_IN = 0, WO_OUT = 110 * MiB, WO_GU = 142 * MiB, WO_DN = 314 * MiB;
constexpr size_t WS_XN = 416 * MiB;
constexpr size_t WS_MIX = 544 * MiB;
constexpr size_t WS_Y = 672 * MiB;
constexpr size_t WS_H = 800 * MiB;
constexpr size_t WS_PROJ = 1056 * MiB;
constexpr size_t WS_SCB = WS_PROJ + 336 * MiB;
constexpr int HM_FQ = 0, HM_FK = 1, HM_FV = 2, HM_GQ = 3, HM_GZ = 6, SCBW = 3 * SCW;
__host__ __device__ constexpr size_t hm_off(int part, int bh) { return ((size_t)(part * (BATCH * FOXH) + bh) * SEQ) * HD; }
constexpr size_t WS_SB = 1496 * MiB;
constexpr size_t WS_SS = 1500 * MiB;
constexpr size_t WS_FG = 1504 * MiB;
constexpr size_t WS_TN = WS_FG + 1 * MiB;
constexpr size_t WS_END = 1506 * MiB;
constexpr int CW_TMO = 0, CW_BAR = 4096, CW_Q = 16384, CW_DYN = 20480;

constexpr int NWAVES = 8;
constexpr int RING_BYTES = 131072, LDSCTL_OFF = RING_BYTES, MISC_OFF = LDSCTL_OFF + 320, LDS_BYTES = 147456;


extern __shared__ __attribute__((aligned(16))) unsigned char g_lds[];
constexpr int TIDTAB_OFF = LDSCTL_OFF + 512;
__device__ __forceinline__ unsigned hw_slot() { return (unsigned)__builtin_amdgcn_s_getreg((5 << 11) | 4) & 63u; }
__device__ __forceinline__ int my_lane() { int l; asm volatile("v_mbcnt_lo_u32_b32 %0, -1, 0\n\tv_mbcnt_hi_u32_b32 %0, -1, %0" : "=v"(l)); return l; }
__device__ __forceinline__ int my_wave() { return __builtin_amdgcn_readfirstlane(*(volatile __attribute__((address_space(3))) int*)((__attribute__((address_space(3))) unsigned char*)g_lds + TIDTAB_OFF + 4 * hw_slot())); }
__device__ __forceinline__ int my_tid() { return my_wave() * 64 + my_lane(); }

#define GAS __attribute__((address_space(1)))
#define LAS __attribute__((address_space(3)))
typedef unsigned short bf16;
typedef unsigned v4u __attribute__((ext_vector_type(4)));
typedef float f32x4 __attribute__((ext_vector_type(4)));
typedef short bf16x8 __attribute__((ext_vector_type(8)));
typedef GAS unsigned gu32;
typedef GAS unsigned long long gu64;
#define RLX_AGENT __ATOMIC_RELAXED, __HIP_MEMORY_SCOPE_AGENT
#define LDS_WAIT() asm volatile("s_waitcnt lgkmcnt(0)" ::: "memory")
#define VM_WAIT() asm volatile("s_waitcnt vmcnt(0)" ::: "memory")
__device__ __forceinline__ unsigned long long rt() { return __builtin_amdgcn_s_memrealtime(); }
__device__ __forceinline__ unsigned f2bf(float f) { unsigned u = __builtin_bit_cast(unsigned, f); return (u + 0x7fffu + ((u >> 16) & 1u)) >> 16; }
__device__ __forceinline__ unsigned pk2(float lo, float hi) { return f2bf(lo) | (f2bf(hi) << 16); }

#define XB_TMO      128
#define XB_XCNT(j)  (256  + 64 * (j))
#define XB_XSUB(j)  (1280 + 64 * (j))
#define XB_XGEN(j)  (2304 + 64 * (j))
#define XB_TOP      3328
#define XB_TOPGEN   3392
#define XCD_BAR_WORDS 3456
#define XB_SPIN_CAP (1u << 18)

__device__ __forceinline__ unsigned xb_ld(unsigned* p)              { return __hip_atomic_load(p, __ATOMIC_RELAXED, __HIP_MEMORY_SCOPE_AGENT); }
__device__ __forceinline__ unsigned xb_add(unsigned* p, unsigned v) { return __hip_atomic_fetch_add(p, v, __ATOMIC_RELAXED, __HIP_MEMORY_SCOPE_AGENT); }
__device__ __forceinline__ unsigned xb_xcc_id() { return (unsigned)__builtin_amdgcn_s_getreg((3 << 11) | 20) & 0xFu; }
#define XB_SPIN(cond, bar) do { unsigned _sp = 0; while (cond) { __builtin_amdgcn_s_sleep(1); \
    if ((++_sp & 255u) == 0u) { if (xb_ld(&(bar)[XB_TMO])) break; if (_sp > XB_SPIN_CAP) { atomicAdd(&(bar)[XB_TMO], 1u); break; } } } } while (0)

struct XcdBarrier {
    unsigned* bar; unsigned x;
    volatile LAS unsigned* st;
};

__device__ __forceinline__ XcdBarrier xcd_barrier_post(unsigned* bar, volatile LAS unsigned* st) {
    XcdBarrier b; b.bar = bar; b.x = xb_xcc_id(); b.st = st;
    if (my_tid() == 0) (void)xb_add(&bar[XB_XCNT(b.x)], 1u);
    return b;
}
__device__ __forceinline__ void xcd_barrier_complete(unsigned* bar, unsigned x, unsigned& nloc, unsigned& nx) {
    const unsigned G = gridDim.x * gridDim.y * gridDim.z;
    unsigned sum, cnt, mine, sp = 0u;
    for (;;) {
        sum = 0u; cnt = 0u; mine = 0u;
#pragma unroll
        for (unsigned j = 0; j < 16; ++j) { const unsigned c = xb_ld(&bar[XB_XCNT(j)]); sum += c; cnt += (c > 0u) ? 1u : 0u; mine = (j == x) ? c : mine; }
        if (sum == G) break;
        __builtin_amdgcn_s_sleep(1);
        if ((++sp & 255u) == 0u) { if (xb_ld(&bar[XB_TMO])) break; if (sp > XB_SPIN_CAP) { atomicAdd(&bar[XB_TMO], 1u); break; } }
    }
    nloc = mine > 0u ? mine : 1u; nx = cnt > 0u ? cnt : 1u;
}

__device__ __forceinline__ void xcd_barrier(const XcdBarrier& b) {
    asm volatile("s_waitcnt vmcnt(0)" ::: "memory");
    __syncthreads();
    if (my_tid() == 0) {
        unsigned* bar = b.bar;
        __builtin_amdgcn_s_waitcnt(0);
        unsigned nloc = b.st[0], nx = b.st[1];
        if (nloc == 0u) { xcd_barrier_complete(bar, b.x, nloc, nx); b.st[0] = nloc; b.st[1] = nx; }
        const unsigned old = xb_add(&bar[XB_XSUB(b.x)], 1u);
        const unsigned gen = old / nloc;
        if (old + 1u == (gen + 1u) * nloc) {
            __builtin_amdgcn_fence(__ATOMIC_RELEASE, "agent");
            asm volatile("s_waitcnt vmcnt(0)" ::: "memory");
            const unsigned og = xb_add(&bar[XB_TOP], 1u);
            const unsigned tg = og / nx;
            if (og + 1u == (tg + 1u) * nx) xb_add(&bar[XB_TOPGEN], 1u);
            else XB_SPIN(xb_ld(&bar[XB_TOPGEN]) == tg, bar);
            __builtin_amdgcn_fence(__ATOMIC_ACQUIRE, "agent");
            xb_add(&bar[XB_XGEN(b.x)], 1u);
            asm volatile("s_waitcnt vmcnt(0)" ::: "memory");
        } else {
            XB_SPIN(xb_ld(&bar[XB_XGEN(b.x)]) == gen, bar);
            __builtin_amdgcn_fence(__ATOMIC_ACQUIRE, "agent");
            asm volatile("s_waitcnt vmcnt(0)" ::: "memory");
        }
    }
    __syncthreads();
}

namespace pg8 {
#define PG8_LAS __attribute__((address_space(3)))
typedef unsigned short bf16_t;
typedef short bf16x8 __attribute__((ext_vector_type(8)));
typedef float f32x4 __attribute__((ext_vector_type(4)));
typedef unsigned u32x4 __attribute__((ext_vector_type(4)));
constexpr int BM = 256, BK = 64, HALF = 128, HTB = HALF * BK * 2  , STAGE_BYTES = 8 * HTB, NXCD = 8, WGM = 8;

__host__ __device__ __forceinline__ int lds_byte(int r, int c) { const int st = (r >> 4) * 2 + (c >> 5), rr = r & 15, cc = c & 31, ob = rr * 64 + cc * 2; return st * 1024 + (ob ^ (((ob >> 9) & 1) << 5)); }
__host__ __device__ __forceinline__ void stage_rc(int b, int& R, int& C) { const int st = b / 1024, sb = b % 1024, swz = sb ^ (((sb >> 9) & 1) << 5); R = (st >> 1) * 16 + swz / 64; C = (st & 1) * 32 + (swz % 64) / 2; }
__host__ __device__ __forceinline__ int perm32(int rho) { const int n = rho >> 4, i = rho & 15; return 8 * (i >> 2) + 4 * n + (i & 3); }

struct Unit { int pm, pn; };
struct Gemm { const bf16_t* A; const bf16_t* Bt; int M, N, K; };

struct StaticOrder {
    static constexpr bool DYN = false;
    int nM, nN, nwg, G, c;
    __host__ __device__ void init(int M, int N, int G_, int c_) { nM = M / BM; nN = N / BM; nwg = nM * nN; G = G_; c = c_; }
    __host__ __device__ bool next(int i, Unit& u) const {
        const long L = (long)i * G + c; if (L >= nwg) return false;
        int wgid = (int)L; { const int q = nwg / NXCD, r = nwg % NXCD, xcd = wgid % NXCD, off = wgid / NXCD; wgid = (xcd < r ? xcd * (q + 1) : r * (q + 1) + (xcd - r) * q) + off; }
        const int nig = WGM * nN, gid = wgid / nig, fm = gid * WGM, gsz = (nM - fm) < WGM ? (nM - fm) : WGM;
        u.pm = fm + ((wgid % nig) % gsz); u.pn = (wgid % nig) / gsz; return true;
    }
    __device__ __forceinline__ void a_ready(const Unit&) const {}
    __device__ __forceinline__ void done(const Unit&) const {}
};


typedef float f32x2e __attribute__((ext_vector_type(2))); typedef __bf16 bf16x2e __attribute__((ext_vector_type(2)));
__device__ __forceinline__ unsigned cvt_pk_bf16(float lo, float hi) { const f32x2e v = {lo, hi}; const bf16x2e b = __builtin_convertvector(v, bf16x2e); return __builtin_bit_cast(unsigned, b); }
__device__ __forceinline__ u32x4 pack8_bf16(const f32x4 v0, const f32x4 v1) { u32x4 w; w.x = cvt_pk_bf16(v0[0], v0[1]); w.y = cvt_pk_bf16(v0[2], v0[3]); w.z = cvt_pk_bf16(v1[0], v1[1]); w.w = cvt_pk_bf16(v1[2], v1[3]); return w; }

struct EpiProj {
    static constexpr bool PERM = true, AFTER_DRAIN = false;
    bf16_t* HM; bf16_t* SCB; float* SBp;
    __device__ __forceinline__ void operator()(const f32x4 (&acc)[2][2][4][2], const Unit& u, int wr, int wc, int fr, int fq) const {
        const int row0 = u.pm * BM + wr * 64 + fr;
        if (u.pn * BM == PC_SMALL) {
            if (wc < 2) {
#pragma unroll
                for (int ai = 0; ai < 2; ++ai)
#pragma unroll
                    for (int m = 0; m < 4; ++m) { float* rp = SBp + (size_t)(row0 + ai * HALF + m * 16) * SBW + wc * 32 + 8 * fq;
                        *(f32x4*)rp = acc[ai][0][m][0]; *(f32x4*)(rp + 4) = acc[ai][0][m][1]; }
            }
            return;
        }
        const int b = (u.pm * BM) / SEQ, s0 = row0 - b * SEQ;
#pragma unroll
        for (int bj = 0; bj < 2; ++bj) { const int colbase = u.pn * BM + bj * HALF;
            bf16_t* dst; size_t pitch;
            if (colbase >= PC_SB && colbase < PC_GQ) { dst = SCB + (size_t)row0 * SCBW + (colbase - PC_SB) + wc * 32 + 8 * fq; pitch = SCBW; }
            else { const int hc = colbase < PC_SB ? colbase : colbase - (PC_GQ - PC_SB), part = hc / 1536, head = (hc % 1536) / HD;
                   dst = HM + hm_off(part, b * FOXH + head) + (size_t)s0 * HD + wc * 32 + 8 * fq; pitch = HD; }
#pragma unroll
            for (int ai = 0; ai < 2; ++ai)
#pragma unroll
                for (int m = 0; m < 4; ++m) *(u32x4*)(dst + (size_t)(ai * HALF + m * 16) * pitch) = pack8_bf16(acc[ai][bj][m][0], acc[ai][bj][m][1]); }
    }
};
struct EpiY {
    static constexpr bool PERM = true, AFTER_DRAIN = false;
    bf16_t* Y; float* SS;
    __device__ __forceinline__ void operator()(const f32x4 (&acc)[2][2][4][2], const Unit& u, int wr, int wc, int fr, int fq) const {
        const int row0 = u.pm * BM + wr * 64 + fr, col0 = u.pn * BM + wc * 32 + 8 * fq;
#pragma unroll
        for (int ai = 0; ai < 2; ++ai)
#pragma unroll
            for (int m = 0; m < 4; ++m) { const int row = row0 + ai * HALF + m * 16; bf16_t* rowp = Y + (size_t)row * DM + col0; float s = 0.f;
#pragma unroll
                for (int bj = 0; bj < 2; ++bj) { const f32x4 a = acc[ai][bj][m][0], b = acc[ai][bj][m][1];
                    s += (a[0] * a[0] + a[1] * a[1]) + (a[2] * a[2] + a[3] * a[3]) + (b[0] * b[0] + b[1] * b[1]) + (b[2] * b[2] + b[3] * b[3]);
                    *(u32x4*)(rowp + bj * HALF) = pack8_bf16(a, b); }
                s += __shfl_xor(s, 16); s += __shfl_xor(s, 32);
                if (fq == 0) SS[(size_t)row * 64 + u.pn * 4 + wc] = s; }
    }
};
__device__ __forceinline__ float silu_f(float x) { return x * __builtin_amdgcn_rcpf(1.0f + __builtin_amdgcn_exp2f(-1.4426950408889634f * x)); }
struct EpiSwiGLU {
    static constexpr bool PERM = true, AFTER_DRAIN = false;
    bf16_t* Hd;
    __device__ __forceinline__ void operator()(const f32x4 (&acc)[2][2][4][2], const Unit& u, int wr, int wc, int fr, int fq) const {
        const int row0 = u.pm * BM + wr * 64 + fr, col0 = u.pn * HALF + wc * 32 + 8 * fq;
#pragma unroll
        for (int ai = 0; ai < 2; ++ai)
#pragma unroll
            for (int m = 0; m < 4; ++m) { const f32x4 g0 = acc[ai][0][m][0], g1 = acc[ai][0][m][1], u0 = acc[ai][1][m][0], u1 = acc[ai][1][m][1]; f32x4 h0, h1;
#pragma unroll
                for (int e = 0; e < 4; ++e) { h0[e] = silu_f(g0[e]) * u0[e]; h1[e] = silu_f(g1[e]) * u1[e]; }
                *(u32x4*)(Hd + (size_t)(row0 + ai * HALF + m * 16) * FFN + col0) = pack8_bf16(h0, h1); }
    }
};

struct PanelOrder {
    static constexpr bool DYN = false;
    int c, nround;
    __device__ __forceinline__ bool next(int i, Unit& u) const { if (i >= nround) return false; const int x = c & 7, k = c >> 3; u.pm = 16 * i + 2 * x + (k >> 4); u.pn = k & 15; return true; }
    __device__ __forceinline__ void a_ready(const Unit&) const {}
    __device__ __forceinline__ void done(const Unit&) const {}
};

struct TailDynOrder {
    static constexpr bool DYN = true;
    StaticOrder S; int istat; __attribute__((address_space(1))) unsigned* ctr; volatile PG8_LAS int* slot;
    __device__ __forceinline__ bool next(int i, Unit& u) const { return S.next(i, u); }
    __device__ __forceinline__ void claim(int i, int wid, int lane) const {
        if (i >= istat && wid == 0 && lane == 0) slot[i & 1] = (int)__hip_atomic_fetch_add(ctr, 1u, __ATOMIC_RELAXED, __HIP_MEMORY_SCOPE_AGENT); }
    __device__ __forceinline__ bool fetch(int i, Unit& u) const {
        if (i < istat) return S.next(i, u);
        const int t = __builtin_amdgcn_readfirstlane(slot[i & 1]);
        const int q = S.nwg / NXCD, off = istat * (S.G / NXCD) + t / NXCD, xcd = t % NXCD;
        if (off >= q) return false;
        const int wgid = xcd * q + off;
        const int nig = WGM * S.nN, gid = wgid / nig, fm = gid * WGM, gsz = (S.nM - fm) < WGM ? (S.nM - fm) : WGM;
        u.pm = fm + ((wgid % nig) % gsz); u.pn = (wgid % nig) / gsz; return true;
    }
    __device__ __forceinline__ void a_ready(const Unit&) const {}
    __device__ __forceinline__ void done(const Unit&) const {}
};
template <class Epi, class Sched, bool ALIGN_EPI = false, bool SP2 = false>
__device__ __forceinline__ void gemm_phase(PG8_LAS unsigned char* lds, const Gemm g, const Sched& S, const Epi& E) {
    int tid_ = my_tid(); asm volatile("" : "+v"(tid_));
    const int tid = tid_, wid = __builtin_amdgcn_readfirstlane(tid >> 6), lane = tid & 63, wr = wid >> 2, wc = wid & 3, fr = lane & 15, fq = lane >> 4;
    const int K = g.K, nt = K / BK;
    unsigned voffA[2], voffB[2];
#pragma unroll
    for (int i = 0; i < 2; ++i) { int R, C; stage_rc(tid * 16 + i * 8192, R, C); const int Rb = Epi::PERM ? ((R & ~31) + perm32(R & 31)) : R;
        voffA[i] = (unsigned)(R * K + C) * 2u; voffB[i] = (unsigned)(Rb * K + C) * 2u; }
    const size_t kstep = (size_t)(BK * 2);
    const size_t hstep = (size_t)HALF * K * 2;
    const size_t tstep = 2 * hstep;
    const unsigned ldsw = (unsigned)wid * 1024u;
    const int aoff = lds_byte(wr * 64 + fr, fq * 8), boff = lds_byte(wc * 32 + fr, fq * 8);
#define PG8_SA(b, h) (((b) * 2 + (h)) * HTB)
#define PG8_SB(b, h) ((4 + (b) * 2 + (h)) * HTB)
#define PG8_STAGE(bufoff, gbase, voff) do { _Pragma("unroll") for (int _i = 0; _i < 2; ++_i) \
        __builtin_amdgcn_global_load_lds((const unsigned*)((const char*)(gbase) + (voff)[_i]), (PG8_LAS unsigned*)(lds + (bufoff) + ldsw + _i * 8192), 16, 0, 0); } while (0)
#define PG8_LDA(dst, b, h) do { _Pragma("unroll") for (int m = 0; m < 4; ++m) _Pragma("unroll") for (int k = 0; k < 2; ++k) dst[m][k] = *(const PG8_LAS bf16x8*)(lds + PG8_SA(b, h) + aoff + m * 2048 + k * 1024); } while (0)
#define PG8_LDB(dst, b, h) do { _Pragma("unroll") for (int n = 0; n < 2; ++n) _Pragma("unroll") for (int k = 0; k < 2; ++k) dst[n][k] = *(const PG8_LAS bf16x8*)(lds + PG8_SB(b, h) + boff + n * 2048 + k * 1024); } while (0)
#define PG8_MMA(ai, bj, At, Bt) do { __builtin_amdgcn_s_setprio(1); _Pragma("unroll") for (int m = 0; m < 4; ++m) _Pragma("unroll") for (int n = 0; n < 2; ++n) _Pragma("unroll") for (int k = 0; k < 2; ++k) \
        acc[ai][bj][m][n] = __builtin_amdgcn_mfma_f32_16x16x32_bf16(Bt[n][k], At[m][k], acc[ai][bj][m][n], 0, 0, 0); __builtin_amdgcn_s_setprio(0); } while (0)
#define PG8_WAIT_V(n) asm volatile("s_waitcnt vmcnt(" #n ")" ::: "memory")
#define PG8_WAIT_L(n) asm volatile("s_waitcnt lgkmcnt(" #n ")" ::: "memory")
#define PG8_BAR __builtin_amdgcn_s_barrier()
#define PG8_SCHED __builtin_amdgcn_sched_barrier(0)
    Unit cur, nxt; int ui = 0;
    if (!S.next(0, cur)) return;
    f32x4 acc[2][2][4][2];
#pragma unroll
    for (int a = 0; a < 2; ++a)
#pragma unroll
        for (int b = 0; b < 2; ++b)
#pragma unroll
            for (int m = 0; m < 4; ++m)
#pragma unroll
                for (int n = 0; n < 2; ++n) acc[a][b][m][n] = (f32x4){0.f, 0.f, 0.f, 0.f};
    bf16x8 At[4][2], B0[2][2], B1[2][2];
    const char* cA = (const char*)g.A + (size_t)cur.pm * tstep; const char* cB = (const char*)g.Bt + (size_t)cur.pn * tstep;
    S.a_ready(cur);
    if constexpr (SP2) {
        PG8_STAGE(PG8_SB(0, 0), cB, voffB); PG8_STAGE(PG8_SB(0, 1), cB + hstep, voffB); PG8_STAGE(PG8_SA(0, 0), cA, voffA); PG8_STAGE(PG8_SA(0, 1), cA + hstep, voffA);
        if (wr == 1) PG8_BAR;
        PG8_WAIT_V(2); PG8_BAR;
        PG8_STAGE(PG8_SB(1, 0), cB + kstep, voffB); PG8_STAGE(PG8_SA(1, 0), cA + kstep, voffA); PG8_STAGE(PG8_SB(1, 1), cB + hstep + kstep, voffB);
        PG8_WAIT_V(6); PG8_BAR;
    } else {
        PG8_STAGE(PG8_SB(0, 0), cB, voffB); PG8_STAGE(PG8_SA(0, 0), cA, voffA); PG8_STAGE(PG8_SB(0, 1), cB + hstep, voffB); PG8_STAGE(PG8_SA(0, 1), cA + hstep, voffA);
        if (wr == 1) PG8_BAR;
        PG8_WAIT_V(4); PG8_BAR;
        PG8_STAGE(PG8_SB(1, 0), cB + kstep, voffB); PG8_STAGE(PG8_SA(1, 0), cA + kstep, voffA); PG8_STAGE(PG8_SB(1, 1), cB + hstep + kstep, voffB);
        PG8_WAIT_V(6); PG8_BAR;
    }
    for (;;) {
        bool has_next = false; const char* nA = cA; const char* nB = cB;
        if constexpr (Sched::DYN) S.claim(ui + 1, wid, lane);
        else { has_next = S.next(ui + 1, nxt);
            nA = has_next ? (const char*)g.A + (size_t)nxt.pm * tstep : cA; nB = has_next ? (const char*)g.Bt + (size_t)nxt.pn * tstep : cB; }
        for (int t = 0; t < nt; t += 2) {
            const bool last = (t == nt - 2);
            if constexpr (Sched::DYN) { if (last) { has_next = S.fetch(ui + 1, nxt);
                nA = has_next ? (const char*)g.A + (size_t)nxt.pm * tstep : cA; nB = has_next ? (const char*)g.Bt + (size_t)nxt.pn * tstep : cB; } }
            const char* a1 = cA + (size_t)(t + 1) * kstep;
            const char* a2 = last ? nA : cA + (size_t)(t + 2) * kstep; const char* b2 = last ? nB : cB + (size_t)(t + 2) * kstep;
            const char* a3 = a2 + kstep; const char* b3 = b2 + kstep;
            if (last && has_next) S.a_ready(nxt);
            if constexpr (SP2) {
            PG8_LDB(B0, 0, 0); PG8_LDB(B1, 0, 1); PG8_SCHED; PG8_LDA(At, 0, 0); PG8_STAGE(PG8_SA(1, 1), a1 + hstep, voffA);
            PG8_WAIT_V(8); PG8_WAIT_L(0); PG8_BAR; PG8_MMA(0, 0, At, B0); PG8_MMA(0, 1, At, B1); PG8_BAR; PG8_SCHED;
            PG8_LDA(At, 0, 1); PG8_STAGE(PG8_SB(0, 0), b2, voffB); PG8_STAGE(PG8_SB(0, 1), b2 + hstep, voffB); PG8_STAGE(PG8_SA(0, 0), a2, voffA);
            PG8_WAIT_V(8); PG8_WAIT_L(0); PG8_BAR; PG8_MMA(1, 0, At, B0); PG8_MMA(1, 1, At, B1); PG8_BAR; PG8_SCHED;
            PG8_LDB(B0, 1, 0); PG8_LDB(B1, 1, 1); PG8_SCHED; PG8_LDA(At, 1, 0); PG8_STAGE(PG8_SA(0, 1), a2 + hstep, voffA);
            PG8_WAIT_V(8); PG8_WAIT_L(0); PG8_BAR; PG8_MMA(0, 0, At, B0); PG8_MMA(0, 1, At, B1); PG8_BAR; PG8_SCHED;
            PG8_LDA(At, 1, 1); PG8_STAGE(PG8_SB(1, 0), b3, voffB); PG8_STAGE(PG8_SB(1, 1), b3 + hstep, voffB); PG8_STAGE(PG8_SA(1, 0), a3, voffA);
            PG8_WAIT_V(8); PG8_WAIT_L(0); PG8_BAR; PG8_MMA(1, 0, At, B0); PG8_MMA(1, 1, At, B1); PG8_BAR; PG8_SCHED;
            } else {
            PG8_LDB(B0, 0, 0); PG8_SCHED; PG8_LDA(At, 0, 0); PG8_STAGE(PG8_SA(1, 1), a1 + hstep, voffA);
            PG8_WAIT_L(8); PG8_BAR; PG8_WAIT_L(0); PG8_MMA(0, 0, At, B0); PG8_BAR; PG8_SCHED;
            PG8_LDB(B1, 0, 1); PG8_STAGE(PG8_SB(0, 0), b2, voffB);
            PG8_BAR; PG8_WAIT_L(0); PG8_MMA(0, 1, At, B1); PG8_BAR;
            PG8_LDA(At, 0, 1); PG8_STAGE(PG8_SA(0, 0), a2, voffA);
            PG8_BAR; PG8_WAIT_L(0); PG8_MMA(1, 0, At, B0); PG8_BAR; PG8_SCHED;
            PG8_STAGE(PG8_SB(0, 1), b2 + hstep, voffB);
            PG8_WAIT_V(6); PG8_BAR; PG8_MMA(1, 1, At, B1); PG8_BAR;
            PG8_LDB(B0, 1, 0); PG8_SCHED; PG8_LDA(At, 1, 0); PG8_STAGE(PG8_SA(0, 1), a2 + hstep, voffA);
            PG8_WAIT_L(8); PG8_BAR; PG8_WAIT_L(0); PG8_MMA(0, 0, At, B0); PG8_BAR; PG8_SCHED;
            PG8_LDB(B1, 1, 1); PG8_STAGE(PG8_SB(1, 0), b3, voffB);
            PG8_BAR; PG8_WAIT_L(0); PG8_MMA(0, 1, At, B1); PG8_BAR;
            PG8_LDA(At, 1, 1); PG8_STAGE(PG8_SA(1, 0), a3, voffA);
            PG8_BAR; PG8_WAIT_L(0); PG8_MMA(1, 0, At, B0); PG8_BAR; PG8_SCHED;
            PG8_STAGE(PG8_SB(1, 1), b3 + hstep, voffB);
            PG8_WAIT_V(6); PG8_BAR; PG8_MMA(1, 1, At, B1); PG8_BAR;
            }
        }
        if constexpr (ALIGN_EPI) { if (wr == 0) PG8_BAR; }
        if constexpr (!Epi::AFTER_DRAIN) { E(acc, cur, wr, wc, fr, fq); S.done(cur); }
        if (!has_next) break;
#pragma unroll
        for (int a = 0; a < 2; ++a)
#pragma unroll
            for (int b = 0; b < 2; ++b)
#pragma unroll
                for (int m = 0; m < 4; ++m)
#pragma unroll
                    for (int n = 0; n < 2; ++n) acc[a][b][m][n] = (f32x4){0.f, 0.f, 0.f, 0.f};
        cur = nxt; cA = nA; cB = nB; ++ui;
        if constexpr (ALIGN_EPI) { if (wr == 1) PG8_BAR; }
    }
    PG8_WAIT_V(0);
    if constexpr (!ALIGN_EPI) { if (wr == 0) PG8_BAR; }
    PG8_BAR;
    if constexpr (Epi::AFTER_DRAIN) { E.fused(acc, cur, wr, wc, fr, fq, lds, wid, lane); S.done(cur); }
#undef PG8_SA
#undef PG8_SB
#undef PG8_STAGE
#undef PG8_LDA
#undef PG8_LDB
#undef PG8_MMA
#undef PG8_WAIT_V
#undef PG8_WAIT_L
#undef PG8_BAR
#undef PG8_SCHED
}
}

namespace attn {
constexpr int KVP = HD, OP = DM;
constexpr float SCALE = 0.08838834764831845f;
constexpr int D = 128;
constexpr int NW = 8, QBLK = 32, KVBLK = 64, QB = NW * QBLK;
constexpr int SHM_V = KVBLK * D * 2, SHM_K = KVBLK * D * 2;
constexpr int FB_OFF = 2 * SHM_V + 2 * SHM_K + NW * 64 * 4;
constexpr int LDS_BYTES = FB_OFF + 2 * 64 * 4;
constexpr bool WSKIP = false;
constexpr float THR = 16.f;

using bf16 = __hip_bfloat16;
typedef short bf16x8 __attribute__((ext_vector_type(8)));
typedef short s16x4 __attribute__((ext_vector_type(4)));
typedef float f32x16 __attribute__((ext_vector_type(16)));
typedef float f32x4 __attribute__((ext_vector_type(4)));
typedef unsigned u32x4 __attribute__((ext_vector_type(4)));
template <class A, class Bt> struct same_t { static constexpr bool v = false; };
template <class A> struct same_t<A, A> { static constexpr bool v = true; };

#define KSWZ(row, colB) ((row) * 256 + ((colB) ^ (((row) & 7) << 4)))
#define SBAR() __builtin_amdgcn_sched_barrier(0)
__device__ __forceinline__ int v_st(int k, int c) { const int kk = (k & ~0xC) | ((k & 4) << 1) | ((k & 8) >> 1); return ((kk >> 3) * 4 + (c >> 5)) * 512 + ((kk & 7) * 32 + (c & 31)) * 2; }
__device__ __forceinline__ int v_rd_base(int lane) { return ((lane & 3) << 3) | (((lane >> 2) & 3) << 6) | (((lane >> 4) & 1) << 5) | (((lane >> 5) & 1) << 8); }
constexpr int v_rd_off(int d0, int ks, int half) { return d0 * 512 + ks * 4096 + half * 2048; }
__device__ __forceinline__ int crow(int r, int hi) { return (r & 3) + 8 * (r >> 2) + 4 * hi; }
__device__ __forceinline__ unsigned cvtpk(float lo, float hi) {
    unsigned r; asm volatile("v_cvt_pk_bf16_f32 %0, %1, %2" : "=v"(r) : "v"(lo), "v"(hi)); return r;
}
__device__ __forceinline__ bf16x8 pack8(f32x4 a, f32x4 b) {
    u32x4 w = {cvtpk(a[0], a[1]), cvtpk(a[2], a[3]), cvtpk(b[0], b[1]), cvtpk(b[2], b[3])};
    return *reinterpret_cast<bf16x8*>(&w);
}
template <class T> __device__ __forceinline__ bf16x8 load8(const T* p) {
    if constexpr (same_t<T, float>::v) { return pack8(*(const f32x4*)p, *(const f32x4*)(p + 4)); }
    else { return *reinterpret_cast<const bf16x8*>(p); }
}
__device__ __forceinline__ void mask_tile(f32x16& p0, f32x16& p1, int dq, unsigned W) {
    const float NEG = -__builtin_inff();
#pragma unroll
    for (int r = 0; r < 16; ++r) {
        const int c = (r & 3) + 8 * (r >> 2);
        if ((unsigned)(dq - c) >= W) p0[r] = NEG;
        if ((unsigned)(dq - c - 32) >= W) p1[r] = NEG;
    }
}
__device__ __forceinline__ void partialSM(f32x16& p0, f32x16& p1, float& m_reg, float& mn, float& alpha) {
    float pmax = p0[0]; for (int r = 1; r < 16; ++r) pmax = fmaxf(pmax, p0[r]); for (int r = 0; r < 16; ++r) pmax = fmaxf(pmax, p1[r]);
    { auto rr = __builtin_amdgcn_permlane32_swap(__float_as_uint(pmax), __float_as_uint(pmax), false, false);
      pmax = fmaxf(__uint_as_float(rr[0]), __uint_as_float(rr[1])); }
    constexpr float C2 = 1.4426950408889634f * SCALE;
    if (__builtin_expect(__all((pmax - m_reg) * SCALE <= THR), 1)) { mn = m_reg; alpha = 1.f; }
    else { mn = fmaxf(m_reg, pmax); alpha = __builtin_amdgcn_exp2f((m_reg - mn) * C2); m_reg = mn; }
    const float mnL = -mn * C2;
    for (int r = 0; r < 16; ++r) p0[r] = fmaf(p0[r], C2, mnL); for (int r = 0; r < 16; ++r) p1[r] = fmaf(p1[r], C2, mnL);
    for (int r = 0; r < 16; ++r) p0[r] = __builtin_amdgcn_exp2f(p0[r]);
}
__device__ __forceinline__ void finishSM(f32x16& p0, f32x16& p1, float alpha, float& l_reg, bf16x8& pa0, bf16x8& pa1, bf16x8& pa2, bf16x8& pa3) {
    for (int r = 0; r < 16; ++r) p1[r] = __builtin_amdgcn_exp2f(p1[r]);
    float ps = 0; for (int r = 0; r < 16; ++r) ps += p0[r]; for (int r = 0; r < 16; ++r) ps += p1[r];
    { auto rr = __builtin_amdgcn_permlane32_swap(__float_as_uint(ps), __float_as_uint(ps), false, false);
      ps = __uint_as_float(rr[0]) + __uint_as_float(rr[1]); }
    l_reg = l_reg * alpha + ps;
#define PK4(P, B_, OUT) do { unsigned a0 = cvtpk(P[B_+0], P[B_+1]), a1 = cvtpk(P[B_+2], P[B_+3]);                          \
        unsigned b0 = cvtpk(P[B_+4], P[B_+5]), b1 = cvtpk(P[B_+6], P[B_+7]);                                             \
        auto r0 = __builtin_amdgcn_permlane32_swap(a0, b0, false, false); auto r1 = __builtin_amdgcn_permlane32_swap(a1, b1, false, false); \
        u32x4 w = {r0[0], r1[0], r0[1], r1[1]}; OUT = *reinterpret_cast<bf16x8*>(&w); } while (0)
    PK4(p0, 0, pa0); PK4(p0, 8, pa1); PK4(p1, 0, pa2); PK4(p1, 8, pa3);
#undef PK4
}
template <int KB, bool SK>
__device__ __forceinline__ void qkt(f32x16& p0, f32x16& p1, const char* K_lds, int r32, int hi, const bf16x8* qr, bool act) {
    if (SK && !act) { const float NEG = -__builtin_inff();
#pragma unroll
        for (int r = 0; r < 16; ++r) { p0[r] = NEG; p1[r] = NEG; } return; }
    { const char* fb = K_lds + 2 * SHM_K + NW * 64 * 4 + KB * 256 + hi * 16;
#pragma unroll
      for (int g = 0; g < 4; ++g) { const f32x4 a = *reinterpret_cast<const f32x4*>(fb + g * 32), b = *reinterpret_cast<const f32x4*>(fb + 128 + g * 32);
          p0[4 * g] = a[0]; p0[4 * g + 1] = a[1]; p0[4 * g + 2] = a[2]; p0[4 * g + 3] = a[3]; p1[4 * g] = b[0]; p1[4 * g + 1] = b[1]; p1[4 * g + 2] = b[2]; p1[4 * g + 3] = b[3]; } }
    const char* kb[4];
#pragma unroll
    for (int dd = 0; dd < 4; ++dd) kb[dd] = K_lds + KB * SHM_K + KSWZ(r32, (dd * 16 + hi * 8) * 2);
#pragma unroll
    for (int d0 = 0; d0 < 8; ++d0) { const char* a = kb[d0 & 3] + (d0 >> 2) * 128;
        bf16x8 b0 = *reinterpret_cast<const bf16x8*>(a);
        bf16x8 b1 = *reinterpret_cast<const bf16x8*>(a + 32 * 256);
        p0 = __builtin_amdgcn_mfma_f32_32x32x16_bf16(b0, qr[d0], p0, 0, 0, 0);
        p1 = __builtin_amdgcn_mfma_f32_32x32x16_bf16(b1, qr[d0], p1, 0, 0, 0); }
}
template <int VB, bool SK>
__device__ __forceinline__ void pv_tile(f32x16* o, int vb0, bf16x8 pa0, bf16x8 pa1, bf16x8 pa2, bf16x8 pa3, bool act) {
    if (SK && !act) return;
#define TRRD(dst, off) asm volatile("ds_read_b64_tr_b16 %0, %1 offset:%2" : "=&v"(dst) : "v"(vb0), "i"(off) : "memory")
#define PV_D0(d0) do { s16x4 l0, l1, l2, l3, h0, h1, h2, h3; constexpr int b_ = VB * SHM_V + v_rd_off(d0, 0, 0);     \
        TRRD(l0, b_); TRRD(h0, b_ + 2048); TRRD(l1, b_ + 4096); TRRD(h1, b_ + 6144); TRRD(l2, b_ + 8192); TRRD(h2, b_ + 10240); TRRD(l3, b_ + 12288); TRRD(h3, b_ + 14336); \
        asm volatile("s_waitcnt lgkmcnt(0)" ::: "memory"); SBAR();                 \
        o[d0] = __builtin_amdgcn_mfma_f32_32x32x16_bf16(pa0, (bf16x8){l0[0], l0[1], l0[2], l0[3], h0[0], h0[1], h0[2], h0[3]}, o[d0], 0, 0, 0);   \
        o[d0] = __builtin_amdgcn_mfma_f32_32x32x16_bf16(pa1, (bf16x8){l1[0], l1[1], l1[2], l1[3], h1[0], h1[1], h1[2], h1[3]}, o[d0], 0, 0, 0);   \
        o[d0] = __builtin_amdgcn_mfma_f32_32x32x16_bf16(pa2, (bf16x8){l2[0], l2[1], l2[2], l2[3], h2[0], h2[1], h2[2], h2[3]}, o[d0], 0, 0, 0);   \
        o[d0] = __builtin_amdgcn_mfma_f32_32x32x16_bf16(pa3, (bf16x8){l3[0], l3[1], l3[2], l3[3], h3[0], h3[1], h3[2], h3[3]}, o[d0], 0, 0, 0); } while (0)
    PV_D0(0); PV_D0(1); PV_D0(2); PV_D0(3);
#undef PV_D0
#undef TRRD
}

template <class TIn, class TOut> struct BlockRef { const TIn* Q; const TIn* K; const TIn* V; const float* F; TOut* O; int P0; int JLO; };
template <class TIn> struct Seam {
    bf16x8 qr[8];
    bf16x8 st_v0, st_v1, st_k0, st_k1; float st_f; f32x4 sf0, sf1, sf2, sf3;
    f32x4 tq[16];
};
__device__ __forceinline__ int swa_jlo(int P0, int W) { const int lowk = P0 - W + 1; return lowk > 0 ? lowk / KVBLK : 0; }
#define ROW(p, k0, rr) ((p) + (size_t)((k0) + (rr)) * KVP + sc)
#define VMW() asm volatile("s_waitcnt vmcnt(0)" ::: "memory")
#define VMWN(n) asm volatile("s_waitcnt vmcnt(%0)" :: "i"(n) : "memory")
#define SLOAD_H(Kp, Vp, Fp, k0) do { S.st_v0 = load8<TIn>(ROW(Vp, k0, sr)); S.st_v1 = load8<TIn>(ROW(Vp, k0, 32 + sr));              \
                         S.st_k0 = load8<TIn>(ROW(Kp, k0, sr)); S.st_k1 = load8<TIn>(ROW(Kp, k0, 32 + sr)); if (tid < 64) S.st_f = (Fp)[(k0) + tid]; } while (0)
#define SWRITE_HK(bf) do { *(bf16x8*)(K_lds + (bf) * SHM_K + kws) = S.st_k0; *(bf16x8*)(K_lds + (bf) * SHM_K + kws + 32 * 256) = S.st_k1; if (tid < 64) *(float*)(K_lds + 2 * SHM_K + NW * 64 * 4 + (bf) * 256 + tid * 4) = S.st_f; } while (0)
#define SWRITE_HV(bf) do { *(bf16x8*)(V_lds + (bf) * SHM_V + vst0) = S.st_v0; *(bf16x8*)(V_lds + (bf) * SHM_V + vst1) = S.st_v1; } while (0)
#define SWRITE_H(bf) do { SWRITE_HV(bf); SWRITE_HK(bf); } while (0)
#define SLOAD_F(p, k0) do { S.sf0 = *(const f32x4*)ROW(p, k0, sr); S.sf1 = *(const f32x4*)(ROW(p, k0, sr) + 4);                \
                            S.sf2 = *(const f32x4*)ROW(p, k0, 32 + sr); S.sf3 = *(const f32x4*)(ROW(p, k0, 32 + sr) + 4); } while (0)
#define SWRITE_KF(bf) do { *(bf16x8*)(K_lds + (bf) * SHM_K + kws) = pack8(S.sf0, S.sf1); *(bf16x8*)(K_lds + (bf) * SHM_K + kws + 32 * 256) = pack8(S.sf2, S.sf3); } while (0)
#define SWRITE_VF(bf) do { *(bf16x8*)(V_lds + (bf) * SHM_V + vst0) = pack8(S.sf0, S.sf1); *(bf16x8*)(V_lds + (bf) * SHM_V + vst1) = pack8(S.sf2, S.sf3); } while (0)
template <class TIn, class TOut>
__device__ __forceinline__ void causal_swa_prime(const BlockRef<TIn, TOut>& cur, int W, char* lds, Seam<TIn>& S) {
    constexpr bool F32 = same_t<TIn, float>::v;
    int tid_ = my_tid(); asm volatile("" : "+v"(tid_));
    const int tid = tid_, wid = __builtin_amdgcn_readfirstlane(tid >> 6), lane = tid & 63, r32 = lane & 31, hi = lane >> 5;
    const int sr = tid >> 4, sc = (tid & 15) * 8, kws = KSWZ(sr, sc * 2); char* K_lds = lds + 2 * SHM_V;
    const int kb0 = cur.JLO * KVBLK;
    for (int d0 = 0; d0 < 8; ++d0) S.qr[d0] = load8<TIn>(cur.Q + (size_t)(wid * QBLK + r32) * KVP + d0 * 16 + hi * 8);
    if constexpr (F32) { SLOAD_F((const float*)cur.K, kb0); VMW(); SWRITE_KF(0); SBAR(); SLOAD_F((const float*)cur.V, kb0); }
    else { SLOAD_H(cur.K, cur.V, cur.F, kb0); VMW(); SWRITE_HK(0); }
    __syncthreads();
}
template <class TIn, class TOut>
__device__ __forceinline__ void causal_swa_block(const BlockRef<TIn, TOut>& cur, const BlockRef<TIn, TOut>& nxt, int skv, int W, char* lds, Seam<TIn>& S, const float* const __attribute__((address_space(4)))* gslot, int goff) {
    constexpr bool F32 = same_t<TIn, float>::v;
    int tid_ = my_tid(); asm volatile("" : "+v"(tid_));
    const int tid = tid_, wid = __builtin_amdgcn_readfirstlane(tid >> 6), lane = tid & 63, r32 = lane & 31, hi = lane >> 5;
    const int j_lo = cur.JLO;
    int j_hi = (cur.P0 + QB - 1) / KVBLK + 1; if (j_hi > skv / KVBLK) j_hi = skv / KVBLK;
    const int NT = j_hi - j_lo;
    const int kbn = nxt.JLO * KVBLK;
    const int qlo = cur.P0 + wid * QBLK, qm = qlo + r32 - 4 * hi;
    char* V_lds = lds; char* K_lds = lds + 2 * SHM_V;
    float* ws = (float*)(lds + 2 * SHM_V + 2 * SHM_K) + wid * 64; float* li_l = ws, * al_l = ws + 32;
    float m_reg = -1e30f, l_reg = 0; f32x16 o[4] = {};
    const int sr = tid >> 4, sc = (tid & 15) * 8, vst0 = v_st(sr, sc), vst1 = v_st(32 + sr, sc), kws = KSWZ(sr, sc * 2);
    const int vb0 = (int)(uintptr_t)V_lds + v_rd_base(lane);
    const TIn* Kh = cur.K; const TIn* Vh = cur.V; const float* Fh = cur.F;
#define RESC(a) do { if (__any((a) < 1.f)) { if (hi == 0) al_l[r32] = (a); asm volatile("s_waitcnt lgkmcnt(0)" ::: "memory");              \
                     for (int d_ = 0; d_ < 4; ++d_) for (int r = 0; r < 16; ++r) o[d_][r] *= al_l[crow(r, hi)]; } } while (0)
#define KBASE(t) ((j_lo + (t)) * KVBLK)
#define ACT(t) (KBASE(t) <= qlo + QBLK - 1 && KBASE(t) + KVBLK - 1 >= qlo - W + 1)
#define MASKT(P0_, P1_, t) do { const int kb_ = KBASE(t); if ((!SK || ACT(t)) && (kb_ + KVBLK - 1 > qlo || kb_ <= qlo + QBLK - 1 - W)) mask_tile(P0_, P1_, qm - kb_, (unsigned)W); } while (0)
    constexpr int NQL = F32 ? 16 : 8;
    constexpr bool SK = WSKIP && !F32;
#define SEAM_K0() do { VMWN(NQL); if constexpr (F32) { SWRITE_KF(0); SBAR(); SLOAD_F((const float*)nxt.V, kbn); } else { SWRITE_HK(0); } SBAR(); } while (0)
    f32x16 pA0, pA1, pB0, pB1; float mnA, mnB, alA, alB; bf16x8 pa0, pa1, pa2, pa3;
    if constexpr (F32) { VMW(); SWRITE_VF(0); SBAR(); } else { SWRITE_HV(0); SBAR(); }
    if (NT > 1) { if constexpr (F32) SLOAD_F((const float*)Kh, KBASE(1)); else SLOAD_H(Kh, Vh, Fh, KBASE(1)); }
    SBAR(); qkt<0, SK>(pA0, pA1, K_lds, r32, hi, S.qr, ACT(0));
    if constexpr (F32) { if (NT > 1) { VMW(); SWRITE_KF(1); SBAR(); SLOAD_F((const float*)Vh, KBASE(1)); } }
    MASKT(pA0, pA1, 0); partialSM(pA0, pA1, m_reg, mnA, alA);
    if (NT > 1) { VMW(); if constexpr (F32) { SWRITE_VF(1); SBAR(); if (NT > 2) SLOAD_F((const float*)Kh, KBASE(2)); } else SWRITE_H(1); }
    __syncthreads();
#define HALF_STEP(PX0, PX1, mnX, alX, PY0, PY1, alY, t, KB, VB, SB) do {                                                      \
        SBAR(); qkt<KB, SK>(PX0, PX1, K_lds, r32, hi, S.qr, ACT(t));                                             \
        finishSM(PY0, PY1, alY, l_reg, pa0, pa1, pa2, pa3); SBAR();                                                           \
        if ((t) + 1 < NT) { if constexpr (F32) { VMW(); SWRITE_KF(SB); SBAR(); SLOAD_F((const float*)Vh, KBASE((t) + 1)); }  \
                            else { SLOAD_H(Kh, Vh, Fh, KBASE((t) + 1)); } SBAR(); }                                               \
        pv_tile<VB, SK>(o, vb0, pa0, pa1, pa2, pa3, ACT((t) - 1)); MASKT(PX0, PX1, (t)); partialSM(PX0, PX1, m_reg, mnX, alX);                                        \
        __syncthreads();                                                                                                      \
        if ((t) + 1 < NT) { VMW(); if constexpr (F32) { SWRITE_VF(SB); SBAR(); if ((t) + 2 < NT) SLOAD_F((const float*)Kh, KBASE((t) + 2)); } \
                            else { SWRITE_H(SB); } }                                                                          \
        RESC(alX); __syncthreads(); } while (0)
    for (int t = 1; t + 1 < NT; t += 2) {
        HALF_STEP(pB0, pB1, mnB, alB, pA0, pA1, alA, t, 1, 0, 0);
        HALF_STEP(pA0, pA1, mnA, alA, pB0, pB1, alB, t + 1, 0, 1, 1);
    }
    const bool even = (NT & 1) == 0;
    if (even) { SBAR(); qkt<1, SK>(pB0, pB1, K_lds, r32, hi, S.qr, ACT(NT - 1)); SBAR(); }
#define QROW(e) (nxt.Q + (size_t)(wid * QBLK + r32) * KVP + ((e) >> 1) * 16 + hi * 8 + ((e) & 1) * 4)
    if constexpr (F32) { SLOAD_F((const float*)nxt.K, kbn); SBAR();
#pragma unroll
        for (int e = 0; e < 8; ++e) S.tq[e] = *(const f32x4*)QROW(e); }
    else { SLOAD_H(nxt.K, nxt.V, nxt.F, kbn); SBAR();
#pragma unroll
        for (int d0 = 0; d0 < 8; ++d0) S.qr[d0] = load8<TIn>(nxt.Q + (size_t)(wid * QBLK + r32) * KVP + d0 * 16 + hi * 8); }
    SBAR();
    finishSM(pA0, pA1, alA, l_reg, pa0, pa1, pa2, pa3); SBAR();
    if constexpr (F32) {
#pragma unroll
        for (int e = 8; e < 16; ++e) S.tq[e] = *(const f32x4*)QROW(e); SBAR(); }
#undef QROW
    pv_tile<0, SK>(o, vb0, pa0, pa1, pa2, pa3, ACT(even ? NT - 2 : NT - 1));
    if (even) { MASKT(pB0, pB1, NT - 1); partialSM(pB0, pB1, m_reg, mnB, alB); __syncthreads(); RESC(alB);
        finishSM(pB0, pB1, alB, l_reg, pa0, pa1, pa2, pa3); SBAR(); pv_tile<1, SK>(o, vb0, pa0, pa1, pa2, pa3, ACT(NT - 1)); }
    SBAR(); SEAM_K0();
    if (hi == 0) li_l[r32] = l_reg; asm volatile("s_waitcnt lgkmcnt(0)" ::: "memory");
    float rli[16];
#pragma unroll
    for (int r = 0; r < 16; ++r) rli[r] = __builtin_amdgcn_rcpf(li_l[crow(r, hi)]);
    TOut* Ow = cur.O + (size_t)(wid * QBLK) * OP;
    float gn[4];
    { const float* G = *gslot + goff;
#pragma unroll
    for (int d0 = 0; d0 < 4; ++d0) gn[d0] = G[d0 * 32 + r32]; }
#pragma unroll
    for (int r = 0; r < 16; ++r) { const int orow = crow(r, hi);
        float y[4]; float ss = 0.f;
#pragma unroll
        for (int d0 = 0; d0 < 4; ++d0) { y[d0] = o[d0][r] * rli[r]; ss += y[d0] * y[d0]; }
        ss += __shfl_xor(ss, 1); ss += __shfl_xor(ss, 2); ss += __shfl_xor(ss, 4); ss += __shfl_xor(ss, 8); ss += __shfl_xor(ss, 16);
        const float rs = __builtin_amdgcn_rsqf(ss * (1.0f / 128.0f) + 1e-6f);
#pragma unroll
        for (int d0 = 0; d0 < 4; ++d0) { const float v = y[d0] * rs * gn[d0];
            if constexpr (same_t<TOut, float>::v) { Ow[(size_t)orow * OP + d0 * 32 + r32] = v; }
            else { const float vn = __shfl_xor(v, 1);
                   if ((r32 & 1) == 0) *(unsigned*)(Ow + (size_t)orow * OP + d0 * 32 + r32) = cvtpk(v, vn); } }
        SBAR(); }
    if constexpr (F32) {
#pragma unroll
        for (int d0 = 0; d0 < 8; ++d0) S.qr[d0] = pack8(S.tq[2 * d0], S.tq[2 * d0 + 1]); }
    __syncthreads();
#undef RESC
#undef KBASE
#undef ACT
#undef MASKT
#undef SEAM_K0
#undef HALF_STEP
}
#undef ROW
#undef VMW
#undef VMWN
#undef SLOAD_H
#undef SWRITE_HK
#undef SWRITE_HV
#undef SWRITE_H
#undef SLOAD_F
#undef SWRITE_KF
#undef SWRITE_VF


}

__device__ __forceinline__ float bflo(unsigned w) { return __uint_as_float(w << 16); }
__device__ __forceinline__ float bfhi(unsigned w) { return __uint_as_float(w & 0xffff0000u); }
__device__ __forceinline__ float wave_sum(float v) {
#pragma unroll
    for (int o = 1; o < 64; o <<= 1) v += __shfl_xor(v, o);
    return v;
}
__device__ __forceinline__ float sigmoid_f(float x) { return 1.0f / (1.0f + __expf(-x)); }
__device__ __forceinline__ float silu_acc(float x) { return x / (1.0f + __expf(-x)); }
__device__ __forceinline__ float softplus_f(float x) { return fmaxf(x, 0.f) + log1pf(__expf(-fabsf(x))); }
__device__ __forceinline__ float logsigmoid_f(float x) { return fminf(x, 0.f) - log1pf(__expf(-fabsf(x))); }

struct Args { const float* in[17]; float* out; unsigned char* ws; int ph_lo, ph_hi; };
typedef const __attribute__((address_space(4))) Args* ArgsP;
enum { I_X = 0, I_MIXPRE, I_WIN, I_FOXFB, I_FOXON, I_SCW, I_GDNCW, I_GDNALOG, I_GDNDTB, I_GDNON, I_WOUT, I_MIXPOST, I_FFNPRE, I_WGATE, I_WUP, I_WDOWN, I_FFNPOST };
struct Ptrs {
    ArgsP ap;
    int tid, lane, wave, gw, NGW, G, bid;
};
__device__ __forceinline__ Ptrs fresh_ptrs(ArgsP ap0);
__device__ __forceinline__ int ftid() { int t = my_tid(); asm volatile("" : "+v"(t)); return t; }
__device__ __forceinline__ int fbid() { int b = blockIdx.x; asm volatile("" : "+s"(b)); return b; }
__device__ __forceinline__ ArgsP fresh(ArgsP a) { asm volatile("" : "+s"(a)); return a; }
__device__ __forceinline__ Ptrs fresh_ptrs(ArgsP ap0) { Ptrs P; P.ap = fresh(ap0); P.tid = ftid(); P.lane = P.tid & 63; P.wave = __builtin_amdgcn_readfirstlane(P.tid >> 6); P.bid = fbid();
    P.G = gridDim.x; P.gw = P.bid * NWAVES + P.wave; P.NGW = P.G * NWAVES; return P; }

__device__ __forceinline__ int win_src4(int d) {
    if (d < PC_SB) return d;
    if (d < PC_GQ) return d - PC_SB + SRC_SB;
    if (d < PC_GZ) return d - PC_GQ + SRC_GQ;
    if (d < PC_SMALL) return d - PC_GZ + SRC_GZ;
    const int e = d - PC_SMALL;
    if (e < 12) return SRC_FF + e;
    if (e < 24) return SRC_GA + e - 12;
    if (e < 36) return SRC_GB + e - 24;
    return -1;
}
struct TrItem { const float* W; int Ns, scol, k0; bf16* WT; int K, dn0; };
__device__ __forceinline__ void tr_load(const TrItem& t, f32x4 (&v)[8], int lane) {
    const int sub = lane >> 3;
#pragma unroll
    for (int i = 0; i < 8; ++i) { const int kk = 8 * i + sub; v[i] = (f32x4){0.f, 0.f, 0.f, 0.f}; if (t.scol >= 0) v[i] = *(const f32x4*)(t.W + (size_t)(t.k0 + kk) * t.Ns + t.scol); }
}
__device__ __forceinline__ void tr_store(const TrItem& t, const f32x4 (&v)[8], LAS float* scr, int lane) {
    const int sub = lane >> 3, g = lane & 7;
#pragma unroll
    for (int i = 0; i < 8; ++i) { const int kk = 8 * i + sub; LAS float* s = scr + kk * 33 + 4 * g; s[0] = v[i][0]; s[1] = v[i][1]; s[2] = v[i][2]; s[3] = v[i][3]; }
    LDS_WAIT(); asm volatile("" ::: "memory");
    const int c = lane & 7;
#pragma unroll
    for (int j = 0; j < 4; ++j) { const int n = (lane >> 3) + 8 * j; const LAS float* s = scr + (8 * c) * 33 + n;
        v4u o; o.x = pk2(s[0 * 33], s[1 * 33]); o.y = pk2(s[2 * 33], s[3 * 33]); o.z = pk2(s[4 * 33], s[5 * 33]); o.w = pk2(s[6 * 33], s[7 * 33]);
        *(v4u*)(t.WT + (size_t)(t.dn0 + n) * t.K + t.k0 + 8 * c) = o; }
    LDS_WAIT(); asm volatile("" ::: "memory");
}
constexpr int I_IN = 64 * (NP / 32), I_OUT = 64 * (DM / 32), I_GU = 64 * (NGU / 32), I_DN = (FFN / 64) * (DM / 32), I_LAYER = I_IN + I_OUT + I_GU + I_DN;
#ifndef CV_TAIL_DN
#define CV_TAIL_DN 12000
#endif
#ifndef CV_TAIL_IN
#define CV_TAIL_IN 25000
#endif
constexpr int I_3 = I_IN + I_OUT + I_GU;

typedef unsigned u32x2t __attribute__((ext_vector_type(2)));
__device__ __forceinline__ float sq4(const f32x4 v) { return (v[0] * v[0] + v[1] * v[1]) + (v[2] * v[2] + v[3] * v[3]); }
__device__ __forceinline__ void rms_row_to_bf16(const float* xrow, const float* gain, bf16* orow, int lane) {
    f32x4 a[16]; float ss = 0.f;
#pragma unroll
    for (int j = 0; j < 16; ++j) { a[j] = *(const f32x4*)(xrow + 256 * j + 4 * lane); ss += sq4(a[j]); }
    const float r = 1.0f / sqrtf(wave_sum(ss) * (1.0f / DM) + RMS_EPS);
#pragma unroll
    for (int j = 0; j < 16; ++j) { const f32x4 g = *(const f32x4*)(gain + 256 * j + 4 * lane);
        u32x2t o; o.x = pk2(a[j][0] * r * g[0], a[j][1] * r * g[1]); o.y = pk2(a[j][2] * r * g[2], a[j][3] * r * g[3]);
        *(u32x2t*)(orow + 256 * j + 4 * lane) = o; }
}
__device__ __forceinline__ void resid_norm_row(const float* base_row, const bf16* yrow, const float* ssrow, const float* gpost, float* out_row, const float* gnext, bf16* xn_row, int lane) {
    const float ry = 1.0f / sqrtf(wave_sum(ssrow[lane]) * (1.0f / DM) + RMS_EPS);
    f32x4 a[16]; float ss = 0.f;
#pragma unroll
    for (int j = 0; j < 16; ++j) { const int c = 256 * j + 4 * lane; const u32x2t yw = *(const u32x2t*)(yrow + c);
        const f32x4 x0 = *(const f32x4*)(base_row + c), g0 = *(const f32x4*)(gpost + c);
        a[j][0] = x0[0] + bflo(yw.x) * ry * g0[0]; a[j][1] = x0[1] + bfhi(yw.x) * ry * g0[1]; a[j][2] = x0[2] + bflo(yw.y) * ry * g0[2]; a[j][3] = x0[3] + bfhi(yw.y) * ry * g0[3];
        *(f32x4*)(out_row + c) = a[j]; ss += sq4(a[j]); }
    if (gnext) {
        const float r = 1.0f / sqrtf(wave_sum(ss) * (1.0f / DM) + RMS_EPS);
#pragma unroll
        for (int j = 0; j < 16; ++j) { const f32x4 g = *(const f32x4*)(gnext + 256 * j + 4 * lane);
            u32x2t o; o.x = pk2(a[j][0] * r * g[0], a[j][1] * r * g[1]); o.y = pk2(a[j][2] * r * g[2], a[j][3] * r * g[3]);
            *(u32x2t*)(xn_row + 256 * j + 4 * lane) = o; }
    }
}

__device__ __forceinline__ TrItem cv_item(ArgsP A, int l, int it, int g) {
    bf16* wl = (bf16*)(A->ws + WS_W);
    int r = it; TrItem t;
    if (r < I_IN) { const int kb = r / (NP / 32), nb = r % (NP / 32);
        t.W = A->in[I_WIN] + (size_t)l * DM * PROJ_SRC; t.Ns = PROJ_SRC; t.scol = win_src4(32 * nb + 4 * g); t.k0 = 64 * kb; t.WT = (bf16*)((unsigned char*)wl + WO_IN); t.K = DM; t.dn0 = 32 * nb; return t; }
    r -= I_IN;
    if (r < I_OUT) { const int kb = r / (DM / 32), nb = r % (DM / 32);
        t.W = A->in[I_WOUT] + (size_t)l * DM * DM; t.Ns = DM; t.scol = 32 * nb + 4 * g; t.k0 = 64 * kb; t.WT = (bf16*)((unsigned char*)wl + WO_OUT); t.K = DM; t.dn0 = 32 * nb; return t; }
    r -= I_OUT;
    if (r < I_GU) { const int kb = r / (NGU / 32), nb = r % (NGU / 32), dn0 = 32 * nb, j = dn0 >> 8, w = dn0 & 255;
        t.W = (w < 128 ? A->in[I_WGATE] : A->in[I_WUP]) + (size_t)l * DM * FFN; t.Ns = FFN; t.scol = 128 * j + (w & 127) + 4 * g; t.k0 = 64 * kb; t.WT = (bf16*)((unsigned char*)wl + WO_GU); t.K = DM; t.dn0 = dn0; return t; }
    r -= I_GU;
    { const int kb = r / (DM / 32), nb = r % (DM / 32);
        t.W = A->in[I_WDOWN] + (size_t)l * FFN * DM; t.Ns = DM; t.scol = 32 * nb + 4 * g; t.k0 = 64 * kb; t.WT = (bf16*)((unsigned char*)wl + WO_DN); t.K = FFN; t.dn0 = 32 * nb; return t; }
}
__device__ __forceinline__ void convert_weights(ArgsP ap0, LAS unsigned char* lds, int l, int lo = 0, int hi = I_LAYER, int wg_lo = 0) {
    const Ptrs P = fresh_ptrs(ap0); const ArgsP A = P.ap;
    if (P.bid < wg_lo) return;
    LAS float* scr = (LAS float*)(lds + P.wave * 16384);
    const int g = P.lane & 7, stride = (P.G - wg_lo) * NWAVES;
    int it = lo + (P.bid - wg_lo) * NWAVES + P.wave;
    if (it >= hi) return;
    f32x4 va[8], vb[8];
    tr_load(cv_item(A, l, it, g), va, P.lane);
    for (;;) {
        { const int nit = it + stride; const bool hasn = nit < hi; if (hasn) tr_load(cv_item(A, l, nit, g), vb, P.lane);
          tr_store(cv_item(A, l, it, g), va, scr, P.lane); if (!hasn) break; it = nit; }
        { const int nit = it + stride; const bool hasn = nit < hi; if (hasn) tr_load(cv_item(A, l, nit, g), va, P.lane);
          tr_store(cv_item(A, l, it, g), vb, scr, P.lane); if (!hasn) break; it = nit; }
    }
}
__device__ __forceinline__ void p0_prologue(ArgsP ap0, LAS unsigned char* lds) {
    convert_weights(ap0, lds, 0, 0, I_3);
    convert_weights(ap0, lds, 0, I_3 + CV_TAIL_DN, I_LAYER);
    const Ptrs P = fresh_ptrs(ap0); const ArgsP A = P.ap;
    bf16* XN = (bf16*)(A->ws + WS_XN);
    for (int m = P.gw; m < M; m += P.NGW) rms_row_to_bf16(A->in[I_X] + (size_t)m * DM, A->in[I_MIXPRE], XN + (size_t)m * DM, P.lane);
}

__device__ __forceinline__ void p2_prep(ArgsP ap0, LAS unsigned char* lds, int l) {
    const Ptrs P = fresh_ptrs(ap0); const ArgsP A = P.ap;
    const bf16* SCB = (const bf16*)(A->ws + WS_SCB); const float* SB = (const float*)(A->ws + WS_SB);
    bf16* MIX = (bf16*)(A->ws + WS_MIX); float* FG = (float*)(A->ws + WS_FG);
    const int lane = P.lane;
    if (P.bid < BATCH * FOXH) {
        const int bh = P.bid, b = bh / FOXH, h = bh % FOXH; const float fb = A->in[I_FOXFB][l * FOXH + h];
        const float* sb = SB + ((size_t)(b * SEQ) + 16 * P.tid) * SBW + SB_FF + h;
        float ls[16]; float loc = 0.f;
#pragma unroll
        for (int i = 0; i < 16; ++i) ls[i] = sb[(size_t)i * SBW];
#pragma unroll
        for (int i = 0; i < 16; ++i) { ls[i] = logsigmoid_f(ls[i] + fb); loc += ls[i]; }
        float incl = loc;
#pragma unroll
        for (int o = 1; o < 64; o <<= 1) { const float n = __shfl_up(incl, o); if (lane >= o) incl += n; }
        LAS float* wt = (LAS float*)lds;
        if (lane == 63) wt[P.wave] = incl;
        __syncthreads();
        float run = incl - loc;
        for (int w = 0; w < P.wave; ++w) run += wt[w];
        f32x4 o4[4];
#pragma unroll
        for (int i = 0; i < 16; ++i) { run += ls[i]; o4[i >> 2][i & 3] = -run * 11.313708498984761f; }
        float* fo = FG + (size_t)bh * SEQ + 16 * P.tid;
#pragma unroll
        for (int i = 0; i < 4; ++i) *(f32x4*)(fo + 4 * i) = o4[i];
        __syncthreads();
    }
    { const bf16* HMq = (const bf16*)(A->ws + WS_PROJ); float* TN = (float*)(A->ws + WS_TN);
      constexpr int NT_ = BATCH * FOXH * (SEQ / 64);
      for (int it = P.gw; it < NT_; it += P.NGW) {
        const int bh = it / (SEQ / 64), c = it % (SEQ / 64);
        const v4u* qrow = (const v4u*)(HMq + hm_off(HM_FQ, bh) + (size_t)(c * 64 + lane) * HD); const v4u* krow = (const v4u*)(HMq + hm_off(HM_FK, bh) + (size_t)(c * 64 + lane) * HD);
        v4u qv[16], kv[16];
#pragma unroll
        for (int j = 0; j < 16; ++j) { qv[j] = qrow[j]; kv[j] = krow[j]; }
        float sq = 0.f, sk = 0.f, d = 0.f;
#pragma unroll
        for (int j = 0; j < 16; ++j) {
#pragma unroll
            for (int e4 = 0; e4 < 4; ++e4) { const unsigned a = e4 == 0 ? qv[j].x : e4 == 1 ? qv[j].y : e4 == 2 ? qv[j].z : qv[j].w, b = e4 == 0 ? kv[j].x : e4 == 1 ? kv[j].y : e4 == 2 ? kv[j].z : kv[j].w;
                const float a0 = bflo(a), a1 = bfhi(a), b0 = bflo(b), b1 = bfhi(b); sq += a0 * a0 + a1 * a1; sk += b0 * b0 + b1 * b1; d += a0 * b0 + a1 * b1; } }
#pragma unroll
        for (int o = 1; o < 64; o <<= 1) { sq = fmaxf(sq, __shfl_xor(sq, o)); sk = fmaxf(sk, __shfl_xor(sk, o)); d = fminf(d, __shfl_xor(d, o)); }
        if (lane == 0) { TN[it] = sq; TN[NT_ + it] = sk; TN[2 * NT_ + it] = d; }
      } }
    { const float* cw = A->in[I_SCW] + (size_t)l * 3 * SCW;
      for (int idx = P.bid * 512 + P.tid; idx < M * (SCW / 8); idx += P.G * 512) {
        const int m = idx >> 7, c = (idx & 127) * 8, tp = m & (SEQ - 1);
        const bf16* row = SCB + (size_t)m * SCBW;
        const v4u bw = *(const v4u*)(row + c);
        float acc[8];
#pragma unroll
        for (int e = 0; e < 8; ++e) acc[e] = 0.f;
#pragma unroll
        for (int j = 0; j < 3; ++j) { const int dt = 2 - j;
            if (tp - dt >= 0) { const bf16* rj = row - (size_t)dt * SCBW; const v4u cwv = *(const v4u*)(rj + SCW + c), hw = *(const v4u*)(rj + 2 * SCW + c);
                const f32x4 w0 = *(const f32x4*)(cw + j * SCW + c), w1 = *(const f32x4*)(cw + j * SCW + c + 4);
                acc[0] += w0[0] * bflo(cwv.x) * bflo(hw.x); acc[1] += w0[1] * bfhi(cwv.x) * bfhi(hw.x); acc[2] += w0[2] * bflo(cwv.y) * bflo(hw.y); acc[3] += w0[3] * bfhi(cwv.y) * bfhi(hw.y);
                acc[4] += w1[0] * bflo(cwv.z) * bflo(hw.z); acc[5] += w1[1] * bfhi(cwv.z) * bfhi(hw.z); acc[6] += w1[2] * bflo(cwv.w) * bflo(hw.w); acc[7] += w1[3] * bfhi(cwv.w) * bfhi(hw.w); } }
        v4u o; o.x = pk2(acc[0] * bflo(bw.x), acc[1] * bfhi(bw.x)); o.y = pk2(acc[2] * bflo(bw.y), acc[3] * bfhi(bw.y)); o.z = pk2(acc[4] * bflo(bw.z), acc[5] * bfhi(bw.z)); o.w = pk2(acc[6] * bflo(bw.w), acc[7] * bfhi(bw.w));
        *(v4u*)(MIX + (size_t)m * DM + FOXW + c) = o; } }
}


#ifndef GP_REP_S1
#define GP_REP_S1 1
#endif
#ifndef GP_REP_S4
#define GP_REP_S4 1
#endif
constexpr int GD_OPS_BYTES = 57344;
constexpr int GD_F_WN = 0, GD_F_QD = 16, GD_F_AT = 32, GD_F_KT = 40;
constexpr int GD_NCH = SEQ / 64;
constexpr int GD_NCHH = BATCH * GDNH * GD_NCH;
constexpr size_t WS_GOPS = WS_Y, WS_GU = WS_Y + 168 * MiB, WS_GL = WS_Y + 264 * MiB, WS_GO2 = WS_Y + 266 * MiB;
constexpr int GP_QS = 0, GP_KS = 17408, GP_VS = 34816, GP_LT = 68608, GP_AT = 86016, GP_WM = 103424, GP_SM = 120832;
typedef float f32x2v __attribute__((ext_vector_type(2)));
typedef unsigned u32x2v __attribute__((ext_vector_type(2)));
typedef __bf16 bf16x2c_t __attribute__((ext_vector_type(2)));
__device__ __forceinline__ unsigned cvtpk_bf16(float lo, float hi) { const f32x2v v = {lo, hi}; const bf16x2c_t b = __builtin_convertvector(v, bf16x2c_t); return __builtin_bit_cast(unsigned, b); }


template <int N> __device__ __forceinline__ void fma_bcast(float& x, float l, float nxi) {
    asm volatile("v_fmac_f32_dpp %0, %1, %2 row_newbcast:%3 row_mask:0xf bank_mask:0xf" : "+v"(x) : "v"(l), "v"(nxi), "n"(N));
}
template <int I, int R> struct TriRow {
    static __device__ __forceinline__ void run(float (&x)[64], const float (&L)[4], float nxi) { fma_bcast<(R & 15)>(x[R], L[R >> 4], nxi); TriRow<I, R + 1>::run(x, L, nxi); }
};
template <int I> struct TriRow<I, 64> { static __device__ __forceinline__ void run(float (&)[64], const float (&)[4], float) {} };
template <int I> struct TriSolve {
    static __device__ __forceinline__ void run(float (&x)[64], const LAS float* ltb, float (&Lc)[4]) {
        float Ln[4] = {0.f, 0.f, 0.f, 0.f};
        if (I + 1 < 63) {
#pragma unroll
            for (int q = (I + 2) >> 4; q < 4; ++q) Ln[q] = ltb[(I + 1) * 68 + 16 * q]; }
        const float nxi = -x[I];
        asm volatile("s_nop 1" ::: "memory");
        TriRow<I, I + 1>::run(x, Lc, nxi);
#pragma unroll
        for (int q = 0; q < 4; ++q) Lc[q] = Ln[q];
        TriSolve<I + 1>::run(x, ltb, Lc);
    }
};
template <> struct TriSolve<63> { static __device__ __forceinline__ void run(float (&)[64], const LAS float*, float (&)[4]) {} };


template <int NT, int PA = 0, int PB = 3>
__device__ __forceinline__ void gp_s1(LAS unsigned char* lds, const bf16* HMG, const float* cw, int ch, int ltid) {
    const int bh = ch / GD_NCH, n = ch % GD_NCH, h = bh % GDNH;
    constexpr int NI = 3072 / NT, PER = NI / 3, ROWS = NT / 16, NB = (NT == 256 ? 4 : 3);
    const int c = (ltid & 15) * 8;
#pragma unroll
    for (int i0 = PA * PER; i0 < PB * PER; i0 += NB) {
        v4u xw[NB][4];
#pragma unroll
        for (int ib = 0; ib < NB; ++ib) { const int i = i0 + ib, part = i / PER, t = (i % PER) * ROWS + (ltid >> 4), tp = n * 64 + t;
            const bf16* src = HMG + hm_off(part, bh) + (size_t)(n * 64 + t) * HD + c;
#pragma unroll
            for (int j = 0; j < 4; ++j) { xw[ib][j] = (v4u){0u, 0u, 0u, 0u}; if (tp - (3 - j) >= 0) xw[ib][j] = *(const v4u*)(src - (size_t)(3 - j) * HD); } }
#pragma unroll
        for (int ib = 0; ib < NB; ++ib) { const int i = i0 + ib, part = i / PER, t = (i % PER) * ROWS + (ltid >> 4);
            const float* wp = cw + part * GDNW + h * HD + c;
            float acc[8];
#pragma unroll
            for (int e = 0; e < 8; ++e) acc[e] = 0.f;
#pragma unroll
            for (int j = 0; j < 4; ++j) { const v4u xv = xw[ib][j]; const f32x4 w0 = *(const f32x4*)(wp + j * (3 * GDNW)), w1 = *(const f32x4*)(wp + j * (3 * GDNW) + 4);
                acc[0] += w0[0] * bflo(xv.x); acc[1] += w0[1] * bfhi(xv.x); acc[2] += w0[2] * bflo(xv.y); acc[3] += w0[3] * bfhi(xv.y);
                acc[4] += w1[0] * bflo(xv.z); acc[5] += w1[1] * bfhi(xv.z); acc[6] += w1[2] * bflo(xv.w); acc[7] += w1[3] * bfhi(xv.w); }
            float ss = 0.f;
#pragma unroll
            for (int e = 0; e < 8; ++e) { acc[e] = acc[e] * __builtin_amdgcn_rcpf(1.0f + __builtin_amdgcn_exp2f(-1.4426950408889634f * acc[e])); ss += acc[e] * acc[e]; }
            if (part < 2) {
                ss += __shfl_xor(ss, 1); ss += __shfl_xor(ss, 2); ss += __shfl_xor(ss, 4); ss += __shfl_xor(ss, 8);
                const float r = (1.0f / sqrtf(ss + RMS_EPS)) * (part == 0 ? 0.08838834764831845f : 1.0f);
                v4u o; o.x = cvtpk_bf16(acc[0] * r, acc[1] * r); o.y = cvtpk_bf16(acc[2] * r, acc[3] * r); o.z = cvtpk_bf16(acc[4] * r, acc[5] * r); o.w = cvtpk_bf16(acc[6] * r, acc[7] * r);
                *(LAS v4u*)(lds + (part == 0 ? GP_QS : GP_KS) + (t * 136 + c) * 2) = o;
            } else {
                LAS float* vp = (LAS float*)(lds + GP_VS) + t * 132 + c;
                *(LAS f32x4*)vp = (f32x4){acc[0], acc[1], acc[2], acc[3]}; *(LAS f32x4*)(vp + 4) = (f32x4){acc[4], acc[5], acc[6], acc[7]};
            }
        }
    }
}
__device__ __forceinline__ void gp_s2(ArgsP A, LAS float* SMf, const float* SB, float* GL, int l, int ch, int lane) {
    const int bh = ch / GD_NCH, n = ch % GD_NCH, b = bh / GDNH, h = bh % GDNH;
    const size_t m = (size_t)b * SEQ + (size_t)n * 64 + lane;
    const float xb = SB[m * SBW + SB_GB + h], xa = SB[m * SBW + SB_GA + h] + A->in[I_GDNDTB][l * GDNH + h];
    const float bt = __builtin_amdgcn_rcpf(1.0f + __builtin_amdgcn_exp2f(-1.4426950408889634f * xb));
    const float sp = fmaxf(xa, 0.f) + 0.6931471805599453f * __builtin_amdgcn_logf(1.0f + __builtin_amdgcn_exp2f(-1.4426950408889634f * fabsf(xa)));
    const float gg = -__builtin_amdgcn_exp2f(1.4426950408889634f * A->in[I_GDNALOG][l * GDNH + h]) * sp;
    float gc = gg;
#pragma unroll
    for (int o = 1; o < 64; o <<= 1) { const float nb = __shfl_up(gc, o); if (lane >= o) gc += nb; }
    const float gtot = __shfl(gc, 63);
    SMf[lane] = bt; SMf[64 + lane] = gc; SMf[128 + lane] = __builtin_amdgcn_exp2f(1.4426950408889634f * gc); SMf[192 + lane] = __builtin_amdgcn_exp2f(1.4426950408889634f * (gtot - gc));
    if (lane == 63) GL[ch] = __builtin_amdgcn_exp2f(1.4426950408889634f * gtot);
}

__device__ __forceinline__ void gdn_prep(ArgsP ap0, LAS unsigned char* lds, int l) {
    const Ptrs P = fresh_ptrs(ap0); const ArgsP A = P.ap;
    const int tid = P.tid, lane = P.lane, wave = P.wave;
    const bf16* HMG = (const bf16*)(A->ws + WS_PROJ) + hm_off(HM_GQ, 0); const float* SB = (const float*)(A->ws + WS_SB);
    unsigned char* GOPS = A->ws + WS_GOPS; float* GU = (float*)(A->ws + WS_GU); float* GL = (float*)(A->ws + WS_GL);
    const float* cw = A->in[I_GDNCW] + (size_t)l * 4 * (3 * GDNW);
    LAS float* SMf = (LAS float*)(lds + GP_SM);
    LAS unsigned* hb = (LAS unsigned*)(lds + GP_SM + 1024); unsigned hb_epoch = 0u;
    if (tid == 0) *hb = 0u;
    if (P.bid < GD_NCHH) { gp_s1<512>(lds, HMG, cw, P.bid, tid); if (wave == 0) gp_s2(A, SMf, SB, GL, l, P.bid, lane); }
    for (int ch = P.bid; ch < GD_NCHH; ch += P.G) {
        const int bh = ch / GD_NCH, n = ch % GD_NCH, b = bh / GDNH, h = bh % GDNH;
        const size_t row0 = (size_t)b * SEQ + (size_t)n * 64;
        (void)b; (void)h; (void)row0; (void)n;
        __syncthreads();
        {
            const int mat = wave >> 2, mt = wave & 3, q4 = lane >> 4, m16 = lane & 15;
            f32x4 acc[4];
#pragma unroll
            for (int nt = 0; nt < 4; ++nt) acc[nt] = (f32x4){0.f, 0.f, 0.f, 0.f};
            const LAS unsigned char* abase = lds + (mat == 0 ? GP_KS : GP_QS) + ((16 * mt + m16) * 136 + 8 * q4) * 2;
            const LAS unsigned char* bbase = lds + GP_KS + (m16 * 136 + 8 * q4) * 2;
#pragma unroll
            for (int ks = 0; ks < 4; ++ks) { const bf16x8 a = *(const LAS bf16x8*)(abase + ks * 64);
#pragma unroll
                for (int nt = 0; nt < 4; ++nt) { const bf16x8 bb = *(const LAS bf16x8*)(bbase + nt * (16 * 136 * 2) + ks * 64); acc[nt] = __builtin_amdgcn_mfma_f32_16x16x32_bf16(a, bb, acc[nt], 0, 0, 0); } }
            const int c0 = 16 * mt + 4 * q4;
            const f32x4 gcc = *(const LAS f32x4*)(SMf + 64 + c0), btc = *(const LAS f32x4*)(SMf + c0);
#pragma unroll
            for (int nt = 0; nt < 4; ++nt) { const int s = 16 * nt + m16; const float gs = SMf[64 + s];
                if (mat == 0) { f32x4 o;
#pragma unroll
                    for (int r = 0; r < 4; ++r) o[r] = (s < c0 + r) ? btc[r] * acc[nt][r] * __builtin_amdgcn_exp2f(1.4426950408889634f * (gcc[r] - gs)) : 0.f;
                    *(LAS f32x4*)((LAS float*)(lds + GP_LT) + s * 68 + c0) = o;
                } else {
#pragma unroll
                    for (int r = 0; r < 4; ++r) ((LAS float*)(lds + GP_AT))[(c0 + r) * 68 + s] = (s <= c0 + r) ? acc[nt][r] * __builtin_amdgcn_exp2f(1.4426950408889634f * (gcc[r] - gs)) : 0.f;
                } }
        }
        __syncthreads();
        float x[64];
        if (tid < 256) {
            const int j = tid & 127, isw = tid >> 7;
            int vz = 0; asm volatile("" : "+v"(vz));
            const LAS float* SMv = SMf + vz;
#pragma unroll
            for (int r4 = 0; r4 < 16; ++r4) { const f32x4 bt = *(const LAS f32x4*)(SMv + 4 * r4), eg = *(const LAS f32x4*)(SMv + 128 + 4 * r4);
#pragma unroll
                for (int e = 0; e < 4; ++e) { const int r = 4 * r4 + e;
                    x[r] = isw ? __uint_as_float((unsigned)(*(const LAS unsigned short*)(lds + GP_KS + (r * 136 + j) * 2)) << 16) * (bt[e] * eg[e]) : ((const LAS float*)(lds + GP_VS))[r * 132 + j] * bt[e]; } }
        }
        __syncthreads();
        if (tid < 256) {
            const int j = tid & 127, isw = tid >> 7;
            { const LAS float* ltb = (const LAS float*)(lds + GP_LT) + (lane & 15);
              float Lc[4];
#pragma unroll
              for (int q = 0; q < 4; ++q) Lc[q] = ltb[16 * q];
              TriSolve<0>::run(x, ltb, Lc); }
            if (!isw) { float* up = GU + (size_t)ch * 8192 + (size_t)((j >> 4) * 4) * 256 + (j & 15) * 4;
#pragma unroll
                for (int mt = 0; mt < 4; ++mt)
#pragma unroll
                    for (int q4 = 0; q4 < 4; ++q4) *(f32x4*)(up + mt * 256 + q4 * 64) = (f32x4){x[16 * mt + 4 * q4], x[16 * mt + 4 * q4 + 1], x[16 * mt + 4 * q4 + 2], x[16 * mt + 4 * q4 + 3]};
            } else {
#pragma unroll
                for (int r = 0; r < 64; ++r) *(LAS unsigned short*)(lds + GP_WM + (r * 136 + j) * 2) = (unsigned short)f2bf(-x[r]);
            }
            if (ch + P.G < GD_NCHH) gp_s1<256, 2, 3>(lds, HMG, cw, ch + P.G, tid);
        } else {
            const int wv = wave - 4, q4 = lane >> 4, m16 = lane & 15;
            unsigned char* dst = GOPS + (size_t)ch * GD_OPS_BYTES + lane * 16;
            for (int f = wv; f < 40; f += 4) {
                v4u o;
                if (f < 16) { const int mt = f >> 2, ks = f & 3, row = 16 * mt + m16; const float eg = SMf[128 + row];
                    const LAS unsigned char* p = lds + GP_QS + (row * 136 + 32 * ks + 4 * q4) * 2;
                    const u32x2v a = *(const LAS u32x2v*)p, bq = *(const LAS u32x2v*)(p + 32);
                    o.x = cvtpk_bf16(bflo(a.x) * eg, bfhi(a.x) * eg); o.y = cvtpk_bf16(bflo(a.y) * eg, bfhi(a.y) * eg); o.z = cvtpk_bf16(bflo(bq.x) * eg, bfhi(bq.x) * eg); o.w = cvtpk_bf16(bflo(bq.y) * eg, bfhi(bq.y) * eg);
                    *(v4u*)(dst + (GD_F_QD + f) * 1024) = o;
                } else if (f < 24) { const int ff = f - 16, mt = ff >> 1, ks = ff & 1, row = 16 * mt + m16;
                    const LAS float* p = (const LAS float*)(lds + GP_AT) + row * 68 + 32 * ks + 4 * q4;
                    const f32x4 a = *(const LAS f32x4*)p, bq = *(const LAS f32x4*)(p + 16);
                    o.x = cvtpk_bf16(a[0], a[1]); o.y = cvtpk_bf16(a[2], a[3]); o.z = cvtpk_bf16(bq[0], bq[1]); o.w = cvtpk_bf16(bq[2], bq[3]);
                    *(v4u*)(dst + (GD_F_AT + ff) * 1024) = o;
                } else { const int ff = f - 24, mt = ff >> 1, ks = ff & 1, dk = 16 * mt + m16;
                    const int cA = 32 * ks + 4 * q4; const f32x4 ekA = *(const LAS f32x4*)(SMf + 192 + cA), ekB = *(const LAS f32x4*)(SMf + 192 + cA + 16);
                    float kv[8];
#pragma unroll
                    for (int e = 0; e < 4; ++e) { kv[e] = __uint_as_float((unsigned)(*(const LAS unsigned short*)(lds + GP_KS + ((cA + e) * 136 + dk) * 2)) << 16) * ekA[e];
                                                  kv[4 + e] = __uint_as_float((unsigned)(*(const LAS unsigned short*)(lds + GP_KS + ((cA + 16 + e) * 136 + dk) * 2)) << 16) * ekB[e]; }
                    o.x = cvtpk_bf16(kv[0], kv[1]); o.y = cvtpk_bf16(kv[2], kv[3]); o.z = cvtpk_bf16(kv[4], kv[5]); o.w = cvtpk_bf16(kv[6], kv[7]);
                    *(v4u*)(dst + (GD_F_KT + ff) * 1024) = o;
                }
            }
            if (ch + P.G < GD_NCHH) {
                asm volatile("s_waitcnt lgkmcnt(0)" ::: "memory");
                ++hb_epoch;
                if (lane == 0) (void)__hip_atomic_fetch_add(hb, 1u, __ATOMIC_RELAXED, __HIP_MEMORY_SCOPE_WORKGROUP);
                while (__hip_atomic_load(hb, __ATOMIC_RELAXED, __HIP_MEMORY_SCOPE_WORKGROUP) < 4u * hb_epoch) __builtin_amdgcn_s_sleep(1);
                asm volatile("" ::: "memory");
                gp_s1<256, 0, 2>(lds, HMG, cw, ch + P.G, tid - 256); if (wave == 4) gp_s2(A, SMf, SB, GL, l, ch + P.G, lane); }
        }
        __syncthreads();
        { const int q4 = lane >> 4, m16 = lane & 15;
#pragma unroll
          for (int k2 = 0; k2 < 2; ++k2) { const int f = wave * 2 + k2, mt = f >> 2, ks = f & 3, row = 16 * mt + m16;
            const LAS unsigned char* p = lds + GP_WM + (row * 136 + 32 * ks + 4 * q4) * 2;
            const u32x2v a = *(const LAS u32x2v*)p, bq = *(const LAS u32x2v*)(p + 32);
            v4u o; o.x = a.x; o.y = a.y; o.z = bq.x; o.w = bq.y;
            *(v4u*)(GOPS + (size_t)ch * GD_OPS_BYTES + (GD_F_WN + f) * 1024 + lane * 16) = o; } }
    }
    __syncthreads();
}

__device__ __forceinline__ void gdn_scan(ArgsP ap0, LAS unsigned char* lds) {
    const Ptrs P = fresh_ptrs(ap0); const ArgsP A = P.ap;
    const int lane = P.lane, wave = P.wave, bh = P.bid >> 1, b = bh / GDNH, h = bh % GDNH, q4 = lane >> 4, n16 = lane & 15;
    const int cs = (P.bid & 1) * 4 + (wave & 3);
    const bool comp = wave < 4;
    const unsigned char* ops = A->ws + WS_GOPS + (size_t)bh * GD_NCH * GD_OPS_BYTES;
    const float* Up = (const float*)(A->ws + WS_GU) + (size_t)bh * GD_NCH * 8192 + (size_t)(cs * 4) * 256 + lane * 4;
    const float* GLp = (const float*)(A->ws + WS_GL) + (size_t)bh * GD_NCH;
    float* GO = (float*)(A->ws + WS_GO2) + ((size_t)b * SEQ) * GDNW + h * HD + 16 * cs + n16;
    f32x4 S[8];
#pragma unroll
    for (int i = 0; i < 8; ++i) S[i] = (f32x4){0.f, 0.f, 0.f, 0.f};
    f32x4 Un[4]; float gln = 0.f;
#pragma unroll
    for (int i = 0; i < 4; ++i) Un[i] = (f32x4){0.f, 0.f, 0.f, 0.f};
#define GD_DMA(nn, buf) do { _Pragma("unroll") for (int i_ = 0; i_ < 7; ++i_) __builtin_amdgcn_global_load_lds((const unsigned*)(ops + (size_t)(nn) * GD_OPS_BYTES + (i_ * 8 + wave) * 1024 + lane * 16), \
        (LAS unsigned*)(lds + (buf) * GD_OPS_BYTES + (i_ * 8 + wave) * 1024), 16, 0, 0); } while (0)
#define GD_ULOAD(nn) do { if (comp) { _Pragma("unroll") for (int mt_ = 0; mt_ < 4; ++mt_) Un[mt_] = *(const f32x4*)(Up + (size_t)(nn) * 8192 + mt_ * 256); gln = GLp[nn]; } } while (0)
    GD_DMA(0, 0); GD_ULOAD(0);
    for (int n = 0; n < GD_NCH; ++n) {
        asm volatile("s_waitcnt vmcnt(0)" ::: "memory");
        __syncthreads();
        f32x4 Uc[4]; const float gl = gln;
#pragma unroll
        for (int mt = 0; mt < 4; ++mt) Uc[mt] = Un[mt];
        if (n + 1 < GD_NCH) { GD_DMA(n + 1, (n + 1) & 1); GD_ULOAD(n + 1); }
        if (comp) {
        const LAS unsigned char* fr = lds + (n & 1) * GD_OPS_BYTES + lane * 16;
#define GD_FRAG(f) (*(const LAS bf16x8*)(fr + (f) * 1024))
        bf16x8 Sb[4];
#pragma unroll
        for (int ks = 0; ks < 4; ++ks) { v4u w; w.x = cvtpk_bf16(S[2 * ks][0], S[2 * ks][1]); w.y = cvtpk_bf16(S[2 * ks][2], S[2 * ks][3]); w.z = cvtpk_bf16(S[2 * ks + 1][0], S[2 * ks + 1][1]); w.w = cvtpk_bf16(S[2 * ks + 1][2], S[2 * ks + 1][3]);
            Sb[ks] = __builtin_bit_cast(bf16x8, w); }
        f32x4 vn[4];
#pragma unroll
        for (int mt = 0; mt < 4; ++mt) { vn[mt] = Uc[mt];
#pragma unroll
            for (int ks = 0; ks < 4; ++ks) vn[mt] = __builtin_amdgcn_mfma_f32_16x16x32_bf16(GD_FRAG(GD_F_WN + mt * 4 + ks), Sb[ks], vn[mt], 0, 0, 0); }
        bf16x8 Vb[2];
#pragma unroll
        for (int ks = 0; ks < 2; ++ks) { v4u w; w.x = cvtpk_bf16(vn[2 * ks][0], vn[2 * ks][1]); w.y = cvtpk_bf16(vn[2 * ks][2], vn[2 * ks][3]); w.z = cvtpk_bf16(vn[2 * ks + 1][0], vn[2 * ks + 1][1]); w.w = cvtpk_bf16(vn[2 * ks + 1][2], vn[2 * ks + 1][3]);
            Vb[ks] = __builtin_bit_cast(bf16x8, w); }
        float* orow = GO + (size_t)(n * 64 + 4 * q4) * GDNW;
#pragma unroll
        for (int mt = 0; mt < 4; ++mt) { f32x4 o = (f32x4){0.f, 0.f, 0.f, 0.f};
#pragma unroll
            for (int ks = 0; ks < 4; ++ks) o = __builtin_amdgcn_mfma_f32_16x16x32_bf16(GD_FRAG(GD_F_QD + mt * 4 + ks), Sb[ks], o, 0, 0, 0);
#pragma unroll
            for (int ks = 0; ks < 2; ++ks) o = __builtin_amdgcn_mfma_f32_16x16x32_bf16(GD_FRAG(GD_F_AT + mt * 2 + ks), Vb[ks], o, 0, 0, 0);
#pragma unroll
            for (int r = 0; r < 4; ++r) orow[(size_t)(16 * mt + r) * GDNW] = o[r]; }
#pragma unroll
        for (int mt = 0; mt < 8; ++mt) { S[mt] = S[mt] * gl;
#pragma unroll
            for (int ks = 0; ks < 2; ++ks) S[mt] = __builtin_amdgcn_mfma_f32_16x16x32_bf16(GD_FRAG(GD_F_KT + mt * 2 + ks), Vb[ks], S[mt], 0, 0, 0); }
        }
    }
#undef GD_FRAG
#undef GD_DMA
#undef GD_ULOAD
    asm volatile("s_waitcnt vmcnt(0)" ::: "memory");
    __syncthreads();
}
__device__ __forceinline__ void p4_finalize(ArgsP ap0, int l) {
    const Ptrs P = fresh_ptrs(ap0); const ArgsP A = P.ap;
    const float* GO = (const float*)(A->ws + WS_GO2); const bf16* HMZ = (const bf16*)(A->ws + WS_PROJ) + hm_off(HM_GZ, 0);
    bf16* MIX = (bf16*)(A->ws + WS_MIX); const int lane = P.lane;
    typedef float f32x2 __attribute__((ext_vector_type(2)));
    const f32x2 gg = *(const f32x2*)(A->in[I_GDNON] + l * HD + 2 * lane);
    for (int m = P.gw; m < M; m += P.NGW) {
        const int b = m / SEQ, s = m % SEQ;
        f32x2 v[GDNH]; unsigned zw[GDNH];
#pragma unroll
        for (int h = 0; h < GDNH; ++h) { v[h] = *(const f32x2*)(GO + (size_t)m * GDNW + h * HD + 2 * lane); zw[h] = *(const unsigned*)(HMZ + ((size_t)(b * GDNH + h) * SEQ + s) * HD + 2 * lane); }
        float ss[GDNH];
#pragma unroll
        for (int h = 0; h < GDNH; ++h) ss[h] = v[h][0] * v[h][0] + v[h][1] * v[h][1];
#pragma unroll
        for (int o = 1; o < 64; o <<= 1) {
#pragma unroll
            for (int h = 0; h < GDNH; ++h) ss[h] += __shfl_xor(ss[h], o); }
#pragma unroll
        for (int h = 0; h < GDNH; ++h) { const float rr = 1.0f / sqrtf(ss[h] * (1.0f / HD) + RMS_EPS);
            *(unsigned*)(MIX + (size_t)m * DM + FOXW + SCW + h * HD + 2 * lane) = pk2(v[h][0] * rr * gg[0] * silu_acc(bflo(zw[h])), v[h][1] * rr * gg[1] * silu_acc(bfhi(zw[h]))); }
    }
}

constexpr int ATT_PER_X = 3 * (SEQ / attn::QB);
constexpr int ATT_SLOT_OFF = 69632;
static_assert(attn::LDS_BYTES <= ATT_SLOT_OFF, "attention LDS map");
typedef attn::BlockRef<attn::bf16, attn::bf16> FoxRef;
__device__ __forceinline__ int fox_jlo(ArgsP A, int l, int bh, int P0) {
    (void)l;
    const float* FG = (const float*)(A->ws + WS_FG) + (size_t)bh * SEQ; const float* TN = (const float*)(A->ws + WS_TN);
    constexpr int NT_ = BATCH * FOXH * (SEQ / 64);
    const int lane = my_lane(), jd = P0 / attn::KVBLK, tb = bh * (SEQ / 64);
    float qn2 = 0.f, lb = 3.0e38f;
#pragma unroll
    for (int i = 0; i < 4; ++i) { qn2 = fmaxf(qn2, TN[tb + jd + i]); lb = fminf(lb, TN[2 * NT_ + tb + jd + i] + FG[64 * (jd + i)]); }
    const float qnb = sqrtf(qn2) * 1.001f;
    const bool s0 = qnb * sqrtf(TN[NT_ + tb + lane]) + FG[64 * lane + 63] - lb < -600.0f, s1 = qnb * sqrtf(TN[NT_ + tb + lane + 64]) + FG[64 * (lane + 64) + 63] - lb < -600.0f;
    const unsigned long long n0 = ~__ballot(s0), n1 = ~__ballot(s1);
    const int n = n0 ? __builtin_ctzll(n0) : 64 + (n1 ? __builtin_ctzll(n1) : 64);
    return __builtin_amdgcn_readfirstlane(n < jd ? n : jd);
}
__device__ __forceinline__ void fox_head_table(ArgsP A, volatile LAS int* hmap, int lane) {
    const float* FG = (const float*)(A->ws + WS_FG);
    const float v = lane < BATCH * FOXH ? FG[(size_t)lane * SEQ + (SEQ - 1)] : 3.0e38f;
    int rank = 0;
    for (int j = 0; j < BATCH * FOXH; ++j) { const float vj = __shfl(v, j); rank += (vj < v || (vj == v && j < lane)) ? 1 : 0; }
    if (lane < BATCH * FOXH) { const int slot = rank >> 3, qx = slot == 1 ? 15 - rank : (rank & 7); hmap[qx * 3 + slot] = lane; }
}
__device__ __forceinline__ FoxRef fox_ref(ArgsP A, int id, int l, volatile LAS int* hmap) {
    const int qx = id / ATT_PER_X, i = id % ATT_PER_X, bh = __builtin_amdgcn_readfirstlane(hmap[qx * 3 + (i >> 5)]), qb = 31 - (i & 31);
    const int b = bh / FOXH, h = bh % FOXH; const size_t row0 = (size_t)b * SEQ;
    const attn::bf16* HM = (const attn::bf16*)(A->ws + WS_PROJ);
    FoxRef r;
    r.Q = HM + hm_off(HM_FQ, bh) + (size_t)qb * attn::QB * HD;
    r.K = HM + hm_off(HM_FK, bh); r.V = HM + hm_off(HM_FV, bh);
    r.F = (const float*)(A->ws + WS_FG) + (size_t)bh * SEQ;
    r.O = (attn::bf16*)(A->ws + WS_MIX) + (row0 + (size_t)qb * attn::QB) * DM + h * HD; r.P0 = qb * attn::QB; r.JLO = fox_jlo(A, l, bh, r.P0);
    return r;
}
__device__ __forceinline__ int att_claim(gu32* ctrs, volatile LAS int* st) {
    int qx = st[0], tried = st[1], r = -1;
    while (tried < 8) { const unsigned i = __hip_atomic_fetch_add(ctrs + qx * 64, 1u, __ATOMIC_RELAXED, __HIP_MEMORY_SCOPE_AGENT); if (i < (unsigned)ATT_PER_X) { r = qx * ATT_PER_X + (int)i; break; } qx = (qx + 1) & 7; ++tried; }
    st[0] = qx; st[1] = tried;
    return r;
}
__device__ __forceinline__ void p3_attention(ArgsP ap0, char* lds, int l, int rep = 0) {
    const ArgsP A = fresh(ap0);
    gu32* ctrs = (gu32*)(A->ws + WS_CTL) + CW_Q + (rep * 2 + l) * 8 * 64;
    volatile LAS int* slot = (volatile LAS int*)((LAS unsigned char*)lds + ATT_SLOT_OFF);
    volatile LAS int* hmap = slot + 8;
    { const int t_ = ftid(); if (t_ < 64) fox_head_table(A, hmap, t_); if (t_ == 0) { slot[4] = (int)(xb_xcc_id() & 7u); slot[5] = 0; slot[0] = att_claim(ctrs, slot + 4); slot[1] = att_claim(ctrs, slot + 4); } }
    __syncthreads();
    int cur = __builtin_amdgcn_readfirstlane(slot[0]), nxt = __builtin_amdgcn_readfirstlane(slot[1]);
    if (cur < 0) return;
    FoxRef curR = fox_ref(A, cur, l, hmap);
    attn::Seam<attn::bf16> S;
    attn::causal_swa_prime<attn::bf16, attn::bf16>(curR, SEQ, lds, S);
    for (int k = 0;; ++k) {
        if (nxt >= 0 && ftid() == 0) slot[2 + (k & 1)] = att_claim(ctrs, slot + 4);
        const bool last = nxt < 0;
        const FoxRef nxtR = last ? curR : fox_ref(A, nxt, l, hmap);
        attn::causal_swa_block<attn::bf16, attn::bf16>(curR, nxtR, SEQ, SEQ, lds, S, &A->in[I_FOXON], l * HD);
        if (last) break;
        cur = nxt; curR = nxtR; nxt = __builtin_amdgcn_readfirstlane(slot[2 + (k & 1)]);
    }
}

constexpr int N_PHASES = 1 + 9 * DEPTH;

#ifndef PH_EN
#define PH_EN 0x3ff
#endif
#define IN(k) (lo <= (k) && (k) < hi)
#define EN(j) ((PH_EN >> (j)) & 1)
#ifndef REP_MASK
#define REP_MASK 0
#endif
#ifndef EXTRA_BARS
#define EXTRA_BARS 0
#endif
#define REPS(j) (((REP_MASK >> (j)) & 1) ? 2 : 1)
#define SEAM(k) do { if (IN(k) && IN((k) + 1)) { XcdBarrier b_; b_.bar = (unsigned*)(fresh(ap0)->ws + WS_CTL) + CW_BAR; b_.x = xb_xcc_id(); b_.st = (volatile LAS unsigned*)((LAS unsigned char*)lds + MISC_OFF) + 8; xcd_barrier(b_); } } while (0)
#define WSP(T, off) ((T*)(A->ws + (off)))
#ifndef GU_ISTAT
#define GU_ISTAT 19
#endif


template <int l>
__device__ __forceinline__ void layer_phases(ArgsP ap0, LAS unsigned char* ldsl, unsigned char* lds, int lo, int hi) {

        const int pb = 1 + 9 * l;
        if (EN(1) && IN(pb + 0)) {
            const Ptrs P = fresh_ptrs(ap0); const ArgsP A = P.ap;
            pg8::Gemm g{WSP(bf16, WS_XN), WSP(bf16, WS_W + WO_IN), M, NP, DM}; pg8::StaticOrder S; S.init(M, NP, P.G, P.bid);
            pg8::EpiProj E{WSP(bf16, WS_PROJ), WSP(bf16, WS_SCB), WSP(float, WS_SB)};
            for (int rep_ = 0; rep_ < REPS(1); ++rep_) pg8::gemm_phase<pg8::EpiProj, pg8::StaticOrder, true, true>(ldsl, g, S, E);
            convert_weights(ap0, ldsl, l, I_3, I_3 + CV_TAIL_DN, (M / 256) * (NP / 256) % P.G);
            SEAM(pb + 0);
        }
        if (EN(2) && IN(pb + 1)) {
            for (int rep_ = 0; rep_ < REPS(11); ++rep_) p2_prep(ap0, ldsl, l);
            for (int rep_ = 0; rep_ < REPS(2); ++rep_) gdn_prep(ap0, ldsl, l);
            SEAM(pb + 1);
            for (int xb_ = 0; xb_ < EXTRA_BARS; ++xb_) SEAM(pb + 1);
            }
        if (EN(3) && IN(pb + 2)) {
            for (int rep_ = 0; rep_ < REPS(10); ++rep_) if ((int)blockIdx.x < 2 * BATCH * GDNH) gdn_scan(ap0, ldsl);
            for (int rep_ = 0; rep_ < REPS(3); ++rep_) p3_attention(ap0, (char*)lds, l, rep_);
            SEAM(pb + 2);
        }
        if (EN(4) && IN(pb + 3)) { for (int rep_ = 0; rep_ < REPS(4); ++rep_) p4_finalize(ap0, l); SEAM(pb + 3); }
        if (EN(5) && IN(pb + 4)) {
            const Ptrs P = fresh_ptrs(ap0); const ArgsP A = P.ap;
            pg8::Gemm g{WSP(bf16, WS_MIX), WSP(bf16, WS_W + WO_OUT), M, DM, DM}; pg8::StaticOrder S; S.init(M, DM, P.G, P.bid);
            pg8::EpiY E{WSP(bf16, WS_Y), WSP(float, WS_SS)};
            for (int rep_ = 0; rep_ < REPS(5); ++rep_) pg8::gemm_phase<pg8::EpiY, pg8::StaticOrder, true, true>(ldsl, g, S, E);
            SEAM(pb + 4);
        }
        if (EN(6) && IN(pb + 5)) {
            const Ptrs P = fresh_ptrs(ap0); const ArgsP A = P.ap;
            const float* xin = l == 0 ? A->in[I_X] : (const float*)A->out;
            const float* gpost = A->in[I_MIXPOST] + l * DM; const float* gpre = A->in[I_FFNPRE] + l * DM;
            const bf16* Y = WSP(bf16, WS_Y); const float* SS = WSP(float, WS_SS); float* H = WSP(float, WS_H); bf16* XN = WSP(bf16, WS_XN);
            for (int rep_ = 0; rep_ < REPS(6); ++rep_)
            for (int m = P.gw; m < M; m += P.NGW)
                resid_norm_row(xin + (size_t)m * DM, Y + (size_t)m * DM, SS + (size_t)m * 64, gpost, H + (size_t)m * DM, gpre, XN + (size_t)m * DM, P.lane);
            SEAM(pb + 5);
        }
        if (EN(7) && IN(pb + 6)) {
            const Ptrs P = fresh_ptrs(ap0); const ArgsP A = P.ap;
            pg8::Gemm g{WSP(bf16, WS_XN), WSP(bf16, WS_W + WO_GU), M, NGU, DM}; pg8::StaticOrder S; S.init(M, NGU, P.G, P.bid);
            pg8::EpiSwiGLU E{WSP(bf16, WS_PROJ)};
            if (l + 1 == DEPTH && P.G == 256) {
                pg8::TailDynOrder T; T.S = S; T.istat = GU_ISTAT; T.ctr = (gu32*)(A->ws + WS_CTL) + CW_DYN; T.slot = (volatile LAS int*)(ldsl + MISC_OFF) + 24;
                pg8::gemm_phase<pg8::EpiSwiGLU, pg8::TailDynOrder, true, true>(ldsl, g, T, E); }
            else
            for (int rep_ = 0; rep_ < REPS(7); ++rep_) pg8::gemm_phase<pg8::EpiSwiGLU, pg8::StaticOrder, true, true>(ldsl, g, S, E);
            if (l + 1 < DEPTH) convert_weights(ap0, ldsl, l + 1, 0, CV_TAIL_IN, (M / 256) * (NGU / 256) % P.G);
            SEAM(pb + 6);
        }
        if (EN(8) && IN(pb + 7)) {
            const Ptrs P = fresh_ptrs(ap0); const ArgsP A = P.ap;
            pg8::Gemm g{WSP(bf16, WS_PROJ), WSP(bf16, WS_W + WO_DN), M, DM, FFN};
            pg8::EpiY E{WSP(bf16, WS_Y), WSP(float, WS_SS)};
            if (P.G == 256) { pg8::PanelOrder S{P.bid, M / (16 * 256)};
                for (int rep_ = 0; rep_ < REPS(8); ++rep_) pg8::gemm_phase<pg8::EpiY, pg8::PanelOrder, true, true>(ldsl, g, S, E); }
            else { pg8::StaticOrder S; S.init(M, DM, P.G, P.bid);
                for (int rep_ = 0; rep_ < REPS(8); ++rep_) pg8::gemm_phase<pg8::EpiY, pg8::StaticOrder, true, true>(ldsl, g, S, E); }
            SEAM(pb + 7);
        }
        if (EN(9) && IN(pb + 8)) {
            const Ptrs P = fresh_ptrs(ap0); const ArgsP A = P.ap;
            const float* gnext = l + 1 < DEPTH ? A->in[I_MIXPRE] + (l + 1) * DM : nullptr; const float* gpost = A->in[I_FFNPOST] + l * DM;
            const bf16* Y = WSP(bf16, WS_Y); const float* SS = WSP(float, WS_SS); const float* H = WSP(float, WS_H); bf16* XN = WSP(bf16, WS_XN); float* outp = A->out;
            for (int rep_ = 0; rep_ < REPS(9); ++rep_) {
            for (int m = P.gw; m < M; m += P.NGW)
                resid_norm_row(H + (size_t)m * DM, Y + (size_t)m * DM, SS + (size_t)m * 64, gpost, outp + (size_t)m * DM, gnext, XN + (size_t)m * DM, P.lane);
            if (l + 1 < DEPTH) { convert_weights(ap0, ldsl, l + 1, CV_TAIL_IN, I_3); convert_weights(ap0, ldsl, l + 1, I_3 + CV_TAIL_DN, I_LAYER); }
            }
            SEAM(pb + 8);
        }
    }

__global__ void __launch_bounds__(NWAVES * 64, 2) hybrid_fwd(Args args) {
    extern __shared__ __attribute__((aligned(16))) unsigned char lds[];
    LAS unsigned char* ldsl = (LAS unsigned char*)lds;
    volatile LAS unsigned* MISC = (volatile LAS unsigned*)(ldsl + MISC_OFF);
    const ArgsP ap0 = (ArgsP)__builtin_amdgcn_kernarg_segment_ptr();
    for (int u = threadIdx.x; u < (LDS_BYTES - LDSCTL_OFF) / 4; u += NWAVES * 64) ((LAS unsigned*)(ldsl + LDSCTL_OFF))[u] = 0u;
    __syncthreads();
    if ((threadIdx.x & 63) == 0) *(volatile LAS int*)(ldsl + TIDTAB_OFF + 4 * hw_slot()) = (int)(threadIdx.x >> 6);
    __syncthreads();
    const int lo = args.ph_lo, hi = args.ph_hi;
    if (hi - lo > 1) (void)xcd_barrier_post((unsigned*)(args.ws + WS_CTL) + CW_BAR, MISC + 8);
    if (EN(0) && IN(0)) { for (int rep_ = 0; rep_ < REPS(0); ++rep_) p0_prologue(ap0, ldsl); SEAM(0); }
    layer_phases<0>(ap0, ldsl, lds, lo, hi);
    layer_phases<1>(ap0, ldsl, lds, lo, hi);
}

#undef IN
#undef SEAM
extern "C" void kernel_launch(void* const* d_in, const int* in_sizes, int n_in, void* d_out, int out_size, void* d_ws, size_t ws_size, hipStream_t stream) {
    static int grid = 0;
    if (grid == 0) {
        if (n_in != 17 || in_sizes[0] != M * DM || out_size != M * DM || ws_size < WS_END) {
            fprintf(stderr, "kernel_launch: shape/workspace mismatch: n_in %d in0 %d out %d ws %zu (need %zu)\n", n_in, n_in > 0 ? in_sizes[0] : -1, out_size, ws_size, (size_t)WS_END); grid = -1; return; }
        int dev = 0, cus = 0, per_cu = 0;
        if (hipGetDevice(&dev) != hipSuccess || hipDeviceGetAttribute(&cus, hipDeviceAttributeMultiprocessorCount, dev) != hipSuccess) { fprintf(stderr, "kernel_launch: device query failed\n"); grid = -1; return; }
        if (hipFuncSetAttribute((const void*)hybrid_fwd, hipFuncAttributeMaxDynamicSharedMemorySize, LDS_BYTES) != hipSuccess) { fprintf(stderr, "kernel_launch: hipFuncSetAttribute failed\n"); grid = -1; return; }
        if (hipOccupancyMaxActiveBlocksPerMultiprocessor(&per_cu, (const void*)hybrid_fwd, NWAVES * 64, LDS_BYTES) != hipSuccess || per_cu < 1)
            fprintf(stderr, "kernel_launch: note: occupancy query reports %d workgroups per CU\n", per_cu);
        (void)hipGetLastError();
        grid = cus;
    }
    if (grid < 0) return;
    if (hipMemsetAsync((char*)d_ws + WS_CTL, 0, CTL_ZERO_BYTES, stream) != hipSuccess) { fprintf(stderr, "kernel_launch: memset failed\n"); return; }
    Args a{};
    for (int i = 0; i < 17; ++i) a.in[i] = (const float*)d_in[i];
    a.out = (float*)d_out; a.ws = (unsigned char*)d_ws;
#if MK_N_LAUNCHES == 1
    a.ph_lo = 0; a.ph_hi = N_PHASES;
    hipLaunchKernelGGL(hybrid_fwd, dim3(grid), dim3(NWAVES * 64), LDS_BYTES, stream, a);
#else
    for (int p = 0; p < N_PHASES; ++p) { a.ph_lo = p; a.ph_hi = p + 1; hipLaunchKernelGGL(hybrid_fwd, dim3(grid), dim3(NWAVES * 64), LDS_BYTES, stream, a); }
#endif
    const hipError_t le = hipPeekAtLastError();
    if (le != hipSuccess) fprintf(stderr, "kernel_launch: launch failed: %s\n", hipGetErrorName(le));
}
```
